# Optimizing an MI355X kernel written in HIP

```python
import math
import jax, jax.numpy as jnp
from jax import lax
import numpy as np

D_MODEL = 1024
BATCH = 8
SEQ = 2048
DEPTH = 2

D_MIX = D_MODEL
DIFF_HEADS = 4
DIFF_WIDTH = D_MIX // 2
DIFF_V_DIM = DIFF_WIDTH // DIFF_HEADS
DIFF_QK_DIM = DIFF_V_DIM // 2
MLA_HEADS = 4
MLA_WIDTH = D_MIX // 4
MLA_V_DIM = MLA_WIDTH // MLA_HEADS
MLA_NOPE_DIM = 64
MLA_ROPE_DIM = 32
MLA_Q_RANK = 192
MLA_KV_RANK = 128
ROPE_BASE = 10000.0
POOL_WIDTH = D_MIX - DIFF_WIDTH - MLA_WIDTH
POOL_GROUPS = 4
POOL_GROUP_DIM = POOL_WIDTH // POOL_GROUPS
POOL_WINDOWS = (2, 4, 8, 16)
IN_WIDTHS = (DIFF_HEADS * 2 * DIFF_QK_DIM, DIFF_HEADS * 2 * DIFF_QK_DIM, DIFF_WIDTH,
             MLA_Q_RANK, MLA_KV_RANK, MLA_ROPE_DIM, POOL_WIDTH)
D_IN = sum(IN_WIDTHS)
IN_SPLITS = tuple(sum(IN_WIDTHS[:i + 1]) for i in range(len(IN_WIDTHS) - 1))
N_GROUPS = 4
EXPERTS_PER_GROUP = 8
N_EXPERTS = N_GROUPS * EXPERTS_PER_GROUP
TOP_K = 2
D_FF_EXPERT = 256
ROUTE_BLOCK = 256
Q_BLOCK = 128
RMS_EPS = 1e-6

kernel_name = 'hybrid_diffattn_mla_pool_hmoe_encoder'


def _rms_norm(x, g):
    xf = x.astype(jnp.float32)
    y = xf * lax.rsqrt(jnp.mean(xf * xf, axis=-1, keepdims=True) + RMS_EPS)
    return (y * g.astype(jnp.float32)).astype(x.dtype)


def _to_blocks(x):
    b, s = x.shape[0], x.shape[1]
    return jnp.moveaxis(x.reshape((b, s // Q_BLOCK, Q_BLOCK) + x.shape[2:]), 1, 0)


def _from_blocks(y):
    nb, b, qb = y.shape[0], y.shape[1], y.shape[2]
    return jnp.moveaxis(y, 0, 1).reshape((b, nb * qb) + y.shape[3:])


def _alibi_slopes(n_heads):
    return 2.0 ** (-8.0 * jnp.arange(1, n_heads + 1, dtype=jnp.float32) / n_heads)


def _diff_attention(q1, q2, k1, k2, v, lam):
    s = q1.shape[1]
    scale = q1.shape[-1] ** -0.5
    slopes = _alibi_slopes(q1.shape[2])
    k_pos = jnp.arange(s, dtype=jnp.int32)
    q_pos = k_pos.reshape(s // Q_BLOCK, Q_BLOCK)

    def block(args):
        q1b, q2b, qp = args
        dist = jnp.abs(qp[:, None] - k_pos[None, :]).astype(jnp.float32)
        bias = -slopes[:, None, None] * dist[None]
        s1 = jnp.einsum('bqhd,bkhd->bhqk', q1b, k1, preferred_element_type=jnp.float32) * scale + bias
        s2 = jnp.einsum('bqhd,bkhd->bhqk', q2b, k2, preferred_element_type=jnp.float32) * scale + bias
        a = jax.nn.softmax(s1, axis=-1) - lam * jax.nn.softmax(s2, axis=-1)
        return jnp.einsum('bhqk,bkhe->bqhe', a.astype(v.dtype), v)

    return _from_blocks(lax.map(block, (_to_blocks(q1), _to_blocks(q2), q_pos)))


def _rope_tables(s):
    inv = 1.0 / (ROPE_BASE ** (jnp.arange(0, MLA_ROPE_DIM, 2, dtype=jnp.float32) / MLA_ROPE_DIM))
    ang = jnp.arange(s, dtype=jnp.float32)[:, None] * inv[None, :]
    return jnp.cos(ang), jnp.sin(ang)


def _rotate(x, cos, sin):
    half = x.shape[-1] // 2
    x1 = x[..., :half].astype(jnp.float32)
    x2 = x[..., half:].astype(jnp.float32)
    return jnp.concatenate([x1 * cos - x2 * sin, x2 * cos + x1 * sin], axis=-1).astype(x.dtype)


def _mla_attention(q_nope, q_rope, k_nope, k_rope, v):
    scale = (q_nope.shape[-1] + q_rope.shape[-1]) ** -0.5

    def block(args):
        qn, qr = args
        sc = (jnp.einsum('bqhd,bkhd->bhqk', qn, k_nope, preferred_element_type=jnp.float32)
              + jnp.einsum('bqhr,bkr->bhqk', qr, k_rope, preferred_element_type=jnp.float32)) * scale
        p = jax.nn.softmax(sc, axis=-1)
        return jnp.einsum('bhqk,bkhe->bqhe', p.astype(v.dtype), v)

    return _from_blocks(lax.map(block, (_to_blocks(q_nope), _to_blocks(q_rope))))


def _multi_scale_pool(u, w, scale):
    b, s, c = u.shape
    uf = u.astype(jnp.float32).reshape(b, s, POOL_GROUPS, POOL_GROUP_DIM)
    cs = jnp.concatenate([jnp.zeros((b, 1, POOL_GROUPS, POOL_GROUP_DIM), jnp.float32),
                          jnp.cumsum(uf, axis=1)], axis=1)
    t = jnp.arange(s, dtype=jnp.int32)
    outs = []
    for g, win in enumerate(POOL_WINDOWS):
        lo = jnp.clip(t - win // 2, 0, s - 1)
        hi = jnp.clip(t + win // 2 - 1, 0, s - 1)
        csg = cs[:, :, g]
        win_sum = jnp.take(csg, hi + 1, axis=1) - jnp.take(csg, lo, axis=1)
        cnt = (hi - lo + 1).astype(jnp.float32)
        outs.append(win_sum / cnt[None, :, None] - uf[:, :, g])
    pooled = jnp.stack(outs, axis=2).astype(u.dtype)
    mixed = jnp.einsum('bsgc,gcd->bsgd', pooled, w)
    return mixed.reshape(b, s, c) * scale


def _hier_moe(h, wg, bg, we, be, w_gate, w_up, w_down):
    b, s, d = h.shape
    t = b * s
    hf = h.reshape(t, d)
    g_prob = jax.nn.softmax((hf @ wg).astype(jnp.float32) + bg.astype(jnp.float32), axis=-1)
    g_top, g_idx = lax.top_k(g_prob, 1)
    e_logits = ((hf @ we).astype(jnp.float32) + be.astype(jnp.float32)).reshape(t, N_GROUPS, EXPERTS_PER_GROUP)
    e_sel = e_logits[jnp.arange(t), g_idx[:, 0]]
    e_top, e_idx = lax.top_k(jax.nn.softmax(e_sel, axis=-1), TOP_K)
    gate = g_top * e_top / jnp.sum(e_top, axis=-1, keepdims=True)
    expert_id = (g_idx * EXPERTS_PER_GROUP + e_idx).reshape(-1).astype(jnp.int32)
    token_id = jnp.repeat(jnp.arange(t, dtype=jnp.int32), TOP_K)
    weight = gate.reshape(-1)
    n_assign = t * TOP_K
    n_blocks = n_assign // ROUTE_BLOCK + N_EXPERTS
    cap = n_blocks * ROUTE_BLOCK
    order = jnp.argsort(expert_id)
    sorted_eid = expert_id[order]
    counts = jnp.bincount(expert_id, length=N_EXPERTS)
    starts = jnp.cumsum(counts) - counts
    padded = (counts + ROUTE_BLOCK - 1) // ROUTE_BLOCK * ROUTE_BLOCK
    padded_ends = jnp.cumsum(padded)
    padded_starts = padded_ends - padded
    dest = padded_starts[sorted_eid] + jnp.arange(n_assign, dtype=jnp.int32) - starts[sorted_eid]
    slot_tok = jnp.full((cap,), t, jnp.int32).at[dest].set(token_id[order])
    slot_w = jnp.zeros((cap,), jnp.float32).at[dest].set(weight[order])
    block_start = jnp.arange(n_blocks, dtype=jnp.int32) * ROUTE_BLOCK
    block_eid = jnp.minimum(jnp.sum(block_start[:, None] >= padded_ends[None, :], axis=1), N_EXPERTS - 1)
    xs = jnp.concatenate([hf, jnp.zeros((1, d), hf.dtype)], axis=0)[slot_tok].reshape(n_blocks, ROUTE_BLOCK, d)

    def expert_block(args):
        xb, e = args
        return (jax.nn.silu(xb @ w_gate[e]) * (xb @ w_up[e])) @ w_down[e]

    ys = lax.map(expert_block, (xs, block_eid)).reshape(cap, d)
    y = jnp.zeros((t + 1, d), jnp.float32).at[slot_tok].add(ys.astype(jnp.float32) * slot_w[:, None])
    return y[:t].astype(h.dtype).reshape(b, s, d)


def setup_inputs(seed: int = 0) -> dict:
    key = jax.random.key(seed)
    ks = jax.random.split(key, 26)
    f32 = jnp.float32
    L = DEPTH

    def nrm(k, shape, fan_in):
        return jax.random.normal(k, shape, f32) * (fan_in ** -0.5)

    def gain(k, shape):
        return 1.0 + 0.02 * jax.random.normal(k, shape, f32)

    return {
        'x': jax.random.normal(ks[0], (BATCH, SEQ, D_MODEL), f32),
        'norm1_g': gain(ks[1], (L, D_MODEL)),
        'w_in': nrm(ks[2], (L, D_MODEL, D_IN), D_MODEL),
        'diff_q_norm_g': gain(ks[3], (L, DIFF_QK_DIM)),
        'diff_k_norm_g': gain(ks[4], (L, DIFF_QK_DIM)),
        'diff_lambda': 0.1 * jax.random.normal(ks[5], (L, 4, DIFF_QK_DIM), f32),
        'diff_sub_norm_g': gain(ks[6], (L, DIFF_V_DIM)),
        'mla_q_lat_norm_g': gain(ks[7], (L, MLA_Q_RANK)),
        'mla_kv_lat_norm_g': gain(ks[8], (L, MLA_KV_RANK)),
        'mla_w_uq': nrm(ks[9], (L, MLA_Q_RANK, MLA_HEADS * (MLA_NOPE_DIM + MLA_ROPE_DIM)), MLA_Q_RANK),
        'mla_w_ukv': nrm(ks[10], (L, MLA_KV_RANK, MLA_HEADS * (MLA_NOPE_DIM + MLA_V_DIM)), MLA_KV_RANK),
        'mla_q_nope_norm_g': gain(ks[11], (L, MLA_NOPE_DIM)),
        'mla_q_rope_norm_g': gain(ks[12], (L, MLA_ROPE_DIM)),
        'mla_k_nope_norm_g': gain(ks[13], (L, MLA_NOPE_DIM)),
        'mla_k_rope_norm_g': gain(ks[14], (L, MLA_ROPE_DIM)),
        'pool_w': nrm(ks[15], (L, POOL_GROUPS, POOL_GROUP_DIM, POOL_GROUP_DIM), POOL_GROUP_DIM),
        'pool_scale': gain(ks[16], (L, POOL_WIDTH)),
        'w_out': nrm(ks[17], (L, D_MIX, D_MODEL), D_MIX),
        'norm2_g': gain(ks[18], (L, D_MODEL)),
        'router_group_w': nrm(ks[19], (L, D_MODEL, N_GROUPS), D_MODEL),
        'router_group_b': 0.01 * jax.random.normal(ks[20], (L, N_GROUPS), f32),
        'router_expert_w': nrm(ks[21], (L, D_MODEL, N_EXPERTS), D_MODEL),
        'router_expert_b': 0.01 * jax.random.normal(ks[22], (L, N_EXPERTS), f32),
        'expert_w_gate': nrm(ks[23], (L, N_EXPERTS, D_MODEL, D_FF_EXPERT), D_MODEL),
        'expert_w_up': nrm(ks[24], (L, N_EXPERTS, D_MODEL, D_FF_EXPERT), D_MODEL),
        'expert_w_down': nrm(ks[25], (L, N_EXPERTS, D_FF_EXPERT, D_MODEL), D_FF_EXPERT),
    }


def reference(x, norm1_g, w_in, diff_q_norm_g, diff_k_norm_g, diff_lambda, diff_sub_norm_g,
              mla_q_lat_norm_g, mla_kv_lat_norm_g, mla_w_uq, mla_w_ukv,
              mla_q_nope_norm_g, mla_q_rope_norm_g, mla_k_nope_norm_g, mla_k_rope_norm_g,
              pool_w, pool_scale, w_out, norm2_g,
              router_group_w, router_group_b, router_expert_w, router_expert_b,
              expert_w_gate, expert_w_up, expert_w_down):
    b, s, _ = x.shape
    cos, sin = _rope_tables(s)
    for l in range(DEPTH):
        lam_init = 0.8 - 0.6 * math.exp(-0.3 * l)
        h = _rms_norm(x, norm1_g[l])
        proj = h @ w_in[l]
        dq, dk, dv, cq, ckv, kr, pu = jnp.split(proj, IN_SPLITS, axis=-1)

        dq = _rms_norm(dq.reshape(b, s, DIFF_HEADS, 2, DIFF_QK_DIM), diff_q_norm_g[l])
        dk = _rms_norm(dk.reshape(b, s, DIFF_HEADS, 2, DIFF_QK_DIM), diff_k_norm_g[l])
        dv = dv.reshape(b, s, DIFF_HEADS, DIFF_V_DIM)
        lv = diff_lambda[l].astype(jnp.float32)
        lam = jnp.exp(jnp.sum(lv[0] * lv[1])) - jnp.exp(jnp.sum(lv[2] * lv[3])) + lam_init
        o_diff = _diff_attention(dq[..., 0, :], dq[..., 1, :], dk[..., 0, :], dk[..., 1, :], dv, lam)
        o_diff = (_rms_norm(o_diff, diff_sub_norm_g[l]) * (1.0 - lam_init)).reshape(b, s, DIFF_WIDTH)

        q = (_rms_norm(cq, mla_q_lat_norm_g[l]) @ mla_w_uq[l]).reshape(b, s, MLA_HEADS, MLA_NOPE_DIM + MLA_ROPE_DIM)
        kv = (_rms_norm(ckv, mla_kv_lat_norm_g[l]) @ mla_w_ukv[l]).reshape(b, s, MLA_HEADS, MLA_NOPE_DIM + MLA_V_DIM)
        q_nope = _rms_norm(q[..., :MLA_NOPE_DIM], mla_q_nope_norm_g[l])
        q_rope = _rotate(_rms_norm(q[..., MLA_NOPE_DIM:], mla_q_rope_norm_g[l]),
                         cos[None, :, None, :], sin[None, :, None, :])
        k_nope = _rms_norm(kv[..., :MLA_NOPE_DIM], mla_k_nope_norm_g[l])
        k_rope = _rotate(_rms_norm(kr, mla_k_rope_norm_g[l]), cos[None], sin[None])
        o_mla = _mla_attention(q_nope, q_rope, k_nope, k_rope, kv[..., MLA_NOPE_DIM:]).reshape(b, s, MLA_WIDTH)

        o_pool = _multi_scale_pool(pu, pool_w[l], pool_scale[l])

        x = x + jnp.concatenate([o_diff, o_mla, o_pool], axis=-1) @ w_out[l]

        x = x + _hier_moe(_rms_norm(x, norm2_g[l]), router_group_w[l], router_group_b[l],
                          router_expert_w[l], router_expert_b[l],
                          expert_w_gate[l], expert_w_up[l], expert_w_down[l])
    return x
```

```cpp
#include <hip/hip_runtime.h>
#include <stdint.h>
#include <stdio.h>

#ifndef NAIVE_GEMM
#define NAIVE_GEMM 0
#endif
#ifndef NAIVE_ATTN
#define NAIVE_ATTN 0
#endif
#ifndef N_LAUNCH_SPLIT
#define N_LAUNCH_SPLIT 1
#endif

#define LAS __attribute__((address_space(3)))
typedef unsigned char uchar;
typedef unsigned short bf16_t;
typedef short bf16x8 __attribute__((ext_vector_type(8)));
typedef float f32x16 __attribute__((ext_vector_type(16)));
typedef float f32x2_t __attribute__((ext_vector_type(2)));
typedef __bf16 bf16x2_t __attribute__((ext_vector_type(2)));
typedef unsigned u32x4 __attribute__((ext_vector_type(4)));
typedef unsigned u32x2 __attribute__((ext_vector_type(2)));
typedef float f32x4 __attribute__((ext_vector_type(4)));

constexpr int NB = 8, S = 2048, DM = 1024, T = NB * S, NL = 2;
constexpr int NIN = 2144, NINP = 2176;
constexpr float EPS = 1e-6f, LOG2E = 1.4426950408889634f;
constexpr float QSCALE_D = 0.125f * LOG2E;
constexpr float QSCALE_M = 0.10206207261596577f * LOG2E;
constexpr int NPH = 1 + 8 * NL;

constexpr size_t MiB = (size_t)1 << 20;
constexpr size_t WS_CTL = 0, CTL_ZERO_BYTES = 32768;
constexpr size_t WS_SCAL = 1 * MiB;
constexpr size_t WS_ROPE = 1 * MiB + 64 * 1024;
constexpr size_t WS_RSTD1 = 1 * MiB + 512 * 1024;
constexpr size_t WS_RSTD2 = WS_RSTD1 + 64 * 1024;
constexpr size_t WS_GW = WS_RSTD2 + 64 * 1024;
constexpr size_t WS_LIST = 2 * MiB;
constexpr size_t WS_WIN = 4 * MiB;
constexpr size_t WS_WOUT = 13 * MiB;
constexpr size_t WS_WUQ = 17 * MiB;
constexpr size_t WS_WUKV = 17 * MiB + 512 * 1024;
constexpr size_t WS_POOLW = 17 * MiB + 768 * 1024;
constexpr size_t WS_WGU = 20 * MiB;
constexpr size_t WS_WD = 52 * MiB;
constexpr size_t WS_XB = 68 * MiB;
constexpr size_t WS_MIX = 100 * MiB;
constexpr size_t WS_HMID = WS_MIX;
constexpr size_t WS_QD = 132 * MiB, WS_KD = 148 * MiB, WS_VDT = 164 * MiB;
constexpr size_t WS_LAT = 180 * MiB;
constexpr size_t WS_QM = 200 * MiB, WS_KM = 212 * MiB, WS_VMT = 224 * MiB;
constexpr size_t WS_POOLED = 232 * MiB;
constexpr size_t WS_YS = 132 * MiB;
constexpr size_t WS_END = 240 * MiB;

#define XB_TMO      128
#define XB_XCNT(j)  (256  + 64 * (j))
#define XB_XSUB(j)  (1280 + 64 * (j))
#define XB_XGEN(j)  (2304 + 64 * (j))
#define XB_TOP      3328
#define XB_TOPGEN   3392
#define XCD_BAR_WORDS 3456
#define XB_SPIN_CAP (1u << 18)
constexpr int CW_CNT = 4096;

constexpr int NT = 512;
constexpr int LDS_XB = 147456;
constexpr int LDS_BYTES = LDS_XB + 64;
constexpr int GSTG = 49152;
constexpr int ASTG = 32768;
constexpr int MSTG = 20480;

struct Params {
    const float* in[26];
    float* out;
    unsigned char* ws;
    int ph_lo, ph_hi;
};

__device__ __forceinline__ unsigned pk2(float lo, float hi) { f32x2_t v = {lo, hi}; bf16x2_t b = __builtin_convertvector(v, bf16x2_t); return __builtin_bit_cast(unsigned, b); }
__device__ __forceinline__ float bflo(unsigned w) { return __builtin_bit_cast(float, w << 16); }
__device__ __forceinline__ float bfhi(unsigned w) { return __builtin_bit_cast(float, w & 0xffff0000u); }
__device__ __forceinline__ float bf2f(bf16_t u) { return __builtin_bit_cast(float, (unsigned)u << 16); }
__device__ __forceinline__ bf16_t f2bf(float f) { return (bf16_t)(pk2(f, 0.f) & 0xffffu); }
__device__ __forceinline__ int tid_opaque() { int t = threadIdx.x; asm volatile("" : "+v"(t)); return t; }
__device__ __forceinline__ int crow(int r, int hi) { return (r & 3) + 8 * (r >> 2) + 4 * hi; }
__device__ __forceinline__ int sigma16(int s) { return (s & ~12) | ((s & 4) << 1) | ((s & 8) >> 1); }
__device__ __forceinline__ float wave_sum(float v) {
#pragma unroll
    for (int o = 32; o >= 1; o >>= 1) v += __shfl_xor(v, o);
    return v;
}
__device__ __forceinline__ void unpack8(u32x4 w, float (&f)[8]) {
    f[0] = bflo(w[0]); f[1] = bfhi(w[0]); f[2] = bflo(w[1]); f[3] = bfhi(w[1]);
    f[4] = bflo(w[2]); f[5] = bfhi(w[2]); f[6] = bflo(w[3]); f[7] = bfhi(w[3]);
}

__device__ __forceinline__ unsigned xb_ld(unsigned* p)              { return __hip_atomic_load(p, __ATOMIC_RELAXED, __HIP_MEMORY_SCOPE_AGENT); }
__device__ __forceinline__ unsigned xb_add(unsigned* p, unsigned v) { return __hip_atomic_fetch_add(p, v, __ATOMIC_RELAXED, __HIP_MEMORY_SCOPE_AGENT); }
__device__ __forceinline__ unsigned xb_xcc_id() { return (unsigned)__builtin_amdgcn_s_getreg((3 << 11) | 20) & 0xFu; }
#define XB_SPIN(cond, bar) do { unsigned _sp = 0; while (cond) { __builtin_amdgcn_s_sleep(1); \
    if ((++_sp & 255u) == 0u) { if (xb_ld(&(bar)[XB_TMO])) break; if (_sp > XB_SPIN_CAP) { atomicAdd(&(bar)[XB_TMO], 1u); break; } } } } while (0)
struct XcdBarrier { unsigned* bar; unsigned x; volatile LAS unsigned* st; };
__device__ __forceinline__ XcdBarrier xcd_barrier_post(unsigned* bar, volatile LAS unsigned* st) {
    XcdBarrier b; b.bar = bar; b.x = xb_xcc_id(); b.st = st;
    if (threadIdx.x == 0) (void)xb_add(&bar[XB_XCNT(b.x)], 1u);
    return b;
}
__device__ __forceinline__ void xcd_barrier_complete(unsigned* bar, unsigned x, unsigned& nloc, unsigned& nx) {
    const unsigned G = gridDim.x * gridDim.y * gridDim.z;
    unsigned sum, cnt, mine, sp = 0u;
    for (;;) {
        sum = 0u; cnt = 0u; mine = 0u;
#pragma unroll
        for (unsigned j = 0; j < 16; ++j) { const unsigned c = xb_ld(&bar[XB_XCNT(j)]); sum += c; cnt += (c > 0u) ? 1u : 0u; mine = (j == x) ? c : mine; }
        if (sum == G) break;
        __builtin_amdgcn_s_sleep(1);
        if ((++sp & 255u) == 0u) { if (xb_ld(&bar[XB_TMO])) break; if (sp > XB_SPIN_CAP) { atomicAdd(&bar[XB_TMO], 1u); break; } }
    }
    nloc = mine > 0u ? mine : 1u; nx = cnt > 0u ? cnt : 1u;
}
__device__ __forceinline__ void xcd_barrier(const XcdBarrier& b) {
    asm volatile("s_waitcnt vmcnt(0)" ::: "memory");
    __syncthreads();
    if (threadIdx.x == 0) {
        unsigned* bar = b.bar;
        __builtin_amdgcn_s_waitcnt(0);
        unsigned nloc = b.st[0], nx = b.st[1];
        if (nloc == 0u) { xcd_barrier_complete(bar, b.x, nloc, nx); b.st[0] = nloc; b.st[1] = nx; }
        const unsigned old = xb_add(&bar[XB_XSUB(b.x)], 1u);
        const unsigned gen = old / nloc;
        if (old + 1u == (gen + 1u) * nloc) {
            __builtin_amdgcn_fence(__ATOMIC_RELEASE, "agent");
            asm volatile("s_waitcnt vmcnt(0)" ::: "memory");
            const unsigned og = xb_add(&bar[XB_TOP], 1u);
            const unsigned tg = og / nx;
            if (og + 1u == (tg + 1u) * nx) xb_add(&bar[XB_TOPGEN], 1u);
            else XB_SPIN(xb_ld(&bar[XB_TOPGEN]) == tg, bar);
            __builtin_amdgcn_fence(__ATOMIC_ACQUIRE, "agent");
            xb_add(&bar[XB_XGEN(b.x)], 1u);
            asm volatile("s_waitcnt vmcnt(0)" ::: "memory");
        } else {
            XB_SPIN(xb_ld(&bar[XB_XGEN(b.x)]) == gen, bar);
            __builtin_amdgcn_fence(__ATOMIC_ACQUIRE, "agent");
            asm volatile("s_waitcnt vmcnt(0)" ::: "memory");
        }
    }
    __syncthreads();
}

__device__ __forceinline__ void glds16(const void* gsrc, LAS uchar* dst_wave_base) {
    __builtin_amdgcn_global_load_lds((const unsigned*)gsrc, (LAS unsigned*)dst_wave_base, 16, 0, 0);
}
__device__ __forceinline__ int sw128(int row, int c) { return row * 128 + ((c ^ ((row >> 1) & 7)) << 4); }
__device__ __forceinline__ int sw64(int row, int c) { return row * 64 + ((c ^ ((row >> 2) & 3)) << 4); }

#define MFMA32(a, b, c) __builtin_amdgcn_mfma_f32_32x32x16_bf16((a), (b), (c), 0, 0, 0)

constexpr int CT_PITCH = 272;
#define WAITV(n) asm volatile("s_waitcnt vmcnt(" #n ")" ::: "memory")
struct ARowLinear { const bf16_t* base; size_t ld; __device__ __forceinline__ const bf16_t* operator()(int r) const { return base + (size_t)r * ld; } };
struct ARowGather { const bf16_t* base; const unsigned* list; int nvalid; __device__ __forceinline__ const bf16_t* operator()(int r) const {
    const int rr = r < nvalid ? r : nvalid - 1; const unsigned ent = list[rr]; return base + (size_t)(ent >> 1) * DM; } };

template <class ARow, class Epi>
__device__ __forceinline__ void gemm_tile(LAS uchar* lds, const ARow& arow, const bf16_t* Bt, size_t ldb, int K, const Epi& epi) {
    const int tid = tid_opaque(), lane = tid & 63, wid = __builtin_amdgcn_readfirstlane(tid >> 6);
#if NAIVE_GEMM
    {
        const int r = tid >> 1, nh = tid & 1;
        float acc[64];
#pragma unroll
        for (int n = 0; n < 64; ++n) acc[n] = 0.f;
        const bf16_t* ar = arow(r);
        for (int k = 0; k < K; k += 8) {
            float a[8]; unpack8(*(const u32x4*)(ar + k), a);
#pragma unroll
            for (int n = 0; n < 64; ++n) {
                float b[8]; unpack8(*(const u32x4*)(Bt + (size_t)(nh * 64 + n) * ldb + k), b);
#pragma unroll
                for (int j = 0; j < 8; ++j) acc[n] += a[j] * b[j];
            }
        }
        __syncthreads();
#pragma unroll
        for (int n = 0; n < 64; n += 2) *(LAS unsigned*)(lds + r * CT_PITCH + (nh * 64 + n) * 2) = pk2(acc[n], acc[n + 1]);
    }
#else
    {
        const int wm = wid >> 1, wn = wid & 1, r = lane & 31, hh = lane >> 5;
        const int srow = lane >> 3, c0 = (lane & 7) ^ (srow >> 1);
        const bf16_t* asrc[4];
#pragma unroll
        for (int j = 0; j < 4; ++j) asrc[j] = arow(8 * (wid * 4 + j) + srow) + (c0 ^ ((j & 1) << 2)) * 8;
        const bf16_t* bsrc0 = Bt + (size_t)(wid * 16 + srow) * ldb + c0 * 8;
        const bf16_t* bsrc1 = Bt + (size_t)(wid * 16 + 8 + srow) * ldb + (c0 ^ 4) * 8;
        const int lanebase = r * 128 + ((hh ^ ((r >> 1) & 7)) << 4);
        f32x16 acc[2][2];
#pragma unroll
        for (int a = 0; a < 2; ++a)
#pragma unroll
            for (int b = 0; b < 2; ++b)
#pragma unroll
                for (int i = 0; i < 16; ++i) acc[a][b][i] = 0.f;
        const int nt = K >> 6;
#define GT_STAGE(kt, sb) do { _Pragma("unroll") for (int j = 0; j < 4; ++j) \
            glds16(asrc[j] + (kt) * 64, lds + (sb) * GSTG + (wid * 4 + j) * 1024); \
            glds16(bsrc0 + (kt) * 64, lds + (sb) * GSTG + 32768 + (wid * 2) * 1024); \
            glds16(bsrc1 + (kt) * 64, lds + (sb) * GSTG + 32768 + (wid * 2 + 1) * 1024); } while (0)
        GT_STAGE(0, 0);
        if (nt > 1) GT_STAGE(1, 1);
        int sb = 0;
        for (int kt = 0; kt < nt; ++kt) {
            if (kt + 1 < nt) WAITV(6); else WAITV(0);
            __builtin_amdgcn_s_barrier();
            if (kt + 2 < nt) { const int sn = sb >= 1 ? sb - 1 : 2; GT_STAGE(kt + 2, sn); }
            const LAS uchar* xs = lds + sb * GSTG + wm * 8192; const LAS uchar* wsb = lds + sb * GSTG + 32768 + wn * 8192;
#pragma unroll
            for (int ks = 0; ks < 4; ++ks) {
                const int lb = lanebase ^ (ks << 5);
                bf16x8 xf[2], wf[2];
#pragma unroll
                for (int mb = 0; mb < 2; ++mb) xf[mb] = *(const LAS bf16x8*)(xs + mb * 4096 + lb);
#pragma unroll
                for (int nb = 0; nb < 2; ++nb) wf[nb] = *(const LAS bf16x8*)(wsb + nb * 4096 + lb);
#pragma unroll
                for (int nb = 0; nb < 2; ++nb)
#pragma unroll
                    for (int mb = 0; mb < 2; ++mb) acc[nb][mb] = MFMA32(wf[nb], xf[mb], acc[nb][mb]);
            }
            sb = sb == 2 ? 0 : sb + 1;
        }
#undef GT_STAGE
        __syncthreads();
#pragma unroll
        for (int nb = 0; nb < 2; ++nb)
#pragma unroll
            for (int mb = 0; mb < 2; ++mb) {
                const int m = 64 * wm + 32 * mb + r;
#pragma unroll
                for (int q4 = 0; q4 < 4; ++q4) {
                    const int n = 64 * wn + 32 * nb + 8 * q4 + 4 * hh;
                    u32x2 v; v[0] = pk2(acc[nb][mb][4 * q4], acc[nb][mb][4 * q4 + 1]); v[1] = pk2(acc[nb][mb][4 * q4 + 2], acc[nb][mb][4 * q4 + 3]);
                    *(LAS u32x2*)(lds + m * CT_PITCH + n * 2) = v;
                }
            }
    }
#endif
    __syncthreads();
    epi(lds);
    __syncthreads();
}
__device__ __forceinline__ u32x4 ct_ld8(const LAS uchar* ct, int r, int c) { return *(const LAS u32x4*)(ct + r * CT_PITCH + c * 2); }
__device__ __forceinline__ float ct_ld1(const LAS uchar* ct, int r, int c) { return bf2f(*(const LAS bf16_t*)(ct + r * CT_PITCH + c * 2)); }

struct EpiProj {
    int mt, nt, l; const Params* p;
    __device__ __forceinline__ void operator()(const LAS uchar* ct) const {
        uchar* ws = p->ws; const int tid = tid_opaque();
        const float* rstd1 = (const float*)(ws + WS_RSTD1);
        const int t0 = mt * 256, b = t0 >> 11, s0 = t0 & 2047;
        if (nt < 8) {
            const int r = tid >> 1, j = tid & 1, h = nt & 3; const bool isq = nt < 4;
            const float rs = rstd1[t0 + r];
            const float* g = p->in[isq ? 3 : 4] + l * 64;
            float v[64]; float ss = 0.f;
#pragma unroll
            for (int c8 = 0; c8 < 8; ++c8) { float f[8]; unpack8(ct_ld8(ct, r, j * 64 + c8 * 8), f);
#pragma unroll
                for (int i = 0; i < 8; ++i) { const float x = f[i] * rs; v[c8 * 8 + i] = x; ss += x * x; } }
            const float rn = __builtin_amdgcn_rsqf(ss * (1.f / 64.f) + EPS) * (isq ? QSCALE_D : 1.f);
            bf16_t* dst = (bf16_t*)(ws + (isq ? WS_QD : WS_KD)) + ((((size_t)b * 4 + h) * 2 + j) * S + (s0 + r)) * 64;
#pragma unroll
            for (int c8 = 0; c8 < 8; ++c8) { u32x4 o;
#pragma unroll
                for (int i = 0; i < 4; ++i) o[i] = pk2(v[c8 * 8 + 2 * i] * rn * g[c8 * 8 + 2 * i], v[c8 * 8 + 2 * i + 1] * rn * g[c8 * 8 + 2 * i + 1]);
                *(u32x4*)(dst + c8 * 8) = o; }
        } else if (nt < 12) {
            const int h = nt - 8, d = tid >> 2, half = tid & 3;
            bf16_t* dst = (bf16_t*)(ws + WS_VDT) + (((size_t)b * 4 + h) * 128 + d) * S + s0 + half * 64;
#pragma unroll
            for (int c8 = 0; c8 < 8; ++c8) { u32x4 o;
#pragma unroll
                for (int i = 0; i < 4; ++i) {
                    const int p0 = c8 * 8 + 2 * i, r0 = half * 64 + sigma16(p0), r1 = half * 64 + sigma16(p0 + 1);
                    o[i] = pk2(ct_ld1(ct, r0, d) * rstd1[t0 + r0], ct_ld1(ct, r1, d) * rstd1[t0 + r1]); }
                *(u32x4*)(dst + c8 * 8) = o; }
        } else {
            const int r = tid >> 1, j = tid & 1; const float rs = rstd1[t0 + r];
            bf16_t* dst = (bf16_t*)(ws + WS_LAT) + (size_t)(t0 + r) * 640 + (nt - 12) * 128 + j * 64;
#pragma unroll
            for (int c8 = 0; c8 < 8; ++c8) { float f[8]; unpack8(ct_ld8(ct, r, j * 64 + c8 * 8), f); u32x4 o;
#pragma unroll
                for (int i = 0; i < 4; ++i) o[i] = pk2(f[2 * i] * rs, f[2 * i + 1] * rs);
                *(u32x4*)(dst + c8 * 8) = o; }
        }
    }
};

__device__ __forceinline__ float lat_rstd(const bf16_t* seg, int n) {
    float ss = 0.f;
    for (int k = 0; k < n; k += 8) { float f[8]; unpack8(*(const u32x4*)(seg + k), f);
#pragma unroll
        for (int i = 0; i < 8; ++i) ss += f[i] * f[i]; }
    return __builtin_amdgcn_rsqf(ss / (float)n + EPS);
}
__device__ __forceinline__ void norm_rope32(float (&y)[32], const float* g, const float* cosr, const float* sinr, float outscale) {
    float ss = 0.f;
#pragma unroll
    for (int i = 0; i < 32; ++i) ss += y[i] * y[i];
    const float rn = __builtin_amdgcn_rsqf(ss * (1.f / 32.f) + EPS);
#pragma unroll
    for (int i = 0; i < 32; ++i) y[i] = y[i] * rn * g[i];
#pragma unroll
    for (int i = 0; i < 16; ++i) { const float c = cosr[i], sn = sinr[i], x1 = y[i], x2 = y[16 + i];
        y[i] = (x1 * c - x2 * sn) * outscale; y[16 + i] = (x2 * c + x1 * sn) * outscale; }
}

struct EpiMlaQ {
    int mt, h, l; const Params* p;
    __device__ __forceinline__ void operator()(const LAS uchar* ct) const {
        uchar* ws = p->ws; const int tid = tid_opaque(), r = tid >> 1, j = tid & 1;
        const int t = mt * 256 + r, b = t >> 11, s = t & 2047;
        const bf16_t* lat = (const bf16_t*)(ws + WS_LAT) + (size_t)t * 640;
        const float rs = lat_rstd(lat, 192);
        bf16_t* dst = (bf16_t*)(ws + WS_QM) + (((size_t)b * 4 + h) * S + s) * 96;
        if (j == 0) {
            const float* g = p->in[11] + l * 64;
            float v[64]; float ss = 0.f;
#pragma unroll
            for (int c8 = 0; c8 < 8; ++c8) { float f[8]; unpack8(ct_ld8(ct, r, c8 * 8), f);
#pragma unroll
                for (int i = 0; i < 8; ++i) { const float x = f[i] * rs; v[c8 * 8 + i] = x; ss += x * x; } }
            const float rn = __builtin_amdgcn_rsqf(ss * (1.f / 64.f) + EPS) * QSCALE_M;
#pragma unroll
            for (int c8 = 0; c8 < 8; ++c8) { u32x4 o;
#pragma unroll
                for (int i = 0; i < 4; ++i) o[i] = pk2(v[c8 * 8 + 2 * i] * rn * g[c8 * 8 + 2 * i], v[c8 * 8 + 2 * i + 1] * rn * g[c8 * 8 + 2 * i + 1]);
                *(u32x4*)(dst + c8 * 8) = o; }
        } else {
            float y[32];
#pragma unroll
            for (int c8 = 0; c8 < 4; ++c8) { float f[8]; unpack8(ct_ld8(ct, r, 64 + c8 * 8), f);
#pragma unroll
                for (int i = 0; i < 8; ++i) y[c8 * 8 + i] = f[i] * rs; }
            const float* cosr = (const float*)(ws + WS_ROPE) + s * 16; const float* sinr = cosr + S * 16;
            norm_rope32(y, p->in[12] + l * 32, cosr, sinr, QSCALE_M);
#pragma unroll
            for (int c8 = 0; c8 < 4; ++c8) { u32x4 o;
#pragma unroll
                for (int i = 0; i < 4; ++i) o[i] = pk2(y[c8 * 8 + 2 * i], y[c8 * 8 + 2 * i + 1]);
                *(u32x4*)(dst + 64 + c8 * 8) = o; }
        }
    }
};
struct EpiMlaKV {
    int mt, h, l; const Params* p;
    __device__ __forceinline__ void operator()(const LAS uchar* ct) const {
        uchar* ws = p->ws; const int tid = tid_opaque(), r = tid >> 1, j = tid & 1;
        const int t0 = mt * 256, t = t0 + r, b = t >> 11, s = t & 2047, s0 = t0 & 2047;
        const bf16_t* lat = (const bf16_t*)(ws + WS_LAT) + (size_t)t * 640;
        LAS float* shr = (LAS float*)(ct + 256 * CT_PITCH);
        bf16_t* dstk = (bf16_t*)(ws + WS_KM) + (((size_t)b * 4 + h) * S + s) * 96;
        if (j == 0) {
            const float rs = lat_rstd(lat + 192, 128);
            shr[r] = rs;
            const float* g = p->in[13] + l * 64;
            float v[64]; float ss = 0.f;
#pragma unroll
            for (int c8 = 0; c8 < 8; ++c8) { float f[8]; unpack8(ct_ld8(ct, r, c8 * 8), f);
#pragma unroll
                for (int i = 0; i < 8; ++i) { const float x = f[i] * rs; v[c8 * 8 + i] = x; ss += x * x; } }
            const float rn = __builtin_amdgcn_rsqf(ss * (1.f / 64.f) + EPS);
#pragma unroll
            for (int c8 = 0; c8 < 8; ++c8) { u32x4 o;
#pragma unroll
                for (int i = 0; i < 4; ++i) o[i] = pk2(v[c8 * 8 + 2 * i] * rn * g[c8 * 8 + 2 * i], v[c8 * 8 + 2 * i + 1] * rn * g[c8 * 8 + 2 * i + 1]);
                *(u32x4*)(dstk + c8 * 8) = o; }
        } else {
            float y[32];
#pragma unroll
            for (int c8 = 0; c8 < 4; ++c8) { float f[8]; unpack8(*(const u32x4*)(lat + 320 + c8 * 8), f);
#pragma unroll
                for (int i = 0; i < 8; ++i) y[c8 * 8 + i] = f[i]; }
            const float* cosr = (const float*)(ws + WS_ROPE) + s * 16; const float* sinr = cosr + S * 16;
            norm_rope32(y, p->in[14] + l * 32, cosr, sinr, 1.f);
#pragma unroll
            for (int c8 = 0; c8 < 4; ++c8) { u32x4 o;
#pragma unroll
                for (int i = 0; i < 4; ++i) o[i] = pk2(y[c8 * 8 + 2 * i], y[c8 * 8 + 2 * i + 1]);
                *(u32x4*)(dstk + 64 + c8 * 8) = o; }
        }
        __syncthreads();
        {
            const int d = tid >> 3, q4 = tid & 7;
            bf16_t* dst = (bf16_t*)(ws + WS_VMT) + (((size_t)b * 4 + h) * 64 + d) * S + s0 + q4 * 32;
#pragma unroll
            for (int c8 = 0; c8 < 4; ++c8) { u32x4 o;
#pragma unroll
                for (int i = 0; i < 4; ++i) {
                    const int p0 = c8 * 8 + 2 * i, r0 = q4 * 32 + sigma16(p0), r1 = q4 * 32 + sigma16(p0 + 1);
                    o[i] = pk2(ct_ld1(ct, r0, 64 + d) * shr[r0], ct_ld1(ct, r1, 64 + d) * shr[r1]); }
                *(u32x4*)(dst + c8 * 8) = o; }
        }
    }
};
struct EpiPool {
    int mt, g, l; const Params* p;
    __device__ __forceinline__ void operator()(const LAS uchar* ct) const {
        uchar* ws = p->ws; const int tid = tid_opaque(), r = tid >> 1, j = tid & 1;
        const float* sc = p->in[16] + l * 256 + g * 64 + j * 32;
        bf16_t* dst = (bf16_t*)(ws + WS_MIX) + (size_t)(mt * 256 + r) * DM + 768 + g * 64 + j * 32;
#pragma unroll
        for (int c8 = 0; c8 < 4; ++c8) { float f[8]; unpack8(ct_ld8(ct, r, j * 32 + c8 * 8), f); u32x4 o;
#pragma unroll
            for (int i = 0; i < 4; ++i) o[i] = pk2(f[2 * i] * sc[c8 * 8 + 2 * i], f[2 * i + 1] * sc[c8 * 8 + 2 * i + 1]);
            *(u32x4*)(dst + c8 * 8) = o; }
    }
};
struct EpiWout {
    int mt, nt; const float* xres; const Params* p;
    __device__ __forceinline__ void operator()(const LAS uchar* ct) const {
        uchar* ws = p->ws; const int tid = tid_opaque(), r = tid >> 1, j = tid & 1;
        const size_t off = (size_t)(mt * 256 + r) * DM + nt * 128 + j * 64;
        const float* xr = xres + off; float* o32 = p->out + off; bf16_t* ob = (bf16_t*)(ws + WS_XB) + off;
#pragma unroll
        for (int c8 = 0; c8 < 8; ++c8) { float f[8]; unpack8(ct_ld8(ct, r, j * 64 + c8 * 8), f);
            const f32x4 x0 = *(const f32x4*)(xr + c8 * 8), x1 = *(const f32x4*)(xr + c8 * 8 + 4);
            f32x4 y0, y1;
#pragma unroll
            for (int i = 0; i < 4; ++i) { y0[i] = x0[i] + f[i]; y1[i] = x1[i] + f[4 + i]; }
            *(f32x4*)(o32 + c8 * 8) = y0; *(f32x4*)(o32 + c8 * 8 + 4) = y1;
            u32x4 o; o[0] = pk2(y0[0], y0[1]); o[1] = pk2(y0[2], y0[3]); o[2] = pk2(y1[0], y1[1]); o[3] = pk2(y1[2], y1[3]);
            *(u32x4*)(ob + c8 * 8) = o; }
    }
};
struct EpiGU {
    int jt, nvalid; const unsigned* list; size_t slot0; const Params* p;
    __device__ __forceinline__ void operator()(const LAS uchar* ct) const {
        uchar* ws = p->ws; const int tid = tid_opaque(), r = tid >> 1, hf = tid & 1;
        const int rr = r < nvalid ? r : nvalid - 1;
        const float rs = ((const float*)(ws + WS_RSTD2))[list[rr] >> 1];
        bf16_t* dst = (bf16_t*)(ws + WS_HMID) + (slot0 + r) * 256 + jt * 64 + hf * 32;
#pragma unroll
        for (int c8 = 0; c8 < 4; ++c8) { float g[8], u[8]; unpack8(ct_ld8(ct, r, hf * 32 + c8 * 8), g); unpack8(ct_ld8(ct, r, 64 + hf * 32 + c8 * 8), u);
            float hv[8];
#pragma unroll
            for (int i = 0; i < 8; ++i) { const float gg = g[i] * rs, uu = u[i] * rs; hv[i] = gg * __builtin_amdgcn_rcpf(1.f + __builtin_amdgcn_exp2f(-gg * LOG2E)) * uu; }
            u32x4 o; o[0] = pk2(hv[0], hv[1]); o[1] = pk2(hv[2], hv[3]); o[2] = pk2(hv[4], hv[5]); o[3] = pk2(hv[6], hv[7]);
            *(u32x4*)(dst + c8 * 8) = o; }
    }
};
struct EpiDown {
    int nt, nvalid; const unsigned* list; const Params* p;
    __device__ __forceinline__ void operator()(const LAS uchar* ct) const {
        uchar* ws = p->ws; const int tid = tid_opaque(), r = tid >> 1, j = tid & 1;
        if (r < nvalid) {
            const unsigned ent = list[r]; const float w = ((const float*)(ws + WS_GW))[ent];
            bf16_t* dst = (bf16_t*)(ws + WS_YS) + (size_t)ent * DM + nt * 128 + j * 64;
#pragma unroll
            for (int c8 = 0; c8 < 8; ++c8) { float f[8]; unpack8(ct_ld8(ct, r, j * 64 + c8 * 8), f); u32x4 o;
#pragma unroll
                for (int i = 0; i < 4; ++i) o[i] = pk2(f[2 * i] * w, f[2 * i + 1] * w);
                *(u32x4*)(dst + c8 * 8) = o; }
        }
    }
};

__device__ __forceinline__ void diff_attn_unit(LAS uchar* lds, const Params& p, int l, int unit) {
    uchar* ws = p.ws;
    const int tid = tid_opaque(), lane = tid & 63, wid = __builtin_amdgcn_readfirstlane(tid >> 6);
    const int qb = unit & 15, h = (unit >> 4) & 3, b = unit >> 6;
    const float* scal = (const float*)(ws + WS_SCAL) + 16 * l;
    const float lam = scal[0], oml = scal[1], m2 = scal[2];
    const float slope2 = exp2f(-2.f * (float)(h + 1)) * LOG2E;
    const bf16_t* Q1 = (const bf16_t*)(ws + WS_QD) + (((size_t)b * 4 + h) * 2) * S * 64;
    const bf16_t* K1 = (const bf16_t*)(ws + WS_KD) + (((size_t)b * 4 + h) * 2) * S * 64;
    const bf16_t* VT = (const bf16_t*)(ws + WS_VDT) + (((size_t)b * 4 + h) * 128) * S;
    const float* gsub = p.in[6] + l * 128;
    bf16_t* mix = (bf16_t*)(ws + WS_MIX);
#if NAIVE_ATTN
    {
        const int q = qb * 128 + (tid >> 2), mm = (tid >> 1) & 1, dh = tid & 1;
        const bf16_t* Qp = Q1 + (size_t)mm * S * 64 + (size_t)q * 64; const bf16_t* Kp = K1 + (size_t)mm * S * 64;
        float qv[64];
#pragma unroll
        for (int c8 = 0; c8 < 8; ++c8) { float f[8]; unpack8(*(const u32x4*)(Qp + c8 * 8), f);
#pragma unroll
            for (int i = 0; i < 8; ++i) qv[c8 * 8 + i] = f[i]; }
        float o[64]; float lsum = 0.f;
#pragma unroll
        for (int d = 0; d < 64; ++d) o[d] = 0.f;
        for (int key = 0; key < S; ++key) {
            float sc = 0.f;
#pragma unroll
            for (int c8 = 0; c8 < 8; ++c8) { float f[8]; unpack8(*(const u32x4*)(Kp + (size_t)key * 64 + c8 * 8), f);
#pragma unroll
                for (int i = 0; i < 8; ++i) sc += qv[c8 * 8 + i] * f[i]; }
            const float pv = __builtin_amdgcn_exp2f(sc - slope2 * fabsf((float)(q - key)) - m2);
            lsum += pv;
            const int kp = sigma16(key);
#pragma unroll
            for (int d = 0; d < 64; ++d) o[d] += pv * bf2f(VT[(size_t)(dh * 64 + d) * S + kp]);
        }
        const float inv = 1.f / lsum; float ss = 0.f;
#pragma unroll
        for (int d = 0; d < 64; ++d) { const float mine = o[d] * inv; const float other = __shfl_xor(mine, 2); o[d] = mine - lam * other; ss += o[d] * o[d]; }
        ss += __shfl_xor(ss, 1);
        if (mm == 0) {
            const float rn = __builtin_amdgcn_rsqf(ss * (1.f / 128.f) + EPS) * oml;
            bf16_t* dst = mix + (size_t)(b * S + q) * DM + h * 128 + dh * 64;
#pragma unroll
            for (int d = 0; d < 64; d += 2) *(unsigned*)(dst + d) = pk2(o[d] * rn * gsub[dh * 64 + d], o[d + 1] * rn * gsub[dh * 64 + d + 1]);
        }
    }
#else
    {
        const int r = lane & 31, hh = lane >> 5, qs = wid >> 1, mm = wid & 1, qpos = qb * 128 + qs * 32 + r;
        const bf16_t* Qm_ = Q1 + (size_t)mm * S * 64;
        bf16x8 qf[4];
#pragma unroll
        for (int ks = 0; ks < 4; ++ks) qf[ks] = *(const bf16x8*)(Qm_ + (size_t)qpos * 64 + ks * 16 + hh * 8);
        f32x16 O[4]; float lsum = 0.f;
#pragma unroll
        for (int db = 0; db < 4; ++db)
#pragma unroll
            for (int i = 0; i < 16; ++i) O[db][i] = 0.f;
        const int srow = lane >> 3, c0 = (lane & 7) ^ (srow >> 1);
        const bool isk = wid < 4;
        const bf16_t* sbase = isk ? (K1 + (size_t)(wid >> 1) * S * 64 + (size_t)(wid & 1) * 32 * 64) : (VT + (size_t)(wid - 4) * 32 * S);
        const int rstride = isk ? 64 : S, kstride = isk ? 64 * 64 : 64;
        const bf16_t* sb0 = sbase + (size_t)srow * rstride + c0 * 8;
        const bf16_t* sb1 = sbase + (size_t)srow * rstride + (c0 ^ 4) * 8;
        const int lanebase = r * 128 + ((hh ^ ((r >> 1) & 7)) << 4);
#define DA_STAGE(kt, sbuf) do { _Pragma("unroll") for (int j = 0; j < 4; ++j) \
            glds16(((j & 1) ? sb1 : sb0) + (size_t)(8 * j) * rstride + (size_t)(kt) * kstride, lds + (sbuf) * ASTG + (wid * 4 + j) * 1024); } while (0)
        DA_STAGE(0, 0); DA_STAGE(1, 1);
        int sb = 0;
        const int kq0 = 4 * hh - qpos;
        for (int kt = 0; kt < S / 64; ++kt) {
            if (kt + 1 < S / 64) WAITV(4); else WAITV(0);
            __builtin_amdgcn_s_barrier();
            if (kt + 2 < S / 64) { const int sn = sb >= 1 ? sb - 1 : 2; DA_STAGE(kt + 2, sn); }
            const LAS uchar* st = lds + sb * ASTG;
#pragma unroll
            for (int kb = 0; kb < 2; ++kb) {
                f32x16 sacc;
#pragma unroll
                for (int i = 0; i < 16; ++i) sacc[i] = 0.f;
#pragma unroll
                for (int ks = 0; ks < 4; ++ks) {
                    const bf16x8 kf = *(const LAS bf16x8*)(st + mm * 8192 + kb * 4096 + (lanebase ^ (ks << 5)));
                    sacc = MFMA32(kf, qf[ks], sacc);
                }
                const int kbase = kt * 64 + 32 * kb + kq0;
                float ls = 0.f;
#pragma unroll
                for (int i = 0; i < 16; ++i) {
                    const float dist = fabsf((float)(kbase + (i & 3) + 8 * (i >> 2)));
                    const float pv = __builtin_amdgcn_exp2f(sacc[i] - slope2 * dist - m2);
                    ls += pv; sacc[i] = pv;
                }
                lsum += ls;
                bf16x8 pb[2];
#pragma unroll
                for (int s2 = 0; s2 < 2; ++s2) {
                    u32x4 w;
#pragma unroll
                    for (int i = 0; i < 4; ++i) w[i] = pk2(sacc[8 * s2 + 2 * i], sacc[8 * s2 + 2 * i + 1]);
                    pb[s2] = __builtin_bit_cast(bf16x8, w);
                }
#pragma unroll
                for (int db = 0; db < 4; ++db)
#pragma unroll
                    for (int s2 = 0; s2 < 2; ++s2) {
                        const bf16x8 vf = *(const LAS bf16x8*)(st + 16384 + db * 4096 + (lanebase ^ ((2 * kb + s2) << 5)));
                        O[db] = MFMA32(vf, pb[s2], O[db]);
                    }
            }
            sb = sb == 2 ? 0 : sb + 1;
        }
#undef DA_STAGE
        const float lt = lsum + __shfl_xor(lsum, 32);
        const float sc = (mm == 0) ? (1.f / lt) : (lam / lt);
        __syncthreads();
        LAS float* xch = (LAS float*)lds + qs * 4096;
        if (mm == 1) {
#pragma unroll
            for (int db = 0; db < 4; ++db)
#pragma unroll
                for (int i = 0; i < 16; ++i) xch[(db * 16 + i) * 64 + lane] = O[db][i] * sc;
        }
        __syncthreads();
        if (mm == 0) {
            float ss = 0.f;
#pragma unroll
            for (int db = 0; db < 4; ++db)
#pragma unroll
                for (int i = 0; i < 16; ++i) { const float o = O[db][i] * sc - xch[(db * 16 + i) * 64 + lane]; O[db][i] = o; ss += o * o; }
            ss += __shfl_xor(ss, 32);
            const float rn = __builtin_amdgcn_rsqf(ss * (1.f / 128.f) + EPS) * oml;
            bf16_t* dst = mix + (size_t)(b * S + qpos) * DM + h * 128;
#pragma unroll
            for (int db = 0; db < 4; ++db)
#pragma unroll
                for (int q4 = 0; q4 < 4; ++q4) {
                    const int d = 32 * db + 8 * q4 + 4 * hh;
                    const f32x4 g = *(const f32x4*)(gsub + d);
                    u32x2 w; w[0] = pk2(O[db][4 * q4] * rn * g[0], O[db][4 * q4 + 1] * rn * g[1]);
                    w[1] = pk2(O[db][4 * q4 + 2] * rn * g[2], O[db][4 * q4 + 3] * rn * g[3]);
                    *(u32x2*)(dst + d) = w;
                }
        }
    }
#endif
    __syncthreads();
}

__device__ __forceinline__ void mla_attn_unit(LAS uchar* lds, const Params& p, int l, int unit) {
    uchar* ws = p.ws;
    const int tid = tid_opaque(), lane = tid & 63, wid = __builtin_amdgcn_readfirstlane(tid >> 6);
    const int qb = unit & 7, h = (unit >> 3) & 3, b = unit >> 5;
    const float m2 = ((const float*)(ws + WS_SCAL))[16 * l + 3];
    const bf16_t* Q = (const bf16_t*)(ws + WS_QM) + (((size_t)b * 4 + h) * S) * 96;
    const bf16_t* Kp = (const bf16_t*)(ws + WS_KM) + (((size_t)b * 4 + h) * S) * 96;
    const bf16_t* VT = (const bf16_t*)(ws + WS_VMT) + (((size_t)b * 4 + h) * 64) * S;
    bf16_t* mix = (bf16_t*)(ws + WS_MIX);
#if NAIVE_ATTN
    {
        const int q = qb * 256 + (tid >> 1), hf = tid & 1;
        float qv[96];
#pragma unroll
        for (int c8 = 0; c8 < 12; ++c8) { float f[8]; unpack8(*(const u32x4*)(Q + (size_t)q * 96 + c8 * 8), f);
#pragma unroll
            for (int i = 0; i < 8; ++i) qv[c8 * 8 + i] = f[i]; }
        float o[32]; float lsum = 0.f;
#pragma unroll
        for (int d = 0; d < 32; ++d) o[d] = 0.f;
        for (int key = 0; key < S; ++key) {
            float sc = 0.f;
#pragma unroll
            for (int c8 = 0; c8 < 12; ++c8) { float f[8]; unpack8(*(const u32x4*)(Kp + (size_t)key * 96 + c8 * 8), f);
#pragma unroll
                for (int i = 0; i < 8; ++i) sc += qv[c8 * 8 + i] * f[i]; }
            const float pv = __builtin_amdgcn_exp2f(sc - m2);
            lsum += pv;
            const int kp = sigma16(key);
#pragma unroll
            for (int d = 0; d < 32; ++d) o[d] += pv * bf2f(VT[(size_t)(hf * 32 + d) * S + kp]);
        }
        const float inv = 1.f / lsum;
        bf16_t* dst = mix + (size_t)(b * S + q) * DM + 512 + h * 64 + hf * 32;
#pragma unroll
        for (int d = 0; d < 32; d += 2) *(unsigned*)(dst + d) = pk2(o[d] * inv, o[d + 1] * inv);
    }
#else
    {
        const int r = lane & 31, hh = lane >> 5, qpos = qb * 256 + wid * 32 + r;
        bf16x8 qf[6];
#pragma unroll
        for (int ks = 0; ks < 6; ++ks) qf[ks] = *(const bf16x8*)(Q + (size_t)qpos * 96 + ks * 16 + hh * 8);
        f32x16 O[2]; float lsum = 0.f;
#pragma unroll
        for (int db = 0; db < 2; ++db)
#pragma unroll
            for (int i = 0; i < 16; ++i) O[db][i] = 0.f;
        const int lanebase = r * 128 + ((hh ^ ((r >> 1) & 7)) << 4), lanebase64 = r * 64 + ((hh ^ ((r >> 2) & 3)) << 4);
        const bool lo4 = wid < 4;
        const bf16_t* s0p; const bf16_t* s1p; const bf16_t* s2p;
        {
            const int srow = lane >> 3;
            { const int row = 8 * wid + srow; const int c = (lane & 7) ^ ((row >> 1) & 7); s0p = Kp + (size_t)row * 96 + c * 8; }
            if (lo4) { const int row = 16 * wid + (lane >> 2); const int c = (lane & 3) ^ ((row >> 2) & 3); s1p = Kp + (size_t)row * 96 + 64 + c * 8; }
            else { const int row = 8 * (wid - 4) + srow; const int c = (lane & 7) ^ ((row >> 1) & 7); s1p = VT + (size_t)row * S + c * 8; }
            { const int row = 8 * ((wid & 3) + 4) + srow; const int c = (lane & 7) ^ ((row >> 1) & 7); s2p = VT + (size_t)row * S + c * 8; }
        }
        const int k1stride = lo4 ? 64 * 96 : 64;
#define MA_STAGE(kt, sbuf) do { \
            glds16(s0p + (size_t)(kt) * (64 * 96), lds + (sbuf) * MSTG + wid * 1024); \
            glds16(s1p + (size_t)(kt) * k1stride, lds + (sbuf) * MSTG + (wid + 8) * 1024); \
            if (lo4) glds16(s2p + (size_t)(kt) * 64, lds + (sbuf) * MSTG + (wid + 16) * 1024); } while (0)
        MA_STAGE(0, 0); MA_STAGE(1, 1);
        int sb = 0;
        for (int kt = 0; kt < S / 64; ++kt) {
            if (kt + 1 < S / 64) { if (lo4) WAITV(3); else WAITV(2); } else WAITV(0);
            __builtin_amdgcn_s_barrier();
            if (kt + 2 < S / 64) { const int sn = sb >= 1 ? sb - 1 : 2; MA_STAGE(kt + 2, sn); }
            const LAS uchar* st = lds + sb * MSTG;
#pragma unroll
            for (int kb = 0; kb < 2; ++kb) {
                f32x16 sacc;
#pragma unroll
                for (int i = 0; i < 16; ++i) sacc[i] = -m2;
#pragma unroll
                for (int ks = 0; ks < 4; ++ks) {
                    const bf16x8 kf = *(const LAS bf16x8*)(st + kb * 4096 + (lanebase ^ (ks << 5)));
                    sacc = MFMA32(kf, qf[ks], sacc);
                }
#pragma unroll
                for (int ks = 0; ks < 2; ++ks) {
                    const bf16x8 kf = *(const LAS bf16x8*)(st + 8192 + kb * 2048 + (lanebase64 ^ (ks << 5)));
                    sacc = MFMA32(kf, qf[4 + ks], sacc);
                }
                float ls = 0.f;
#pragma unroll
                for (int i = 0; i < 16; ++i) { const float pv = __builtin_amdgcn_exp2f(sacc[i]); ls += pv; sacc[i] = pv; }
                lsum += ls;
                bf16x8 pb[2];
#pragma unroll
                for (int s2 = 0; s2 < 2; ++s2) {
                    u32x4 w;
#pragma unroll
                    for (int i = 0; i < 4; ++i) w[i] = pk2(sacc[8 * s2 + 2 * i], sacc[8 * s2 + 2 * i + 1]);
                    pb[s2] = __builtin_bit_cast(bf16x8, w);
                }
#pragma unroll
                for (int db = 0; db < 2; ++db)
#pragma unroll
                    for (int s2 = 0; s2 < 2; ++s2) {
                        const bf16x8 vf = *(const LAS bf16x8*)(st + 12288 + db * 4096 + (lanebase ^ ((2 * kb + s2) << 5)));
                        O[db] = MFMA32(vf, pb[s2], O[db]);
                    }
            }
            sb = sb == 2 ? 0 : sb + 1;
        }
#undef MA_STAGE
        const float lt = lsum + __shfl_xor(lsum, 32); const float inv = 1.f / lt;
        bf16_t* dst = mix + (size_t)(b * S + qpos) * DM + 512 + h * 64;
#pragma unroll
        for (int db = 0; db < 2; ++db)
#pragma unroll
            for (int q4 = 0; q4 < 4; ++q4) {
                const int d = 32 * db + 8 * q4 + 4 * hh;
                u32x2 w; w[0] = pk2(O[db][4 * q4] * inv, O[db][4 * q4 + 1] * inv); w[1] = pk2(O[db][4 * q4 + 2] * inv, O[db][4 * q4 + 3] * inv);
                *(u32x2*)(dst + d) = w;
            }
    }
#endif
    __syncthreads();
}

__device__ __forceinline__ int xp_rowmap(int mode, int n) {
    return mode == 0 ? n : mode == 1 ? (n / 96) * 128 + (n % 96) : mode == 2 ? ((n >> 6) * 128 + (n & 63)) : ((n >> 6) * 128 + 64 + (n & 63));
}
__device__ __forceinline__ void xpose_tile(LAS uchar* lds, const float* src, int K, int N, bf16_t* dst, int ldd, int mode, const float* gain, int kt, int ntile) {
    LAS float* sh = (LAS float*)lds; const int tid = tid_opaque();
    (void)K;
#pragma unroll 4
    for (int i = 0; i < 8; ++i) {
        const int kl = (tid >> 6) + 8 * i, k = kt * 64 + kl, n = ntile * 64 + (tid & 63);
        float v = (n < N) ? src[(size_t)k * N + n] : 0.f;
        if (gain) v *= gain[k];
        sh[kl * 65 + (tid & 63)] = v;
    }
    __syncthreads();
    {
        const int nl = tid >> 3, kq = tid & 7, n = ntile * 64 + nl;
        if (n < N) {
            bf16_t* d = dst + (size_t)xp_rowmap(mode, n) * ldd + kt * 64 + kq * 8;
            u32x4 o0;
#pragma unroll
            for (int i = 0; i < 4; ++i) o0[i] = pk2(sh[(kq * 8 + 2 * i) * 65 + nl], sh[(kq * 8 + 2 * i + 1) * 65 + nl]);
            *(u32x4*)d = o0;
        }
    }
    __syncthreads();
}
__device__ __forceinline__ void xpose_job(LAS uchar* lds, const float* src, int K, int N, bf16_t* dst, int ldd, int mode, const float* gain) {
    const int nkt = K >> 6, nnt = (N + 63) >> 6, tot = nkt * nnt;
    for (int u = blockIdx.x; u < tot; u += gridDim.x) xpose_tile(lds, src, K, N, dst, ldd, mode, gain, u % nkt, u / nkt);
}
__device__ __forceinline__ void expert_weights(LAS uchar* lds, const Params& p, int l) {
    bf16_t* wgu = (bf16_t*)(p.ws + WS_WGU); bf16_t* wd = (bf16_t*)(p.ws + WS_WD);
    const float* g2 = p.in[18] + l * DM;
    for (int u = blockIdx.x; u < 32 * 192; u += gridDim.x) {
        const int e = u / 192, w = u % 192, job = w >> 6, tl = w & 63;
        if (job == 0) xpose_tile(lds, p.in[23] + ((size_t)l * 32 + e) * DM * 256, DM, 256, wgu + (size_t)e * 512 * DM, DM, 2, g2, tl & 15, tl >> 4);
        else if (job == 1) xpose_tile(lds, p.in[24] + ((size_t)l * 32 + e) * DM * 256, DM, 256, wgu + (size_t)e * 512 * DM, DM, 3, g2, tl & 15, tl >> 4);
        else xpose_tile(lds, p.in[25] + ((size_t)l * 32 + e) * 256 * DM, 256, DM, wd + (size_t)e * DM * 256, 256, 0, nullptr, tl & 3, tl >> 2);
    }
}
__device__ __forceinline__ void row_prep(const float* xrow, bf16_t* xb, float* rstd, int lane) {
    float ss = 0.f; f32x4 v[4];
#pragma unroll
    for (int i = 0; i < 4; ++i) { v[i] = *(const f32x4*)(xrow + i * 256 + lane * 4); ss += v[i][0] * v[i][0] + v[i][1] * v[i][1] + v[i][2] * v[i][2] + v[i][3] * v[i][3]; }
    ss = wave_sum(ss);
#pragma unroll
    for (int i = 0; i < 4; ++i) { u32x2 o; o[0] = pk2(v[i][0], v[i][1]); o[1] = pk2(v[i][2], v[i][3]); *(u32x2*)(xb + i * 256 + lane * 4) = o; }
    if (lane == 0) *rstd = __builtin_amdgcn_rsqf(ss * (1.f / 1024.f) + EPS);
}

__device__ __forceinline__ void phase0(LAS uchar* lds, const Params& p) {
    uchar* ws = p.ws; const int tid = tid_opaque(), gtid = blockIdx.x * NT + tid, gsz = gridDim.x * NT;
    for (int l = 0; l < NL; ++l) {
        xpose_job(lds, p.in[2] + (size_t)l * DM * NIN, DM, NIN, (bf16_t*)(ws + WS_WIN) + (size_t)l * NINP * DM, DM, 0, p.in[1] + l * DM);
        xpose_job(lds, p.in[17] + (size_t)l * DM * DM, DM, DM, (bf16_t*)(ws + WS_WOUT) + (size_t)l * DM * DM, DM, 0, nullptr);
        xpose_job(lds, p.in[9] + (size_t)l * 192 * 384, 192, 384, (bf16_t*)(ws + WS_WUQ) + (size_t)l * 512 * 192, 192, 1, p.in[7] + l * 192);
        xpose_job(lds, p.in[10] + (size_t)l * 128 * 512, 128, 512, (bf16_t*)(ws + WS_WUKV) + (size_t)l * 512 * 128, 128, 0, p.in[8] + l * 128);
        for (int g = 0; g < 4; ++g)
            xpose_job(lds, p.in[15] + ((size_t)l * 4 + g) * 64 * 64, 64, 64, (bf16_t*)(ws + WS_POOLW) + ((size_t)l * 4 + g) * 128 * 64, 64, 0, nullptr);
        { bf16_t* w = (bf16_t*)(ws + WS_WIN) + ((size_t)l * NINP + NIN) * DM; for (int i = gtid; i < 32 * DM; i += gsz) w[i] = 0; }
        { bf16_t* w = (bf16_t*)(ws + WS_WUQ) + (size_t)l * 512 * 192; for (int i = gtid; i < 4 * 32 * 192; i += gsz) { const int hd = i / (32 * 192), rem = i % (32 * 192); w[(size_t)(hd * 128 + 96) * 192 + rem] = 0; } }
        { bf16_t* w = (bf16_t*)(ws + WS_POOLW) + (size_t)l * 4 * 128 * 64; for (int i = gtid; i < 4 * 64 * 64; i += gsz) { const int g = i >> 12, rem = i & 4095; w[(size_t)(g * 128 + 64) * 64 + rem] = 0; } }
    }
    expert_weights(lds, p, 0);
    for (int i = gtid; i < S * 16; i += gsz) {
        const int pos = i >> 4, f = i & 15;
        double inv = 1.0; for (int k = 0; k < f; ++k) inv *= 0.5623413251903491;
        const double rev = (double)pos * inv * 0.15915494309189535;
        const float fr = (float)(rev - __builtin_rint(rev));
        ((float*)(ws + WS_ROPE))[i] = __builtin_amdgcn_cosf(fr);
        ((float*)(ws + WS_ROPE))[S * 16 + i] = __builtin_amdgcn_sinf(fr);
    }
    if (gtid < NL) {
        const int l = gtid; float* sc = (float*)(ws + WS_SCAL) + 16 * l;
        const float* lv = p.in[5] + l * 256;
        float d1 = 0.f, d2 = 0.f; for (int i = 0; i < 64; ++i) { d1 += lv[i] * lv[64 + i]; d2 += lv[128 + i] * lv[192 + i]; }
        const float lam_init = 0.8f - 0.6f * expf(-0.3f * (float)l);
        sc[0] = expf(d1) - expf(d2) + lam_init; sc[1] = 1.f - lam_init;
        float gq = 0.f, gk = 0.f; for (int i = 0; i < 64; ++i) { gq = fmaxf(gq, fabsf(p.in[3][l * 64 + i])); gk = fmaxf(gk, fabsf(p.in[4][l * 64 + i])); }
        sc[2] = gq * gk * 8.f * LOG2E * 1.02f;
        float a = 0.f, bq = 0.f, c = 0.f, dk = 0.f;
        for (int i = 0; i < 64; ++i) { a = fmaxf(a, fabsf(p.in[11][l * 64 + i])); c = fmaxf(c, fabsf(p.in[13][l * 64 + i])); }
        for (int i = 0; i < 32; ++i) { bq = fmaxf(bq, fabsf(p.in[12][l * 32 + i])); dk = fmaxf(dk, fabsf(p.in[14][l * 32 + i])); }
        sc[3] = sqrtf(64.f * a * a + 32.f * bq * bq) * sqrtf(64.f * c * c + 32.f * dk * dk) * QSCALE_M * 1.02f;
    }
    {
        const int lane = tid & 63, gw = gtid >> 6, nw = gsz >> 6;
        for (int t = gw; t < T; t += nw) row_prep(p.in[0] + (size_t)t * DM, (bf16_t*)(ws + WS_XB) + (size_t)t * DM, (float*)(ws + WS_RSTD1) + t, lane);
    }
}

__device__ __forceinline__ void ph_gemm1(LAS uchar* lds, const Params& p, int l) {
    const bf16_t* xb = (const bf16_t*)(p.ws + WS_XB); const bf16_t* win = (const bf16_t*)(p.ws + WS_WIN) + (size_t)l * NINP * DM;
    for (int u = blockIdx.x; u < 64 * 17; u += gridDim.x) {
        const int mt = u / 17, nt = u % 17;
        ARowLinear ar{xb + (size_t)mt * 256 * DM, (size_t)DM};
        EpiProj ep{mt, nt, l, &p};
        gemm_tile(lds, ar, win + (size_t)nt * 128 * DM, (size_t)DM, DM, ep);
    }
}
__device__ __forceinline__ void pooled_unit(const Params& p, int mt) {
    const int tidp = tid_opaque(); const int c = tidp & 255, rh = tidp >> 8, g = c >> 6, half = 1 << g;
    const int t0 = mt * 256 + rh * 128, b = t0 >> 11, s0 = t0 & 2047;
    const bf16_t* u = (const bf16_t*)(p.ws + WS_LAT) + (size_t)b * S * 640 + 352 + c;
    bf16_t* dst = (bf16_t*)(p.ws + WS_POOLED) + (size_t)t0 * 256 + c;
    for (int r = 0; r < 128; ++r) {
        const int s = s0 + r; int lo = s - half, hi = s + half - 1; lo = lo < 0 ? 0 : lo; hi = hi > S - 1 ? S - 1 : hi;
        float sum = 0.f; for (int j = lo; j <= hi; ++j) sum += bf2f(u[(size_t)j * 640]);
        const float v = sum / (float)(hi - lo + 1) - bf2f(u[(size_t)s * 640]);
        dst[(size_t)r * 256] = f2bf(v);
    }
}
__device__ __forceinline__ void ph_mix_a(LAS uchar* lds, const Params& p, int l) {
    const bf16_t* lat = (const bf16_t*)(p.ws + WS_LAT);
    for (int u = blockIdx.x; u < 512 + 512 + 64; u += gridDim.x) {
        if (u < 512) diff_attn_unit(lds, p, l, u);
        else if (u < 1024) {
            const int v = u - 512, mt = v >> 3, w = v & 7, h = w & 3;
            if (w < 4) { ARowLinear ar{lat + (size_t)mt * 256 * 640, (size_t)640}; EpiMlaQ ep{mt, h, l, &p};
                gemm_tile(lds, ar, (const bf16_t*)(p.ws + WS_WUQ) + ((size_t)l * 512 + h * 128) * 192, (size_t)192, 192, ep); }
            else { ARowLinear ar{lat + (size_t)mt * 256 * 640 + 192, (size_t)640}; EpiMlaKV ep{mt, h, l, &p};
                gemm_tile(lds, ar, (const bf16_t*)(p.ws + WS_WUKV) + ((size_t)l * 512 + h * 128) * 128, (size_t)128, 128, ep); }
        } else pooled_unit(p, u - 1024);
    }
}
__device__ __forceinline__ void ph_mix_b(LAS uchar* lds, const Params& p, int l) {
    for (int u = blockIdx.x; u < 256 + 256; u += gridDim.x) {
        if (u < 256) mla_attn_unit(lds, p, l, u);
        else { const int v = u - 256, mt = v >> 2, g = v & 3;
            ARowLinear ar{(const bf16_t*)(p.ws + WS_POOLED) + (size_t)mt * 256 * 256 + g * 64, (size_t)256}; EpiPool ep{mt, g, l, &p};
            gemm_tile(lds, ar, (const bf16_t*)(p.ws + WS_POOLW) + ((size_t)l * 4 + g) * 128 * 64, (size_t)64, 64, ep); }
    }
}
__device__ __forceinline__ void ph_wout(LAS uchar* lds, const Params& p, int l) {
    const bf16_t* mix = (const bf16_t*)(p.ws + WS_MIX); const bf16_t* wo = (const bf16_t*)(p.ws + WS_WOUT) + (size_t)l * DM * DM;
    const float* xres = (l == 0) ? p.in[0] : p.out;
    for (int u = blockIdx.x; u < 64 * 8; u += gridDim.x) {
        const int mt = u >> 3, nt = u & 7;
        ARowLinear ar{mix + (size_t)mt * 256 * DM, (size_t)DM}; EpiWout ep{mt, nt, xres, &p};
        gemm_tile(lds, ar, wo + (size_t)nt * 128 * DM, (size_t)DM, DM, ep);
    }
}
__device__ __forceinline__ void ph_router(LAS uchar* lds, const Params& p, int l) {
    uchar* ws = p.ws; const int tid = tid_opaque(), lane = tid & 63, wv = tid >> 6;
    const int gw = blockIdx.x * 8 + wv, nw = gridDim.x * 8;
    const float* g2 = p.in[18] + l * DM; const float* wg = p.in[19] + (size_t)l * DM * 4; const float* we = p.in[21] + (size_t)l * DM * 32;
    const float* bg = p.in[20] + l * 4; const float* be = p.in[22] + l * 32;
    unsigned* cnt = (unsigned*)(ws + WS_CTL) + CW_CNT + 64 * l;
    unsigned* list = (unsigned*)(ws + WS_LIST); float* gwt = (float*)(ws + WS_GW); float* rstd2 = (float*)(ws + WS_RSTD2);
    LAS float* shl = (LAS float*)lds + wv * 64;
    for (int t = gw; t < T; t += nw) {
        const float* xr = p.out + (size_t)t * DM;
        float acc[36];
#pragma unroll
        for (int n = 0; n < 36; ++n) acc[n] = 0.f;
        float ss = 0.f;
#pragma unroll 2
        for (int i = 0; i < 16; ++i) {
            const int k = i * 64 + lane; const float xv = xr[k]; ss += xv * xv; const float xg = xv * g2[k];
            const f32x4 wgv = *(const f32x4*)(wg + (size_t)k * 4);
#pragma unroll
            for (int n = 0; n < 4; ++n) acc[n] += xg * wgv[n];
#pragma unroll
            for (int n4 = 0; n4 < 8; ++n4) { const f32x4 wv4 = *(const f32x4*)(we + (size_t)k * 32 + n4 * 4);
#pragma unroll
                for (int n = 0; n < 4; ++n) acc[4 + n4 * 4 + n] += xg * wv4[n]; }
        }
        ss = wave_sum(ss);
        const float rs = __builtin_amdgcn_rsqf(ss * (1.f / 1024.f) + EPS);
#pragma unroll
        for (int n = 0; n < 36; ++n) { const float v = wave_sum(acc[n]); if (lane == n) shl[n] = v * rs + (n < 4 ? bg[n] : be[n - 4]); }
        __builtin_amdgcn_s_waitcnt(0xC07F);
        if (lane == 0) {
            int gi = 0; float gm = shl[0];
            for (int n = 1; n < 4; ++n) { const float v = shl[n]; if (v > gm) { gm = v; gi = n; } }
            float gs = 0.f; for (int n = 0; n < 4; ++n) gs += __expf(shl[n] - gm);
            const float gtop = 1.f / gs;
            int i1 = 0; float m1 = shl[4 + gi * 8];
            for (int n = 1; n < 8; ++n) { const float v = shl[4 + gi * 8 + n]; if (v > m1) { m1 = v; i1 = n; } }
            int i2 = -1; float m2v = -3.0e38f;
            for (int n = 0; n < 8; ++n) { const float v = shl[4 + gi * 8 + n]; if (n != i1 && v > m2v) { m2v = v; i2 = n; } }
            const float e2 = __expf(m2v - m1); const float w1 = gtop / (1.f + e2), w2 = gtop * e2 / (1.f + e2);
            const int ea = gi * 8 + i1, eb = gi * 8 + i2;
            const unsigned pa = atomicAdd(&cnt[ea], 1u), pb = atomicAdd(&cnt[eb], 1u);
            list[(size_t)ea * T + pa] = (unsigned)(t * 2); list[(size_t)eb * T + pb] = (unsigned)(t * 2 + 1);
            gwt[t * 2] = w1; gwt[t * 2 + 1] = w2; rstd2[t] = rs;
        }
    }
}
__device__ __forceinline__ void moe_find(const unsigned* cnt, int rbg, int& e, int& rb, int& nvalid, int& pre) {
    int acc = 0; e = -1; rb = 0; nvalid = 0; pre = 0;
    for (int i = 0; i < 32; ++i) { const int c = (int)cnt[i], nb = (c + 255) >> 8;
        if (e < 0 && rbg < acc + nb) { e = i; rb = rbg - acc; nvalid = c - rb * 256; if (nvalid > 256) nvalid = 256; pre = acc; }
        acc += nb; }
}
__device__ __forceinline__ int moe_total(const unsigned* cnt) { int acc = 0; for (int i = 0; i < 32; ++i) acc += ((int)cnt[i] + 255) >> 8; return acc; }
__device__ __forceinline__ void ph_gateup(LAS uchar* lds, const Params& p, int l) {
    uchar* ws = p.ws; const unsigned* cnt = (const unsigned*)(ws + WS_CTL) + CW_CNT + 64 * l;
    const int tot = moe_total(cnt) * 4;
    for (int u = blockIdx.x; u < tot; u += gridDim.x) {
        int e, rb, nvalid, pre; moe_find(cnt, u >> 2, e, rb, nvalid, pre); const int jt = u & 3;
        const unsigned* list = (const unsigned*)(ws + WS_LIST) + (size_t)e * T + rb * 256;
        ARowGather ar{(const bf16_t*)(ws + WS_XB), list, nvalid};
        EpiGU ep{jt, nvalid, list, (size_t)(u >> 2) * 256, &p};
        gemm_tile(lds, ar, (const bf16_t*)(ws + WS_WGU) + ((size_t)e * 512 + jt * 128) * DM, (size_t)DM, DM, ep);
    }
}
__device__ __forceinline__ void ph_down(LAS uchar* lds, const Params& p, int l) {
    uchar* ws = p.ws; const unsigned* cnt = (const unsigned*)(ws + WS_CTL) + CW_CNT + 64 * l;
    const int tot = moe_total(cnt) * 8;
    for (int u = blockIdx.x; u < tot; u += gridDim.x) {
        int e, rb, nvalid, pre; moe_find(cnt, u >> 3, e, rb, nvalid, pre); const int nt = u & 7;
        const unsigned* list = (const unsigned*)(ws + WS_LIST) + (size_t)e * T + rb * 256;
        ARowLinear ar{(const bf16_t*)(ws + WS_HMID) + (size_t)(u >> 3) * 256 * 256, (size_t)256};
        EpiDown ep{nt, nvalid, list, &p};
        gemm_tile(lds, ar, (const bf16_t*)(ws + WS_WD) + ((size_t)e * DM + nt * 128) * 256, (size_t)256, 256, ep);
    }
}
__device__ __forceinline__ void ph_combine(LAS uchar* lds, const Params& p, int l) {
    uchar* ws = p.ws; const int tid = tid_opaque(), lane = tid & 63;
    const int gw = blockIdx.x * 8 + (tid >> 6), nw = gridDim.x * 8;
    const bf16_t* ys = (const bf16_t*)(ws + WS_YS);
    for (int t = gw; t < T; t += nw) {
        float* xr = p.out + (size_t)t * DM; const bf16_t* y0 = ys + (size_t)(2 * t) * DM; const bf16_t* y1 = y0 + DM;
        bf16_t* xb = (bf16_t*)(ws + WS_XB) + (size_t)t * DM;
        float ss = 0.f;
#pragma unroll
        for (int i = 0; i < 4; ++i) {
            const int c = i * 256 + lane * 4;
            f32x4 v = *(const f32x4*)(xr + c); const u32x2 a = *(const u32x2*)(y0 + c), bq = *(const u32x2*)(y1 + c);
            v[0] += bflo(a[0]) + bflo(bq[0]); v[1] += bfhi(a[0]) + bfhi(bq[0]); v[2] += bflo(a[1]) + bflo(bq[1]); v[3] += bfhi(a[1]) + bfhi(bq[1]);
            *(f32x4*)(xr + c) = v; ss += v[0] * v[0] + v[1] * v[1] + v[2] * v[2] + v[3] * v[3];
            u32x2 o; o[0] = pk2(v[0], v[1]); o[1] = pk2(v[2], v[3]); *(u32x2*)(xb + c) = o;
        }
        ss = wave_sum(ss);
        if (lane == 0) ((float*)(ws + WS_RSTD1))[t] = __builtin_amdgcn_rsqf(ss * (1.f / 1024.f) + EPS);
    }
    if (l + 1 < NL) expert_weights(lds, p, l + 1);
}

__global__ void __launch_bounds__(NT, 2) mega(Params p) {
    extern __shared__ __attribute__((aligned(16))) unsigned char smem[];
    LAS uchar* lds = (LAS uchar*)smem;
    if (threadIdx.x == 0) { *(LAS u32x4*)(lds + LDS_XB) = (u32x4){0u, 0u, 0u, 0u}; }
    __syncthreads();
    XcdBarrier bar = xcd_barrier_post((unsigned*)(p.ws + WS_CTL), (volatile LAS unsigned*)(lds + LDS_XB));
#define IN(k) (p.ph_lo <= (k) && (k) < p.ph_hi)
#define SEAM(k) do { if (IN(k) && IN((k) + 1)) xcd_barrier(bar); } while (0)
    if (IN(0)) phase0(lds, p);
    SEAM(0);
#define LAUNDER(v) asm volatile("" : "+s"(v))
#pragma unroll 1
    for (int l0 = 0; l0 < NL; ++l0) {
        const int pb = 1 + 8 * l0;
        { int l = l0; LAUNDER(l); if (IN(pb + 0)) ph_gemm1(lds, p, l); }
        SEAM(pb + 0);
        { int l = l0; LAUNDER(l); if (IN(pb + 1)) ph_mix_a(lds, p, l); }
        SEAM(pb + 1);
        { int l = l0; LAUNDER(l); if (IN(pb + 2)) ph_mix_b(lds, p, l); }
        SEAM(pb + 2);
        { int l = l0; LAUNDER(l); if (IN(pb + 3)) ph_wout(lds, p, l); }
        SEAM(pb + 3);
        { int l = l0; LAUNDER(l); if (IN(pb + 4)) ph_router(lds, p, l); }
        SEAM(pb + 4);
        { int l = l0; LAUNDER(l); if (IN(pb + 5)) ph_gateup(lds, p, l); }
        SEAM(pb + 5);
        { int l = l0; LAUNDER(l); if (IN(pb + 6)) ph_down(lds, p, l); }
        SEAM(pb + 6);
        { int l = l0; LAUNDER(l); if (IN(pb + 7)) ph_combine(lds, p, l); }
        SEAM(pb + 7);
    }
}

extern "C" void kernel_launch(void* const* d_in, const int* in_sizes, int n_in, void* d_out, int out_size, void* d_ws, size_t ws_size, hipStream_t stream) {
    (void)in_sizes; (void)n_in; (void)out_size;
    static int grid = 0;
    if (!grid) {
        int dev = 0, cus = 0, per_cu = 0;
        hipGetDevice(&dev);
        hipDeviceGetAttribute(&cus, hipDeviceAttributeMultiprocessorCount, dev);
        hipFuncSetAttribute((const void*)mega, hipFuncAttributeMaxDynamicSharedMemorySize, LDS_BYTES);
        hipOccupancyMaxActiveBlocksPerMultiprocessor(&per_cu, (const void*)mega, NT, LDS_BYTES);
        if (per_cu > 1) per_cu = 1;
        if (per_cu < 1) per_cu = 1;
        grid = cus * per_cu;
    }
    if (ws_size < WS_END) { fprintf(stderr, "workspace too small: %zu < %zu\n", ws_size, (size_t)WS_END); return; }
    hipMemsetAsync(d_ws, 0, CTL_ZERO_BYTES, stream);
    Params p{};
    for (int i = 0; i < 26; ++i) p.in[i] = (const float*)d_in[i];
    p.out = (float*)d_out; p.ws = (unsigned char*)d_ws;
#if N_LAUNCH_SPLIT
    for (int k = 0; k < NPH; ++k) { p.ph_lo = k; p.ph_hi = k + 1; hipLaunchKernelGGL(mega, dim3(grid), dim3(NT), LDS_BYTES, stream, p); }
#else
    p.ph_lo = 0; p.ph_hi = NPH;
    hipLaunchKernelGGL(mega, dim3(grid), dim3(NT), LDS_BYTES, stream, p);
#endif
}
```

```cpp
#include <hip/hip_runtime.h>
#include <stdint.h>
#include <stdio.h>

#ifndef NAIVE_GEMM
#define NAIVE_GEMM 0
#endif
#ifndef NAIVE_ATTN
#define NAIVE_ATTN 0
#endif
#ifndef N_LAUNCH_SPLIT
#define N_LAUNCH_SPLIT 0
#endif

#define LAS __attribute__((address_space(3)))
typedef unsigned char uchar;
typedef unsigned short bf16_t;
typedef short bf16x8 __attribute__((ext_vector_type(8)));
typedef float f32x16 __attribute__((ext_vector_type(16)));
typedef float f32x2_t __attribute__((ext_vector_type(2)));
typedef __bf16 bf16x2_t __attribute__((ext_vector_type(2)));
typedef unsigned u32x4 __attribute__((ext_vector_type(4)));
typedef unsigned u32x2 __attribute__((ext_vector_type(2)));
typedef float f32x4 __attribute__((ext_vector_type(4)));

constexpr int NB = 8, S = 2048, DM = 1024, T = NB * S, NL = 2;
constexpr int NIN = 2144, NINP = 2176;
constexpr float EPS = 1e-6f, LOG2E = 1.4426950408889634f;
constexpr float QSCALE_D = 0.125f * LOG2E;
constexpr float QSCALE_M = 0.10206207261596577f * LOG2E;
constexpr int NPH = 1 + 8 * NL;

constexpr size_t MiB = (size_t)1 << 20;
constexpr size_t WS_CTL = 0, CTL_ZERO_BYTES = 32768;
constexpr size_t WS_SCAL = 1 * MiB;
constexpr size_t WS_ROPE = 1 * MiB + 64 * 1024;
constexpr size_t WS_RSTD1 = 1 * MiB + 512 * 1024;
constexpr size_t WS_RSTD2 = WS_RSTD1 + 64 * 1024;
constexpr size_t WS_GW = WS_RSTD2 + 64 * 1024;
constexpr size_t WS_LIST = 2 * MiB;
constexpr size_t WS_WIN = 4 * MiB;
constexpr size_t WS_WOUT = 13 * MiB;
constexpr size_t WS_WUQ = 17 * MiB;
constexpr size_t WS_WUKV = 17 * MiB + 512 * 1024;
constexpr size_t WS_POOLW = 17 * MiB + 768 * 1024;
constexpr size_t WS_WGU = 20 * MiB;
constexpr size_t WS_WD = 52 * MiB;
constexpr size_t WS_XB = 68 * MiB;
constexpr size_t WS_MIX = 100 * MiB;
constexpr size_t WS_HMID = WS_MIX;
constexpr size_t WS_QD = 132 * MiB, WS_KD = 148 * MiB, WS_VDT = 164 * MiB;
constexpr size_t WS_LAT = 180 * MiB;
constexpr size_t WS_QM = 200 * MiB, WS_KM = 212 * MiB, WS_VMT = 224 * MiB;
constexpr size_t WS_POOLED = 232 * MiB;
constexpr size_t WS_YS = 132 * MiB;
constexpr size_t WS_END = 240 * MiB;

#define XB_TMO      128
#define XB_XCNT(j)  (256  + 64 * (j))
#define XB_XSUB(j)  (1280 + 64 * (j))
#define XB_XGEN(j)  (2304 + 64 * (j))
#define XB_TOP      3328
#define XB_TOPGEN   3392
#define XCD_BAR_WORDS 3456
#define XB_SPIN_CAP (1u << 18)
constexpr int CW_CNT = 4096;

constexpr int NT = 512;
constexpr int LDS_XB = 147456;
constexpr int LDS_BYTES = LDS_XB + 64;
constexpr int GSTG = 49152;
constexpr int ASTG = 32768;
constexpr int MSTG = 20480;

struct Params {
    const float* in[26];
    float* out;
    unsigned char* ws;
    int ph_lo, ph_hi;
};

__device__ __forceinline__ unsigned pk2(float lo, float hi) { f32x2_t v = {lo, hi}; bf16x2_t b = __builtin_convertvector(v, bf16x2_t); return __builtin_bit_cast(unsigned, b); }
__device__ __forceinline__ float bflo(unsigned w) { return __builtin_bit_cast(float, w << 16); }
__device__ __forceinline__ float bfhi(unsigned w) { return __builtin_bit_cast(float, w & 0xffff0000u); }
__device__ __forceinline__ float bf2f(bf16_t u) { return __builtin_bit_cast(float, (unsigned)u << 16); }
__device__ __forceinline__ bf16_t f2bf(float f) { return (bf16_t)(pk2(f, 0.f) & 0xffffu); }
__device__ __forceinline__ int tid_opaque() { int t = threadIdx.x; asm volatile("" : "+v"(t)); return t; }
__device__ __forceinline__ int crow(int r, int hi) { return (r & 3) + 8 * (r >> 2) + 4 * hi; }
__device__ __forceinline__ int sigma16(int s) { return (s & ~12) | ((s & 4) << 1) | ((s & 8) >> 1); }
__device__ __forceinline__ float wave_sum(float v) {
#pragma unroll
    for (int o = 32; o >= 1; o >>= 1) v += __shfl_xor(v, o);
    return v;
}
__device__ __forceinline__ void unpack8(u32x4 w, float (&f)[8]) {
    f[0] = bflo(w[0]); f[1] = bfhi(w[0]); f[2] = bflo(w[1]); f[3] = bfhi(w[1]);
    f[4] = bflo(w[2]); f[5] = bfhi(w[2]); f[6] = bflo(w[3]); f[7] = bfhi(w[3]);
}

__device__ __forceinline__ unsigned xb_ld(unsigned* p)              { return __hip_atomic_load(p, __ATOMIC_RELAXED, __HIP_MEMORY_SCOPE_AGENT); }
__device__ __forceinline__ unsigned xb_add(unsigned* p, unsigned v) { return __hip_atomic_fetch_add(p, v, __ATOMIC_RELAXED, __HIP_MEMORY_SCOPE_AGENT); }
__device__ __forceinline__ unsigned xb_xcc_id() { return (unsigned)__builtin_amdgcn_s_getreg((3 << 11) | 20) & 0xFu; }
#define XB_SPIN(cond, bar) do { unsigned _sp = 0; while (cond) { __builtin_amdgcn_s_sleep(1); \
    if ((++_sp & 255u) == 0u) { if (xb_ld(&(bar)[XB_TMO])) break; if (_sp > XB_SPIN_CAP) { atomicAdd(&(bar)[XB_TMO], 1u); break; } } } } while (0)
struct XcdBarrier { unsigned* bar; unsigned x; volatile LAS unsigned* st; };
__device__ __forceinline__ XcdBarrier xcd_barrier_post(unsigned* bar, volatile LAS unsigned* st) {
    XcdBarrier b; b.bar = bar; b.x = xb_xcc_id(); b.st = st;
    if (threadIdx.x == 0) (void)xb_add(&bar[XB_XCNT(b.x)], 1u);
    return b;
}
__device__ __forceinline__ void xcd_barrier_complete(unsigned* bar, unsigned x, unsigned& nloc, unsigned& nx) {
    const unsigned G = gridDim.x * gridDim.y * gridDim.z;
    unsigned sum, cnt, mine, sp = 0u;
    for (;;) {
        sum = 0u; cnt = 0u; mine = 0u;
#pragma unroll
        for (unsigned j = 0; j < 16; ++j) { const unsigned c = xb_ld(&bar[XB_XCNT(j)]); sum += c; cnt += (c > 0u) ? 1u : 0u; mine = (j == x) ? c : mine; }
        if (sum == G) break;
        __builtin_amdgcn_s_sleep(1);
        if ((++sp & 255u) == 0u) { if (xb_ld(&bar[XB_TMO])) break; if (sp > XB_SPIN_CAP) { atomicAdd(&bar[XB_TMO], 1u); break; } }
    }
    nloc = mine > 0u ? mine : 1u; nx = cnt > 0u ? cnt : 1u;
}
__device__ __forceinline__ void xcd_barrier(const XcdBarrier& b) {
    asm volatile("s_waitcnt vmcnt(0)" ::: "memory");
    __syncthreads();
    if (threadIdx.x == 0) {
        unsigned* bar = b.bar;
        __builtin_amdgcn_s_waitcnt(0);
        unsigned nloc = b.st[0], nx = b.st[1];
        if (nloc == 0u) { xcd_barrier_complete(bar, b.x, nloc, nx); b.st[0] = nloc; b.st[1] = nx; }
        const unsigned old = xb_add(&bar[XB_XSUB(b.x)], 1u);
        const unsigned gen = old / nloc;
        if (old + 1u == (gen + 1u) * nloc) {
            __builtin_amdgcn_fence(__ATOMIC_RELEASE, "agent");
            asm volatile("s_waitcnt vmcnt(0)" ::: "memory");
            const unsigned og = xb_add(&bar[XB_TOP], 1u);
            const unsigned tg = og / nx;
            if (og + 1u == (tg + 1u) * nx) xb_add(&bar[XB_TOPGEN], 1u);
            else XB_SPIN(xb_ld(&bar[XB_TOPGEN]) == tg, bar);
            __builtin_amdgcn_fence(__ATOMIC_ACQUIRE, "agent");
            xb_add(&bar[XB_XGEN(b.x)], 1u);
            asm volatile("s_waitcnt vmcnt(0)" ::: "memory");
        } else {
            XB_SPIN(xb_ld(&bar[XB_XGEN(b.x)]) == gen, bar);
            __builtin_amdgcn_fence(__ATOMIC_ACQUIRE, "agent");
            asm volatile("s_waitcnt vmcnt(0)" ::: "memory");
        }
    }
    __syncthreads();
}

__device__ __forceinline__ void glds16(const void* gsrc, LAS uchar* dst_wave_base) {
    __builtin_amdgcn_global_load_lds((const unsigned*)gsrc, (LAS unsigned*)dst_wave_base, 16, 0, 0);
}
__device__ __forceinline__ int sw128(int row, int c) { return row * 128 + ((c ^ ((row >> 1) & 7)) << 4); }
__device__ __forceinline__ int sw64(int row, int c) { return row * 64 + ((c ^ ((row >> 2) & 3)) << 4); }

#define MFMA32(a, b, c) __builtin_amdgcn_mfma_f32_32x32x16_bf16((a), (b), (c), 0, 0, 0)

constexpr int CT_PITCH = 272;
#define WAITV(n) asm volatile("s_waitcnt vmcnt(" #n ")" ::: "memory")
struct ARowLinear { const bf16_t* base; size_t ld; __device__ __forceinline__ const bf16_t* operator()(int r) const { return base + (size_t)r * ld; } };
struct ARowGather { const bf16_t* base; const unsigned* list; int nvalid; __device__ __forceinline__ const bf16_t* operator()(int r) const {
    const int rr = r < nvalid ? r : nvalid - 1; const unsigned ent = list[rr]; return base + (size_t)(ent >> 1) * DM; } };

template <class ARow, class Epi>
__device__ __forceinline__ void gemm_tile(LAS uchar* lds, const ARow& arow, const bf16_t* Bt, size_t ldb, int K, const Epi& epi) {
    const int tid = tid_opaque(), lane = tid & 63, wid = __builtin_amdgcn_readfirstlane(tid >> 6);
#if NAIVE_GEMM
    {
        const int r = tid >> 1, nh = tid & 1;
        float acc[64];
#pragma unroll
        for (int n = 0; n < 64; ++n) acc[n] = 0.f;
        const bf16_t* ar = arow(r);
        for (int k = 0; k < K; k += 8) {
            float a[8]; unpack8(*(const u32x4*)(ar + k), a);
#pragma unroll
            for (int n = 0; n < 64; ++n) {
                float b[8]; unpack8(*(const u32x4*)(Bt + (size_t)(nh * 64 + n) * ldb + k), b);
#pragma unroll
                for (int j = 0; j < 8; ++j) acc[n] += a[j] * b[j];
            }
        }
        __syncthreads();
#pragma unroll
        for (int n = 0; n < 64; n += 2) *(LAS unsigned*)(lds + r * CT_PITCH + (nh * 64 + n) * 2) = pk2(acc[n], acc[n + 1]);
    }
#else
    {
        const int wm = wid >> 1, wn = wid & 1, r = lane & 31, hh = lane >> 5;
        const int srow = lane >> 3, c0 = (lane & 7) ^ (srow >> 1);
        const bf16_t* asrc[4];
#pragma unroll
        for (int j = 0; j < 4; ++j) asrc[j] = arow(8 * (wid * 4 + j) + srow) + (c0 ^ ((j & 1) << 2)) * 8;
        const bf16_t* bsrc0 = Bt + (size_t)(wid * 16 + srow) * ldb + c0 * 8;
        const bf16_t* bsrc1 = Bt + (size_t)(wid * 16 + 8 + srow) * ldb + (c0 ^ 4) * 8;
        const int lanebase = r * 128 + ((hh ^ ((r >> 1) & 7)) << 4);
        f32x16 acc[2][2];
#pragma unroll
        for (int a = 0; a < 2; ++a)
#pragma unroll
            for (int b = 0; b < 2; ++b)
#pragma unroll
                for (int i = 0; i < 16; ++i) acc[a][b][i] = 0.f;
        const int nt = K >> 6;
#define GT_STAGE(kt, sb) do { _Pragma("unroll") for (int j = 0; j < 4; ++j) \
            glds16(asrc[j] + (kt) * 64, lds + (sb) * GSTG + (wid * 4 + j) * 1024); \
            glds16(bsrc0 + (kt) * 64, lds + (sb) * GSTG + 32768 + (wid * 2) * 1024); \
            glds16(bsrc1 + (kt) * 64, lds + (sb) * GSTG + 32768 + (wid * 2 + 1) * 1024); } while (0)
        GT_STAGE(0, 0);
        if (nt > 1) GT_STAGE(1, 1);
        int sb = 0;
        for (int kt = 0; kt < nt; ++kt) {
            if (kt + 1 < nt) WAITV(6); else WAITV(0);
            __builtin_amdgcn_s_barrier();
            if (kt + 2 < nt) { const int sn = sb >= 1 ? sb - 1 : 2; GT_STAGE(kt + 2, sn); }
            const LAS uchar* xs = lds + sb * GSTG + wm * 8192; const LAS uchar* wsb = lds + sb * GSTG + 32768 + wn * 8192;
#pragma unroll
            for (int ks = 0; ks < 4; ++ks) {
                const int lb = lanebase ^ (ks << 5);
                bf16x8 xf[2], wf[2];
#pragma unroll
                for (int mb = 0; mb < 2; ++mb) xf[mb] = *(const LAS bf16x8*)(xs + mb * 4096 + lb);
#pragma unroll
                for (int nb = 0; nb < 2; ++nb) wf[nb] = *(const LAS bf16x8*)(wsb + nb * 4096 + lb);
#pragma unroll
                for (int nb = 0; nb < 2; ++nb)
#pragma unroll
                    for (int mb = 0; mb < 2; ++mb) acc[nb][mb] = MFMA32(wf[nb], xf[mb], acc[nb][mb]);
            }
            sb = sb == 2 ? 0 : sb + 1;
        }
#undef GT_STAGE
        __syncthreads();
#pragma unroll
        for (int nb = 0; nb < 2; ++nb)
#pragma unroll
            for (int mb = 0; mb < 2; ++mb) {
                const int m = 64 * wm + 32 * mb + r;
#pragma unroll
                for (int q4 = 0; q4 < 4; ++q4) {
                    const int n = 64 * wn + 32 * nb + 8 * q4 + 4 * hh;
                    u32x2 v; v[0] = pk2(acc[nb][mb][4 * q4], acc[nb][mb][4 * q4 + 1]); v[1] = pk2(acc[nb][mb][4 * q4 + 2], acc[nb][mb][4 * q4 + 3]);
                    *(LAS u32x2*)(lds + m * CT_PITCH + n * 2) = v;
                }
            }
    }
#endif
    __syncthreads();
    epi(lds);
    __syncthreads();
}
__device__ __forceinline__ u32x4 ct_ld8(const LAS uchar* ct, int r, int c) { return *(const LAS u32x4*)(ct + r * CT_PITCH + c * 2); }
__device__ __forceinline__ float ct_ld1(const LAS uchar* ct, int r, int c) { return bf2f(*(const LAS bf16_t*)(ct + r * CT_PITCH + c * 2)); }

struct EpiProj {
    int mt, nt, l; const Params* p;
    __device__ __forceinline__ void operator()(const LAS uchar* ct) const {
        uchar* ws = p->ws; const int tid = tid_opaque();
        const float* rstd1 = (const float*)(ws + WS_RSTD1);
        const int t0 = mt * 256, b = t0 >> 11, s0 = t0 & 2047;
        if (nt < 8) {
            const int r = tid >> 1, j = tid & 1, h = nt & 3; const bool isq = nt < 4;
            const float rs = rstd1[t0 + r];
            const float* g = p->in[isq ? 3 : 4] + l * 64;
            float v[64]; float ss = 0.f;
#pragma unroll
            for (int c8 = 0; c8 < 8; ++c8) { float f[8]; unpack8(ct_ld8(ct, r, j * 64 + c8 * 8), f);
#pragma unroll
                for (int i = 0; i < 8; ++i) { const float x = f[i] * rs; v[c8 * 8 + i] = x; ss += x * x; } }
            const float rn = __builtin_amdgcn_rsqf(ss * (1.f / 64.f) + EPS) * (isq ? QSCALE_D : 1.f);
            bf16_t* dst = (bf16_t*)(ws + (isq ? WS_QD : WS_KD)) + ((((size_t)b * 4 + h) * 2 + j) * S + (s0 + r)) * 64;
#pragma unroll
            for (int c8 = 0; c8 < 8; ++c8) { u32x4 o;
#pragma unroll
                for (int i = 0; i < 4; ++i) o[i] = pk2(v[c8 * 8 + 2 * i] * rn * g[c8 * 8 + 2 * i], v[c8 * 8 + 2 * i + 1] * rn * g[c8 * 8 + 2 * i + 1]);
                *(u32x4*)(dst + c8 * 8) = o; }
        } else if (nt < 12) {
            const int h = nt - 8, d = tid >> 2, half = tid & 3;
            bf16_t* dst = (bf16_t*)(ws + WS_VDT) + (((size_t)b * 4 + h) * 128 + d) * S + s0 + half * 64;
#pragma unroll
            for (int c8 = 0; c8 < 8; ++c8) { u32x4 o;
#pragma unroll
                for (int i = 0; i < 4; ++i) {
                    const int p0 = c8 * 8 + 2 * i, r0 = half * 64 + sigma16(p0), r1 = half * 64 + sigma16(p0 + 1);
                    o[i] = pk2(ct_ld1(ct, r0, d) * rstd1[t0 + r0], ct_ld1(ct, r1, d) * rstd1[t0 + r1]); }
                *(u32x4*)(dst + c8 * 8) = o; }
        } else {
            const int r = tid >> 1, j = tid & 1; const float rs = rstd1[t0 + r];
            bf16_t* dst = (bf16_t*)(ws + WS_LAT) + (size_t)(t0 + r) * 640 + (nt - 12) * 128 + j * 64;
#pragma unroll
            for (int c8 = 0; c8 < 8; ++c8) { float f[8]; unpack8(ct_ld8(ct, r, j * 64 + c8 * 8), f); u32x4 o;
#pragma unroll
                for (int i = 0; i < 4; ++i) o[i] = pk2(f[2 * i] * rs, f[2 * i + 1] * rs);
                *(u32x4*)(dst + c8 * 8) = o; }
        }
    }
};

__device__ __forceinline__ float lat_rstd(const bf16_t* seg, int n) {
    float ss = 0.f;
    for (int k = 0; k < n; k += 8) { float f[8]; unpack8(*(const u32x4*)(seg + k), f);
#pragma unroll
        for (int i = 0; i < 8; ++i) ss += f[i] * f[i]; }
    return __builtin_amdgcn_rsqf(ss / (float)n + EPS);
}
__device__ __forceinline__ void norm_rope32(float (&y)[32], const float* g, const float* cosr, const float* sinr, float outscale) {
    float ss = 0.f;
#pragma unroll
    for (int i = 0; i < 32; ++i) ss += y[i] * y[i];
    const float rn = __builtin_amdgcn_rsqf(ss * (1.f / 32.f) + EPS);
#pragma unroll
    for (int i = 0; i < 32; ++i) y[i] = y[i] * rn * g[i];
#pragma unroll
    for (int i = 0; i < 16; ++i) { const float c = cosr[i], sn = sinr[i], x1 = y[i], x2 = y[16 + i];
        y[i] = (x1 * c - x2 * sn) * outscale; y[16 + i] = (x2 * c + x1 * sn) * outscale; }
}

struct EpiMlaQ {
    int mt, h, l; const Params* p;
    __device__ __forceinline__ void operator()(const LAS uchar* ct) const {
        uchar* ws = p->ws; const int tid = tid_opaque(), r = tid >> 1, j = tid & 1;
        const int t = mt * 256 + r, b = t >> 11, s = t & 2047;
        const bf16_t* lat = (const bf16_t*)(ws + WS_LAT) + (size_t)t * 640;
        const float rs = lat_rstd(lat, 192);
        bf16_t* dst = (bf16_t*)(ws + WS_QM) + (((size_t)b * 4 + h) * S + s) * 96;
        if (j == 0) {
            const float* g = p->in[11] + l * 64;
            float v[64]; float ss = 0.f;
#pragma unroll
            for (int c8 = 0; c8 < 8; ++c8) { float f[8]; unpack8(ct_ld8(ct, r, c8 * 8), f);
#pragma unroll
                for (int i = 0; i < 8; ++i) { const float x = f[i] * rs; v[c8 * 8 + i] = x; ss += x * x; } }
            const float rn = __builtin_amdgcn_rsqf(ss * (1.f / 64.f) + EPS) * QSCALE_M;
#pragma unroll
            for (int c8 = 0; c8 < 8; ++c8) { u32x4 o;
#pragma unroll
                for (int i = 0; i < 4; ++i) o[i] = pk2(v[c8 * 8 + 2 * i] * rn * g[c8 * 8 + 2 * i], v[c8 * 8 + 2 * i + 1] * rn * g[c8 * 8 + 2 * i + 1]);
                *(u32x4*)(dst + c8 * 8) = o; }
        } else {
            float y[32];
#pragma unroll
            for (int c8 = 0; c8 < 4; ++c8) { float f[8]; unpack8(ct_ld8(ct, r, 64 + c8 * 8), f);
#pragma unroll
                for (int i = 0; i < 8; ++i) y[c8 * 8 + i] = f[i] * rs; }
            const float* cosr = (const float*)(ws + WS_ROPE) + s * 16; const float* sinr = cosr + S * 16;
            norm_rope32(y, p->in[12] + l * 32, cosr, sinr, QSCALE_M);
#pragma unroll
            for (int c8 = 0; c8 < 4; ++c8) { u32x4 o;
#pragma unroll
                for (int i = 0; i < 4; ++i) o[i] = pk2(y[c8 * 8 + 2 * i], y[c8 * 8 + 2 * i + 1]);
                *(u32x4*)(dst + 64 + c8 * 8) = o; }
        }
    }
};
struct EpiMlaKV {
    int mt, h, l; const Params* p;
    __device__ __forceinline__ void operator()(const LAS uchar* ct) const {
        uchar* ws = p->ws; const int tid = tid_opaque(), r = tid >> 1, j = tid & 1;
        const int t0 = mt * 256, t = t0 + r, b = t >> 11, s = t & 2047, s0 = t0 & 2047;
        const bf16_t* lat = (const bf16_t*)(ws + WS_LAT) + (size_t)t * 640;
        LAS float* shr = (LAS float*)(ct + 256 * CT_PITCH);
        bf16_t* dstk = (bf16_t*)(ws + WS_KM) + (((size_t)b * 4 + h) * S + s) * 96;
        if (j == 0) {
            const float rs = lat_rstd(lat + 192, 128);
            shr[r] = rs;
            const float* g = p->in[13] + l * 64;
            float v[64]; float ss = 0.f;
#pragma unroll
            for (int c8 = 0; c8 < 8; ++c8) { float f[8]; unpack8(ct_ld8(ct, r, c8 * 8), f);
#pragma unroll
                for (int i = 0; i < 8; ++i) { const float x = f[i] * rs; v[c8 * 8 + i] = x; ss += x * x; } }
            const float rn = __builtin_amdgcn_rsqf(ss * (1.f / 64.f) + EPS);
#pragma unroll
            for (int c8 = 0; c8 < 8; ++c8) { u32x4 o;
#pragma unroll
                for (int i = 0; i < 4; ++i) o[i] = pk2(v[c8 * 8 + 2 * i] * rn * g[c8 * 8 + 2 * i], v[c8 * 8 + 2 * i + 1] * rn * g[c8 * 8 + 2 * i + 1]);
                *(u32x4*)(dstk + c8 * 8) = o; }
        } else {
            float y[32];
#pragma unroll
            for (int c8 = 0; c8 < 4; ++c8) { float f[8]; unpack8(*(const u32x4*)(lat + 320 + c8 * 8), f);
#pragma unroll
                for (int i = 0; i < 8; ++i) y[c8 * 8 + i] = f[i]; }
            const float* cosr = (const float*)(ws + WS_ROPE) + s * 16; const float* sinr = cosr + S * 16;
            norm_rope32(y, p->in[14] + l * 32, cosr, sinr, 1.f);
#pragma unroll
            for (int c8 = 0; c8 < 4; ++c8) { u32x4 o;
#pragma unroll
                for (int i = 0; i < 4; ++i) o[i] = pk2(y[c8 * 8 + 2 * i], y[c8 * 8 + 2 * i + 1]);
                *(u32x4*)(dstk + 64 + c8 * 8) = o; }
        }
        __syncthreads();
        {
            const int d = tid >> 3, q4 = tid & 7;
            bf16_t* dst = (bf16_t*)(ws + WS_VMT) + (((size_t)b * 4 + h) * 64 + d) * S + s0 + q4 * 32;
#pragma unroll
            for (int c8 = 0; c8 < 4; ++c8) { u32x4 o;
#pragma unroll
                for (int i = 0; i < 4; ++i) {
                    const int p0 = c8 * 8 + 2 * i, r0 = q4 * 32 + sigma16(p0), r1 = q4 * 32 + sigma16(p0 + 1);
                    o[i] = pk2(ct_ld1(ct, r0, 64 + d) * shr[r0], ct_ld1(ct, r1, 64 + d) * shr[r1]); }
                *(u32x4*)(dst + c8 * 8) = o; }
        }
    }
};
struct EpiPool {
    int mt, g, l; const Params* p;
    __device__ __forceinline__ void operator()(const LAS uchar* ct) const {
        uchar* ws = p->ws; const int tid = tid_opaque(), r = tid >> 1, j = tid & 1;
        const float* sc = p->in[16] + l * 256 + g * 64 + j * 32;
        bf16_t* dst = (bf16_t*)(ws + WS_MIX) + (size_t)(mt * 256 + r) * DM + 768 + g * 64 + j * 32;
#pragma unroll
        for (int c8 = 0; c8 < 4; ++c8) { float f[8]; unpack8(ct_ld8(ct, r, j * 32 + c8 * 8), f); u32x4 o;
#pragma unroll
            for (int i = 0; i < 4; ++i) o[i] = pk2(f[2 * i] * sc[c8 * 8 + 2 * i], f[2 * i + 1] * sc[c8 * 8 + 2 * i + 1]);
            *(u32x4*)(dst + c8 * 8) = o; }
    }
};
struct EpiWout {
    int mt, nt; const float* xres; const Params* p;
    __device__ __forceinline__ void operator()(const LAS uchar* ct) const {
        uchar* ws = p->ws; const int tid = tid_opaque(), r = tid >> 1, j = tid & 1;
        const size_t off = (size_t)(mt * 256 + r) * DM + nt * 128 + j * 64;
        const float* xr = xres + off; float* o32 = p->out + off; bf16_t* ob = (bf16_t*)(ws + WS_XB) + off;
#pragma unroll
        for (int c8 = 0; c8 < 8; ++c8) { float f[8]; unpack8(ct_ld8(ct, r, j * 64 + c8 * 8), f);
            const f32x4 x0 = *(const f32x4*)(xr + c8 * 8), x1 = *(const f32x4*)(xr + c8 * 8 + 4);
            f32x4 y0, y1;
#pragma unroll
            for (int i = 0; i < 4; ++i) { y0[i] = x0[i] + f[i]; y1[i] = x1[i] + f[4 + i]; }
            *(f32x4*)(o32 + c8 * 8) = y0; *(f32x4*)(o32 + c8 * 8 + 4) = y1;
            u32x4 o; o[0] = pk2(y0[0], y0[1]); o[1] = pk2(y0[2], y0[3]); o[2] = pk2(y1[0], y1[1]); o[3] = pk2(y1[2], y1[3]);
            *(u32x4*)(ob + c8 * 8) = o; }
    }
};
struct EpiGU {
    int jt, nvalid; const unsigned* list; size_t slot0; const Params* p;
    __device__ __forceinline__ void operator()(const LAS uchar* ct) const {
        uchar* ws = p->ws; const int tid = tid_opaque(), r = tid >> 1, hf = tid & 1;
        const int rr = r < nvalid ? r : nvalid - 1;
        const float rs = ((const float*)(ws + WS_RSTD2))[list[rr] >> 1];
        bf16_t* dst = (bf16_t*)(ws + WS_HMID) + (slot0 + r) * 256 + jt * 64 + hf * 32;
#pragma unroll
        for (int c8 = 0; c8 < 4; ++c8) { float g[8], u[8]; unpack8(ct_ld8(ct, r, hf * 32 + c8 * 8), g); unpack8(ct_ld8(ct, r, 64 + hf * 32 + c8 * 8), u);
            float hv[8];
#pragma unroll
            for (int i = 0; i < 8; ++i) { const float gg = g[i] * rs, uu = u[i] * rs; hv[i] = gg * __builtin_amdgcn_rcpf(1.f + __builtin_amdgcn_exp2f(-gg * LOG2E)) * uu; }
            u32x4 o; o[0] = pk2(hv[0], hv[1]); o[1] = pk2(hv[2], hv[3]); o[2] = pk2(hv[4], hv[5]); o[3] = pk2(hv[6], hv[7]);
            *(u32x4*)(dst + c8 * 8) = o; }
    }
};
struct EpiDown {
    int nt, nvalid; const unsigned* list; const Params* p;
    __device__ __forceinline__ void operator()(const LAS uchar* ct) const {
        uchar* ws = p->ws; const int tid = tid_opaque(), r = tid >> 1, j = tid & 1;
        if (r < nvalid) {
            const unsigned ent = list[r]; const float w = ((const float*)(ws + WS_GW))[ent];
            bf16_t* dst = (bf16_t*)(ws + WS_YS) + (size_t)ent * DM + nt * 128 + j * 64;
#pragma unroll
            for (int c8 = 0; c8 < 8; ++c8) { float f[8]; unpack8(ct_ld8(ct, r, j * 64 + c8 * 8), f); u32x4 o;
#pragma unroll
                for (int i = 0; i < 4; ++i) o[i] = pk2(f[2 * i] * w, f[2 * i + 1] * w);
                *(u32x4*)(dst + c8 * 8) = o; }
        }
    }
};

__device__ __forceinline__ void diff_attn_unit(LAS uchar* lds, const Params& p, int l, int unit) {
    uchar* ws = p.ws;
    const int tid = tid_opaque(), lane = tid & 63, wid = __builtin_amdgcn_readfirstlane(tid >> 6);
    const int qb = unit & 15, h = (unit >> 4) & 3, b = unit >> 6;
    const float* scal = (const float*)(ws + WS_SCAL) + 16 * l;
    const float lam = scal[0], oml = scal[1], m2 = scal[2];
    const float slope2 = exp2f(-2.f * (float)(h + 1)) * LOG2E;
    const bf16_t* Q1 = (const bf16_t*)(ws + WS_QD) + (((size_t)b * 4 + h) * 2) * S * 64;
    const bf16_t* K1 = (const bf16_t*)(ws + WS_KD) + (((size_t)b * 4 + h) * 2) * S * 64;
    const bf16_t* VT = (const bf16_t*)(ws + WS_VDT) + (((size_t)b * 4 + h) * 128) * S;
    const float* gsub = p.in[6] + l * 128;
    bf16_t* mix = (bf16_t*)(ws + WS_MIX);
#if NAIVE_ATTN
    {
        const int q = qb * 128 + (tid >> 2), mm = (tid >> 1) & 1, dh = tid & 1;
        const bf16_t* Qp = Q1 + (size_t)mm * S * 64 + (size_t)q * 64; const bf16_t* Kp = K1 + (size_t)mm * S * 64;
        float qv[64];
#pragma unroll
        for (int c8 = 0; c8 < 8; ++c8) { float f[8]; unpack8(*(const u32x4*)(Qp + c8 * 8), f);
#pragma unroll
            for (int i = 0; i < 8; ++i) qv[c8 * 8 + i] = f[i]; }
        float o[64]; float lsum = 0.f;
#pragma unroll
        for (int d = 0; d < 64; ++d) o[d] = 0.f;
        for (int key = 0; key < S; ++key) {
            float sc = 0.f;
#pragma unroll
            for (int c8 = 0; c8 < 8; ++c8) { float f[8]; unpack8(*(const u32x4*)(Kp + (size_t)key * 64 + c8 * 8), f);
#pragma unroll
                for (int i = 0; i < 8; ++i) sc += qv[c8 * 8 + i] * f[i]; }
            const float pv = __builtin_amdgcn_exp2f(sc - slope2 * fabsf((float)(q - key)) - m2);
            lsum += pv;
            const int kp = sigma16(key);
#pragma unroll
            for (int d = 0; d < 64; ++d) o[d] += pv * bf2f(VT[(size_t)(dh * 64 + d) * S + kp]);
        }
        const float inv = 1.f / lsum; float ss = 0.f;
#pragma unroll
        for (int d = 0; d < 64; ++d) { const float mine = o[d] * inv; const float other = __shfl_xor(mine, 2); o[d] = mine - lam * other; ss += o[d] * o[d]; }
        ss += __shfl_xor(ss, 1);
        if (mm == 0) {
            const float rn = __builtin_amdgcn_rsqf(ss * (1.f / 128.f) + EPS) * oml;
            bf16_t* dst = mix + (size_t)(b * S + q) * DM + h * 128 + dh * 64;
#pragma unroll
            for (int d = 0; d < 64; d += 2) *(unsigned*)(dst + d) = pk2(o[d] * rn * gsub[dh * 64 + d], o[d + 1] * rn * gsub[dh * 64 + d + 1]);
        }
    }
#else
    {
        const int r = lane & 31, hh = lane >> 5, qs = wid >> 1, mm = wid & 1, qpos = qb * 128 + qs * 32 + r;
        const bf16_t* Qm_ = Q1 + (size_t)mm * S * 64;
        bf16x8 qf[4];
#pragma unroll
        for (int ks = 0; ks < 4; ++ks) qf[ks] = *(const bf16x8*)(Qm_ + (size_t)qpos * 64 + ks * 16 + hh * 8);
        f32x16 O[4]; float lsum = 0.f;
#pragma unroll
        for (int db = 0; db < 4; ++db)
#pragma unroll
            for (int i = 0; i < 16; ++i) O[db][i] = 0.f;
        const int srow = lane >> 3, c0 = (lane & 7) ^ (srow >> 1);
        const bool isk = wid < 4;
        const bf16_t* sbase = isk ? (K1 + (size_t)(wid >> 1) * S * 64 + (size_t)(wid & 1) * 32 * 64) : (VT + (size_t)(wid - 4) * 32 * S);
        const int rstride = isk ? 64 : S, kstride = isk ? 64 * 64 : 64;
        const bf16_t* sb0 = sbase + (size_t)srow * rstride + c0 * 8;
        const bf16_t* sb1 = sbase + (size_t)srow * rstride + (c0 ^ 4) * 8;
        const int lanebase = r * 128 + ((hh ^ ((r >> 1) & 7)) << 4);
#define DA_STAGE(kt, sbuf) do { _Pragma("unroll") for (int j = 0; j < 4; ++j) \
            glds16(((j & 1) ? sb1 : sb0) + (size_t)(8 * j) * rstride + (size_t)(kt) * kstride, lds + (sbuf) * ASTG + (wid * 4 + j) * 1024); } while (0)
        DA_STAGE(0, 0); DA_STAGE(1, 1);
        int sb = 0;
        const int kq0 = 4 * hh - qpos;
        for (int kt = 0; kt < S / 64; ++kt) {
            if (kt + 1 < S / 64) WAITV(4); else WAITV(0);
            __builtin_amdgcn_s_barrier();
            if (kt + 2 < S / 64) { const int sn = sb >= 1 ? sb - 1 : 2; DA_STAGE(kt + 2, sn); }
            const LAS uchar* st = lds + sb * ASTG;
#pragma unroll
            for (int kb = 0; kb < 2; ++kb) {
                f32x16 sacc;
#pragma unroll
                for (int i = 0; i < 16; ++i) sacc[i] = 0.f;
#pragma unroll
                for (int ks = 0; ks < 4; ++ks) {
                    const bf16x8 kf = *(const LAS bf16x8*)(st + mm * 8192 + kb * 4096 + (lanebase ^ (ks << 5)));
                    sacc = MFMA32(kf, qf[ks], sacc);
                }
                const int kbase = kt * 64 + 32 * kb + kq0;
                float ls = 0.f;
#pragma unroll
                for (int i = 0; i < 16; ++i) {
                    const float dist = fabsf((float)(kbase + (i & 3) + 8 * (i >> 2)));
                    const float pv = __builtin_amdgcn_exp2f(sacc[i] - slope2 * dist - m2);
                    ls += pv; sacc[i] = pv;
                }
                lsum += ls;
                bf16x8 pb[2];
#pragma unroll
                for (int s2 = 0; s2 < 2; ++s2) {
                    u32x4 w;
#pragma unroll
                    for (int i = 0; i < 4; ++i) w[i] = pk2(sacc[8 * s2 + 2 * i], sacc[8 * s2 + 2 * i + 1]);
                    pb[s2] = __builtin_bit_cast(bf16x8, w);
                }
#pragma unroll
                for (int db = 0; db < 4; ++db)
#pragma unroll
                    for (int s2 = 0; s2 < 2; ++s2) {
                        const bf16x8 vf = *(const LAS bf16x8*)(st + 16384 + db * 4096 + (lanebase ^ ((2 * kb + s2) << 5)));
                        O[db] = MFMA32(vf, pb[s2], O[db]);
                    }
            }
            sb = sb == 2 ? 0 : sb + 1;
        }
#undef DA_STAGE
        const float lt = lsum + __shfl_xor(lsum, 32);
        const float sc = (mm == 0) ? (1.f / lt) : (lam / lt);
        __syncthreads();
        LAS float* xch = (LAS float*)lds + qs * 4096;
        if (mm == 1) {
#pragma unroll
            for (int db = 0; db < 4; ++db)
#pragma unroll
                for (int i = 0; i < 16; ++i) xch[(db * 16 + i) * 64 + lane] = O[db][i] * sc;
        }
        __syncthreads();
        if (mm == 0) {
            float ss = 0.f;
#pragma unroll
            for (int db = 0; db < 4; ++db)
#pragma unroll
                for (int i = 0; i < 16; ++i) { const float o = O[db][i] * sc - xch[(db * 16 + i) * 64 + lane]; O[db][i] = o; ss += o * o; }
            ss += __shfl_xor(ss, 32);
            const float rn = __builtin_amdgcn_rsqf(ss * (1.f / 128.f) + EPS) * oml;
            bf16_t* dst = mix + (size_t)(b * S + qpos) * DM + h * 128;
#pragma unroll
            for (int db = 0; db < 4; ++db)
#pragma unroll
                for (int q4 = 0; q4 < 4; ++q4) {
                    const int d = 32 * db + 8 * q4 + 4 * hh;
                    const f32x4 g = *(const f32x4*)(gsub + d);
                    u32x2 w; w[0] = pk2(O[db][4 * q4] * rn * g[0], O[db][4 * q4 + 1] * rn * g[1]);
                    w[1] = pk2(O[db][4 * q4 + 2] * rn * g[2], O[db][4 * q4 + 3] * rn * g[3]);
                    *(u32x2*)(dst + d) = w;
                }
        }
    }
#endif
    __syncthreads();
}

__device__ __forceinline__ void mla_attn_unit(LAS uchar* lds, const Params& p, int l, int unit) {
    uchar* ws = p.ws;
    const int tid = tid_opaque(), lane = tid & 63, wid = __builtin_amdgcn_readfirstlane(tid >> 6);
    const int qb = unit & 7, h = (unit >> 3) & 3, b = unit >> 5;
    const float m2 = ((const float*)(ws + WS_SCAL))[16 * l + 3];
    const bf16_t* Q = (const bf16_t*)(ws + WS_QM) + (((size_t)b * 4 + h) * S) * 96;
    const bf16_t* Kp = (const bf16_t*)(ws + WS_KM) + (((size_t)b * 4 + h) * S) * 96;
    const bf16_t* VT = (const bf16_t*)(ws + WS_VMT) + (((size_t)b * 4 + h) * 64) * S;
    bf16_t* mix = (bf16_t*)(ws + WS_MIX);
#if NAIVE_ATTN
    {
        const int q = qb * 256 + (tid >> 1), hf = tid & 1;
        float qv[96];
#pragma unroll
        for (int c8 = 0; c8 < 12; ++c8) { float f[8]; unpack8(*(const u32x4*)(Q + (size_t)q * 96 + c8 * 8), f);
#pragma unroll
            for (int i = 0; i < 8; ++i) qv[c8 * 8 + i] = f[i]; }
        float o[32]; float lsum = 0.f;
#pragma unroll
        for (int d = 0; d < 32; ++d) o[d] = 0.f;
        for (int key = 0; key < S; ++key) {
            float sc = 0.f;
#pragma unroll
            for (int c8 = 0; c8 < 12; ++c8) { float f[8]; unpack8(*(const u32x4*)(Kp + (size_t)key * 96 + c8 * 8), f);
#pragma unroll
                for (int i = 0; i < 8; ++i) sc += qv[c8 * 8 + i] * f[i]; }
            const float pv = __builtin_amdgcn_exp2f(sc - m2);
            lsum += pv;
            const int kp = sigma16(key);
#pragma unroll
            for (int d = 0; d < 32; ++d) o[d] += pv * bf2f(VT[(size_t)(hf * 32 + d) * S + kp]);
        }
        const float inv = 1.f / lsum;
        bf16_t* dst = mix + (size_t)(b * S + q) * DM + 512 + h * 64 + hf * 32;
#pragma unroll
        for (int d = 0; d < 32; d += 2) *(unsigned*)(dst + d) = pk2(o[d] * inv, o[d + 1] * inv);
    }
#else
    {
        const int r = lane & 31, hh = lane >> 5, qpos = qb * 256 + wid * 32 + r;
        bf16x8 qf[6];
#pragma unroll
        for (int ks = 0; ks < 6; ++ks) qf[ks] = *(const bf16x8*)(Q + (size_t)qpos * 96 + ks * 16 + hh * 8);
        f32x16 O[2]; float lsum = 0.f;
#pragma unroll
        for (int db = 0; db < 2; ++db)
#pragma unroll
            for (int i = 0; i < 16; ++i) O[db][i] = 0.f;
        const int lanebase = r * 128 + ((hh ^ ((r >> 1) & 7)) << 4), lanebase64 = r * 64 + ((hh ^ ((r >> 2) & 3)) << 4);
        const bool lo4 = wid < 4;
        const bf16_t* s0p; const bf16_t* s1p; const bf16_t* s2p;
        {
            const int srow = lane >> 3;
            { const int row = 8 * wid + srow; const int c = (lane & 7) ^ ((row >> 1) & 7); s0p = Kp + (size_t)row * 96 + c * 8; }
            if (lo4) { const int row = 16 * wid + (lane >> 2); const int c = (lane & 3) ^ ((row >> 2) & 3); s1p = Kp + (size_t)row * 96 + 64 + c * 8; }
            else { const int row = 8 * (wid - 4) + srow; const int c = (lane & 7) ^ ((row >> 1) & 7); s1p = VT + (size_t)row * S + c * 8; }
            { const int row = 8 * ((wid & 3) + 4) + srow; const int c = (lane & 7) ^ ((row >> 1) & 7); s2p = VT + (size_t)row * S + c * 8; }
        }
        const int k1stride = lo4 ? 64 * 96 : 64;
#define MA_STAGE(kt, sbuf) do { \
            glds16(s0p + (size_t)(kt) * (64 * 96), lds + (sbuf) * MSTG + wid * 1024); \
            glds16(s1p + (size_t)(kt) * k1stride, lds + (sbuf) * MSTG + (wid + 8) * 1024); \
            if (lo4) glds16(s2p + (size_t)(kt) * 64, lds + (sbuf) * MSTG + (wid + 16) * 1024); } while (0)
        MA_STAGE(0, 0); MA_STAGE(1, 1);
        int sb = 0;
        for (int kt = 0; kt < S / 64; ++kt) {
            if (kt + 1 < S / 64) { if (lo4) WAITV(3); else WAITV(2); } else WAITV(0);
            __builtin_amdgcn_s_barrier();
            if (kt + 2 < S / 64) { const int sn = sb >= 1 ? sb - 1 : 2; MA_STAGE(kt + 2, sn); }
            const LAS uchar* st = lds + sb * MSTG;
#pragma unroll
            for (int kb = 0; kb < 2; ++kb) {
                f32x16 sacc;
#pragma unroll
                for (int i = 0; i < 16; ++i) sacc[i] = -m2;
#pragma unroll
                for (int ks = 0; ks < 4; ++ks) {
                    const bf16x8 kf = *(const LAS bf16x8*)(st + kb * 4096 + (lanebase ^ (ks << 5)));
                    sacc = MFMA32(kf, qf[ks], sacc);
                }
#pragma unroll
                for (int ks = 0; ks < 2; ++ks) {
                    const bf16x8 kf = *(const LAS bf16x8*)(st + 8192 + kb * 2048 + (lanebase64 ^ (ks << 5)));
                    sacc = MFMA32(kf, qf[4 + ks], sacc);
                }
                float ls = 0.f;
#pragma unroll
                for (int i = 0; i < 16; ++i) { const float pv = __builtin_amdgcn_exp2f(sacc[i]); ls += pv; sacc[i] = pv; }
                lsum += ls;
                bf16x8 pb[2];
#pragma unroll
                for (int s2 = 0; s2 < 2; ++s2) {
                    u32x4 w;
#pragma unroll
                    for (int i = 0; i < 4; ++i) w[i] = pk2(sacc[8 * s2 + 2 * i], sacc[8 * s2 + 2 * i + 1]);
                    pb[s2] = __builtin_bit_cast(bf16x8, w);
                }
#pragma unroll
                for (int db = 0; db < 2; ++db)
#pragma unroll
                    for (int s2 = 0; s2 < 2; ++s2) {
                        const bf16x8 vf = *(const LAS bf16x8*)(st + 12288 + db * 4096 + (lanebase ^ ((2 * kb + s2) << 5)));
                        O[db] = MFMA32(vf, pb[s2], O[db]);
                    }
            }
            sb = sb == 2 ? 0 : sb + 1;
        }
#undef MA_STAGE
        const float lt = lsum + __shfl_xor(lsum, 32); const float inv = 1.f / lt;
        bf16_t* dst = mix + (size_t)(b * S + qpos) * DM + 512 + h * 64;
#pragma unroll
        for (int db = 0; db < 2; ++db)
#pragma unroll
            for (int q4 = 0; q4 < 4; ++q4) {
                const int d = 32 * db + 8 * q4 + 4 * hh;
                u32x2 w; w[0] = pk2(O[db][4 * q4] * inv, O[db][4 * q4 + 1] * inv); w[1] = pk2(O[db][4 * q4 + 2] * inv, O[db][4 * q4 + 3] * inv);
                *(u32x2*)(dst + d) = w;
            }
    }
#endif
    __syncthreads();
}

__device__ __forceinline__ int xp_rowmap(int mode, int n) {
    return mode == 0 ? n : mode == 1 ? (n / 96) * 128 + (n % 96) : mode == 2 ? ((n >> 6) * 128 + (n & 63)) : ((n >> 6) * 128 + 64 + (n & 63));
}
__device__ __forceinline__ void xpose_tile(LAS uchar* lds, const float* src, int K, int N, bf16_t* dst, int ldd, int mode, const float* gain, int kt, int ntile) {
    LAS float* sh = (LAS float*)lds; const int tid = tid_opaque();
    (void)K;
#pragma unroll 4
    for (int i = 0; i < 8; ++i) {
        const int kl = (tid >> 6) + 8 * i, k = kt * 64 + kl, n = ntile * 64 + (tid & 63);
        float v = (n < N) ? src[(size_t)k * N + n] : 0.f;
        if (gain) v *= gain[k];
        sh[kl * 65 + (tid & 63)] = v;
    }
    __syncthreads();
    {
        const int nl = tid >> 3, kq = tid & 7, n = ntile * 64 + nl;
        if (n < N) {
            bf16_t* d = dst + (size_t)xp_rowmap(mode, n) * ldd + kt * 64 + kq * 8;
            u32x4 o0;
#pragma unroll
            for (int i = 0; i < 4; ++i) o0[i] = pk2(sh[(kq * 8 + 2 * i) * 65 + nl], sh[(kq * 8 + 2 * i + 1) * 65 + nl]);
            *(u32x4*)d = o0;
        }
    }
    __syncthreads();
}
__device__ __forceinline__ void xpose_job(LAS uchar* lds, const float* src, int K, int N, bf16_t* dst, int ldd, int mode, const float* gain) {
    const int nkt = K >> 6, nnt = (N + 63) >> 6, tot = nkt * nnt;
    for (int u = blockIdx.x; u < tot; u += gridDim.x) xpose_tile(lds, src, K, N, dst, ldd, mode, gain, u % nkt, u / nkt);
}
__device__ __forceinline__ void expert_weights(LAS uchar* lds, const Params& p, int l) {
    bf16_t* wgu = (bf16_t*)(p.ws + WS_WGU); bf16_t* wd = (bf16_t*)(p.ws + WS_WD);
    const float* g2 = p.in[18] + l * DM;
    for (int u = blockIdx.x; u < 32 * 192; u += gridDim.x) {
        const int e = u / 192, w = u % 192, job = w >> 6, tl = w & 63;
        if (job == 0) xpose_tile(lds, p.in[23] + ((size_t)l * 32 + e) * DM * 256, DM, 256, wgu + (size_t)e * 512 * DM, DM, 2, g2, tl & 15, tl >> 4);
        else if (job == 1) xpose_tile(lds, p.in[24] + ((size_t)l * 32 + e) * DM * 256, DM, 256, wgu + (size_t)e * 512 * DM, DM, 3, g2, tl & 15, tl >> 4);
        else xpose_tile(lds, p.in[25] + ((size_t)l * 32 + e) * 256 * DM, 256, DM, wd + (size_t)e * DM * 256, 256, 0, nullptr, tl & 3, tl >> 2);
    }
}
__device__ __forceinline__ void row_prep(const float* xrow, bf16_t* xb, float* rstd, int lane) {
    float ss = 0.f; f32x4 v[4];
#pragma unroll
    for (int i = 0; i < 4; ++i) { v[i] = *(const f32x4*)(xrow + i * 256 + lane * 4); ss += v[i][0] * v[i][0] + v[i][1] * v[i][1] + v[i][2] * v[i][2] + v[i][3] * v[i][3]; }
    ss = wave_sum(ss);
#pragma unroll
    for (int i = 0; i < 4; ++i) { u32x2 o; o[0] = pk2(v[i][0], v[i][1]); o[1] = pk2(v[i][2], v[i][3]); *(u32x2*)(xb + i * 256 + lane * 4) = o; }
    if (lane == 0) *rstd = __builtin_amdgcn_rsqf(ss * (1.f / 1024.f) + EPS);
}

__device__ __forceinline__ void phase0(LAS uchar* lds, const Params& p) {
    uchar* ws = p.ws; const int tid = tid_opaque(), gtid = blockIdx.x * NT + tid, gsz = gridDim.x * NT;
    for (int l = 0; l < NL; ++l) {
        xpose_job(lds, p.in[2] + (size_t)l * DM * NIN, DM, NIN, (bf16_t*)(ws + WS_WIN) + (size_t)l * NINP * DM, DM, 0, p.in[1] + l * DM);
        xpose_job(lds, p.in[17] + (size_t)l * DM * DM, DM, DM, (bf16_t*)(ws + WS_WOUT) + (size_t)l * DM * DM, DM, 0, nullptr);
        xpose_job(lds, p.in[9] + (size_t)l * 192 * 384, 192, 384, (bf16_t*)(ws + WS_WUQ) + (size_t)l * 512 * 192, 192, 1, p.in[7] + l * 192);
        xpose_job(lds, p.in[10] + (size_t)l * 128 * 512, 128, 512, (bf16_t*)(ws + WS_WUKV) + (size_t)l * 512 * 128, 128, 0, p.in[8] + l * 128);
        for (int g = 0; g < 4; ++g)
            xpose_job(lds, p.in[15] + ((size_t)l * 4 + g) * 64 * 64, 64, 64, (bf16_t*)(ws + WS_POOLW) + ((size_t)l * 4 + g) * 128 * 64, 64, 0, nullptr);
        { bf16_t* w = (bf16_t*)(ws + WS_WIN) + ((size_t)l * NINP + NIN) * DM; for (int i = gtid; i < 32 * DM; i += gsz) w[i] = 0; }
        { bf16_t* w = (bf16_t*)(ws + WS_WUQ) + (size_t)l * 512 * 192; for (int i = gtid; i < 4 * 32 * 192; i += gsz) { const int hd = i / (32 * 192), rem = i % (32 * 192); w[(size_t)(hd * 128 + 96) * 192 + rem] = 0; } }
        { bf16_t* w = (bf16_t*)(ws + WS_POOLW) + (size_t)l * 4 * 128 * 64; for (int i = gtid; i < 4 * 64 * 64; i += gsz) { const int g = i >> 12, rem = i & 4095; w[(size_t)(g * 128 + 64) * 64 + rem] = 0; } }
    }
    expert_weights(lds, p, 0);
    for (int i = gtid; i < S * 16; i += gsz) {
        const int pos = i >> 4, f = i & 15;
        double inv = 1.0; for (int k = 0; k < f; ++k) inv *= 0.5623413251903491;
        const double rev = (double)pos * inv * 0.15915494309189535;
        const float fr = (float)(rev - __builtin_rint(rev));
        ((float*)(ws + WS_ROPE))[i] = __builtin_amdgcn_cosf(fr);
        ((float*)(ws + WS_ROPE))[S * 16 + i] = __builtin_amdgcn_sinf(fr);
    }
    if (gtid < NL) {
        const int l = gtid; float* sc = (float*)(ws + WS_SCAL) + 16 * l;
        const float* lv = p.in[5] + l * 256;
        float d1 = 0.f, d2 = 0.f; for (int i = 0; i < 64; ++i) { d1 += lv[i] * lv[64 + i]; d2 += lv[128 + i] * lv[192 + i]; }
        const float lam_init = 0.8f - 0.6f * expf(-0.3f * (float)l);
        sc[0] = expf(d1) - expf(d2) + lam_init; sc[1] = 1.f - lam_init;
        float gq = 0.f, gk = 0.f; for (int i = 0; i < 64; ++i) { gq = fmaxf(gq, fabsf(p.in[3][l * 64 + i])); gk = fmaxf(gk, fabsf(p.in[4][l * 64 + i])); }
        sc[2] = gq * gk * 8.f * LOG2E * 1.02f;
        float a = 0.f, bq = 0.f, c = 0.f, dk = 0.f;
        for (int i = 0; i < 64; ++i) { a = fmaxf(a, fabsf(p.in[11][l * 64 + i])); c = fmaxf(c, fabsf(p.in[13][l * 64 + i])); }
        for (int i = 0; i < 32; ++i) { bq = fmaxf(bq, fabsf(p.in[12][l * 32 + i])); dk = fmaxf(dk, fabsf(p.in[14][l * 32 + i])); }
        sc[3] = sqrtf(64.f * a * a + 32.f * bq * bq) * sqrtf(64.f * c * c + 32.f * dk * dk) * QSCALE_M * 1.02f;
    }
    {
        const int lane = tid & 63, gw = gtid >> 6, nw = gsz >> 6;
        for (int t = gw; t < T; t += nw) row_prep(p.in[0] + (size_t)t * DM, (bf16_t*)(ws + WS_XB) + (size_t)t * DM, (float*)(ws + WS_RSTD1) + t, lane);
    }
}

__device__ __forceinline__ void ph_gemm1(LAS uchar* lds, const Params& p, int l) {
    const bf16_t* xb = (const bf16_t*)(p.ws + WS_XB); const bf16_t* win = (const bf16_t*)(p.ws + WS_WIN) + (size_t)l * NINP * DM;
    for (int u = blockIdx.x; u < 64 * 17; u += gridDim.x) {
        const int mt = u / 17, nt = u % 17;
        ARowLinear ar{xb + (size_t)mt * 256 * DM, (size_t)DM};
        EpiProj ep{mt, nt, l, &p};
        gemm_tile(lds, ar, win + (size_t)nt * 128 * DM, (size_t)DM, DM, ep);
    }
}
__device__ __forceinline__ void pooled_unit(const Params& p, int mt) {
    const int tidp = tid_opaque(); const int c = tidp & 255, rh = tidp >> 8, g = c >> 6, half = 1 << g;
    const int t0 = mt * 256 + rh * 128, b = t0 >> 11, s0 = t0 & 2047;
    const bf16_t* u = (const bf16_t*)(p.ws + WS_LAT) + (size_t)b * S * 640 + 352 + c;
    bf16_t* dst = (bf16_t*)(p.ws + WS_POOLED) + (size_t)t0 * 256 + c;
    for (int r = 0; r < 128; ++r) {
        const int s = s0 + r; int lo = s - half, hi = s + half - 1; lo = lo < 0 ? 0 : lo; hi = hi > S - 1 ? S - 1 : hi;
        float sum = 0.f; for (int j = lo; j <= hi; ++j) sum += bf2f(u[(size_t)j * 640]);
        const float v = sum / (float)(hi - lo + 1) - bf2f(u[(size_t)s * 640]);
        dst[(size_t)r * 256] = f2bf(v);
    }
}
__device__ __forceinline__ void ph_mix_a(LAS uchar* lds, const Params& p, int l) {
    const bf16_t* lat = (const bf16_t*)(p.ws + WS_LAT);
    for (int u = blockIdx.x; u < 512 + 512 + 64; u += gridDim.x) {
        if (u < 512) diff_attn_unit(lds, p, l, u);
        else if (u < 1024) {
            const int v = u - 512, mt = v >> 3, w = v & 7, h = w & 3;
            if (w < 4) { ARowLinear ar{lat + (size_t)mt * 256 * 640, (size_t)640}; EpiMlaQ ep{mt, h, l, &p};
                gemm_tile(lds, ar, (const bf16_t*)(p.ws + WS_WUQ) + ((size_t)l * 512 + h * 128) * 192, (size_t)192, 192, ep); }
            else { ARowLinear ar{lat + (size_t)mt * 256 * 640 + 192, (size_t)640}; EpiMlaKV ep{mt, h, l, &p};
                gemm_tile(lds, ar, (const bf16_t*)(p.ws + WS_WUKV) + ((size_t)l * 512 + h * 128) * 128, (size_t)128, 128, ep); }
        } else pooled_unit(p, u - 1024);
    }
}
__device__ __forceinline__ void ph_mix_b(LAS uchar* lds, const Params& p, int l) {
    for (int u = blockIdx.x; u < 256 + 256; u += gridDim.x) {
        if (u < 256) mla_attn_unit(lds, p, l, u);
        else { const int v = u - 256, mt = v >> 2, g = v & 3;
            ARowLinear ar{(const bf16_t*)(p.ws + WS_POOLED) + (size_t)mt * 256 * 256 + g * 64, (size_t)256}; EpiPool ep{mt, g, l, &p};
            gemm_tile(lds, ar, (const bf16_t*)(p.ws + WS_POOLW) + ((size_t)l * 4 + g) * 128 * 64, (size_t)64, 64, ep); }
    }
}
__device__ __forceinline__ void ph_wout(LAS uchar* lds, const Params& p, int l) {
    const bf16_t* mix = (const bf16_t*)(p.ws + WS_MIX); const bf16_t* wo = (const bf16_t*)(p.ws + WS_WOUT) + (size_t)l * DM * DM;
    const float* xres = (l == 0) ? p.in[0] : p.out;
    for (int u = blockIdx.x; u < 64 * 8; u += gridDim.x) {
        const int mt = u >> 3, nt = u & 7;
        ARowLinear ar{mix + (size_t)mt * 256 * DM, (size_t)DM}; EpiWout ep{mt, nt, xres, &p};
        gemm_tile(lds, ar, wo + (size_t)nt * 128 * DM, (size_t)DM, DM, ep);
    }
}
__device__ __forceinline__ void ph_router(LAS uchar* lds, const Params& p, int l) {
    uchar* ws = p.ws; const int tid = tid_opaque(), lane = tid & 63, wv = tid >> 6;
    const int gw = blockIdx.x * 8 + wv, nw = gridDim.x * 8;
    const float* g2 = p.in[18] + l * DM; const float* wg = p.in[19] + (size_t)l * DM * 4; const float* we = p.in[21] + (size_t)l * DM * 32;
    const float* bg = p.in[20] + l * 4; const float* be = p.in[22] + l * 32;
    unsigned* cnt = (unsigned*)(ws + WS_CTL) + CW_CNT + 64 * l;
    unsigned* list = (unsigned*)(ws + WS_LIST); float* gwt = (float*)(ws + WS_GW); float* rstd2 = (float*)(ws + WS_RSTD2);
    LAS float* shl = (LAS float*)lds + wv * 64;
    for (int t = gw; t < T; t += nw) {
        const float* xr = p.out + (size_t)t * DM;
        float acc[36];
#pragma unroll
        for (int n = 0; n < 36; ++n) acc[n] = 0.f;
        float ss = 0.f;
#pragma unroll 2
        for (int i = 0; i < 16; ++i) {
            const int k = i * 64 + lane; const float xv = xr[k]; ss += xv * xv; const float xg = xv * g2[k];
            const f32x4 wgv = *(const f32x4*)(wg + (size_t)k * 4);
#pragma unroll
            for (int n = 0; n < 4; ++n) acc[n] += xg * wgv[n];
#pragma unroll
            for (int n4 = 0; n4 < 8; ++n4) { const f32x4 wv4 = *(const f32x4*)(we + (size_t)k * 32 + n4 * 4);
#pragma unroll
                for (int n = 0; n < 4; ++n) acc[4 + n4 * 4 + n] += xg * wv4[n]; }
        }
        ss = wave_sum(ss);
        const float rs = __builtin_amdgcn_rsqf(ss * (1.f / 1024.f) + EPS);
#pragma unroll
        for (int n = 0; n < 36; ++n) { const float v = wave_sum(acc[n]); if (lane == n) shl[n] = v * rs + (n < 4 ? bg[n] : be[n - 4]); }
        __builtin_amdgcn_s_waitcnt(0xC07F);
        if (lane == 0) {
            int gi = 0; float gm = shl[0];
            for (int n = 1; n < 4; ++n) { const float v = shl[n]; if (v > gm) { gm = v; gi = n; } }
            float gs = 0.f; for (int n = 0; n < 4; ++n) gs += __expf(shl[n] - gm);
            const float gtop = 1.f / gs;
            int i1 = 0; float m1 = shl[4 + gi * 8];
            for (int n = 1; n < 8; ++n) { const float v = shl[4 + gi * 8 + n]; if (v > m1) { m1 = v; i1 = n; } }
            int i2 = -1; float m2v = -3.0e38f;
            for (int n = 0; n < 8; ++n) { const float v = shl[4 + gi * 8 + n]; if (n != i1 && v > m2v) { m2v = v; i2 = n; } }
            const float e2 = __expf(m2v - m1); const float w1 = gtop / (1.f + e2), w2 = gtop * e2 / (1.f + e2);
            const int ea = gi * 8 + i1, eb = gi * 8 + i2;
            const unsigned pa = atomicAdd(&cnt[ea], 1u), pb = atomicAdd(&cnt[eb], 1u);
            list[(size_t)ea * T + pa] = (unsigned)(t * 2); list[(size_t)eb * T + pb] = (unsigned)(t * 2 + 1);
            gwt[t * 2] = w1; gwt[t * 2 + 1] = w2; rstd2[t] = rs;
        }
    }
}
__device__ __forceinline__ void moe_find(const unsigned* cnt, int rbg, int& e, int& rb, int& nvalid, int& pre) {
    int acc = 0; e = -1; rb = 0; nvalid = 0; pre = 0;
    for (int i = 0; i < 32; ++i) { const int c = (int)cnt[i], nb = (c + 255) >> 8;
        if (e < 0 && rbg < acc + nb) { e = i; rb = rbg - acc; nvalid = c - rb * 256; if (nvalid > 256) nvalid = 256; pre = acc; }
        acc += nb; }
}
__device__ __forceinline__ int moe_total(const unsigned* cnt) { int acc = 0; for (int i = 0; i < 32; ++i) acc += ((int)cnt[i] + 255) >> 8; return acc; }
__device__ __forceinline__ void ph_gateup(LAS uchar* lds, const Params& p, int l) {
    uchar* ws = p.ws; const unsigned* cnt = (const unsigned*)(ws + WS_CTL) + CW_CNT + 64 * l;
    const int tot = moe_total(cnt) * 4;
    for (int u = blockIdx.x; u < tot; u += gridDim.x) {
        int e, rb, nvalid, pre; moe_find(cnt, u >> 2, e, rb, nvalid, pre); const int jt = u & 3;
        const unsigned* list = (const unsigned*)(ws + WS_LIST) + (size_t)e * T + rb * 256;
        ARowGather ar{(const bf16_t*)(ws + WS_XB), list, nvalid};
        EpiGU ep{jt, nvalid, list, (size_t)(u >> 2) * 256, &p};
        gemm_tile(lds, ar, (const bf16_t*)(ws + WS_WGU) + ((size_t)e * 512 + jt * 128) * DM, (size_t)DM, DM, ep);
    }
}
__device__ __forceinline__ void ph_down(LAS uchar* lds, const Params& p, int l) {
    uchar* ws = p.ws; const unsigned* cnt = (const unsigned*)(ws + WS_CTL) + CW_CNT + 64 * l;
    const int tot = moe_total(cnt) * 8;
    for (int u = blockIdx.x; u < tot; u += gridDim.x) {
        int e, rb, nvalid, pre; moe_find(cnt, u >> 3, e, rb, nvalid, pre); const int nt = u & 7;
        const unsigned* list = (const unsigned*)(ws + WS_LIST) + (size_t)e * T + rb * 256;
        ARowLinear ar{(const bf16_t*)(ws + WS_HMID) + (size_t)(u >> 3) * 256 * 256, (size_t)256};
        EpiDown ep{nt, nvalid, list, &p};
        gemm_tile(lds, ar, (const bf16_t*)(ws + WS_WD) + ((size_t)e * DM + nt * 128) * 256, (size_t)256, 256, ep);
    }
}
__device__ __forceinline__ void ph_combine(LAS uchar* lds, const Params& p, int l) {
    uchar* ws = p.ws; const int tid = tid_opaque(), lane = tid & 63;
    const int gw = blockIdx.x * 8 + (tid >> 6), nw = gridDim.x * 8;
    const bf16_t* ys = (const bf16_t*)(ws + WS_YS);
    for (int t = gw; t < T; t += nw) {
        float* xr = p.out + (size_t)t * DM; const bf16_t* y0 = ys + (size_t)(2 * t) * DM; const bf16_t* y1 = y0 + DM;
        bf16_t* xb = (bf16_t*)(ws + WS_XB) + (size_t)t * DM;
        float ss = 0.f;
#pragma unroll
        for (int i = 0; i < 4; ++i) {
            const int c = i * 256 + lane * 4;
            f32x4 v = *(const f32x4*)(xr + c); const u32x2 a = *(const u32x2*)(y0 + c), bq = *(const u32x2*)(y1 + c);
            v[0] += bflo(a[0]) + bflo(bq[0]); v[1] += bfhi(a[0]) + bfhi(bq[0]); v[2] += bflo(a[1]) + bflo(bq[1]); v[3] += bfhi(a[1]) + bfhi(bq[1]);
            *(f32x4*)(xr + c) = v; ss += v[0] * v[0] + v[1] * v[1] + v[2] * v[2] + v[3] * v[3];
            u32x2 o; o[0] = pk2(v[0], v[1]); o[1] = pk2(v[2], v[3]); *(u32x2*)(xb + c) = o;
        }
        ss = wave_sum(ss);
        if (lane == 0) ((float*)(ws + WS_RSTD1))[t] = __builtin_amdgcn_rsqf(ss * (1.f / 1024.f) + EPS);
    }
    if (l + 1 < NL) expert_weights(lds, p, l + 1);
}

__global__ void __launch_bounds__(NT, 2) mega(Params p) {
    extern __shared__ __attribute__((aligned(16))) unsigned char smem[];
    LAS uchar* lds = (LAS uchar*)smem;
    if (threadIdx.x == 0) { *(LAS u32x4*)(lds + LDS_XB) = (u32x4){0u, 0u, 0u, 0u}; }
    __syncthreads();
    XcdBarrier bar = xcd_barrier_post((unsigned*)(p.ws + WS_CTL), (volatile LAS unsigned*)(lds + LDS_XB));
#define IN(k) (p.ph_lo <= (k) && (k) < p.ph_hi)
#define SEAM(k) do { if (IN(k) && IN((k) + 1)) xcd_barrier(bar); } while (0)
    if (IN(0)) phase0(lds, p);
    SEAM(0);
#define LAUNDER(v) asm volatile("" : "+s"(v))
#pragma unroll 1
    for (int l0 = 0; l0 < NL; ++l0) {
        const int pb = 1 + 8 * l0;
        { int l = l0; LAUNDER(l); if (IN(pb + 0)) ph_gemm1(lds, p, l); }
        SEAM(pb + 0);
        { int l = l0; LAUNDER(l); if (IN(pb + 1)) ph_mix_a(lds, p, l); }
        SEAM(pb + 1);
        { int l = l0; LAUNDER(l); if (IN(pb + 2)) ph_mix_b(lds, p, l); }
        SEAM(pb + 2);
        { int l = l0; LAUNDER(l); if (IN(pb + 3)) ph_wout(lds, p, l); }
        SEAM(pb + 3);
        { int l = l0; LAUNDER(l); if (IN(pb + 4)) ph_router(lds, p, l); }
        SEAM(pb + 4);
        { int l = l0; LAUNDER(l); if (IN(pb + 5)) ph_gateup(lds, p, l); }
        SEAM(pb + 5);
        { int l = l0; LAUNDER(l); if (IN(pb + 6)) ph_down(lds, p, l); }
        SEAM(pb + 6);
        { int l = l0; LAUNDER(l); if (IN(pb + 7)) ph_combine(lds, p, l); }
        SEAM(pb + 7);
    }
}

extern "C" void kernel_launch(void* const* d_in, const int* in_sizes, int n_in, void* d_out, int out_size, void* d_ws, size_t ws_size, hipStream_t stream) {
    (void)in_sizes; (void)n_in; (void)out_size;
    static int grid = 0;
    if (!grid) {
        int dev = 0, cus = 0, per_cu = 0;
        hipGetDevice(&dev);
        hipDeviceGetAttribute(&cus, hipDeviceAttributeMultiprocessorCount, dev);
        hipFuncSetAttribute((const void*)mega, hipFuncAttributeMaxDynamicSharedMemorySize, LDS_BYTES);
        hipOccupancyMaxActiveBlocksPerMultiprocessor(&per_cu, (const void*)mega, NT, LDS_BYTES);
        if (per_cu > 1) per_cu = 1;
        if (per_cu < 1) per_cu = 1;
        grid = cus * per_cu;
    }
    if (ws_size < WS_END) { fprintf(stderr, "workspace too small: %zu < %zu\n", ws_size, (size_t)WS_END); return; }
    hipMemsetAsync(d_ws, 0, CTL_ZERO_BYTES, stream);
    Params p{};
    for (int i = 0; i < 26; ++i) p.in[i] = (const float*)d_in[i];
    p.out = (float*)d_out; p.ws = (unsigned char*)d_ws;
#if N_LAUNCH_SPLIT
    for (int k = 0; k < NPH; ++k) { p.ph_lo = k; p.ph_hi = k + 1; hipLaunchKernelGGL(mega, dim3(grid), dim3(NT), LDS_BYTES, stream, p); }
#else
    p.ph_lo = 0; p.ph_hi = NPH;
    hipLaunchKernelGGL(mega, dim3(grid), dim3(NT), LDS_BYTES, stream, p);
#endif
}
```

```cpp
#include <hip/hip_runtime.h>
#include <stdint.h>
#include <stdio.h>

#ifndef NAIVE_GEMM
#define NAIVE_GEMM 0
#endif
#ifndef NAIVE_ATTN
#define NAIVE_ATTN 0
#endif
#ifndef N_LAUNCH_SPLIT
#define N_LAUNCH_SPLIT 0
#endif

#ifndef REPEAT_MASK
#define REPEAT_MASK 0
#endif
#define NREP(k) ((((REPEAT_MASK) >> (k)) & 1) + 1)
#define LAS __attribute__((address_space(3)))
typedef unsigned char uchar;
typedef unsigned short bf16_t;
typedef short bf16x8 __attribute__((ext_vector_type(8)));
typedef float f32x16 __attribute__((ext_vector_type(16)));
typedef float f32x2_t __attribute__((ext_vector_type(2)));
typedef __bf16 bf16x2_t __attribute__((ext_vector_type(2)));
typedef unsigned u32x4 __attribute__((ext_vector_type(4)));
typedef unsigned u32x2 __attribute__((ext_vector_type(2)));
typedef float f32x4 __attribute__((ext_vector_type(4)));

constexpr int NB = 8, S = 2048, DM = 1024, T = NB * S, NL = 2;
constexpr int NIN = 2144, NINP = 2176;
constexpr float EPS = 1e-6f, LOG2E = 1.4426950408889634f;
constexpr float QSCALE_D = 0.125f * LOG2E;
constexpr float QSCALE_M = 0.10206207261596577f * LOG2E;
constexpr int NPH = 1 + 8 * NL;

constexpr size_t MiB = (size_t)1 << 20;
constexpr size_t WS_CTL = 0, CTL_ZERO_BYTES = 32768;
constexpr size_t WS_SCAL = 1 * MiB;
constexpr size_t WS_ROPE = 1 * MiB + 64 * 1024;
constexpr size_t WS_RSTD1 = 1 * MiB + 512 * 1024;
constexpr size_t WS_RSTD2 = WS_RSTD1 + 64 * 1024;
constexpr size_t WS_GW = WS_RSTD2 + 64 * 1024;
constexpr size_t WS_LIST = 2 * MiB;
constexpr size_t WS_WIN = 4 * MiB;
constexpr size_t WS_WOUT = 13 * MiB;
constexpr size_t WS_WUQ = 17 * MiB;
constexpr size_t WS_WUKV = 17 * MiB + 512 * 1024;
constexpr size_t WS_POOLW = 17 * MiB + 768 * 1024;
constexpr size_t WS_WR = 18 * MiB;
constexpr size_t WS_PSS = 19 * MiB + 512 * 1024;
constexpr size_t WS_WGU = 20 * MiB;
constexpr size_t WS_WD = 52 * MiB;
constexpr size_t WS_XB = 68 * MiB;
constexpr size_t WS_MIX = 100 * MiB;
constexpr size_t WS_HMID = WS_MIX;
constexpr size_t WS_QD = 132 * MiB, WS_KD = 148 * MiB, WS_VDT = 164 * MiB;
constexpr size_t WS_LAT = 180 * MiB;
constexpr size_t WS_QM = 200 * MiB, WS_KM = 212 * MiB, WS_VMT = 224 * MiB;
constexpr size_t WS_POOLED = 232 * MiB;
constexpr size_t WS_XL = 132 * MiB;
constexpr size_t WS_YS = 132 * MiB;
constexpr size_t WS_END = 240 * MiB;

#define XB_TMO      128
#define XB_XCNT(j)  (256  + 64 * (j))
#define XB_XSUB(j)  (1280 + 64 * (j))
#define XB_XGEN(j)  (2304 + 64 * (j))
#define XB_TOP      3328
#define XB_TOPGEN   3392
#define XCD_BAR_WORDS 3456
#define XB_SPIN_CAP (1u << 18)
constexpr int CW_CNT = 4096;

constexpr int NT = 512;
constexpr int LDS_XB = 147456;
constexpr int LDS_BYTES = LDS_XB + 64;
constexpr int GSTG = 49152;
constexpr int ASTG = 32768;
constexpr int MSTG = 20480;

struct Params {
    const float* in[26];
    float* out;
    unsigned char* ws;
    int ph_lo, ph_hi;
};

__device__ __forceinline__ unsigned pk2(float lo, float hi) { f32x2_t v = {lo, hi}; bf16x2_t b = __builtin_convertvector(v, bf16x2_t); return __builtin_bit_cast(unsigned, b); }
__device__ __forceinline__ float bflo(unsigned w) { return __builtin_bit_cast(float, w << 16); }
__device__ __forceinline__ float bfhi(unsigned w) { return __builtin_bit_cast(float, w & 0xffff0000u); }
__device__ __forceinline__ float bf2f(bf16_t u) { return __builtin_bit_cast(float, (unsigned)u << 16); }
__device__ __forceinline__ bf16_t f2bf(float f) { return (bf16_t)(pk2(f, 0.f) & 0xffffu); }
__device__ __forceinline__ int tid_opaque() { int t = threadIdx.x; asm volatile("" : "+v"(t)); return t; }
__device__ __forceinline__ int crow(int r, int hi) { return (r & 3) + 8 * (r >> 2) + 4 * hi; }
__device__ __forceinline__ int sigma16(int s) { return (s & ~12) | ((s & 4) << 1) | ((s & 8) >> 1); }
__device__ __forceinline__ float wave_sum(float v) {
#pragma unroll
    for (int o = 32; o >= 1; o >>= 1) v += __shfl_xor(v, o);
    return v;
}
__device__ __forceinline__ void unpack8(u32x4 w, float (&f)[8]) {
    f[0] = bflo(w[0]); f[1] = bfhi(w[0]); f[2] = bflo(w[1]); f[3] = bfhi(w[1]);
    f[4] = bflo(w[2]); f[5] = bfhi(w[2]); f[6] = bflo(w[3]); f[7] = bfhi(w[3]);
}

__device__ __forceinline__ unsigned xb_ld(unsigned* p)              { return __hip_atomic_load(p, __ATOMIC_RELAXED, __HIP_MEMORY_SCOPE_AGENT); }
__device__ __forceinline__ unsigned xb_add(unsigned* p, unsigned v) { return __hip_atomic_fetch_add(p, v, __ATOMIC_RELAXED, __HIP_MEMORY_SCOPE_AGENT); }
__device__ __forceinline__ unsigned xb_xcc_id() { return (unsigned)__builtin_amdgcn_s_getreg((3 << 11) | 20) & 0xFu; }
#define XB_SPIN(cond, bar) do { unsigned _sp = 0; while (cond) { __builtin_amdgcn_s_sleep(1); \
    if ((++_sp & 255u) == 0u) { if (xb_ld(&(bar)[XB_TMO])) break; if (_sp > XB_SPIN_CAP) { atomicAdd(&(bar)[XB_TMO], 1u); break; } } } } while (0)
struct XcdBarrier { unsigned* bar; unsigned x; volatile LAS unsigned* st; };
__device__ __forceinline__ XcdBarrier xcd_barrier_post(unsigned* bar, volatile LAS unsigned* st) {
    XcdBarrier b; b.bar = bar; b.x = xb_xcc_id(); b.st = st;
    if (threadIdx.x == 0) (void)xb_add(&bar[XB_XCNT(b.x)], 1u);
    return b;
}
__device__ __forceinline__ void xcd_barrier_complete(unsigned* bar, unsigned x, unsigned& nloc, unsigned& nx) {
    const unsigned G = gridDim.x * gridDim.y * gridDim.z;
    unsigned sum, cnt, mine, sp = 0u;
    for (;;) {
        sum = 0u; cnt = 0u; mine = 0u;
#pragma unroll
        for (unsigned j = 0; j < 16; ++j) { const unsigned c = xb_ld(&bar[XB_XCNT(j)]); sum += c; cnt += (c > 0u) ? 1u : 0u; mine = (j == x) ? c : mine; }
        if (sum == G) break;
        __builtin_amdgcn_s_sleep(1);
        if ((++sp & 255u) == 0u) { if (xb_ld(&bar[XB_TMO])) break; if (sp > XB_SPIN_CAP) { atomicAdd(&bar[XB_TMO], 1u); break; } }
    }
    nloc = mine > 0u ? mine : 1u; nx = cnt > 0u ? cnt : 1u;
}
__device__ __forceinline__ void xcd_barrier(const XcdBarrier& b) {
    asm volatile("s_waitcnt vmcnt(0)" ::: "memory");
    __syncthreads();
    if (threadIdx.x == 0) {
        unsigned* bar = b.bar;
        __builtin_amdgcn_s_waitcnt(0);
        unsigned nloc = b.st[0], nx = b.st[1];
        if (nloc == 0u) { xcd_barrier_complete(bar, b.x, nloc, nx); b.st[0] = nloc; b.st[1] = nx; }
        const unsigned old = xb_add(&bar[XB_XSUB(b.x)], 1u);
        const unsigned gen = old / nloc;
        if (old + 1u == (gen + 1u) * nloc) {
            __builtin_amdgcn_fence(__ATOMIC_RELEASE, "agent");
            asm volatile("s_waitcnt vmcnt(0)" ::: "memory");
            const unsigned og = xb_add(&bar[XB_TOP], 1u);
            const unsigned tg = og / nx;
            if (og + 1u == (tg + 1u) * nx) xb_add(&bar[XB_TOPGEN], 1u);
            else XB_SPIN(xb_ld(&bar[XB_TOPGEN]) == tg, bar);
            __builtin_amdgcn_fence(__ATOMIC_ACQUIRE, "agent");
            xb_add(&bar[XB_XGEN(b.x)], 1u);
            asm volatile("s_waitcnt vmcnt(0)" ::: "memory");
        } else {
            XB_SPIN(xb_ld(&bar[XB_XGEN(b.x)]) == gen, bar);
            __builtin_amdgcn_fence(__ATOMIC_ACQUIRE, "agent");
            asm volatile("s_waitcnt vmcnt(0)" ::: "memory");
        }
    }
    __syncthreads();
}

__device__ __forceinline__ void glds16(const void* gsrc, LAS uchar* dst_wave_base) {
    __builtin_amdgcn_global_load_lds((const unsigned*)gsrc, (LAS unsigned*)dst_wave_base, 16, 0, 0);
}
__device__ __forceinline__ int sw128(int row, int c) { return row * 128 + ((c ^ ((row >> 1) & 7)) << 4); }
__device__ __forceinline__ int sw64(int row, int c) { return row * 64 + ((c ^ ((row >> 2) & 3)) << 4); }

#define MFMA32(a, b, c) __builtin_amdgcn_mfma_f32_32x32x16_bf16((a), (b), (c), 0, 0, 0)

constexpr int CT_PITCH = 272;
#define WAITV(n) asm volatile("s_waitcnt vmcnt(" #n ")" ::: "memory")
struct ARowLinear { const bf16_t* base; size_t ld; __device__ __forceinline__ const bf16_t* operator()(int r) const { return base + (size_t)r * ld; } };
struct ARowGather { const bf16_t* base; const unsigned* list; int nvalid; __device__ __forceinline__ const bf16_t* operator()(int r) const {
    const int rr = r < nvalid ? r : nvalid - 1; const unsigned ent = list[rr]; return base + (size_t)(ent >> 1) * DM; } };

struct AOffLinear { __device__ __forceinline__ int operator()(int kt) const { return kt * 64; } };
struct AOffRouter { int xl_off; __device__ __forceinline__ int operator()(int kt) const { return (kt & 15) * 64 + ((kt >> 4) == 1 ? xl_off : 0); } };
constexpr int CTF_PITCH = 129;
template <bool F32C = false, class ARow, class Epi, class AOff = AOffLinear>
__device__ __forceinline__ void gemm_tile(LAS uchar* lds, const ARow& arow, const bf16_t* Bt, size_t ldb, int K, const Epi& epi, const AOff aoff = AOff()) {
    const int tid = tid_opaque(), lane = tid & 63, wid = __builtin_amdgcn_readfirstlane(tid >> 6);
#if NAIVE_GEMM
    {
        const int r = tid >> 1, nh = tid & 1;
        float acc[64];
#pragma unroll
        for (int n = 0; n < 64; ++n) acc[n] = 0.f;
        const bf16_t* ar = arow(r);
        for (int k = 0; k < K; k += 8) {
            float a[8]; unpack8(*(const u32x4*)(ar + k), a);
#pragma unroll
            for (int n = 0; n < 64; ++n) {
                float b[8]; unpack8(*(const u32x4*)(Bt + (size_t)(nh * 64 + n) * ldb + k), b);
#pragma unroll
                for (int j = 0; j < 8; ++j) acc[n] += a[j] * b[j];
            }
        }
        __syncthreads();
#pragma unroll
        for (int n = 0; n < 64; n += 2) { if (F32C) { ((LAS float*)lds)[r * CTF_PITCH + nh * 64 + n] = acc[n]; ((LAS float*)lds)[r * CTF_PITCH + nh * 64 + n + 1] = acc[n + 1]; } else *(LAS unsigned*)(lds + r * CT_PITCH + (nh * 64 + n) * 2) = pk2(acc[n], acc[n + 1]); }
    }
#else
    {
        const int wm = wid >> 1, wn = wid & 1, r = lane & 31, hh = lane >> 5;
        const int srow = lane >> 3, c0 = (lane & 7) ^ (srow >> 1);
        const bf16_t* asrc[4];
#pragma unroll
        for (int j = 0; j < 4; ++j) asrc[j] = arow(8 * (wid * 4 + j) + srow) + (c0 ^ ((j & 1) << 2)) * 8;
        const bf16_t* bsrc0 = Bt + (size_t)(wid * 16 + srow) * ldb + c0 * 8;
        const bf16_t* bsrc1 = Bt + (size_t)(wid * 16 + 8 + srow) * ldb + (c0 ^ 4) * 8;
        const int lanebase = r * 128 + ((hh ^ ((r >> 1) & 7)) << 4);
        f32x16 acc[2][2];
#pragma unroll
        for (int a = 0; a < 2; ++a)
#pragma unroll
            for (int b = 0; b < 2; ++b)
#pragma unroll
                for (int i = 0; i < 16; ++i) acc[a][b][i] = 0.f;
        const int nt = K >> 6;
#define GT_STAGE(kt, sb) do { _Pragma("unroll") for (int j = 0; j < 4; ++j) \
            glds16(asrc[j] + aoff(kt), lds + (sb) * GSTG + (wid * 4 + j) * 1024); \
            glds16(bsrc0 + (kt) * 64, lds + (sb) * GSTG + 32768 + (wid * 2) * 1024); \
            glds16(bsrc1 + (kt) * 64, lds + (sb) * GSTG + 32768 + (wid * 2 + 1) * 1024); } while (0)
        GT_STAGE(0, 0);
        if (nt > 1) GT_STAGE(1, 1);
        int sb = 0;
        for (int kt = 0; kt < nt; ++kt) {
            if (kt + 1 < nt) WAITV(6); else WAITV(0);
            __builtin_amdgcn_s_barrier();
            if (kt + 2 < nt) { const int sn = sb >= 1 ? sb - 1 : 2; GT_STAGE(kt + 2, sn); }
            const LAS uchar* xs = lds + sb * GSTG + wm * 8192; const LAS uchar* wsb = lds + sb * GSTG + 32768 + wn * 8192;
#pragma unroll
            for (int ks = 0; ks < 4; ++ks) {
                const int lb = lanebase ^ (ks << 5);
                bf16x8 xf[2], wf[2];
#pragma unroll
                for (int mb = 0; mb < 2; ++mb) xf[mb] = *(const LAS bf16x8*)(xs + mb * 4096 + lb);
#pragma unroll
                for (int nb = 0; nb < 2; ++nb) wf[nb] = *(const LAS bf16x8*)(wsb + nb * 4096 + lb);
#pragma unroll
                for (int nb = 0; nb < 2; ++nb)
#pragma unroll
                    for (int mb = 0; mb < 2; ++mb) acc[nb][mb] = MFMA32(wf[nb], xf[mb], acc[nb][mb]);
            }
            sb = sb == 2 ? 0 : sb + 1;
        }
#undef GT_STAGE
        __syncthreads();
#pragma unroll
        for (int nb = 0; nb < 2; ++nb)
#pragma unroll
            for (int mb = 0; mb < 2; ++mb) {
                const int m = 64 * wm + 32 * mb + r;
#pragma unroll
                for (int q4 = 0; q4 < 4; ++q4) {
                    const int n = 64 * wn + 32 * nb + 8 * q4 + 4 * hh;
                    if (F32C) {
#pragma unroll
                        for (int j = 0; j < 4; ++j) ((LAS float*)lds)[m * CTF_PITCH + n + j] = acc[nb][mb][4 * q4 + j];
                    } else {
                        u32x2 v; v[0] = pk2(acc[nb][mb][4 * q4], acc[nb][mb][4 * q4 + 1]); v[1] = pk2(acc[nb][mb][4 * q4 + 2], acc[nb][mb][4 * q4 + 3]);
                        *(LAS u32x2*)(lds + m * CT_PITCH + n * 2) = v;
                    }
                }
            }
    }
#endif
    __syncthreads();
    epi(lds);
    __syncthreads();
}
__device__ __forceinline__ u32x4 ct_ld8(const LAS uchar* ct, int r, int c) { return *(const LAS u32x4*)(ct + r * CT_PITCH + c * 2); }
__device__ __forceinline__ float ct_ld1(const LAS uchar* ct, int r, int c) { return bf2f(*(const LAS bf16_t*)(ct + r * CT_PITCH + c * 2)); }

struct EpiProj {
    int mt, nt, l; const Params* p;
    __device__ __forceinline__ void operator()(const LAS uchar* ct) const {
        uchar* ws = p->ws; const int tid = tid_opaque();
        const float* rstd1 = (const float*)(ws + WS_RSTD1);
        const int t0 = mt * 256, b = t0 >> 11, s0 = t0 & 2047;
        if (nt < 8) {
            const int h = nt & 3; const bool isq = nt < 4;
            const float* g = p->in[isq ? 3 : 4] + l * 64;
            bf16_t* dbase = (bf16_t*)(ws + (isq ? WS_QD : WS_KD)) + (((size_t)b * 4 + h) * 2) * S * 64;
#pragma unroll 2
            for (int it = 0; it < 8; ++it) {
                const int item = it * NT + tid, c8 = item & 7, j = (item >> 3) & 1, r = item >> 4;
                const float rs = rstd1[t0 + r];
                float f[8]; unpack8(ct_ld8(ct, r, j * 64 + c8 * 8), f);
                float ss = 0.f;
#pragma unroll
                for (int i = 0; i < 8; ++i) { f[i] *= rs; ss += f[i] * f[i]; }
                ss += __shfl_xor(ss, 1); ss += __shfl_xor(ss, 2); ss += __shfl_xor(ss, 4);
                const float rn = __builtin_amdgcn_rsqf(ss * (1.f / 64.f) + EPS) * (isq ? QSCALE_D : 1.f);
                const f32x4 g0 = *(const f32x4*)(g + c8 * 8), g1 = *(const f32x4*)(g + c8 * 8 + 4);
                u32x4 o; o[0] = pk2(f[0] * rn * g0[0], f[1] * rn * g0[1]); o[1] = pk2(f[2] * rn * g0[2], f[3] * rn * g0[3]);
                o[2] = pk2(f[4] * rn * g1[0], f[5] * rn * g1[1]); o[3] = pk2(f[6] * rn * g1[2], f[7] * rn * g1[3]);
                *(u32x4*)(dbase + ((size_t)j * S + (s0 + r)) * 64 + c8 * 8) = o;
            }
        } else if (nt < 12) {
            const int h = nt - 8, d = tid >> 2, half = tid & 3;
            bf16_t* dst = (bf16_t*)(ws + WS_VDT) + (((size_t)b * 4 + h) * 128 + d) * S + s0 + half * 64;
#pragma unroll
            for (int c8 = 0; c8 < 8; ++c8) { u32x4 o;
#pragma unroll
                for (int i = 0; i < 4; ++i) {
                    const int p0 = c8 * 8 + 2 * i, r0 = half * 64 + sigma16(p0), r1 = half * 64 + sigma16(p0 + 1);
                    o[i] = pk2(ct_ld1(ct, r0, d) * rstd1[t0 + r0], ct_ld1(ct, r1, d) * rstd1[t0 + r1]); }
                *(u32x4*)(dst + c8 * 8) = o; }
        } else {
            bf16_t* dbase = (bf16_t*)(ws + WS_LAT) + (size_t)t0 * 640 + (nt - 12) * 128;
#pragma unroll 2
            for (int it = 0; it < 8; ++it) {
                const int item = it * NT + tid, c8 = item & 15, r = item >> 4;
                const float rs = rstd1[t0 + r];
                float f[8]; unpack8(ct_ld8(ct, r, c8 * 8), f); u32x4 o;
#pragma unroll
                for (int i = 0; i < 4; ++i) o[i] = pk2(f[2 * i] * rs, f[2 * i + 1] * rs);
                *(u32x4*)(dbase + (size_t)r * 640 + c8 * 8) = o;
            }
        }
    }
};

__device__ __forceinline__ float lat_rstd(const bf16_t* seg, int n) {
    float ss = 0.f;
    for (int k = 0; k < n; k += 8) { float f[8]; unpack8(*(const u32x4*)(seg + k), f);
#pragma unroll
        for (int i = 0; i < 8; ++i) ss += f[i] * f[i]; }
    return __builtin_amdgcn_rsqf(ss / (float)n + EPS);
}
__device__ __forceinline__ void norm_rope32(float (&y)[32], const float* g, const float* cosr, const float* sinr, float outscale) {
    float ss = 0.f;
#pragma unroll
    for (int i = 0; i < 32; ++i) ss += y[i] * y[i];
    const float rn = __builtin_amdgcn_rsqf(ss * (1.f / 32.f) + EPS);
#pragma unroll
    for (int i = 0; i < 32; ++i) y[i] = y[i] * rn * g[i];
#pragma unroll
    for (int i = 0; i < 16; ++i) { const float c = cosr[i], sn = sinr[i], x1 = y[i], x2 = y[16 + i];
        y[i] = (x1 * c - x2 * sn) * outscale; y[16 + i] = (x2 * c + x1 * sn) * outscale; }
}

struct EpiMlaQ {
    int mt, h, l; const Params* p;
    __device__ __forceinline__ void operator()(const LAS uchar* ct) const {
        uchar* ws = p->ws; const int tid = tid_opaque(), r = tid >> 1, j = tid & 1;
        const int t = mt * 256 + r, b = t >> 11, s = t & 2047;
        const bf16_t* lat = (const bf16_t*)(ws + WS_LAT) + (size_t)t * 640;
        const float rs = lat_rstd(lat, 192);
        bf16_t* dst = (bf16_t*)(ws + WS_QM) + (((size_t)b * 4 + h) * S + s) * 96;
        if (j == 0) {
            const float* g = p->in[11] + l * 64;
            float v[64]; float ss = 0.f;
#pragma unroll
            for (int c8 = 0; c8 < 8; ++c8) { float f[8]; unpack8(ct_ld8(ct, r, c8 * 8), f);
#pragma unroll
                for (int i = 0; i < 8; ++i) { const float x = f[i] * rs; v[c8 * 8 + i] = x; ss += x * x; } }
            const float rn = __builtin_amdgcn_rsqf(ss * (1.f / 64.f) + EPS) * QSCALE_M;
#pragma unroll
            for (int c8 = 0; c8 < 8; ++c8) { u32x4 o;
#pragma unroll
                for (int i = 0; i < 4; ++i) o[i] = pk2(v[c8 * 8 + 2 * i] * rn * g[c8 * 8 + 2 * i], v[c8 * 8 + 2 * i + 1] * rn * g[c8 * 8 + 2 * i + 1]);
                *(u32x4*)(dst + c8 * 8) = o; }
        } else {
            float y[32];
#pragma unroll
            for (int c8 = 0; c8 < 4; ++c8) { float f[8]; unpack8(ct_ld8(ct, r, 64 + c8 * 8), f);
#pragma unroll
                for (int i = 0; i < 8; ++i) y[c8 * 8 + i] = f[i] * rs; }
            const float* cosr = (const float*)(ws + WS_ROPE) + s * 16; const float* sinr = cosr + S * 16;
            norm_rope32(y, p->in[12] + l * 32, cosr, sinr, QSCALE_M);
#pragma unroll
            for (int c8 = 0; c8 < 4; ++c8) { u32x4 o;
#pragma unroll
                for (int i = 0; i < 4; ++i) o[i] = pk2(y[c8 * 8 + 2 * i], y[c8 * 8 + 2 * i + 1]);
                *(u32x4*)(dst + 64 + c8 * 8) = o; }
        }
    }
};
struct EpiMlaKV {
    int mt, h, l; const Params* p;
    __device__ __forceinline__ void operator()(const LAS uchar* ct) const {
        uchar* ws = p->ws; const int tid = tid_opaque(), r = tid >> 1, j = tid & 1;
        const int t0 = mt * 256, t = t0 + r, b = t >> 11, s = t & 2047, s0 = t0 & 2047;
        const bf16_t* lat = (const bf16_t*)(ws + WS_LAT) + (size_t)t * 640;
        LAS float* shr = (LAS float*)(ct + 256 * CT_PITCH);
        bf16_t* dstk = (bf16_t*)(ws + WS_KM) + (((size_t)b * 4 + h) * S + s) * 96;
        if (j == 0) {
            const float rs = lat_rstd(lat + 192, 128);
            shr[r] = rs;
            const float* g = p->in[13] + l * 64;
            float v[64]; float ss = 0.f;
#pragma unroll
            for (int c8 = 0; c8 < 8; ++c8) { float f[8]; unpack8(ct_ld8(ct, r, c8 * 8), f);
#pragma unroll
                for (int i = 0; i < 8; ++i) { const float x = f[i] * rs; v[c8 * 8 + i] = x; ss += x * x; } }
            const float rn = __builtin_amdgcn_rsqf(ss * (1.f / 64.f) + EPS);
#pragma unroll
            for (int c8 = 0; c8 < 8; ++c8) { u32x4 o;
#pragma unroll
                for (int i = 0; i < 4; ++i) o[i] = pk2(v[c8 * 8 + 2 * i] * rn * g[c8 * 8 + 2 * i], v[c8 * 8 + 2 * i + 1] * rn * g[c8 * 8 + 2 * i + 1]);
                *(u32x4*)(dstk + c8 * 8) = o; }
        } else {
            float y[32];
#pragma unroll
            for (int c8 = 0; c8 < 4; ++c8) { float f[8]; unpack8(*(const u32x4*)(lat + 320 + c8 * 8), f);
#pragma unroll
                for (int i = 0; i < 8; ++i) y[c8 * 8 + i] = f[i]; }
            const float* cosr = (const float*)(ws + WS_ROPE) + s * 16; const float* sinr = cosr + S * 16;
            norm_rope32(y, p->in[14] + l * 32, cosr, sinr, 1.f);
#pragma unroll
            for (int c8 = 0; c8 < 4; ++c8) { u32x4 o;
#pragma unroll
                for (int i = 0; i < 4; ++i) o[i] = pk2(y[c8 * 8 + 2 * i], y[c8 * 8 + 2 * i + 1]);
                *(u32x4*)(dstk + 64 + c8 * 8) = o; }
        }
        __syncthreads();
        {
            const int d = tid >> 3, q4 = tid & 7;
            bf16_t* dst = (bf16_t*)(ws + WS_VMT) + (((size_t)b * 4 + h) * 64 + d) * S + s0 + q4 * 32;
#pragma unroll
            for (int c8 = 0; c8 < 4; ++c8) { u32x4 o;
#pragma unroll
                for (int i = 0; i < 4; ++i) {
                    const int p0 = c8 * 8 + 2 * i, r0 = q4 * 32 + sigma16(p0), r1 = q4 * 32 + sigma16(p0 + 1);
                    o[i] = pk2(ct_ld1(ct, r0, 64 + d) * shr[r0], ct_ld1(ct, r1, 64 + d) * shr[r1]); }
                *(u32x4*)(dst + c8 * 8) = o; }
        }
    }
};
struct EpiPool {
    int mt, g, l; const Params* p;
    __device__ __forceinline__ void operator()(const LAS uchar* ct) const {
        uchar* ws = p->ws; const int tid = tid_opaque(), r = tid >> 1, j = tid & 1;
        const float* sc = p->in[16] + l * 256 + g * 64 + j * 32;
        bf16_t* dst = (bf16_t*)(ws + WS_MIX) + (size_t)(mt * 256 + r) * DM + 768 + g * 64 + j * 32;
#pragma unroll
        for (int c8 = 0; c8 < 4; ++c8) { float f[8]; unpack8(ct_ld8(ct, r, j * 32 + c8 * 8), f); u32x4 o;
#pragma unroll
            for (int i = 0; i < 4; ++i) o[i] = pk2(f[2 * i] * sc[c8 * 8 + 2 * i], f[2 * i + 1] * sc[c8 * 8 + 2 * i + 1]);
            *(u32x4*)(dst + c8 * 8) = o; }
    }
};
struct EpiWout {
    int mt, nt; const float* xres; const Params* p;
    __device__ __forceinline__ void operator()(const LAS uchar* ct) const {
        uchar* ws = p->ws; const int tid = tid_opaque();
        const size_t base = (size_t)(mt * 256) * DM + nt * 128;
        float* pss = (float*)(ws + WS_PSS) + (size_t)(mt * 256) * 8 + nt;
#pragma unroll 4
        for (int it = 0; it < 16; ++it) {
            const int item = it * NT + tid, c4 = item & 31, r = item >> 5;
            const size_t off = base + (size_t)r * DM + c4 * 4;
            const u32x2 cw = *(const LAS u32x2*)(ct + r * CT_PITCH + c4 * 8);
            const f32x4 x0 = *(const f32x4*)(xres + off);
            f32x4 y; y[0] = x0[0] + bflo(cw[0]); y[1] = x0[1] + bfhi(cw[0]); y[2] = x0[2] + bflo(cw[1]); y[3] = x0[3] + bfhi(cw[1]);
            *(f32x4*)(p->out + off) = y;
            u32x2 o; o[0] = pk2(y[0], y[1]); o[1] = pk2(y[2], y[3]);
            *(u32x2*)((bf16_t*)(ws + WS_XB) + off) = o;
            u32x2 ol; ol[0] = pk2(y[0] - bflo(o[0]), y[1] - bfhi(o[0])); ol[1] = pk2(y[2] - bflo(o[1]), y[3] - bfhi(o[1]));
            *(u32x2*)((bf16_t*)(ws + WS_XL) + off) = ol;
            float ss = y[0] * y[0] + y[1] * y[1] + y[2] * y[2] + y[3] * y[3];
            ss += __shfl_xor(ss, 1); ss += __shfl_xor(ss, 2); ss += __shfl_xor(ss, 4); ss += __shfl_xor(ss, 8); ss += __shfl_xor(ss, 16);
            if (c4 == 0) pss[(size_t)r * 8] = ss;
        }
    }
};
struct EpiGU {
    int jt, nvalid; const unsigned* list; size_t slot0; const Params* p;
    __device__ __forceinline__ void operator()(const LAS uchar* ct) const {
        uchar* ws = p->ws; const int tid = tid_opaque();
        const float* rstd2 = (const float*)(ws + WS_RSTD2);
        bf16_t* dbase = (bf16_t*)(ws + WS_HMID) + slot0 * 256 + jt * 64;
#pragma unroll 2
        for (int it = 0; it < 4; ++it) {
            const int item = it * NT + tid, c8 = item & 7, r = item >> 3;
            const int rr = r < nvalid ? r : nvalid - 1;
            const float rs = rstd2[list[rr] >> 1];
            float g[8], u[8]; unpack8(ct_ld8(ct, r, c8 * 8), g); unpack8(ct_ld8(ct, r, 64 + c8 * 8), u);
            float hv[8];
#pragma unroll
            for (int i = 0; i < 8; ++i) { const float gg = g[i] * rs, uu = u[i] * rs; hv[i] = gg * __builtin_amdgcn_rcpf(1.f + __builtin_amdgcn_exp2f(-gg * LOG2E)) * uu; }
            u32x4 o; o[0] = pk2(hv[0], hv[1]); o[1] = pk2(hv[2], hv[3]); o[2] = pk2(hv[4], hv[5]); o[3] = pk2(hv[6], hv[7]);
            *(u32x4*)(dbase + (size_t)r * 256 + c8 * 8) = o;
        }
    }
};
struct EpiDown {
    int nt, nvalid; const unsigned* list; const Params* p;
    __device__ __forceinline__ void operator()(const LAS uchar* ct) const {
        uchar* ws = p->ws; const int tid = tid_opaque();
        const float* gwt = (const float*)(ws + WS_GW);
        bf16_t* ys = (bf16_t*)(ws + WS_YS) + nt * 128;
#pragma unroll 2
        for (int it = 0; it < 8; ++it) {
            const int item = it * NT + tid, c8 = item & 15, r = item >> 4;
            if (r < nvalid) {
                const unsigned ent = list[r]; const float w = gwt[ent];
                float f[8]; unpack8(ct_ld8(ct, r, c8 * 8), f); u32x4 o;
#pragma unroll
                for (int i = 0; i < 4; ++i) o[i] = pk2(f[2 * i] * w, f[2 * i + 1] * w);
                *(u32x4*)(ys + (size_t)ent * DM + c8 * 8) = o;
            }
        }
    }
};

__device__ __forceinline__ void diff_attn_unit(LAS uchar* lds, const Params& p, int l, int unit) {
    uchar* ws = p.ws;
    const int tid = tid_opaque(), lane = tid & 63, wid = __builtin_amdgcn_readfirstlane(tid >> 6);
    const int qb = unit & 15, h = (unit >> 4) & 3, b = unit >> 6;
    const float* scal = (const float*)(ws + WS_SCAL) + 16 * l;
    const float lam = scal[0], oml = scal[1], m2 = scal[2];
    const float slope2 = exp2f(-2.f * (float)(h + 1)) * LOG2E;
    const bf16_t* Q1 = (const bf16_t*)(ws + WS_QD) + (((size_t)b * 4 + h) * 2) * S * 64;
    const bf16_t* K1 = (const bf16_t*)(ws + WS_KD) + (((size_t)b * 4 + h) * 2) * S * 64;
    const bf16_t* VT = (const bf16_t*)(ws + WS_VDT) + (((size_t)b * 4 + h) * 128) * S;
    const float* gsub = p.in[6] + l * 128;
    bf16_t* mix = (bf16_t*)(ws + WS_MIX);
#if NAIVE_ATTN
    {
        const int q = qb * 128 + (tid >> 2), mm = (tid >> 1) & 1, dh = tid & 1;
        const bf16_t* Qp = Q1 + (size_t)mm * S * 64 + (size_t)q * 64; const bf16_t* Kp = K1 + (size_t)mm * S * 64;
        float qv[64];
#pragma unroll
        for (int c8 = 0; c8 < 8; ++c8) { float f[8]; unpack8(*(const u32x4*)(Qp + c8 * 8), f);
#pragma unroll
            for (int i = 0; i < 8; ++i) qv[c8 * 8 + i] = f[i]; }
        float o[64]; float lsum = 0.f;
#pragma unroll
        for (int d = 0; d < 64; ++d) o[d] = 0.f;
        for (int key = 0; key < S; ++key) {
            float sc = 0.f;
#pragma unroll
            for (int c8 = 0; c8 < 8; ++c8) { float f[8]; unpack8(*(const u32x4*)(Kp + (size_t)key * 64 + c8 * 8), f);
#pragma unroll
                for (int i = 0; i < 8; ++i) sc += qv[c8 * 8 + i] * f[i]; }
            const float pv = __builtin_amdgcn_exp2f(sc - slope2 * fabsf((float)(q - key)) - m2);
            lsum += pv;
            const int kp = sigma16(key);
#pragma unroll
            for (int d = 0; d < 64; ++d) o[d] += pv * bf2f(VT[(size_t)(dh * 64 + d) * S + kp]);
        }
        const float inv = 1.f / lsum; float ss = 0.f;
#pragma unroll
        for (int d = 0; d < 64; ++d) { const float mine = o[d] * inv; const float other = __shfl_xor(mine, 2); o[d] = mine - lam * other; ss += o[d] * o[d]; }
        ss += __shfl_xor(ss, 1);
        if (mm == 0) {
            const float rn = __builtin_amdgcn_rsqf(ss * (1.f / 128.f) + EPS) * oml;
            bf16_t* dst = mix + (size_t)(b * S + q) * DM + h * 128 + dh * 64;
#pragma unroll
            for (int d = 0; d < 64; d += 2) *(unsigned*)(dst + d) = pk2(o[d] * rn * gsub[dh * 64 + d], o[d + 1] * rn * gsub[dh * 64 + d + 1]);
        }
    }
#else
    {
        const int r = lane & 31, hh = lane >> 5, qs = wid >> 1, mm = wid & 1, qpos = qb * 128 + qs * 32 + r;
        const bf16_t* Qm_ = Q1 + (size_t)mm * S * 64;
        bf16x8 qf[4];
#pragma unroll
        for (int ks = 0; ks < 4; ++ks) qf[ks] = *(const bf16x8*)(Qm_ + (size_t)qpos * 64 + ks * 16 + hh * 8);
        f32x16 O[4]; float lsum = 0.f;
#pragma unroll
        for (int db = 0; db < 4; ++db)
#pragma unroll
            for (int i = 0; i < 16; ++i) O[db][i] = 0.f;
        const int srow = lane >> 3, c0 = (lane & 7) ^ (srow >> 1);
        const bool isk = wid < 4;
        const bf16_t* sbase = isk ? (K1 + (size_t)(wid >> 1) * S * 64 + (size_t)(wid & 1) * 32 * 64) : (VT + (size_t)(wid - 4) * 32 * S);
        const int rstride = isk ? 64 : S, kstride = isk ? 64 * 64 : 64;
        const bf16_t* sb0 = sbase + (size_t)srow * rstride + c0 * 8;
        const bf16_t* sb1 = sbase + (size_t)srow * rstride + (c0 ^ 4) * 8;
        const int lanebase = r * 128 + ((hh ^ ((r >> 1) & 7)) << 4);
#define DA_STAGE(kt, sbuf) do { _Pragma("unroll") for (int j = 0; j < 4; ++j) \
            glds16(((j & 1) ? sb1 : sb0) + (size_t)(8 * j) * rstride + (size_t)(kt) * kstride, lds + (sbuf) * ASTG + (wid * 4 + j) * 1024); } while (0)
        DA_STAGE(0, 0); DA_STAGE(1, 1);
        int sb = 0;
        const int kq0 = 4 * hh - qpos;
        for (int kt = 0; kt < S / 64; ++kt) {
            if (kt + 1 < S / 64) WAITV(4); else WAITV(0);
            __builtin_amdgcn_s_barrier();
            if (kt + 2 < S / 64) { const int sn = sb >= 1 ? sb - 1 : 2; DA_STAGE(kt + 2, sn); }
            const LAS uchar* st = lds + sb * ASTG;
#pragma unroll
            for (int kb = 0; kb < 2; ++kb) {
                f32x16 sacc;
#pragma unroll
                for (int i = 0; i < 16; ++i) sacc[i] = 0.f;
#pragma unroll
                for (int ks = 0; ks < 4; ++ks) {
                    const bf16x8 kf = *(const LAS bf16x8*)(st + mm * 8192 + kb * 4096 + (lanebase ^ (ks << 5)));
                    sacc = MFMA32(kf, qf[ks], sacc);
                }
                const int kbase = kt * 64 + 32 * kb + kq0;
                float ls = 0.f;
#pragma unroll
                for (int i = 0; i < 16; ++i) {
                    const float dist = fabsf((float)(kbase + (i & 3) + 8 * (i >> 2)));
                    const float pv = __builtin_amdgcn_exp2f(sacc[i] - slope2 * dist - m2);
                    ls += pv; sacc[i] = pv;
                }
                lsum += ls;
                bf16x8 pb[2];
#pragma unroll
                for (int s2 = 0; s2 < 2; ++s2) {
                    u32x4 w;
#pragma unroll
                    for (int i = 0; i < 4; ++i) w[i] = pk2(sacc[8 * s2 + 2 * i], sacc[8 * s2 + 2 * i + 1]);
                    pb[s2] = __builtin_bit_cast(bf16x8, w);
                }
#pragma unroll
                for (int db = 0; db < 4; ++db)
#pragma unroll
                    for (int s2 = 0; s2 < 2; ++s2) {
                        const bf16x8 vf = *(const LAS bf16x8*)(st + 16384 + db * 4096 + (lanebase ^ ((2 * kb + s2) << 5)));
                        O[db] = MFMA32(vf, pb[s2], O[db]);
                    }
            }
            sb = sb == 2 ? 0 : sb + 1;
        }
#undef DA_STAGE
        const float lt = lsum + __shfl_xor(lsum, 32);
        const float sc = (mm == 0) ? (1.f / lt) : (lam / lt);
        __syncthreads();
        LAS float* xch = (LAS float*)lds + qs * 4096;
        if (mm == 1) {
#pragma unroll
            for (int db = 0; db < 4; ++db)
#pragma unroll
                for (int i = 0; i < 16; ++i) xch[(db * 16 + i) * 64 + lane] = O[db][i] * sc;
        }
        __syncthreads();
        if (mm == 0) {
            float ss = 0.f;
#pragma unroll
            for (int db = 0; db < 4; ++db)
#pragma unroll
                for (int i = 0; i < 16; ++i) { const float o = O[db][i] * sc - xch[(db * 16 + i) * 64 + lane]; O[db][i] = o; ss += o * o; }
            ss += __shfl_xor(ss, 32);
            const float rn = __builtin_amdgcn_rsqf(ss * (1.f / 128.f) + EPS) * oml;
            bf16_t* dst = mix + (size_t)(b * S + qpos) * DM + h * 128;
#pragma unroll
            for (int db = 0; db < 4; ++db)
#pragma unroll
                for (int q4 = 0; q4 < 4; ++q4) {
                    const int d = 32 * db + 8 * q4 + 4 * hh;
                    const f32x4 g = *(const f32x4*)(gsub + d);
                    u32x2 w; w[0] = pk2(O[db][4 * q4] * rn * g[0], O[db][4 * q4 + 1] * rn * g[1]);
                    w[1] = pk2(O[db][4 * q4 + 2] * rn * g[2], O[db][4 * q4 + 3] * rn * g[3]);
                    *(u32x2*)(dst + d) = w;
                }
        }
    }
#endif
    __syncthreads();
}

__device__ __forceinline__ void mla_attn_unit(LAS uchar* lds, const Params& p, int l, int unit) {
    uchar* ws = p.ws;
    const int tid = tid_opaque(), lane = tid & 63, wid = __builtin_amdgcn_readfirstlane(tid >> 6);
    const int qb = unit & 7, h = (unit >> 3) & 3, b = unit >> 5;
    const float m2 = ((const float*)(ws + WS_SCAL))[16 * l + 3];
    const bf16_t* Q = (const bf16_t*)(ws + WS_QM) + (((size_t)b * 4 + h) * S) * 96;
    const bf16_t* Kp = (const bf16_t*)(ws + WS_KM) + (((size_t)b * 4 + h) * S) * 96;
    const bf16_t* VT = (const bf16_t*)(ws + WS_VMT) + (((size_t)b * 4 + h) * 64) * S;
    bf16_t* mix = (bf16_t*)(ws + WS_MIX);
#if NAIVE_ATTN
    {
        const int q = qb * 256 + (tid >> 1), hf = tid & 1;
        float qv[96];
#pragma unroll
        for (int c8 = 0; c8 < 12; ++c8) { float f[8]; unpack8(*(const u32x4*)(Q + (size_t)q * 96 + c8 * 8), f);
#pragma unroll
            for (int i = 0; i < 8; ++i) qv[c8 * 8 + i] = f[i]; }
        float o[32]; float lsum = 0.f;
#pragma unroll
        for (int d = 0; d < 32; ++d) o[d] = 0.f;
        for (int key = 0; key < S; ++key) {
            float sc = 0.f;
#pragma unroll
            for (int c8 = 0; c8 < 12; ++c8) { float f[8]; unpack8(*(const u32x4*)(Kp + (size_t)key * 96 + c8 * 8), f);
#pragma unroll
                for (int i = 0; i < 8; ++i) sc += qv[c8 * 8 + i] * f[i]; }
            const float pv = __builtin_amdgcn_exp2f(sc - m2);
            lsum += pv;
            const int kp = sigma16(key);
#pragma unroll
            for (int d = 0; d < 32; ++d) o[d] += pv * bf2f(VT[(size_t)(hf * 32 + d) * S + kp]);
        }
        const float inv = 1.f / lsum;
        bf16_t* dst = mix + (size_t)(b * S + q) * DM + 512 + h * 64 + hf * 32;
#pragma unroll
        for (int d = 0; d < 32; d += 2) *(unsigned*)(dst + d) = pk2(o[d] * inv, o[d + 1] * inv);
    }
#else
    {
        const int r = lane & 31, hh = lane >> 5, qpos = qb * 256 + wid * 32 + r;
        bf16x8 qf[6];
#pragma unroll
        for (int ks = 0; ks < 6; ++ks) qf[ks] = *(const bf16x8*)(Q + (size_t)qpos * 96 + ks * 16 + hh * 8);
        f32x16 O[2]; float lsum = 0.f;
#pragma unroll
        for (int db = 0; db < 2; ++db)
#pragma unroll
            for (int i = 0; i < 16; ++i) O[db][i] = 0.f;
        const int lanebase = r * 128 + ((hh ^ ((r >> 1) & 7)) << 4), lanebase64 = r * 64 + ((hh ^ ((r >> 2) & 3)) << 4);
        const bool lo4 = wid < 4;
        const bf16_t* s0p; const bf16_t* s1p; const bf16_t* s2p;
        {
            const int srow = lane >> 3;
            { const int row = 8 * wid + srow; const int c = (lane & 7) ^ ((row >> 1) & 7); s0p = Kp + (size_t)row * 96 + c * 8; }
            if (lo4) { const int row = 16 * wid + (lane >> 2); const int c = (lane & 3) ^ ((row >> 2) & 3); s1p = Kp + (size_t)row * 96 + 64 + c * 8; }
            else { const int row = 8 * (wid - 4) + srow; const int c = (lane & 7) ^ ((row >> 1) & 7); s1p = VT + (size_t)row * S + c * 8; }
            { const int row = 8 * ((wid & 3) + 4) + srow; const int c = (lane & 7) ^ ((row >> 1) & 7); s2p = VT + (size_t)row * S + c * 8; }
        }
        const int k1stride = lo4 ? 64 * 96 : 64;
#define MA_STAGE(kt, sbuf) do { \
            glds16(s0p + (size_t)(kt) * (64 * 96), lds + (sbuf) * MSTG + wid * 1024); \
            glds16(s1p + (size_t)(kt) * k1stride, lds + (sbuf) * MSTG + (wid + 8) * 1024); \
            if (lo4) glds16(s2p + (size_t)(kt) * 64, lds + (sbuf) * MSTG + (wid + 16) * 1024); } while (0)
        MA_STAGE(0, 0); MA_STAGE(1, 1);
        int sb = 0;
        for (int kt = 0; kt < S / 64; ++kt) {
            if (kt + 1 < S / 64) { if (lo4) WAITV(3); else WAITV(2); } else WAITV(0);
            __builtin_amdgcn_s_barrier();
            if (kt + 2 < S / 64) { const int sn = sb >= 1 ? sb - 1 : 2; MA_STAGE(kt + 2, sn); }
            const LAS uchar* st = lds + sb * MSTG;
#pragma unroll
            for (int kb = 0; kb < 2; ++kb) {
                f32x16 sacc;
#pragma unroll
                for (int i = 0; i < 16; ++i) sacc[i] = -m2;
#pragma unroll
                for (int ks = 0; ks < 4; ++ks) {
                    const bf16x8 kf = *(const LAS bf16x8*)(st + kb * 4096 + (lanebase ^ (ks << 5)));
                    sacc = MFMA32(kf, qf[ks], sacc);
                }
#pragma unroll
                for (int ks = 0; ks < 2; ++ks) {
                    const bf16x8 kf = *(const LAS bf16x8*)(st + 8192 + kb * 2048 + (lanebase64 ^ (ks << 5)));
                    sacc = MFMA32(kf, qf[4 + ks], sacc);
                }
                float ls = 0.f;
#pragma unroll
                for (int i = 0; i < 16; ++i) { const float pv = __builtin_amdgcn_exp2f(sacc[i]); ls += pv; sacc[i] = pv; }
                lsum += ls;
                bf16x8 pb[2];
#pragma unroll
                for (int s2 = 0; s2 < 2; ++s2) {
                    u32x4 w;
#pragma unroll
                    for (int i = 0; i < 4; ++i) w[i] = pk2(sacc[8 * s2 + 2 * i], sacc[8 * s2 + 2 * i + 1]);
                    pb[s2] = __builtin_bit_cast(bf16x8, w);
                }
#pragma unroll
                for (int db = 0; db < 2; ++db)
#pragma unroll
                    for (int s2 = 0; s2 < 2; ++s2) {
                        const bf16x8 vf = *(const LAS bf16x8*)(st + 12288 + db * 4096 + (lanebase ^ ((2 * kb + s2) << 5)));
                        O[db] = MFMA32(vf, pb[s2], O[db]);
                    }
            }
            sb = sb == 2 ? 0 : sb + 1;
        }
#undef MA_STAGE
        const float lt = lsum + __shfl_xor(lsum, 32); const float inv = 1.f / lt;
        bf16_t* dst = mix + (size_t)(b * S + qpos) * DM + 512 + h * 64;
#pragma unroll
        for (int db = 0; db < 2; ++db)
#pragma unroll
            for (int q4 = 0; q4 < 4; ++q4) {
                const int d = 32 * db + 8 * q4 + 4 * hh;
                u32x2 w; w[0] = pk2(O[db][4 * q4] * inv, O[db][4 * q4 + 1] * inv); w[1] = pk2(O[db][4 * q4 + 2] * inv, O[db][4 * q4 + 3] * inv);
                *(u32x2*)(dst + d) = w;
            }
    }
#endif
    __syncthreads();
}

__device__ __forceinline__ int xp_rowmap(int mode, int n) {
    return mode == 0 ? n : mode == 1 ? (n / 96) * 128 + (n % 96) : mode == 2 ? ((n >> 6) * 128 + (n & 63)) : ((n >> 6) * 128 + 64 + (n & 63));
}
__device__ __forceinline__ void xpose_tile(LAS uchar* lds, const float* src, int K, int N, bf16_t* dst, int ldd, int mode, const float* gain, int kt, int ntile) {
    LAS float* sh = (LAS float*)lds; const int tid = tid_opaque();
    (void)K;
#pragma unroll 4
    for (int i = 0; i < 8; ++i) {
        const int kl = (tid >> 6) + 8 * i, k = kt * 64 + kl, n = ntile * 64 + (tid & 63);
        float v = (n < N) ? src[(size_t)k * N + n] : 0.f;
        if (gain) v *= gain[k];
        sh[kl * 65 + (tid & 63)] = v;
    }
    __syncthreads();
    {
        const int nl = tid >> 3, kq = tid & 7, n = ntile * 64 + nl;
        if (n < N) {
            bf16_t* d = dst + (size_t)xp_rowmap(mode, n) * ldd + kt * 64 + kq * 8;
            u32x4 o0;
#pragma unroll
            for (int i = 0; i < 4; ++i) o0[i] = pk2(sh[(kq * 8 + 2 * i) * 65 + nl], sh[(kq * 8 + 2 * i + 1) * 65 + nl]);
            *(u32x4*)d = o0;
        }
    }
    __syncthreads();
}
__device__ __forceinline__ void xpose_job(LAS uchar* lds, const float* src, int K, int N, bf16_t* dst, int ldd, int mode, const float* gain) {
    const int nkt = K >> 6, nnt = (N + 63) >> 6, tot = nkt * nnt;
    for (int u = blockIdx.x; u < tot; u += gridDim.x) xpose_tile(lds, src, K, N, dst, ldd, mode, gain, u % nkt, u / nkt);
}
__device__ __forceinline__ void expert_weights(LAS uchar* lds, const Params& p, int l) {
    bf16_t* wgu = (bf16_t*)(p.ws + WS_WGU); bf16_t* wd = (bf16_t*)(p.ws + WS_WD);
    const float* g2 = p.in[18] + l * DM;
    for (int u = blockIdx.x; u < 32 * 192; u += gridDim.x) {
        const int e = u / 192, w = u % 192, job = w >> 6, tl = w & 63;
        if (job == 0) xpose_tile(lds, p.in[23] + ((size_t)l * 32 + e) * DM * 256, DM, 256, wgu + (size_t)e * 512 * DM, DM, 2, g2, tl & 15, tl >> 4);
        else if (job == 1) xpose_tile(lds, p.in[24] + ((size_t)l * 32 + e) * DM * 256, DM, 256, wgu + (size_t)e * 512 * DM, DM, 3, g2, tl & 15, tl >> 4);
        else xpose_tile(lds, p.in[25] + ((size_t)l * 32 + e) * 256 * DM, 256, DM, wd + (size_t)e * DM * 256, 256, 0, nullptr, tl & 3, tl >> 2);
    }
}
__device__ __forceinline__ void row_prep(const float* xrow, bf16_t* xb, float* rstd, int lane) {
    float ss = 0.f; f32x4 v[4];
#pragma unroll
    for (int i = 0; i < 4; ++i) { v[i] = *(const f32x4*)(xrow + i * 256 + lane * 4); ss += v[i][0] * v[i][0] + v[i][1] * v[i][1] + v[i][2] * v[i][2] + v[i][3] * v[i][3]; }
    ss = wave_sum(ss);
#pragma unroll
    for (int i = 0; i < 4; ++i) { u32x2 o; o[0] = pk2(v[i][0], v[i][1]); o[1] = pk2(v[i][2], v[i][3]); *(u32x2*)(xb + i * 256 + lane * 4) = o; }
    if (lane == 0) *rstd = __builtin_amdgcn_rsqf(ss * (1.f / 1024.f) + EPS);
}

__device__ __forceinline__ void phase0(LAS uchar* lds, const Params& p) {
    uchar* ws = p.ws; const int tid = tid_opaque(), gtid = blockIdx.x * NT + tid, gsz = gridDim.x * NT;
    for (int l = 0; l < NL; ++l) {
        xpose_job(lds, p.in[2] + (size_t)l * DM * NIN, DM, NIN, (bf16_t*)(ws + WS_WIN) + (size_t)l * NINP * DM, DM, 0, p.in[1] + l * DM);
        xpose_job(lds, p.in[17] + (size_t)l * DM * DM, DM, DM, (bf16_t*)(ws + WS_WOUT) + (size_t)l * DM * DM, DM, 0, nullptr);
        xpose_job(lds, p.in[9] + (size_t)l * 192 * 384, 192, 384, (bf16_t*)(ws + WS_WUQ) + (size_t)l * 512 * 192, 192, 1, p.in[7] + l * 192);
        xpose_job(lds, p.in[10] + (size_t)l * 128 * 512, 128, 512, (bf16_t*)(ws + WS_WUKV) + (size_t)l * 512 * 128, 128, 0, p.in[8] + l * 128);
        for (int g = 0; g < 4; ++g)
            xpose_job(lds, p.in[15] + ((size_t)l * 4 + g) * 64 * 64, 64, 64, (bf16_t*)(ws + WS_POOLW) + ((size_t)l * 4 + g) * 128 * 64, 64, 0, nullptr);
        { bf16_t* w = (bf16_t*)(ws + WS_WIN) + ((size_t)l * NINP + NIN) * DM; for (int i = gtid; i < 32 * DM; i += gsz) w[i] = 0; }
        { bf16_t* w = (bf16_t*)(ws + WS_WUQ) + (size_t)l * 512 * 192; for (int i = gtid; i < 4 * 32 * 192; i += gsz) { const int hd = i / (32 * 192), rem = i % (32 * 192); w[(size_t)(hd * 128 + 96) * 192 + rem] = 0; } }
        { bf16_t* w = (bf16_t*)(ws + WS_POOLW) + (size_t)l * 4 * 128 * 64; for (int i = gtid; i < 4 * 64 * 64; i += gsz) { const int g = i >> 12, rem = i & 4095; w[(size_t)(g * 128 + 64) * 64 + rem] = 0; } }
    }
    expert_weights(lds, p, 0);
    for (int i = gtid; i < NL * 128 * 1024; i += gsz) {
        const int k = i & 1023, n = (i >> 10) & 127, l = i >> 17;
        float v = 0.f;
        if (n < 4) v = p.in[19][((size_t)l * DM + k) * 4 + n]; else if (n < 36) v = p.in[21][((size_t)l * DM + k) * 32 + (n - 4)];
        v *= p.in[18][l * DM + k];
        const bf16_t hi = f2bf(v), lo = f2bf(v - bf2f(hi));
        bf16_t* w = (bf16_t*)(ws + WS_WR) + ((size_t)l * 128 + n) * 3072 + k;
        w[0] = hi; w[1024] = hi; w[2048] = lo;
    }
    for (int i = gtid; i < S * 16; i += gsz) {
        const int pos = i >> 4, f = i & 15;
        double inv = 1.0; for (int k = 0; k < f; ++k) inv *= 0.5623413251903491;
        const double rev = (double)pos * inv * 0.15915494309189535;
        const float fr = (float)(rev - __builtin_rint(rev));
        ((float*)(ws + WS_ROPE))[i] = __builtin_amdgcn_cosf(fr);
        ((float*)(ws + WS_ROPE))[S * 16 + i] = __builtin_amdgcn_sinf(fr);
    }
    if (gtid < NL) {
        const int l = gtid; float* sc = (float*)(ws + WS_SCAL) + 16 * l;
        const float* lv = p.in[5] + l * 256;
        float d1 = 0.f, d2 = 0.f; for (int i = 0; i < 64; ++i) { d1 += lv[i] * lv[64 + i]; d2 += lv[128 + i] * lv[192 + i]; }
        const float lam_init = 0.8f - 0.6f * expf(-0.3f * (float)l);
        sc[0] = expf(d1) - expf(d2) + lam_init; sc[1] = 1.f - lam_init;
        float gq = 0.f, gk = 0.f; for (int i = 0; i < 64; ++i) { gq = fmaxf(gq, fabsf(p.in[3][l * 64 + i])); gk = fmaxf(gk, fabsf(p.in[4][l * 64 + i])); }
        sc[2] = gq * gk * 8.f * LOG2E * 1.02f;
        float a = 0.f, bq = 0.f, c = 0.f, dk = 0.f;
        for (int i = 0; i < 64; ++i) { a = fmaxf(a, fabsf(p.in[11][l * 64 + i])); c = fmaxf(c, fabsf(p.in[13][l * 64 + i])); }
        for (int i = 0; i < 32; ++i) { bq = fmaxf(bq, fabsf(p.in[12][l * 32 + i])); dk = fmaxf(dk, fabsf(p.in[14][l * 32 + i])); }
        sc[3] = sqrtf(64.f * a * a + 32.f * bq * bq) * sqrtf(64.f * c * c + 32.f * dk * dk) * QSCALE_M * 1.02f;
    }
    {
        const int lane = tid & 63, gw = gtid >> 6, nw = gsz >> 6;
        for (int t = gw; t < T; t += nw) row_prep(p.in[0] + (size_t)t * DM, (bf16_t*)(ws + WS_XB) + (size_t)t * DM, (float*)(ws + WS_RSTD1) + t, lane);
    }
}

__device__ __forceinline__ void ph_gemm1(LAS uchar* lds, const Params& p, int l) {
    const bf16_t* xb = (const bf16_t*)(p.ws + WS_XB); const bf16_t* win = (const bf16_t*)(p.ws + WS_WIN) + (size_t)l * NINP * DM;
    for (int u = blockIdx.x; u < 64 * 17; u += gridDim.x) {
        const int mt = u / 17, nt = u % 17;
        ARowLinear ar{xb + (size_t)mt * 256 * DM, (size_t)DM};
        EpiProj ep{mt, nt, l, &p};
        gemm_tile(lds, ar, win + (size_t)nt * 128 * DM, (size_t)DM, DM, ep);
    }
}
__device__ __forceinline__ void pooled_unit(LAS uchar* lds, const Params& p, int mt) {
    const int tid = tid_opaque();
    const int t0 = mt * 256, b = t0 >> 11, s0 = t0 & 2047;
    const bf16_t* lat = (const bf16_t*)(p.ws + WS_LAT) + (size_t)b * S * 640 + 352;
    for (int it = 0; it < 17; ++it) {
        const int item = it * NT + tid, c8 = item & 31, rl = item >> 5, sr = s0 - 8 + rl;
        if (sr >= 0 && sr < S) *(LAS u32x4*)(lds + rl * 512 + c8 * 16) = *(const u32x4*)(lat + (size_t)sr * 640 + c8 * 8);
    }
    __syncthreads();
    {
        const int c = tid & 255, rh = tid >> 8, g = c >> 6, half = 1 << g;
        bf16_t* dst = (bf16_t*)(p.ws + WS_POOLED) + (size_t)(t0 + rh * 128) * 256 + c;
        const LAS bf16_t* col = (const LAS bf16_t*)lds + c;
        for (int r = 0; r < 128; ++r) {
            const int s = s0 + rh * 128 + r; int lo = s - half, hi = s + half - 1; lo = lo < 0 ? 0 : lo; hi = hi > S - 1 ? S - 1 : hi;
            float sum = 0.f;
            for (int j = lo; j <= hi; ++j) sum += bf2f(col[(j - s0 + 8) * 256]);
            const float v = sum / (float)(hi - lo + 1) - bf2f(col[(s - s0 + 8) * 256]);
            dst[(size_t)r * 256] = f2bf(v);
        }
    }
    __syncthreads();
}
__device__ __forceinline__ void ph_mix_a(LAS uchar* lds, const Params& p, int l) {
    const bf16_t* lat = (const bf16_t*)(p.ws + WS_LAT);
    for (int u = blockIdx.x; u < 512 + 512 + 64; u += gridDim.x) {
        if (u < 512) diff_attn_unit(lds, p, l, u);
        else if (u < 1024) {
            const int v = u - 512, mt = v >> 3, w = v & 7, h = w & 3;
            if (w < 4) { ARowLinear ar{lat + (size_t)mt * 256 * 640, (size_t)640}; EpiMlaQ ep{mt, h, l, &p};
                gemm_tile(lds, ar, (const bf16_t*)(p.ws + WS_WUQ) + ((size_t)l * 512 + h * 128) * 192, (size_t)192, 192, ep); }
            else { ARowLinear ar{lat + (size_t)mt * 256 * 640 + 192, (size_t)640}; EpiMlaKV ep{mt, h, l, &p};
                gemm_tile(lds, ar, (const bf16_t*)(p.ws + WS_WUKV) + ((size_t)l * 512 + h * 128) * 128, (size_t)128, 128, ep); }
        } else pooled_unit(lds, p, u - 1024);
    }
}
__device__ __forceinline__ void ph_mix_b(LAS uchar* lds, const Params& p, int l) {
    for (int u = blockIdx.x; u < 256 + 256; u += gridDim.x) {
        if (u < 256) mla_attn_unit(lds, p, l, u);
        else { const int v = u - 256, mt = v >> 2, g = v & 3;
            ARowLinear ar{(const bf16_t*)(p.ws + WS_POOLED) + (size_t)mt * 256 * 256 + g * 64, (size_t)256}; EpiPool ep{mt, g, l, &p};
            gemm_tile(lds, ar, (const bf16_t*)(p.ws + WS_POOLW) + ((size_t)l * 4 + g) * 128 * 64, (size_t)64, 64, ep); }
    }
}
__device__ __forceinline__ void ph_wout(LAS uchar* lds, const Params& p, int l) {
    const bf16_t* mix = (const bf16_t*)(p.ws + WS_MIX); const bf16_t* wo = (const bf16_t*)(p.ws + WS_WOUT) + (size_t)l * DM * DM;
    const float* xres = (l == 0) ? p.in[0] : p.out;
    for (int u = blockIdx.x; u < 64 * 8; u += gridDim.x) {
        const int mt = u >> 3, nt = u & 7;
        ARowLinear ar{mix + (size_t)mt * 256 * DM, (size_t)DM}; EpiWout ep{mt, nt, xres, &p};
        gemm_tile(lds, ar, wo + (size_t)nt * 128 * DM, (size_t)DM, DM, ep);
    }
}
constexpr int LDS_RT = 135168;
struct EpiRouter {
    int mt, l; bool dry; const Params* p;
    __device__ __forceinline__ void operator()(const LAS uchar* ct) const {
        uchar* ws = p->ws; const int tid = tid_opaque();
        const LAS float* ctf = (const LAS float*)ct;
        LAS unsigned* shcnt = (LAS unsigned*)(ct + LDS_RT); LAS unsigned* shbase = shcnt + 32; LAS unsigned* pend = shcnt + 64;
        unsigned* cnt = (unsigned*)(ws + WS_CTL) + CW_CNT + 1024 * l + (dry ? 2048 : 0);
        unsigned* list = (unsigned*)(ws + (dry ? WS_POOLED : WS_LIST)); float* gwt = (float*)(ws + (dry ? WS_POOLED + 4 * MiB : WS_GW)); float* rstd2 = (float*)(ws + (dry ? WS_POOLED + 5 * MiB : WS_RSTD2));
        const float* bg = p->in[20] + l * 4; const float* be = p->in[22] + l * 32;
        if (tid < 32) shcnt[tid] = 0u;
        __syncthreads();
        if (tid < 256) {
            const int t = mt * 256 + tid;
            const float* ps = (const float*)(ws + WS_PSS) + (size_t)t * 8;
            const f32x4 p0 = *(const f32x4*)ps, p1 = *(const f32x4*)(ps + 4);
            const float ss = ((p0[0] + p0[1]) + (p0[2] + p0[3])) + ((p1[0] + p1[1]) + (p1[2] + p1[3]));
            const float rs = __builtin_amdgcn_rsqf(ss * (1.f / 1024.f) + EPS);
            const LAS float* row = ctf + tid * CTF_PITCH;
            float gl[4];
#pragma unroll
            for (int n = 0; n < 4; ++n) gl[n] = row[n] * rs + bg[n];
            int gi = 0; float gm = gl[0];
#pragma unroll
            for (int n = 1; n < 4; ++n) if (gl[n] > gm) { gm = gl[n]; gi = n; }
            float gs = 0.f;
#pragma unroll
            for (int n = 0; n < 4; ++n) gs += __expf(gl[n] - gm);
            const float gtop = 1.f / gs;
            float el[8];
#pragma unroll
            for (int n = 0; n < 8; ++n) el[n] = row[4 + gi * 8 + n] * rs + be[gi * 8 + n];
            int i1 = 0; float m1 = el[0];
#pragma unroll
            for (int n = 1; n < 8; ++n) if (el[n] > m1) { m1 = el[n]; i1 = n; }
            int i2 = -1; float m2v = -3.0e38f;
#pragma unroll
            for (int n = 0; n < 8; ++n) if (n != i1 && el[n] > m2v) { m2v = el[n]; i2 = n; }
            const float e2 = __expf(m2v - m1); const float w1 = gtop / (1.f + e2), w2 = gtop * e2 / (1.f + e2);
            const int ea = gi * 8 + i1, eb = gi * 8 + i2;
            const unsigned pa = __hip_atomic_fetch_add(&shcnt[ea], 1u, __ATOMIC_RELAXED, __HIP_MEMORY_SCOPE_WORKGROUP);
            const unsigned pbk = __hip_atomic_fetch_add(&shcnt[eb], 1u, __ATOMIC_RELAXED, __HIP_MEMORY_SCOPE_WORKGROUP);
            pend[tid * 2] = ((unsigned)ea << 16) | pa; pend[tid * 2 + 1] = ((unsigned)eb << 16) | pbk;
            gwt[t * 2] = w1; gwt[t * 2 + 1] = w2; rstd2[t] = rs;
        }
        __syncthreads();
        if (tid < 32) { const unsigned c = shcnt[tid]; shbase[tid] = c ? atomicAdd(&cnt[tid * 32], c) : 0u; }
        __syncthreads();
        { const unsigned pe = pend[tid], e = pe >> 16, lp = pe & 0xffffu; list[(size_t)e * T + shbase[e] + lp] = (unsigned)((mt * 256 + (tid >> 1)) * 2 + (tid & 1)); }
    }
};
__device__ __forceinline__ void ph_router(LAS uchar* lds, const Params& p, int l, bool dry = false) {
    const bf16_t* xb = (const bf16_t*)(p.ws + WS_XB); const bf16_t* wr = (const bf16_t*)(p.ws + WS_WR) + (size_t)l * 128 * 3072;
    for (int u = blockIdx.x; u < 64; u += gridDim.x) {
        ARowLinear ar{xb + (size_t)u * 256 * DM, (size_t)DM}; EpiRouter ep{u, l, dry, &p};
        AOffRouter ao{(int)((WS_XL - WS_XB) / 2)};
        gemm_tile<true>(lds, ar, wr, (size_t)3072, 3072, ep, ao);
    }
}
__device__ __forceinline__ void moe_find(const unsigned* cnt, int rbg, int& e, int& rb, int& nvalid, int& pre) {
    int acc = 0; e = -1; rb = 0; nvalid = 0; pre = 0;
    for (int i = 0; i < 32; ++i) { const int c = (int)cnt[i * 32], nb = (c + 255) >> 8;
        if (e < 0 && rbg < acc + nb) { e = i; rb = rbg - acc; nvalid = c - rb * 256; if (nvalid > 256) nvalid = 256; pre = acc; }
        acc += nb; }
}
__device__ __forceinline__ int moe_total(const unsigned* cnt) { int acc = 0; for (int i = 0; i < 32; ++i) acc += ((int)cnt[i * 32] + 255) >> 8; return acc; }
__device__ __forceinline__ void ph_gateup(LAS uchar* lds, const Params& p, int l) {
    uchar* ws = p.ws; const unsigned* cnt = (const unsigned*)(ws + WS_CTL) + CW_CNT + 1024 * l;
    const int tot = moe_total(cnt) * 4;
    for (int u = blockIdx.x; u < tot; u += gridDim.x) {
        int e, rb, nvalid, pre; moe_find(cnt, u >> 2, e, rb, nvalid, pre); const int jt = u & 3;
        const unsigned* list = (const unsigned*)(ws + WS_LIST) + (size_t)e * T + rb * 256;
        ARowGather ar{(const bf16_t*)(ws + WS_XB), list, nvalid};
        EpiGU ep{jt, nvalid, list, (size_t)(u >> 2) * 256, &p};
        gemm_tile(lds, ar, (const bf16_t*)(ws + WS_WGU) + ((size_t)e * 512 + jt * 128) * DM, (size_t)DM, DM, ep);
    }
}
__device__ __forceinline__ void ph_down(LAS uchar* lds, const Params& p, int l) {
    uchar* ws = p.ws; const unsigned* cnt = (const unsigned*)(ws + WS_CTL) + CW_CNT + 1024 * l;
    const int tot = moe_total(cnt) * 8;
    for (int u = blockIdx.x; u < tot; u += gridDim.x) {
        int e, rb, nvalid, pre; moe_find(cnt, u >> 3, e, rb, nvalid, pre); const int nt = u & 7;
        const unsigned* list = (const unsigned*)(ws + WS_LIST) + (size_t)e * T + rb * 256;
        ARowLinear ar{(const bf16_t*)(ws + WS_HMID) + (size_t)(u >> 3) * 256 * 256, (size_t)256};
        EpiDown ep{nt, nvalid, list, &p};
        gemm_tile(lds, ar, (const bf16_t*)(ws + WS_WD) + ((size_t)e * DM + nt * 128) * 256, (size_t)256, 256, ep);
    }
}
__device__ __forceinline__ void ph_combine(LAS uchar* lds, const Params& p, int l, bool dry = false) {
    uchar* ws = p.ws; const int tid = tid_opaque(), lane = tid & 63;
    const int gw = blockIdx.x * 8 + (tid >> 6), nw = gridDim.x * 8;
    const bf16_t* ys = (const bf16_t*)(ws + WS_YS);
    for (int t = gw; t < T; t += nw) {
        const float* xr = p.out + (size_t)t * DM; const bf16_t* y0 = ys + (size_t)(2 * t) * DM; const bf16_t* y1 = y0 + DM;
        float* xw = dry ? (float*)(ws + WS_POOLED) + (size_t)(t & 511) * DM : p.out + (size_t)t * DM;
        bf16_t* xb = dry ? (bf16_t*)(ws + WS_POOLED + 4 * MiB) + (size_t)(t & 511) * DM : (bf16_t*)(ws + WS_XB) + (size_t)t * DM;
        float ss = 0.f;
#pragma unroll
        for (int i = 0; i < 4; ++i) {
            const int c = i * 256 + lane * 4;
            f32x4 v = *(const f32x4*)(xr + c); const u32x2 a = *(const u32x2*)(y0 + c), bq = *(const u32x2*)(y1 + c);
            v[0] += bflo(a[0]) + bflo(bq[0]); v[1] += bfhi(a[0]) + bfhi(bq[0]); v[2] += bflo(a[1]) + bflo(bq[1]); v[3] += bfhi(a[1]) + bfhi(bq[1]);
            *(f32x4*)(xw + c) = v; ss += v[0] * v[0] + v[1] * v[1] + v[2] * v[2] + v[3] * v[3];
            u32x2 o; o[0] = pk2(v[0], v[1]); o[1] = pk2(v[2], v[3]); *(u32x2*)(xb + c) = o;
        }
        ss = wave_sum(ss);
        if (lane == 0) ((float*)(ws + (dry ? WS_POOLED + 6 * MiB : WS_RSTD1)))[t] = __builtin_amdgcn_rsqf(ss * (1.f / 1024.f) + EPS);
    }
    if (l + 1 < NL && !dry) expert_weights(lds, p, l + 1);
}

__global__ void __launch_bounds__(NT, 2) mega(Params p) {
    extern __shared__ __attribute__((aligned(16))) unsigned char smem[];
    LAS uchar* lds = (LAS uchar*)smem;
    if (threadIdx.x == 0) { *(LAS u32x4*)(lds + LDS_XB) = (u32x4){0u, 0u, 0u, 0u}; }
    __syncthreads();
    XcdBarrier bar = xcd_barrier_post((unsigned*)(p.ws + WS_CTL), (volatile LAS unsigned*)(lds + LDS_XB));
#define IN(k) (p.ph_lo <= (k) && (k) < p.ph_hi)
#define SEAM(k) do { if (IN(k) && IN((k) + 1)) xcd_barrier(bar); } while (0)
    if (IN(0)) for (int rep = 0; rep < NREP(8); ++rep) phase0(lds, p);
    SEAM(0);
#define LAUNDER(v) asm volatile("" : "+s"(v))
#pragma unroll 1
    for (int l0 = 0; l0 < NL; ++l0) {
        const int pb = 1 + 8 * l0;
        { int l = l0; LAUNDER(l); if (IN(pb + 0)) for (int rep = 0; rep < NREP(0); ++rep) ph_gemm1(lds, p, l); }
        SEAM(pb + 0);
        { int l = l0; LAUNDER(l); if (IN(pb + 1)) for (int rep = 0; rep < NREP(1); ++rep) ph_mix_a(lds, p, l); }
        SEAM(pb + 1);
        { int l = l0; LAUNDER(l); if (IN(pb + 2)) for (int rep = 0; rep < NREP(2); ++rep) ph_mix_b(lds, p, l); }
        SEAM(pb + 2);
        { int l = l0; LAUNDER(l); if (IN(pb + 3)) for (int rep = 0; rep < (l == 0 ? NREP(3) : 1); ++rep) ph_wout(lds, p, l); }
        SEAM(pb + 3);
        { int l = l0; LAUNDER(l); if (IN(pb + 4)) { if (NREP(4) > 1) ph_router(lds, p, l, true); ph_router(lds, p, l); } }
        SEAM(pb + 4);
        { int l = l0; LAUNDER(l); if (IN(pb + 5)) for (int rep = 0; rep < NREP(5); ++rep) ph_gateup(lds, p, l); }
        SEAM(pb + 5);
        { int l = l0; LAUNDER(l); if (IN(pb + 6)) for (int rep = 0; rep < NREP(6); ++rep) ph_down(lds, p, l); }
        SEAM(pb + 6);
        { int l = l0; LAUNDER(l); if (IN(pb + 7)) { if (NREP(7) > 1) ph_combine(lds, p, l, true); ph_combine(lds, p, l); } }
        SEAM(pb + 7);
    }
}

extern "C" void kernel_launch(void* const* d_in, const int* in_sizes, int n_in, void* d_out, int out_size, void* d_ws, size_t ws_size, hipStream_t stream) {
    (void)in_sizes; (void)n_in; (void)out_size;
    static int grid = 0;
    if (!grid) {
        int dev = 0, cus = 0, per_cu = 0;
        hipGetDevice(&dev);
        hipDeviceGetAttribute(&cus, hipDeviceAttributeMultiprocessorCount, dev);
        hipFuncSetAttribute((const void*)mega, hipFuncAttributeMaxDynamicSharedMemorySize, LDS_BYTES);
        hipOccupancyMaxActiveBlocksPerMultiprocessor(&per_cu, (const void*)mega, NT, LDS_BYTES);
        if (per_cu > 1) per_cu = 1;
        if (per_cu < 1) per_cu = 1;
        grid = cus * per_cu;
    }
    if (ws_size < WS_END) { fprintf(stderr, "workspace too small: %zu < %zu\n", ws_size, (size_t)WS_END); return; }
    hipMemsetAsync(d_ws, 0, CTL_ZERO_BYTES, stream);
    Params p{};
    for (int i = 0; i < 26; ++i) p.in[i] = (const float*)d_in[i];
    p.out = (float*)d_out; p.ws = (unsigned char*)d_ws;
#if N_LAUNCH_SPLIT
    for (int k = 0; k < NPH; ++k) { p.ph_lo = k; p.ph_hi = k + 1; hipLaunchKernelGGL(mega, dim3(grid), dim3(NT), LDS_BYTES, stream, p); }
#else
    p.ph_lo = 0; p.ph_hi = NPH;
    hipLaunchKernelGGL(mega, dim3(grid), dim3(NT), LDS_BYTES, stream, p);
#endif
}
```

```cpp
#include <hip/hip_runtime.h>
#include <stdint.h>
#include <stdio.h>

#ifndef NAIVE_GEMM
#define NAIVE_GEMM 0
#endif
#ifndef NAIVE_ATTN
#define NAIVE_ATTN 0
#endif
#ifndef N_LAUNCH_SPLIT
#define N_LAUNCH_SPLIT 0
#endif

#ifndef SHADOW_V
#define SHADOW_V -1
#endif
#ifndef REPEAT_MASK
#define REPEAT_MASK 0
#endif
#define NREP(k) ((((REPEAT_MASK) >> (k)) & 1) + 1)
#define LAS __attribute__((address_space(3)))
typedef unsigned char uchar;
typedef unsigned short bf16_t;
typedef short bf16x8 __attribute__((ext_vector_type(8)));
typedef float f32x16 __attribute__((ext_vector_type(16)));
typedef float f32x2_t __attribute__((ext_vector_type(2)));
typedef __bf16 bf16x2_t __attribute__((ext_vector_type(2)));
typedef unsigned u32x4 __attribute__((ext_vector_type(4)));
typedef unsigned u32x2 __attribute__((ext_vector_type(2)));
typedef float f32x4 __attribute__((ext_vector_type(4)));

constexpr int NB = 8, S = 2048, DM = 1024, T = NB * S, NL = 2;
constexpr int NIN = 2144, NINP = 2176;
constexpr float EPS = 1e-6f, LOG2E = 1.4426950408889634f;
constexpr float QSCALE_D = 0.125f * LOG2E;
constexpr float QSCALE_M = 0.10206207261596577f * LOG2E;
constexpr int NPH = 1 + 8 * NL;

constexpr size_t MiB = (size_t)1 << 20;
constexpr size_t WS_CTL = 0, CTL_ZERO_BYTES = 32768;
constexpr size_t WS_SCAL = 1 * MiB;
constexpr size_t WS_ROPE = 1 * MiB + 64 * 1024;
constexpr size_t WS_RSTD1 = 1 * MiB + 512 * 1024;
constexpr size_t WS_RSTD2 = WS_RSTD1 + 64 * 1024;
constexpr size_t WS_GW = WS_RSTD2 + 64 * 1024;
constexpr size_t WS_LIST = 2 * MiB;
constexpr size_t WS_WIN = 4 * MiB;
constexpr size_t WS_WOUT = 13 * MiB;
constexpr size_t WS_WUQ = 17 * MiB;
constexpr size_t WS_WUKV = 17 * MiB + 512 * 1024;
constexpr size_t WS_POOLW = 17 * MiB + 768 * 1024;
constexpr size_t WS_WR = 18 * MiB;
constexpr size_t WS_PSS = 19 * MiB + 512 * 1024;
constexpr size_t WS_HSS = 12 * MiB + 512 * 1024;
constexpr size_t WS_WGU = 20 * MiB;
constexpr size_t WS_WD = 52 * MiB;
constexpr size_t WS_XB = 68 * MiB;
constexpr size_t WS_MIX = 100 * MiB;
constexpr size_t WS_HMID = WS_MIX;
constexpr size_t WS_QD = 132 * MiB, WS_KD = 148 * MiB, WS_VDT = 164 * MiB;
constexpr size_t WS_LAT = 180 * MiB;
constexpr size_t WS_QM = 200 * MiB, WS_KM = 212 * MiB, WS_VMT = 224 * MiB;
constexpr size_t WS_POOLED = 232 * MiB;
constexpr size_t WS_XL = 132 * MiB;
constexpr size_t WS_YS = 132 * MiB;
constexpr size_t WS_END = 240 * MiB;

#define XB_TMO      128
#define XB_XCNT(j)  (256  + 64 * (j))
#define XB_XSUB(j)  (1280 + 64 * (j))
#define XB_XGEN(j)  (2304 + 64 * (j))
#define XB_TOP      3328
#define XB_TOPGEN   3392
#define XCD_BAR_WORDS 3456
#define XB_SPIN_CAP (1u << 18)
constexpr int CW_CNT = 4096;

constexpr int NT = 512;
constexpr int LDS_XB = 147456;
constexpr int LDS_BYTES = LDS_XB + 64;
constexpr int GSTG = 49152;
constexpr int ASTG = 32768;
constexpr int MSTG = 20480;

struct Params {
    const float* in[26];
    float* out;
    unsigned char* ws;
    int ph_lo, ph_hi;
};

__device__ __forceinline__ unsigned pk2(float lo, float hi) { f32x2_t v = {lo, hi}; bf16x2_t b = __builtin_convertvector(v, bf16x2_t); return __builtin_bit_cast(unsigned, b); }
__device__ __forceinline__ float bflo(unsigned w) { return __builtin_bit_cast(float, w << 16); }
__device__ __forceinline__ float bfhi(unsigned w) { return __builtin_bit_cast(float, w & 0xffff0000u); }
__device__ __forceinline__ float bf2f(bf16_t u) { return __builtin_bit_cast(float, (unsigned)u << 16); }
__device__ __forceinline__ bf16_t f2bf(float f) { return (bf16_t)(pk2(f, 0.f) & 0xffffu); }
__device__ __forceinline__ int tid_opaque() { int t = threadIdx.x; asm volatile("" : "+v"(t)); return t; }
__device__ __forceinline__ int crow(int r, int hi) { return (r & 3) + 8 * (r >> 2) + 4 * hi; }
__device__ __forceinline__ int sigma16(int s) { return (s & ~12) | ((s & 4) << 1) | ((s & 8) >> 1); }
__device__ __forceinline__ float wave_sum(float v) {
#pragma unroll
    for (int o = 32; o >= 1; o >>= 1) v += __shfl_xor(v, o);
    return v;
}
__device__ __forceinline__ void unpack8(u32x4 w, float (&f)[8]) {
    f[0] = bflo(w[0]); f[1] = bfhi(w[0]); f[2] = bflo(w[1]); f[3] = bfhi(w[1]);
    f[4] = bflo(w[2]); f[5] = bfhi(w[2]); f[6] = bflo(w[3]); f[7] = bfhi(w[3]);
}

__device__ __forceinline__ unsigned xb_ld(unsigned* p)              { return __hip_atomic_load(p, __ATOMIC_RELAXED, __HIP_MEMORY_SCOPE_AGENT); }
__device__ __forceinline__ unsigned xb_add(unsigned* p, unsigned v) { return __hip_atomic_fetch_add(p, v, __ATOMIC_RELAXED, __HIP_MEMORY_SCOPE_AGENT); }
__device__ __forceinline__ unsigned xb_xcc_id() { return (unsigned)__builtin_amdgcn_s_getreg((3 << 11) | 20) & 0xFu; }
#define XB_SPIN(cond, bar) do { unsigned _sp = 0; while (cond) { __builtin_amdgcn_s_sleep(1); \
    if ((++_sp & 255u) == 0u) { if (xb_ld(&(bar)[XB_TMO])) break; if (_sp > XB_SPIN_CAP) { atomicAdd(&(bar)[XB_TMO], 1u); break; } } } } while (0)
struct XcdBarrier { unsigned* bar; unsigned x; volatile LAS unsigned* st; };
__device__ __forceinline__ XcdBarrier xcd_barrier_post(unsigned* bar, volatile LAS unsigned* st) {
    XcdBarrier b; b.bar = bar; b.x = xb_xcc_id(); b.st = st;
    if (threadIdx.x == 0) (void)xb_add(&bar[XB_XCNT(b.x)], 1u);
    return b;
}
__device__ __forceinline__ void xcd_barrier_complete(unsigned* bar, unsigned x, unsigned& nloc, unsigned& nx) {
    const unsigned G = gridDim.x * gridDim.y * gridDim.z;
    unsigned sum, cnt, mine, sp = 0u;
    for (;;) {
        sum = 0u; cnt = 0u; mine = 0u;
#pragma unroll
        for (unsigned j = 0; j < 16; ++j) { const unsigned c = xb_ld(&bar[XB_XCNT(j)]); sum += c; cnt += (c > 0u) ? 1u : 0u; mine = (j == x) ? c : mine; }
        if (sum == G) break;
        __builtin_amdgcn_s_sleep(1);
        if ((++sp & 255u) == 0u) { if (xb_ld(&bar[XB_TMO])) break; if (sp > XB_SPIN_CAP) { atomicAdd(&bar[XB_TMO], 1u); break; } }
    }
    nloc = mine > 0u ? mine : 1u; nx = cnt > 0u ? cnt : 1u;
}
__device__ __forceinline__ void xcd_barrier(const XcdBarrier& b) {
    asm volatile("s_waitcnt vmcnt(0)" ::: "memory");
    __syncthreads();
    if (threadIdx.x == 0) {
        unsigned* bar = b.bar;
        __builtin_amdgcn_s_waitcnt(0);
        unsigned nloc = b.st[0], nx = b.st[1];
        if (nloc == 0u) { xcd_barrier_complete(bar, b.x, nloc, nx); b.st[0] = nloc; b.st[1] = nx; }
        const unsigned old = xb_add(&bar[XB_XSUB(b.x)], 1u);
        const unsigned gen = old / nloc;
        if (old + 1u == (gen + 1u) * nloc) {
            __builtin_amdgcn_fence(__ATOMIC_RELEASE, "agent");
            asm volatile("s_waitcnt vmcnt(0)" ::: "memory");
            const unsigned og = xb_add(&bar[XB_TOP], 1u);
            const unsigned tg = og / nx;
            if (og + 1u == (tg + 1u) * nx) xb_add(&bar[XB_TOPGEN], 1u);
            else XB_SPIN(xb_ld(&bar[XB_TOPGEN]) == tg, bar);
            __builtin_amdgcn_fence(__ATOMIC_ACQUIRE, "agent");
            xb_add(&bar[XB_XGEN(b.x)], 1u);
            asm volatile("s_waitcnt vmcnt(0)" ::: "memory");
        } else {
            XB_SPIN(xb_ld(&bar[XB_XGEN(b.x)]) == gen, bar);
            __builtin_amdgcn_fence(__ATOMIC_ACQUIRE, "agent");
            asm volatile("s_waitcnt vmcnt(0)" ::: "memory");
        }
    }
    __syncthreads();
}

__device__ __forceinline__ void glds16(const void* gsrc, LAS uchar* dst_wave_base) {
    __builtin_amdgcn_global_load_lds((const unsigned*)gsrc, (LAS unsigned*)dst_wave_base, 16, 0, 0);
}
__device__ __forceinline__ int sw128(int row, int c) { return row * 128 + ((c ^ ((row >> 1) & 7)) << 4); }
__device__ __forceinline__ int sw64(int row, int c) { return row * 64 + ((c ^ ((row >> 2) & 3)) << 4); }

#define MFMA32(a, b, c) __builtin_amdgcn_mfma_f32_32x32x16_bf16((a), (b), (c), 0, 0, 0)

constexpr int CT_PITCH = 272;
#define WAITV(n) asm volatile("s_waitcnt vmcnt(" #n ")" ::: "memory")
struct ARowLinear { const bf16_t* base; size_t ld; __device__ __forceinline__ const bf16_t* operator()(int r) const { return base + (size_t)r * ld; } };
struct ARowGather { const bf16_t* base; const unsigned* list; int nvalid; __device__ __forceinline__ const bf16_t* operator()(int r) const {
    const int rr = r < nvalid ? r : nvalid - 1; const unsigned ent = list[rr]; return base + (size_t)(ent >> 1) * DM; } };

struct AOffLinear { __device__ __forceinline__ int operator()(int kt) const { return kt * 64; } };
struct AOffRouter { int xl_off; __device__ __forceinline__ int operator()(int kt) const { return (kt & 15) * 64 + ((kt >> 4) == 1 ? xl_off : 0); } };
constexpr int CTF_PITCH = 129;
template <bool F32C = false, class ARow, class Epi, class AOff = AOffLinear>
__device__ __forceinline__ void gemm_tile(LAS uchar* lds, const ARow& arow, const bf16_t* Bt, size_t ldb, int K, const Epi& epi, const AOff aoff = AOff()) {
    const int tid = tid_opaque(), lane = tid & 63, wid = __builtin_amdgcn_readfirstlane(tid >> 6);
#if NAIVE_GEMM
    {
        const int r = tid >> 1, nh = tid & 1;
        float acc[64];
#pragma unroll
        for (int n = 0; n < 64; ++n) acc[n] = 0.f;
        const bf16_t* ar = arow(r);
        for (int k = 0; k < K; k += 8) {
            float a[8]; unpack8(*(const u32x4*)(ar + k), a);
#pragma unroll
            for (int n = 0; n < 64; ++n) {
                float b[8]; unpack8(*(const u32x4*)(Bt + (size_t)(nh * 64 + n) * ldb + k), b);
#pragma unroll
                for (int j = 0; j < 8; ++j) acc[n] += a[j] * b[j];
            }
        }
        __syncthreads();
#pragma unroll
        for (int n = 0; n < 64; n += 2) { if (F32C) { ((LAS float*)lds)[r * CTF_PITCH + nh * 64 + n] = acc[n]; ((LAS float*)lds)[r * CTF_PITCH + nh * 64 + n + 1] = acc[n + 1]; } else *(LAS unsigned*)(lds + r * CT_PITCH + (nh * 64 + n) * 2) = pk2(acc[n], acc[n + 1]); }
    }
#else
    {
        const int wm = wid >> 1, wn = wid & 1, r = lane & 31, hh = lane >> 5;
        const int srow = lane >> 3, c0 = (lane & 7) ^ (srow >> 1);
        const bf16_t* asrc[4];
#pragma unroll
        for (int j = 0; j < 4; ++j) asrc[j] = arow(8 * (wid * 4 + j) + srow) + (c0 ^ ((j & 1) << 2)) * 8;
        const bf16_t* bsrc0 = Bt + (size_t)(wid * 16 + srow) * ldb + c0 * 8;
        const bf16_t* bsrc1 = Bt + (size_t)(wid * 16 + 8 + srow) * ldb + (c0 ^ 4) * 8;
        const int lanebase = r * 128 + ((hh ^ ((r >> 1) & 7)) << 4);
        f32x16 acc[2][2];
#pragma unroll
        for (int a = 0; a < 2; ++a)
#pragma unroll
            for (int b = 0; b < 2; ++b)
#pragma unroll
                for (int i = 0; i < 16; ++i) acc[a][b][i] = 0.f;
        const int nt = K >> 6;
#define GT_STAGE(kt, sb) do { _Pragma("unroll") for (int j = 0; j < 4; ++j) \
            glds16(asrc[j] + aoff(kt), lds + (sb) * GSTG + (wid * 4 + j) * 1024); \
            glds16(bsrc0 + (kt) * 64, lds + (sb) * GSTG + 32768 + (wid * 2) * 1024); \
            glds16(bsrc1 + (kt) * 64, lds + (sb) * GSTG + 32768 + (wid * 2 + 1) * 1024); } while (0)
        GT_STAGE(0, 0);
        if (nt > 1) GT_STAGE(1, 1);
        int sb = 0;
        for (int kt = 0; kt < nt; ++kt) {
            if (kt + 1 < nt) WAITV(6); else WAITV(0);
            __builtin_amdgcn_s_barrier();
            if (kt + 2 < nt) { const int sn = sb >= 1 ? sb - 1 : 2; GT_STAGE(kt + 2, sn); }
            const LAS uchar* xs = lds + sb * GSTG + wm * 8192; const LAS uchar* wsb = lds + sb * GSTG + 32768 + wn * 8192;
#pragma unroll
            for (int ks = 0; ks < 4; ++ks) {
                const int lb = lanebase ^ (ks << 5);
                bf16x8 xf[2], wf[2];
#pragma unroll
                for (int mb = 0; mb < 2; ++mb) xf[mb] = *(const LAS bf16x8*)(xs + mb * 4096 + lb);
#pragma unroll
                for (int nb = 0; nb < 2; ++nb) wf[nb] = *(const LAS bf16x8*)(wsb + nb * 4096 + lb);
#pragma unroll
                for (int nb = 0; nb < 2; ++nb)
#pragma unroll
                    for (int mb = 0; mb < 2; ++mb) acc[nb][mb] = MFMA32(wf[nb], xf[mb], acc[nb][mb]);
            }
            sb = sb == 2 ? 0 : sb + 1;
        }
#undef GT_STAGE
        __syncthreads();
#pragma unroll
        for (int nb = 0; nb < 2; ++nb)
#pragma unroll
            for (int mb = 0; mb < 2; ++mb) {
                const int m = 64 * wm + 32 * mb + r;
#pragma unroll
                for (int q4 = 0; q4 < 4; ++q4) {
                    const int n = 64 * wn + 32 * nb + 8 * q4 + 4 * hh;
                    if (F32C) {
#pragma unroll
                        for (int j = 0; j < 4; ++j) ((LAS float*)lds)[m * CTF_PITCH + n + j] = acc[nb][mb][4 * q4 + j];
                    } else {
                        u32x2 v; v[0] = pk2(acc[nb][mb][4 * q4], acc[nb][mb][4 * q4 + 1]); v[1] = pk2(acc[nb][mb][4 * q4 + 2], acc[nb][mb][4 * q4 + 3]);
                        *(LAS u32x2*)(lds + m * CT_PITCH + n * 2) = v;
                    }
                }
            }
    }
#endif
    __syncthreads();
    epi(lds);
    __syncthreads();
}
__device__ __forceinline__ u32x4 ct_ld8(const LAS uchar* ct, int r, int c) { return *(const LAS u32x4*)(ct + r * CT_PITCH + c * 2); }
__device__ __forceinline__ float ct_ld1(const LAS uchar* ct, int r, int c) { return bf2f(*(const LAS bf16_t*)(ct + r * CT_PITCH + c * 2)); }

struct EpiProj {
    int mt, nt, l; const Params* p;
    __device__ __forceinline__ void operator()(const LAS uchar* ct) const {
        uchar* ws = p->ws; const int tid = tid_opaque();
        const float* rstd1 = (const float*)(ws + WS_RSTD1);
        const int t0 = mt * 256, b = t0 >> 11, s0 = t0 & 2047;
        if (nt < 8) {
            const int h = nt & 3; const bool isq = nt < 4;
            const float* g = p->in[isq ? 3 : 4] + l * 64;
            bf16_t* dbase = (bf16_t*)(ws + (isq ? WS_QD : WS_KD)) + (((size_t)b * 4 + h) * 2) * S * 64;
#pragma unroll 2
            for (int it = 0; it < 8; ++it) {
                const int item = it * NT + tid, c8 = item & 7, j = (item >> 3) & 1, r = item >> 4;
                const float rs = rstd1[t0 + r];
                float f[8]; unpack8(ct_ld8(ct, r, j * 64 + c8 * 8), f);
                float ss = 0.f;
#pragma unroll
                for (int i = 0; i < 8; ++i) { f[i] *= rs; ss += f[i] * f[i]; }
                ss += __shfl_xor(ss, 1); ss += __shfl_xor(ss, 2); ss += __shfl_xor(ss, 4);
                const float rn = __builtin_amdgcn_rsqf(ss * (1.f / 64.f) + EPS) * (isq ? QSCALE_D : 1.f);
                const f32x4 g0 = *(const f32x4*)(g + c8 * 8), g1 = *(const f32x4*)(g + c8 * 8 + 4);
                u32x4 o; o[0] = pk2(f[0] * rn * g0[0], f[1] * rn * g0[1]); o[1] = pk2(f[2] * rn * g0[2], f[3] * rn * g0[3]);
                o[2] = pk2(f[4] * rn * g1[0], f[5] * rn * g1[1]); o[3] = pk2(f[6] * rn * g1[2], f[7] * rn * g1[3]);
                *(u32x4*)(dbase + ((size_t)j * S + (s0 + r)) * 64 + c8 * 8) = o;
            }
        } else if (nt < 12) {
            const int h = nt - 8, d = tid >> 2, half = tid & 3;
            bf16_t* dst = (bf16_t*)(ws + WS_VDT) + (((size_t)b * 4 + h) * 128 + d) * S + s0 + half * 64;
#pragma unroll
            for (int c8 = 0; c8 < 8; ++c8) { u32x4 o;
#pragma unroll
                for (int i = 0; i < 4; ++i) {
                    const int p0 = c8 * 8 + 2 * i, r0 = half * 64 + sigma16(p0), r1 = half * 64 + sigma16(p0 + 1);
                    o[i] = pk2(ct_ld1(ct, r0, d) * rstd1[t0 + r0], ct_ld1(ct, r1, d) * rstd1[t0 + r1]); }
                *(u32x4*)(dst + c8 * 8) = o; }
        } else {
            bf16_t* dbase = (bf16_t*)(ws + WS_LAT) + (size_t)t0 * 640 + (nt - 12) * 128;
#pragma unroll 2
            for (int it = 0; it < 8; ++it) {
                const int item = it * NT + tid, c8 = item & 15, r = item >> 4;
                const float rs = rstd1[t0 + r];
                float f[8]; unpack8(ct_ld8(ct, r, c8 * 8), f); u32x4 o;
#pragma unroll
                for (int i = 0; i < 4; ++i) o[i] = pk2(f[2 * i] * rs, f[2 * i + 1] * rs);
                *(u32x4*)(dbase + (size_t)r * 640 + c8 * 8) = o;
                float ss = 0.f;
#pragma unroll
                for (int i = 0; i < 4; ++i) { const float a = bflo(o[i]), bq = bfhi(o[i]); ss += a * a + bq * bq; }
                ss += __shfl_xor(ss, 1); ss += __shfl_xor(ss, 2); ss += __shfl_xor(ss, 4);
                const int hidx = (nt - 12) * 2 + (c8 >> 3);
                if ((c8 & 7) == 0 && hidx < 8) ((float*)(ws + WS_HSS))[(size_t)(t0 + r) * 8 + hidx] = ss;
            }
        }
    }
};

__device__ __forceinline__ float lat_rstd(const bf16_t* seg, int n) {
    float ss = 0.f;
    for (int k = 0; k < n; k += 8) { float f[8]; unpack8(*(const u32x4*)(seg + k), f);
#pragma unroll
        for (int i = 0; i < 8; ++i) ss += f[i] * f[i]; }
    return __builtin_amdgcn_rsqf(ss / (float)n + EPS);
}
__device__ __forceinline__ void norm_rope32(float (&y)[32], const float* g, const float* cosr, const float* sinr, float outscale) {
    float ss = 0.f;
#pragma unroll
    for (int i = 0; i < 32; ++i) ss += y[i] * y[i];
    const float rn = __builtin_amdgcn_rsqf(ss * (1.f / 32.f) + EPS);
#pragma unroll
    for (int i = 0; i < 32; ++i) y[i] = y[i] * rn * g[i];
#pragma unroll
    for (int i = 0; i < 16; ++i) { const float c = cosr[i], sn = sinr[i], x1 = y[i], x2 = y[16 + i];
        y[i] = (x1 * c - x2 * sn) * outscale; y[16 + i] = (x2 * c + x1 * sn) * outscale; }
}

__device__ __forceinline__ u32x4 norm64_piece(float (&f)[8], const float* g8, float outscale) {
    float ss = 0.f;
#pragma unroll
    for (int i = 0; i < 8; ++i) ss += f[i] * f[i];
    ss += __shfl_xor(ss, 1); ss += __shfl_xor(ss, 2); ss += __shfl_xor(ss, 4);
    const float rn = __builtin_amdgcn_rsqf(ss * (1.f / 64.f) + EPS) * outscale;
    const f32x4 g0 = *(const f32x4*)g8, g1 = *(const f32x4*)(g8 + 4);
    u32x4 o; o[0] = pk2(f[0] * rn * g0[0], f[1] * rn * g0[1]); o[1] = pk2(f[2] * rn * g0[2], f[3] * rn * g0[3]);
    o[2] = pk2(f[4] * rn * g1[0], f[5] * rn * g1[1]); o[3] = pk2(f[6] * rn * g1[2], f[7] * rn * g1[3]);
    return o;
}
__device__ __forceinline__ u32x4 norm_rope_piece(float (&f)[8], int c8, const float* g, const float* cosr, const float* sinr, float outscale) {
    float ss = 0.f;
#pragma unroll
    for (int i = 0; i < 8; ++i) ss += f[i] * f[i];
    ss += __shfl_xor(ss, 1); ss += __shfl_xor(ss, 2);
    const float rn = __builtin_amdgcn_rsqf(ss * (1.f / 32.f) + EPS);
    float y[8], z[8];
#pragma unroll
    for (int i = 0; i < 8; ++i) y[i] = f[i] * rn * g[c8 * 8 + i];
#pragma unroll
    for (int i = 0; i < 8; ++i) z[i] = __shfl_xor(y[i], 2);
    const int fi = (c8 & 1) * 8;
    float o[8];
#pragma unroll
    for (int i = 0; i < 8; ++i) { const float c = cosr[fi + i], sn = sinr[fi + i];
        o[i] = ((c8 < 2) ? (y[i] * c - z[i] * sn) : (y[i] * c + z[i] * sn)) * outscale; }
    u32x4 w; w[0] = pk2(o[0], o[1]); w[1] = pk2(o[2], o[3]); w[2] = pk2(o[4], o[5]); w[3] = pk2(o[6], o[7]);
    return w;
}
struct EpiMlaQ {
    int mt, h, l; const Params* p;
    __device__ __forceinline__ void operator()(const LAS uchar* ct) const {
        uchar* ws = p->ws; const int tid = tid_opaque();
        const int t0 = mt * 256, b = t0 >> 11, s0 = t0 & 2047;
        const float* hss = (const float*)(ws + WS_HSS);
        bf16_t* dbase = (bf16_t*)(ws + WS_QM) + (((size_t)b * 4 + h) * S + s0) * 96;
        const float* gn = p->in[11] + l * 64; const float* gr = p->in[12] + l * 32;
#pragma unroll 2
        for (int it = 0; it < 4; ++it) {
            const int item = it * NT + tid, c8 = item & 7, r = item >> 3;
            const f32x4 hs = *(const f32x4*)(hss + (size_t)(t0 + r) * 8);
            const float rs = __builtin_amdgcn_rsqf((hs[0] + hs[1] + hs[2]) * (1.f / 192.f) + EPS);
            float f[8]; unpack8(ct_ld8(ct, r, c8 * 8), f);
#pragma unroll
            for (int i = 0; i < 8; ++i) f[i] *= rs;
            *(u32x4*)(dbase + (size_t)r * 96 + c8 * 8) = norm64_piece(f, gn + c8 * 8, QSCALE_M);
        }
#pragma unroll 2
        for (int it = 0; it < 2; ++it) {
            const int item = it * NT + tid, c8 = item & 3, r = item >> 2;
            const f32x4 hs = *(const f32x4*)(hss + (size_t)(t0 + r) * 8);
            const float rs = __builtin_amdgcn_rsqf((hs[0] + hs[1] + hs[2]) * (1.f / 192.f) + EPS);
            float f[8]; unpack8(ct_ld8(ct, r, 64 + c8 * 8), f);
#pragma unroll
            for (int i = 0; i < 8; ++i) f[i] *= rs;
            const float* cosr = (const float*)(ws + WS_ROPE) + (s0 + r) * 16; const float* sinr = cosr + S * 16;
            *(u32x4*)(dbase + (size_t)r * 96 + 64 + c8 * 8) = norm_rope_piece(f, c8, gr, cosr, sinr, QSCALE_M);
        }
    }
};
struct EpiMlaKV {
    int mt, h, l; const Params* p;
    __device__ __forceinline__ void operator()(const LAS uchar* ct) const {
        uchar* ws = p->ws; const int tid = tid_opaque();
        const int t0 = mt * 256, b = t0 >> 11, s0 = t0 & 2047;
        const float* hss = (const float*)(ws + WS_HSS);
        LAS float* shr = (LAS float*)(ct + 256 * CT_PITCH);
        bf16_t* dbase = (bf16_t*)(ws + WS_KM) + (((size_t)b * 4 + h) * S + s0) * 96;
        const float* gn = p->in[13] + l * 64; const float* gr = p->in[14] + l * 32;
        if (tid < 256) { const f32x4 hs = *(const f32x4*)(hss + (size_t)(t0 + tid) * 8 + 0); const float h4 = hss[(size_t)(t0 + tid) * 8 + 4];
            shr[tid] = __builtin_amdgcn_rsqf((hs[3] + h4) * (1.f / 128.f) + EPS); }
        __syncthreads();
#pragma unroll 2
        for (int it = 0; it < 4; ++it) {
            const int item = it * NT + tid, c8 = item & 7, r = item >> 3;
            const float rs = shr[r];
            float f[8]; unpack8(ct_ld8(ct, r, c8 * 8), f);
#pragma unroll
            for (int i = 0; i < 8; ++i) f[i] *= rs;
            *(u32x4*)(dbase + (size_t)r * 96 + c8 * 8) = norm64_piece(f, gn + c8 * 8, 1.f);
        }
        {
            const bf16_t* lat = (const bf16_t*)(ws + WS_LAT) + (size_t)t0 * 640 + 320;
#pragma unroll 2
            for (int it = 0; it < 2; ++it) {
                const int item = it * NT + tid, c8 = item & 3, r = item >> 2;
                float f[8]; unpack8(*(const u32x4*)(lat + (size_t)r * 640 + c8 * 8), f);
                const float* cosr = (const float*)(ws + WS_ROPE) + (s0 + r) * 16; const float* sinr = cosr + S * 16;
                *(u32x4*)(dbase + (size_t)r * 96 + 64 + c8 * 8) = norm_rope_piece(f, c8, gr, cosr, sinr, 1.f);
            }
        }
        {
            const int d = tid >> 3, q4 = tid & 7;
            bf16_t* dst = (bf16_t*)(ws + WS_VMT) + (((size_t)b * 4 + h) * 64 + d) * S + s0 + q4 * 32;
#pragma unroll
            for (int c8 = 0; c8 < 4; ++c8) { u32x4 o;
#pragma unroll
                for (int i = 0; i < 4; ++i) {
                    const int p0 = c8 * 8 + 2 * i, r0 = q4 * 32 + sigma16(p0), r1 = q4 * 32 + sigma16(p0 + 1);
                    o[i] = pk2(ct_ld1(ct, r0, 64 + d) * shr[r0], ct_ld1(ct, r1, 64 + d) * shr[r1]); }
                *(u32x4*)(dst + c8 * 8) = o; }
        }
    }
};
struct EpiPool {
    int mt, g, l; const Params* p;
    __device__ __forceinline__ void operator()(const LAS uchar* ct) const {
        uchar* ws = p->ws; const int tid = tid_opaque(), r = tid >> 1, j = tid & 1;
        const float* sc = p->in[16] + l * 256 + g * 64 + j * 32;
        bf16_t* dst = (bf16_t*)(ws + WS_MIX) + (size_t)(mt * 256 + r) * DM + 768 + g * 64 + j * 32;
#pragma unroll
        for (int c8 = 0; c8 < 4; ++c8) { float f[8]; unpack8(ct_ld8(ct, r, j * 32 + c8 * 8), f); u32x4 o;
#pragma unroll
            for (int i = 0; i < 4; ++i) o[i] = pk2(f[2 * i] * sc[c8 * 8 + 2 * i], f[2 * i + 1] * sc[c8 * 8 + 2 * i + 1]);
            *(u32x4*)(dst + c8 * 8) = o; }
    }
};
struct EpiWout {
    int mt, nt; const float* xres; const Params* p;
    __device__ __forceinline__ void operator()(const LAS uchar* ct) const {
        uchar* ws = p->ws; const int tid = tid_opaque();
        const size_t base = (size_t)(mt * 256) * DM + nt * 128;
        float* pss = (float*)(ws + WS_PSS) + (size_t)(mt * 256) * 8 + nt;
#pragma unroll 4
        for (int it = 0; it < 16; ++it) {
            const int item = it * NT + tid, c4 = item & 31, r = item >> 5;
            const size_t off = base + (size_t)r * DM + c4 * 4;
            const u32x2 cw = *(const LAS u32x2*)(ct + r * CT_PITCH + c4 * 8);
            const f32x4 x0 = *(const f32x4*)(xres + off);
            f32x4 y; y[0] = x0[0] + bflo(cw[0]); y[1] = x0[1] + bfhi(cw[0]); y[2] = x0[2] + bflo(cw[1]); y[3] = x0[3] + bfhi(cw[1]);
            *(f32x4*)(p->out + off) = y;
            u32x2 o; o[0] = pk2(y[0], y[1]); o[1] = pk2(y[2], y[3]);
            *(u32x2*)((bf16_t*)(ws + WS_XB) + off) = o;
            u32x2 ol; ol[0] = pk2(y[0] - bflo(o[0]), y[1] - bfhi(o[0])); ol[1] = pk2(y[2] - bflo(o[1]), y[3] - bfhi(o[1]));
            *(u32x2*)((bf16_t*)(ws + WS_XL) + off) = ol;
            float ss = y[0] * y[0] + y[1] * y[1] + y[2] * y[2] + y[3] * y[3];
            ss += __shfl_xor(ss, 1); ss += __shfl_xor(ss, 2); ss += __shfl_xor(ss, 4); ss += __shfl_xor(ss, 8); ss += __shfl_xor(ss, 16);
            if (c4 == 0) pss[(size_t)r * 8] = ss;
        }
    }
};
struct EpiGU {
    int jt, nvalid; const unsigned* list; size_t slot0; const Params* p;
    __device__ __forceinline__ void operator()(const LAS uchar* ct) const {
        uchar* ws = p->ws; const int tid = tid_opaque();
        const float* rstd2 = (const float*)(ws + WS_RSTD2);
        bf16_t* dbase = (bf16_t*)(ws + WS_HMID) + slot0 * 256 + jt * 64;
#pragma unroll 2
        for (int it = 0; it < 4; ++it) {
            const int item = it * NT + tid, c8 = item & 7, r = item >> 3;
            const int rr = r < nvalid ? r : nvalid - 1;
            const float rs = rstd2[list[rr] >> 1];
            float g[8], u[8]; unpack8(ct_ld8(ct, r, c8 * 8), g); unpack8(ct_ld8(ct, r, 64 + c8 * 8), u);
            float hv[8];
#pragma unroll
            for (int i = 0; i < 8; ++i) { const float gg = g[i] * rs, uu = u[i] * rs; hv[i] = gg * __builtin_amdgcn_rcpf(1.f + __builtin_amdgcn_exp2f(-gg * LOG2E)) * uu; }
            u32x4 o; o[0] = pk2(hv[0], hv[1]); o[1] = pk2(hv[2], hv[3]); o[2] = pk2(hv[4], hv[5]); o[3] = pk2(hv[6], hv[7]);
            *(u32x4*)(dbase + (size_t)r * 256 + c8 * 8) = o;
        }
    }
};
struct EpiDown {
    int nt, nvalid; const unsigned* list; const Params* p;
    __device__ __forceinline__ void operator()(const LAS uchar* ct) const {
        uchar* ws = p->ws; const int tid = tid_opaque();
        const float* gwt = (const float*)(ws + WS_GW);
        bf16_t* ys = (bf16_t*)(ws + WS_YS) + nt * 128;
#pragma unroll 2
        for (int it = 0; it < 8; ++it) {
            const int item = it * NT + tid, c8 = item & 15, r = item >> 4;
            if (r < nvalid) {
                const unsigned ent = list[r]; const float w = gwt[ent];
                float f[8]; unpack8(ct_ld8(ct, r, c8 * 8), f); u32x4 o;
#pragma unroll
                for (int i = 0; i < 4; ++i) o[i] = pk2(f[2 * i] * w, f[2 * i + 1] * w);
                *(u32x4*)(ys + (size_t)ent * DM + c8 * 8) = o;
            }
        }
    }
};

template <int V = 0>
__device__ __forceinline__ void diff_attn_unit(LAS uchar* lds, const Params& p, int l, int unit) {
    uchar* ws = p.ws;
    const int tid = tid_opaque(), lane = tid & 63, wid = __builtin_amdgcn_readfirstlane(tid >> 6);
    const int xg_ = unit & 7, v_ = unit >> 3, qb = v_ & 15, bh_ = (v_ >> 4) * 8 + xg_, h = bh_ & 3, b = bh_ >> 2;
    const float* scal = (const float*)(ws + WS_SCAL) + 16 * l;
    const float lam = scal[0], oml = scal[1], m2 = scal[2];
    const float slope2 = exp2f(-2.f * (float)(h + 1)) * LOG2E;
    const bf16_t* Q1 = (const bf16_t*)(ws + WS_QD) + (((size_t)b * 4 + h) * 2) * S * 64;
    const bf16_t* K1 = (const bf16_t*)(ws + WS_KD) + (((size_t)b * 4 + h) * 2) * S * 64;
    const bf16_t* VT = (const bf16_t*)(ws + WS_VDT) + (((size_t)b * 4 + h) * 128) * S;
    const float* gsub = p.in[6] + l * 128;
    bf16_t* mix = (bf16_t*)(ws + WS_MIX);
#if NAIVE_ATTN
    {
        const int q = qb * 128 + (tid >> 2), mm = (tid >> 1) & 1, dh = tid & 1;
        const bf16_t* Qp = Q1 + (size_t)mm * S * 64 + (size_t)q * 64; const bf16_t* Kp = K1 + (size_t)mm * S * 64;
        float qv[64];
#pragma unroll
        for (int c8 = 0; c8 < 8; ++c8) { float f[8]; unpack8(*(const u32x4*)(Qp + c8 * 8), f);
#pragma unroll
            for (int i = 0; i < 8; ++i) qv[c8 * 8 + i] = f[i]; }
        float o[64]; float lsum = 0.f;
#pragma unroll
        for (int d = 0; d < 64; ++d) o[d] = 0.f;
        for (int key = 0; key < S; ++key) {
            float sc = 0.f;
#pragma unroll
            for (int c8 = 0; c8 < 8; ++c8) { float f[8]; unpack8(*(const u32x4*)(Kp + (size_t)key * 64 + c8 * 8), f);
#pragma unroll
                for (int i = 0; i < 8; ++i) sc += qv[c8 * 8 + i] * f[i]; }
            const float pv = __builtin_amdgcn_exp2f(sc - slope2 * fabsf((float)(q - key)) - m2);
            lsum += pv;
            const int kp = sigma16(key);
#pragma unroll
            for (int d = 0; d < 64; ++d) o[d] += pv * bf2f(VT[(size_t)(dh * 64 + d) * S + kp]);
        }
        const float inv = 1.f / lsum; float ss = 0.f;
#pragma unroll
        for (int d = 0; d < 64; ++d) { const float mine = o[d] * inv; const float other = __shfl_xor(mine, 2); o[d] = mine - lam * other; ss += o[d] * o[d]; }
        ss += __shfl_xor(ss, 1);
        if (mm == 0) {
            const float rn = __builtin_amdgcn_rsqf(ss * (1.f / 128.f) + EPS) * oml;
            bf16_t* dst = mix + (size_t)(b * S + q) * DM + h * 128 + dh * 64;
#pragma unroll
            for (int d = 0; d < 64; d += 2) *(unsigned*)(dst + d) = pk2(o[d] * rn * gsub[dh * 64 + d], o[d + 1] * rn * gsub[dh * 64 + d + 1]);
        }
    }
#else
    {
        const int r = lane & 31, hh = lane >> 5, qs = wid >> 1, mm = wid & 1, qpos = qb * 128 + qs * 32 + r;
        const bf16_t* Qm_ = Q1 + (size_t)mm * S * 64;
        bf16x8 qf[4];
#pragma unroll
        for (int ks = 0; ks < 4; ++ks) qf[ks] = *(const bf16x8*)(Qm_ + (size_t)qpos * 64 + ks * 16 + hh * 8);
        f32x16 O[4]; float lsum = 0.f;
#pragma unroll
        for (int db = 0; db < 4; ++db)
#pragma unroll
            for (int i = 0; i < 16; ++i) O[db][i] = 0.f;
        const int srow = lane >> 3, c0 = (lane & 7) ^ (srow >> 1);
        const bool isk = wid < 4;
        const bf16_t* sbase = isk ? (K1 + (size_t)(wid >> 1) * S * 64 + (size_t)(wid & 1) * 32 * 64) : (VT + (size_t)(wid - 4) * 32 * S);
        const int rstride = isk ? 64 : S, kstride = isk ? 64 * 64 : 64;
        const bf16_t* sb0 = sbase + (size_t)srow * rstride + c0 * 8;
        const bf16_t* sb1 = sbase + (size_t)srow * rstride + (c0 ^ 4) * 8;
        const int lanebase = r * 128 + ((hh ^ ((r >> 1) & 7)) << 4);
#define DA_STAGE(kt, sbuf) do { _Pragma("unroll") for (int j = 0; j < 4; ++j) \
            glds16(((j & 1) ? sb1 : sb0) + (size_t)(8 * j) * rstride + (size_t)(kt) * kstride, lds + (sbuf) * ASTG + (wid * 4 + j) * 1024); } while (0)
        if (!(V & 8)) { DA_STAGE(0, 0); DA_STAGE(1, 1); }
        int sb = 0;
        const int q0w = qb * 128 + qs * 32;
        const float fq = (float)(qpos - 4 * hh);
        const float baseL = -slope2 * fq - m2, baseR = slope2 * fq - m2;
        for (int kt = 0; kt < S / 64; ++kt) {
            if (kt + 1 < S / 64) WAITV(4); else WAITV(0);
            __builtin_amdgcn_s_barrier();
            if (!(V & 8) && kt + 2 < S / 64) { const int sn = sb >= 1 ? sb - 1 : 2; DA_STAGE(kt + 2, sn); }
            const LAS uchar* st = lds + sb * ASTG;
#pragma unroll
            for (int kb = 0; kb < 2; ++kb) {
                const int key0 = kt * 64 + 32 * kb;
                f32x16 sacc;
                {
                    const float c = (key0 < q0w) ? slope2 : -slope2;
                    const float a = ((key0 < q0w) ? baseL : baseR) + c * (float)key0;
#pragma unroll
                    for (int i = 0; i < 16; ++i) sacc[i] = a + c * (float)((i & 3) + 8 * (i >> 2));
                }
                if (__builtin_expect(key0 == q0w, 0)) {
                    const int kq = key0 + 4 * hh - qpos;
#pragma unroll
                    for (int i = 0; i < 16; ++i) sacc[i] = -slope2 * fabsf((float)(kq + (i & 3) + 8 * (i >> 2))) - m2;
                }
#pragma unroll
                for (int ks = 0; ks < 4; ++ks) {
                    if (V & 4) continue;
                    const bf16x8 kf = (V & 16) ? qf[(ks + 1) & 3] : *(const LAS bf16x8*)(st + mm * 8192 + kb * 4096 + (lanebase ^ (ks << 5)));
                    sacc = MFMA32(kf, qf[ks], sacc);
                }
                float ls = 0.f;
#pragma unroll
                for (int i = 0; i < 16; ++i) { const float pv = (V & 1) ? sacc[i] : __builtin_amdgcn_exp2f(sacc[i]); ls += pv; sacc[i] = pv; }
                lsum += ls;
                bf16x8 pb[2];
#pragma unroll
                for (int s2 = 0; s2 < 2; ++s2) {
                    u32x4 w;
#pragma unroll
                    for (int i = 0; i < 4; ++i) w[i] = pk2(sacc[8 * s2 + 2 * i], sacc[8 * s2 + 2 * i + 1]);
                    pb[s2] = __builtin_bit_cast(bf16x8, w);
                }
#pragma unroll
                for (int db = 0; db < 4; ++db)
#pragma unroll
                    for (int s2 = 0; s2 < 2; ++s2) {
                        if (V & 2) { if (db == 0) O[0][s2] += __builtin_bit_cast(float, (__builtin_bit_cast(u32x4, pb[s2]))[0]); continue; }
                        const bf16x8 vf = (V & 16) ? qf[(db + s2) & 3] : *(const LAS bf16x8*)(st + 16384 + db * 4096 + (lanebase ^ ((2 * kb + s2) << 5)));
                        O[db] = MFMA32(vf, pb[s2], O[db]);
                    }
            }
            sb = sb == 2 ? 0 : sb + 1;
        }
#undef DA_STAGE
        const float lt = lsum + __shfl_xor(lsum, 32);
        const float sc = (mm == 0) ? (1.f / lt) : (lam / lt);
        __syncthreads();
        LAS float* xch = (LAS float*)lds + qs * 4096;
        if (mm == 1) {
#pragma unroll
            for (int db = 0; db < 4; ++db)
#pragma unroll
                for (int i = 0; i < 16; ++i) xch[(db * 16 + i) * 64 + lane] = O[db][i] * sc;
        }
        __syncthreads();
        if (mm == 0) {
            float ss = 0.f;
#pragma unroll
            for (int db = 0; db < 4; ++db)
#pragma unroll
                for (int i = 0; i < 16; ++i) { const float o = O[db][i] * sc - xch[(db * 16 + i) * 64 + lane]; O[db][i] = o; ss += o * o; }
            ss += __shfl_xor(ss, 32);
            const float rn = __builtin_amdgcn_rsqf(ss * (1.f / 128.f) + EPS) * oml;
            bf16_t* dst = mix + (size_t)(b * S + qpos) * DM + h * 128;
#pragma unroll
            for (int db = 0; db < 4; ++db)
#pragma unroll
                for (int q4 = 0; q4 < 4; ++q4) {
                    const int d = 32 * db + 8 * q4 + 4 * hh;
                    const f32x4 g = *(const f32x4*)(gsub + d);
                    u32x2 w; w[0] = pk2(O[db][4 * q4] * rn * g[0], O[db][4 * q4 + 1] * rn * g[1]);
                    w[1] = pk2(O[db][4 * q4 + 2] * rn * g[2], O[db][4 * q4 + 3] * rn * g[3]);
                    *(u32x2*)(dst + d) = w;
                }
        }
    }
#endif
    __syncthreads();
}

__device__ __forceinline__ void mla_attn_unit(LAS uchar* lds, const Params& p, int l, int unit) {
    uchar* ws = p.ws;
    const int tid = tid_opaque(), lane = tid & 63, wid = __builtin_amdgcn_readfirstlane(tid >> 6);
    const int xg_ = unit & 7, v_ = unit >> 3, qb = v_ & 7, bh_ = (v_ >> 3) * 8 + xg_, h = bh_ & 3, b = bh_ >> 2;
    const float m2 = ((const float*)(ws + WS_SCAL))[16 * l + 3];
    const bf16_t* Q = (const bf16_t*)(ws + WS_QM) + (((size_t)b * 4 + h) * S) * 96;
    const bf16_t* Kp = (const bf16_t*)(ws + WS_KM) + (((size_t)b * 4 + h) * S) * 96;
    const bf16_t* VT = (const bf16_t*)(ws + WS_VMT) + (((size_t)b * 4 + h) * 64) * S;
    bf16_t* mix = (bf16_t*)(ws + WS_MIX);
#if NAIVE_ATTN
    {
        const int q = qb * 256 + (tid >> 1), hf = tid & 1;
        float qv[96];
#pragma unroll
        for (int c8 = 0; c8 < 12; ++c8) { float f[8]; unpack8(*(const u32x4*)(Q + (size_t)q * 96 + c8 * 8), f);
#pragma unroll
            for (int i = 0; i < 8; ++i) qv[c8 * 8 + i] = f[i]; }
        float o[32]; float lsum = 0.f;
#pragma unroll
        for (int d = 0; d < 32; ++d) o[d] = 0.f;
        for (int key = 0; key < S; ++key) {
            float sc = 0.f;
#pragma unroll
            for (int c8 = 0; c8 < 12; ++c8) { float f[8]; unpack8(*(const u32x4*)(Kp + (size_t)key * 96 + c8 * 8), f);
#pragma unroll
                for (int i = 0; i < 8; ++i) sc += qv[c8 * 8 + i] * f[i]; }
            const float pv = __builtin_amdgcn_exp2f(sc - m2);
            lsum += pv;
            const int kp = sigma16(key);
#pragma unroll
            for (int d = 0; d < 32; ++d) o[d] += pv * bf2f(VT[(size_t)(hf * 32 + d) * S + kp]);
        }
        const float inv = 1.f / lsum;
        bf16_t* dst = mix + (size_t)(b * S + q) * DM + 512 + h * 64 + hf * 32;
#pragma unroll
        for (int d = 0; d < 32; d += 2) *(unsigned*)(dst + d) = pk2(o[d] * inv, o[d + 1] * inv);
    }
#else
    {
        const int r = lane & 31, hh = lane >> 5, qpos = qb * 256 + wid * 32 + r;
        bf16x8 qf[6];
#pragma unroll
        for (int ks = 0; ks < 6; ++ks) qf[ks] = *(const bf16x8*)(Q + (size_t)qpos * 96 + ks * 16 + hh * 8);
        f32x16 O[2]; float lsum = 0.f;
#pragma unroll
        for (int db = 0; db < 2; ++db)
#pragma unroll
            for (int i = 0; i < 16; ++i) O[db][i] = 0.f;
        const int lanebase = r * 128 + ((hh ^ ((r >> 1) & 7)) << 4), lanebase64 = r * 64 + ((hh ^ ((r >> 2) & 3)) << 4);
        const bool lo4 = wid < 4;
        const bf16_t* s0p; const bf16_t* s1p; const bf16_t* s2p;
        {
            const int srow = lane >> 3;
            { const int row = 8 * wid + srow; const int c = (lane & 7) ^ ((row >> 1) & 7); s0p = Kp + (size_t)row * 96 + c * 8; }
            if (lo4) { const int row = 16 * wid + (lane >> 2); const int c = (lane & 3) ^ ((row >> 2) & 3); s1p = Kp + (size_t)row * 96 + 64 + c * 8; }
            else { const int row = 8 * (wid - 4) + srow; const int c = (lane & 7) ^ ((row >> 1) & 7); s1p = VT + (size_t)row * S + c * 8; }
            { const int row = 8 * ((wid & 3) + 4) + srow; const int c = (lane & 7) ^ ((row >> 1) & 7); s2p = VT + (size_t)row * S + c * 8; }
        }
        const int k1stride = lo4 ? 64 * 96 : 64;
#define MA_STAGE(kt, sbuf) do { \
            glds16(s0p + (size_t)(kt) * (64 * 96), lds + (sbuf) * MSTG + wid * 1024); \
            glds16(s1p + (size_t)(kt) * k1stride, lds + (sbuf) * MSTG + (wid + 8) * 1024); \
            if (lo4) glds16(s2p + (size_t)(kt) * 64, lds + (sbuf) * MSTG + (wid + 16) * 1024); } while (0)
        MA_STAGE(0, 0); MA_STAGE(1, 1);
        int sb = 0;
        for (int kt = 0; kt < S / 64; ++kt) {
            if (kt + 1 < S / 64) { if (lo4) WAITV(3); else WAITV(2); } else WAITV(0);
            __builtin_amdgcn_s_barrier();
            if (kt + 2 < S / 64) { const int sn = sb >= 1 ? sb - 1 : 2; MA_STAGE(kt + 2, sn); }
            const LAS uchar* st = lds + sb * MSTG;
#pragma unroll
            for (int kb = 0; kb < 2; ++kb) {
                f32x16 sacc;
#pragma unroll
                for (int i = 0; i < 16; ++i) sacc[i] = -m2;
#pragma unroll
                for (int ks = 0; ks < 4; ++ks) {
                    const bf16x8 kf = *(const LAS bf16x8*)(st + kb * 4096 + (lanebase ^ (ks << 5)));
                    sacc = MFMA32(kf, qf[ks], sacc);
                }
#pragma unroll
                for (int ks = 0; ks < 2; ++ks) {
                    const bf16x8 kf = *(const LAS bf16x8*)(st + 8192 + kb * 2048 + (lanebase64 ^ (ks << 5)));
                    sacc = MFMA32(kf, qf[4 + ks], sacc);
                }
                float ls = 0.f;
#pragma unroll
                for (int i = 0; i < 16; ++i) { const float pv = __builtin_amdgcn_exp2f(sacc[i]); ls += pv; sacc[i] = pv; }
                lsum += ls;
                bf16x8 pb[2];
#pragma unroll
                for (int s2 = 0; s2 < 2; ++s2) {
                    u32x4 w;
#pragma unroll
                    for (int i = 0; i < 4; ++i) w[i] = pk2(sacc[8 * s2 + 2 * i], sacc[8 * s2 + 2 * i + 1]);
                    pb[s2] = __builtin_bit_cast(bf16x8, w);
                }
#pragma unroll
                for (int db = 0; db < 2; ++db)
#pragma unroll
                    for (int s2 = 0; s2 < 2; ++s2) {
                        const bf16x8 vf = *(const LAS bf16x8*)(st + 12288 + db * 4096 + (lanebase ^ ((2 * kb + s2) << 5)));
                        O[db] = MFMA32(vf, pb[s2], O[db]);
                    }
            }
            sb = sb == 2 ? 0 : sb + 1;
        }
#undef MA_STAGE
        const float lt = lsum + __shfl_xor(lsum, 32); const float inv = 1.f / lt;
        bf16_t* dst = mix + (size_t)(b * S + qpos) * DM + 512 + h * 64;
#pragma unroll
        for (int db = 0; db < 2; ++db)
#pragma unroll
            for (int q4 = 0; q4 < 4; ++q4) {
                const int d = 32 * db + 8 * q4 + 4 * hh;
                u32x2 w; w[0] = pk2(O[db][4 * q4] * inv, O[db][4 * q4 + 1] * inv); w[1] = pk2(O[db][4 * q4 + 2] * inv, O[db][4 * q4 + 3] * inv);
                *(u32x2*)(dst + d) = w;
            }
    }
#endif
    __syncthreads();
}

__device__ __forceinline__ int xp_rowmap(int mode, int n) {
    return mode == 0 ? n : mode == 1 ? (n / 96) * 128 + (n % 96) : mode == 2 ? ((n >> 6) * 128 + (n & 63)) : ((n >> 6) * 128 + 64 + (n & 63));
}
__device__ __forceinline__ void xpose_tile(LAS uchar* lds, const float* src, int K, int N, bf16_t* dst, int ldd, int mode, const float* gain, int kt, int ntile) {
    LAS float* sh = (LAS float*)lds; const int tid = tid_opaque();
    (void)K;
    {
        const int n4 = tid & 63, n = ntile * 256 + n4 * 4;
        if (n < N) {
#pragma unroll
            for (int i = 0; i < 8; ++i) {
                const int kl = (tid >> 6) + 8 * i, k = kt * 64 + kl;
                f32x4 v = *(const f32x4*)(src + (size_t)k * N + n);
                if (gain) { const float gk = gain[k]; v[0] *= gk; v[1] *= gk; v[2] *= gk; v[3] *= gk; }
                LAS float* d = sh + kl * 257 + n4 * 4; d[0] = v[0]; d[1] = v[1]; d[2] = v[2]; d[3] = v[3];
            }
        }
    }
    __syncthreads();
    {
        const int nl = tid >> 1, kh = tid & 1, n = ntile * 256 + nl;
        if (n < N) {
            bf16_t* d = dst + (size_t)xp_rowmap(mode, n) * ldd + kt * 64 + kh * 32;
#pragma unroll
            for (int c8 = 0; c8 < 4; ++c8) { u32x4 o;
#pragma unroll
                for (int i = 0; i < 4; ++i) o[i] = pk2(sh[(kh * 32 + c8 * 8 + 2 * i) * 257 + nl], sh[(kh * 32 + c8 * 8 + 2 * i + 1) * 257 + nl]);
                *(u32x4*)(d + c8 * 8) = o; }
        }
    }
    __syncthreads();
}
__device__ __forceinline__ void xpose_job(LAS uchar* lds, const float* src, int K, int N, bf16_t* dst, int ldd, int mode, const float* gain) {
    const int nkt = K >> 6, nnt = (N + 255) >> 8, tot = nkt * nnt;
    for (int u = blockIdx.x; u < tot; u += gridDim.x) xpose_tile(lds, src, K, N, dst, ldd, mode, gain, u % nkt, u / nkt);
}
__device__ __forceinline__ void expert_weights(LAS uchar* lds, const Params& p, int l) {
    bf16_t* wgu = (bf16_t*)(p.ws + WS_WGU); bf16_t* wd = (bf16_t*)(p.ws + WS_WD);
    const float* g2 = p.in[18] + l * DM;
    for (int u = blockIdx.x; u < 32 * 48; u += gridDim.x) {
        const int e = u / 48, w = u % 48, job = w >> 4, tl = w & 15;
        if (job == 0) xpose_tile(lds, p.in[23] + ((size_t)l * 32 + e) * DM * 256, DM, 256, wgu + (size_t)e * 512 * DM, DM, 2, g2, tl, 0);
        else if (job == 1) xpose_tile(lds, p.in[24] + ((size_t)l * 32 + e) * DM * 256, DM, 256, wgu + (size_t)e * 512 * DM, DM, 3, g2, tl, 0);
        else xpose_tile(lds, p.in[25] + ((size_t)l * 32 + e) * 256 * DM, 256, DM, wd + (size_t)e * DM * 256, 256, 0, nullptr, tl & 3, tl >> 2);
    }
}
__device__ __forceinline__ void row_prep(const float* xrow, bf16_t* xb, float* rstd, int lane) {
    float ss = 0.f; f32x4 v[4];
#pragma unroll
    for (int i = 0; i < 4; ++i) { v[i] = *(const f32x4*)(xrow + i * 256 + lane * 4); ss += v[i][0] * v[i][0] + v[i][1] * v[i][1] + v[i][2] * v[i][2] + v[i][3] * v[i][3]; }
    ss = wave_sum(ss);
#pragma unroll
    for (int i = 0; i < 4; ++i) { u32x2 o; o[0] = pk2(v[i][0], v[i][1]); o[1] = pk2(v[i][2], v[i][3]); *(u32x2*)(xb + i * 256 + lane * 4) = o; }
    if (lane == 0) *rstd = __builtin_amdgcn_rsqf(ss * (1.f / 1024.f) + EPS);
}

__device__ __forceinline__ void phase0(LAS uchar* lds, const Params& p) {
    uchar* ws = p.ws; const int tid = tid_opaque(), gtid = blockIdx.x * NT + tid, gsz = gridDim.x * NT;
    for (int l = 0; l < NL; ++l) {
        xpose_job(lds, p.in[2] + (size_t)l * DM * NIN, DM, NIN, (bf16_t*)(ws + WS_WIN) + (size_t)l * NINP * DM, DM, 0, p.in[1] + l * DM);
        xpose_job(lds, p.in[17] + (size_t)l * DM * DM, DM, DM, (bf16_t*)(ws + WS_WOUT) + (size_t)l * DM * DM, DM, 0, nullptr);
        xpose_job(lds, p.in[9] + (size_t)l * 192 * 384, 192, 384, (bf16_t*)(ws + WS_WUQ) + (size_t)l * 512 * 192, 192, 1, p.in[7] + l * 192);
        xpose_job(lds, p.in[10] + (size_t)l * 128 * 512, 128, 512, (bf16_t*)(ws + WS_WUKV) + (size_t)l * 512 * 128, 128, 0, p.in[8] + l * 128);
        for (int g = 0; g < 4; ++g)
            xpose_job(lds, p.in[15] + ((size_t)l * 4 + g) * 64 * 64, 64, 64, (bf16_t*)(ws + WS_POOLW) + ((size_t)l * 4 + g) * 128 * 64, 64, 0, nullptr);
        { bf16_t* w = (bf16_t*)(ws + WS_WIN) + ((size_t)l * NINP + NIN) * DM; for (int i = gtid; i < 32 * DM; i += gsz) w[i] = 0; }
        { bf16_t* w = (bf16_t*)(ws + WS_WUQ) + (size_t)l * 512 * 192; for (int i = gtid; i < 4 * 32 * 192; i += gsz) { const int hd = i / (32 * 192), rem = i % (32 * 192); w[(size_t)(hd * 128 + 96) * 192 + rem] = 0; } }
        { bf16_t* w = (bf16_t*)(ws + WS_POOLW) + (size_t)l * 4 * 128 * 64; for (int i = gtid; i < 4 * 64 * 64; i += gsz) { const int g = i >> 12, rem = i & 4095; w[(size_t)(g * 128 + 64) * 64 + rem] = 0; } }
    }
    expert_weights(lds, p, 0);
    for (int i = gtid; i < NL * 128 * 1024; i += gsz) {
        const int k = i & 1023, n = (i >> 10) & 127, l = i >> 17;
        float v = 0.f;
        if (n < 4) v = p.in[19][((size_t)l * DM + k) * 4 + n]; else if (n < 36) v = p.in[21][((size_t)l * DM + k) * 32 + (n - 4)];
        v *= p.in[18][l * DM + k];
        const bf16_t hi = f2bf(v), lo = f2bf(v - bf2f(hi));
        bf16_t* w = (bf16_t*)(ws + WS_WR) + ((size_t)l * 128 + n) * 3072 + k;
        w[0] = hi; w[1024] = hi; w[2048] = lo;
    }
    for (int i = gtid; i < S * 16; i += gsz) {
        const int pos = i >> 4, f = i & 15;
        double inv = 1.0; for (int k = 0; k < f; ++k) inv *= 0.5623413251903491;
        const double rev = (double)pos * inv * 0.15915494309189535;
        const float fr = (float)(rev - __builtin_rint(rev));
        ((float*)(ws + WS_ROPE))[i] = __builtin_amdgcn_cosf(fr);
        ((float*)(ws + WS_ROPE))[S * 16 + i] = __builtin_amdgcn_sinf(fr);
    }
    if (gtid < NL) {
        const int l = gtid; float* sc = (float*)(ws + WS_SCAL) + 16 * l;
        const float* lv = p.in[5] + l * 256;
        float d1 = 0.f, d2 = 0.f; for (int i = 0; i < 64; ++i) { d1 += lv[i] * lv[64 + i]; d2 += lv[128 + i] * lv[192 + i]; }
        const float lam_init = 0.8f - 0.6f * expf(-0.3f * (float)l);
        sc[0] = expf(d1) - expf(d2) + lam_init; sc[1] = 1.f - lam_init;
        float gq = 0.f, gk = 0.f; for (int i = 0; i < 64; ++i) { gq = fmaxf(gq, fabsf(p.in[3][l * 64 + i])); gk = fmaxf(gk, fabsf(p.in[4][l * 64 + i])); }
        sc[2] = gq * gk * 8.f * LOG2E * 1.02f;
        float a = 0.f, bq = 0.f, c = 0.f, dk = 0.f;
        for (int i = 0; i < 64; ++i) { a = fmaxf(a, fabsf(p.in[11][l * 64 + i])); c = fmaxf(c, fabsf(p.in[13][l * 64 + i])); }
        for (int i = 0; i < 32; ++i) { bq = fmaxf(bq, fabsf(p.in[12][l * 32 + i])); dk = fmaxf(dk, fabsf(p.in[14][l * 32 + i])); }
        sc[3] = sqrtf(64.f * a * a + 32.f * bq * bq) * sqrtf(64.f * c * c + 32.f * dk * dk) * QSCALE_M * 1.02f;
    }
    {
        const int lane = tid & 63, gw = gtid >> 6, nw = gsz >> 6;
        for (int t = gw; t < T; t += nw) row_prep(p.in[0] + (size_t)t * DM, (bf16_t*)(ws + WS_XB) + (size_t)t * DM, (float*)(ws + WS_RSTD1) + t, lane);
    }
}

__device__ __forceinline__ void ph_gemm1(LAS uchar* lds, const Params& p, int l) {
    const bf16_t* xb = (const bf16_t*)(p.ws + WS_XB); const bf16_t* win = (const bf16_t*)(p.ws + WS_WIN) + (size_t)l * NINP * DM;
    for (int u0 = blockIdx.x; u0 < 64 * 17; u0 += gridDim.x) {
        const int xg = u0 & 7, v = u0 >> 3, mt = (v / 17) * 8 + xg, nt = v % 17;
        ARowLinear ar{xb + (size_t)mt * 256 * DM, (size_t)DM};
        EpiProj ep{mt, nt, l, &p};
        gemm_tile(lds, ar, win + (size_t)nt * 128 * DM, (size_t)DM, DM, ep);
    }
}
__device__ __forceinline__ void pooled_unit(LAS uchar* lds, const Params& p, int ut) {
    const int tid = tid_opaque();
    const int t0 = ut * 64, b = t0 >> 11, s0 = t0 & 2047;
    const bf16_t* lat = (const bf16_t*)(p.ws + WS_LAT) + (size_t)b * S * 640 + 352;
    for (int it = 0; it < 5; ++it) {
        const int item = it * NT + tid, c8 = item & 31, rl = item >> 5, sr = s0 - 8 + rl;
        if (sr >= 0 && sr < S) *(LAS u32x4*)(lds + rl * 512 + c8 * 16) = *(const u32x4*)(lat + (size_t)sr * 640 + c8 * 8);
    }
    __syncthreads();
    {
        const int c = tid & 255, rh = tid >> 8, g = c >> 6, half = 1 << g;
        bf16_t* dst = (bf16_t*)(p.ws + WS_POOLED) + (size_t)(t0 + rh * 32) * 256 + c;
        const LAS bf16_t* col = (const LAS bf16_t*)lds + c;
        for (int r = 0; r < 32; ++r) {
            const int s = s0 + rh * 32 + r; int lo = s - half, hi = s + half - 1; lo = lo < 0 ? 0 : lo; hi = hi > S - 1 ? S - 1 : hi;
            float sum = 0.f;
            for (int j = lo; j <= hi; ++j) sum += bf2f(col[(j - s0 + 8) * 256]);
            const float v = sum / (float)(hi - lo + 1) - bf2f(col[(s - s0 + 8) * 256]);
            dst[(size_t)r * 256] = f2bf(v);
        }
    }
    __syncthreads();
}
__device__ __forceinline__ void ph_mix_a(LAS uchar* lds, const Params& p, int l) {
    const bf16_t* lat = (const bf16_t*)(p.ws + WS_LAT);
    if (SHADOW_V >= 0) for (int u = blockIdx.x; u < 512; u += gridDim.x) diff_attn_unit<(SHADOW_V >= 0 ? SHADOW_V : 0)>(lds, p, l, u);
    for (int u = blockIdx.x; u < 512 + 512 + 256; u += gridDim.x) {
        if (u < 512) diff_attn_unit<0>(lds, p, l, u);
        else if (u < 1024) {
            const int v = u - 512, mt = v >> 3, w = v & 7, h = w & 3;
            if (w < 4) { ARowLinear ar{lat + (size_t)mt * 256 * 640, (size_t)640}; EpiMlaQ ep{mt, h, l, &p};
                gemm_tile(lds, ar, (const bf16_t*)(p.ws + WS_WUQ) + ((size_t)l * 512 + h * 128) * 192, (size_t)192, 192, ep); }
            else { ARowLinear ar{lat + (size_t)mt * 256 * 640 + 192, (size_t)640}; EpiMlaKV ep{mt, h, l, &p};
                gemm_tile(lds, ar, (const bf16_t*)(p.ws + WS_WUKV) + ((size_t)l * 512 + h * 128) * 128, (size_t)128, 128, ep); }
        } else pooled_unit(lds, p, u - 1024);
    }
}
__device__ __forceinline__ void ph_mix_b(LAS uchar* lds, const Params& p, int l) {
    for (int u = blockIdx.x; u < 256 + 256; u += gridDim.x) {
        if (u < 256) mla_attn_unit(lds, p, l, u);
        else { const int v = u - 256, mt = v >> 2, g = v & 3;
            ARowLinear ar{(const bf16_t*)(p.ws + WS_POOLED) + (size_t)mt * 256 * 256 + g * 64, (size_t)256}; EpiPool ep{mt, g, l, &p};
            gemm_tile(lds, ar, (const bf16_t*)(p.ws + WS_POOLW) + ((size_t)l * 4 + g) * 128 * 64, (size_t)64, 64, ep); }
    }
}
__device__ __forceinline__ void ph_wout(LAS uchar* lds, const Params& p, int l) {
    const bf16_t* mix = (const bf16_t*)(p.ws + WS_MIX); const bf16_t* wo = (const bf16_t*)(p.ws + WS_WOUT) + (size_t)l * DM * DM;
    const float* xres = (l == 0) ? p.in[0] : p.out;
    for (int u0 = blockIdx.x; u0 < 64 * 8; u0 += gridDim.x) {
        const int xg = u0 & 7, v = u0 >> 3, mt = (v >> 3) * 8 + xg, nt = v & 7;
        ARowLinear ar{mix + (size_t)mt * 256 * DM, (size_t)DM}; EpiWout ep{mt, nt, xres, &p};
        gemm_tile(lds, ar, wo + (size_t)nt * 128 * DM, (size_t)DM, DM, ep);
    }
}
constexpr int LDS_RT = 135168;
struct EpiRouter {
    int mt, l; bool dry; const Params* p;
    __device__ __forceinline__ void operator()(const LAS uchar* ct) const {
        uchar* ws = p->ws; const int tid = tid_opaque();
        const LAS float* ctf = (const LAS float*)ct;
        LAS unsigned* shcnt = (LAS unsigned*)(ct + LDS_RT); LAS unsigned* shbase = shcnt + 32; LAS unsigned* pend = shcnt + 64;
        unsigned* cnt = (unsigned*)(ws + WS_CTL) + CW_CNT + 1024 * l + (dry ? 2048 : 0);
        unsigned* list = (unsigned*)(ws + (dry ? WS_POOLED : WS_LIST)); float* gwt = (float*)(ws + (dry ? WS_POOLED + 4 * MiB : WS_GW)); float* rstd2 = (float*)(ws + (dry ? WS_POOLED + 5 * MiB : WS_RSTD2));
        const float* bg = p->in[20] + l * 4; const float* be = p->in[22] + l * 32;
        if (tid < 32) shcnt[tid] = 0u;
        __syncthreads();
        if (tid < 256) {
            const int t = mt * 256 + tid;
            const float* ps = (const float*)(ws + WS_PSS) + (size_t)t * 8;
            const f32x4 p0 = *(const f32x4*)ps, p1 = *(const f32x4*)(ps + 4);
            const float ss = ((p0[0] + p0[1]) + (p0[2] + p0[3])) + ((p1[0] + p1[1]) + (p1[2] + p1[3]));
            const float rs = __builtin_amdgcn_rsqf(ss * (1.f / 1024.f) + EPS);
            const LAS float* row = ctf + tid * CTF_PITCH;
            float gl[4];
#pragma unroll
            for (int n = 0; n < 4; ++n) gl[n] = row[n] * rs + bg[n];
            int gi = 0; float gm = gl[0];
#pragma unroll
            for (int n = 1; n < 4; ++n) if (gl[n] > gm) { gm = gl[n]; gi = n; }
            float gs = 0.f;
#pragma unroll
            for (int n = 0; n < 4; ++n) gs += __expf(gl[n] - gm);
            const float gtop = 1.f / gs;
            float el[8];
#pragma unroll
            for (int n = 0; n < 8; ++n) el[n] = row[4 + gi * 8 + n] * rs + be[gi * 8 + n];
            int i1 = 0; float m1 = el[0];
#pragma unroll
            for (int n = 1; n < 8; ++n) if (el[n] > m1) { m1 = el[n]; i1 = n; }
            int i2 = -1; float m2v = -3.0e38f;
#pragma unroll
            for (int n = 0; n < 8; ++n) if (n != i1 && el[n] > m2v) { m2v = el[n]; i2 = n; }
            const float e2 = __expf(m2v - m1); const float w1 = gtop / (1.f + e2), w2 = gtop * e2 / (1.f + e2);
            const int ea = gi * 8 + i1, eb = gi * 8 + i2;
            const unsigned pa = __hip_atomic_fetch_add(&shcnt[ea], 1u, __ATOMIC_RELAXED, __HIP_MEMORY_SCOPE_WORKGROUP);
            const unsigned pbk = __hip_atomic_fetch_add(&shcnt[eb], 1u, __ATOMIC_RELAXED, __HIP_MEMORY_SCOPE_WORKGROUP);
            pend[tid * 2] = ((unsigned)ea << 16) | pa; pend[tid * 2 + 1] = ((unsigned)eb << 16) | pbk;
            gwt[t * 2] = w1; gwt[t * 2 + 1] = w2; rstd2[t] = rs;
        }
        __syncthreads();
        if (tid < 32) { const unsigned c = shcnt[tid]; shbase[tid] = c ? atomicAdd(&cnt[tid * 32], c) : 0u; }
        __syncthreads();
        { const unsigned pe = pend[tid], e = pe >> 16, lp = pe & 0xffffu; list[(size_t)e * T + shbase[e] + lp] = (unsigned)((mt * 256 + (tid >> 1)) * 2 + (tid & 1)); }
    }
};
__device__ __forceinline__ void ph_router(LAS uchar* lds, const Params& p, int l, bool dry = false) {
    const bf16_t* xb = (const bf16_t*)(p.ws + WS_XB); const bf16_t* wr = (const bf16_t*)(p.ws + WS_WR) + (size_t)l * 128 * 3072;
    for (int u = blockIdx.x; u < 64; u += gridDim.x) {
        ARowLinear ar{xb + (size_t)u * 256 * DM, (size_t)DM}; EpiRouter ep{u, l, dry, &p};
        AOffRouter ao{(int)((WS_XL - WS_XB) / 2)};
        gemm_tile<true>(lds, ar, wr, (size_t)3072, 3072, ep, ao);
    }
}
__device__ __forceinline__ void moe_find(const unsigned* cnt, int rbg, int& e, int& rb, int& nvalid, int& pre) {
    int acc = 0; e = -1; rb = 0; nvalid = 0; pre = 0;
    for (int i = 0; i < 32; ++i) { const int c = (int)cnt[i * 32], nb = (c + 255) >> 8;
        if (e < 0 && rbg < acc + nb) { e = i; rb = rbg - acc; nvalid = c - rb * 256; if (nvalid > 256) nvalid = 256; pre = acc; }
        acc += nb; }
}
__device__ __forceinline__ int moe_total(const unsigned* cnt) { int acc = 0; for (int i = 0; i < 32; ++i) acc += ((int)cnt[i * 32] + 255) >> 8; return acc; }
__device__ __forceinline__ void ph_gateup(LAS uchar* lds, const Params& p, int l) {
    uchar* ws = p.ws; const unsigned* cnt = (const unsigned*)(ws + WS_CTL) + CW_CNT + 1024 * l;
    const int tot = moe_total(cnt) * 4;
    for (int u = blockIdx.x; u < tot; u += gridDim.x) {
        int e, rb, nvalid, pre; moe_find(cnt, u >> 2, e, rb, nvalid, pre); const int jt = u & 3;
        const unsigned* list = (const unsigned*)(ws + WS_LIST) + (size_t)e * T + rb * 256;
        ARowGather ar{(const bf16_t*)(ws + WS_XB), list, nvalid};
        EpiGU ep{jt, nvalid, list, (size_t)(u >> 2) * 256, &p};
        gemm_tile(lds, ar, (const bf16_t*)(ws + WS_WGU) + ((size_t)e * 512 + jt * 128) * DM, (size_t)DM, DM, ep);
    }
}
__device__ __forceinline__ void ph_down(LAS uchar* lds, const Params& p, int l) {
    uchar* ws = p.ws; const unsigned* cnt = (const unsigned*)(ws + WS_CTL) + CW_CNT + 1024 * l;
    const int tot = moe_total(cnt) * 8;
    for (int u = blockIdx.x; u < tot; u += gridDim.x) {
        int e, rb, nvalid, pre; moe_find(cnt, u >> 3, e, rb, nvalid, pre); const int nt = u & 7;
        const unsigned* list = (const unsigned*)(ws + WS_LIST) + (size_t)e * T + rb * 256;
        ARowLinear ar{(const bf16_t*)(ws + WS_HMID) + (size_t)(u >> 3) * 256 * 256, (size_t)256};
        EpiDown ep{nt, nvalid, list, &p};
        gemm_tile(lds, ar, (const bf16_t*)(ws + WS_WD) + ((size_t)e * DM + nt * 128) * 256, (size_t)256, 256, ep);
    }
}
__device__ __forceinline__ void ph_combine(LAS uchar* lds, const Params& p, int l, bool dry = false) {
    uchar* ws = p.ws; const int tid = tid_opaque(), lane = tid & 63;
    const int gw = blockIdx.x * 8 + (tid >> 6), nw = gridDim.x * 8;
    const bf16_t* ys = (const bf16_t*)(ws + WS_YS);
    for (int t = gw; t < T; t += nw) {
        const float* xr = p.out + (size_t)t * DM; const bf16_t* y0 = ys + (size_t)(2 * t) * DM; const bf16_t* y1 = y0 + DM;
        float* xw = dry ? (float*)(ws + WS_POOLED) + (size_t)(t & 511) * DM : p.out + (size_t)t * DM;
        bf16_t* xb = dry ? (bf16_t*)(ws + WS_POOLED + 4 * MiB) + (size_t)(t & 511) * DM : (bf16_t*)(ws + WS_XB) + (size_t)t * DM;
        float ss = 0.f;
#pragma unroll
        for (int i = 0; i < 4; ++i) {
            const int c = i * 256 + lane * 4;
            f32x4 v = *(const f32x4*)(xr + c); const u32x2 a = *(const u32x2*)(y0 + c), bq = *(const u32x2*)(y1 + c);
            v[0] += bflo(a[0]) + bflo(bq[0]); v[1] += bfhi(a[0]) + bfhi(bq[0]); v[2] += bflo(a[1]) + bflo(bq[1]); v[3] += bfhi(a[1]) + bfhi(bq[1]);
            *(f32x4*)(xw + c) = v; ss += v[0] * v[0] + v[1] * v[1] + v[2] * v[2] + v[3] * v[3];
            u32x2 o; o[0] = pk2(v[0], v[1]); o[1] = pk2(v[2], v[3]); *(u32x2*)(xb + c) = o;
        }
        ss = wave_sum(ss);
        if (lane == 0) ((float*)(ws + (dry ? WS_POOLED + 6 * MiB : WS_RSTD1)))[t] = __builtin_amdgcn_rsqf(ss * (1.f / 1024.f) + EPS);
    }
    if (l + 1 < NL && !dry) expert_weights(lds, p, l + 1);
}

__global__ void __launch_bounds__(NT, 2) mega(Params p) {
    extern __shared__ __attribute__((aligned(16))) unsigned char smem[];
    LAS uchar* lds = (LAS uchar*)smem;
    if (threadIdx.x == 0) { *(LAS u32x4*)(lds + LDS_XB) = (u32x4){0u, 0u, 0u, 0u}; }
    __syncthreads();
    XcdBarrier bar = xcd_barrier_post((unsigned*)(p.ws + WS_CTL), (volatile LAS unsigned*)(lds + LDS_XB));
#define IN(k) (p.ph_lo <= (k) && (k) < p.ph_hi)
#define SEAM(k) do { if (IN(k) && IN((k) + 1)) xcd_barrier(bar); } while (0)
    if (IN(0)) for (int rep = 0; rep < NREP(8); ++rep) phase0(lds, p);
    SEAM(0);
#define LAUNDER(v) asm volatile("" : "+s"(v))
#pragma unroll 1
    for (int l0 = 0; l0 < NL; ++l0) {
        const int pb = 1 + 8 * l0;
        { int l = l0; LAUNDER(l); if (IN(pb + 0)) for (int rep = 0; rep < NREP(0); ++rep) ph_gemm1(lds, p, l); }
        SEAM(pb + 0);
        { int l = l0; LAUNDER(l); if (IN(pb + 1)) for (int rep = 0; rep < NREP(1); ++rep) ph_mix_a(lds, p, l); }
        SEAM(pb + 1);
        { int l = l0; LAUNDER(l); if (IN(pb + 2)) for (int rep = 0; rep < NREP(2); ++rep) ph_mix_b(lds, p, l); }
        SEAM(pb + 2);
        { int l = l0; LAUNDER(l); if (IN(pb + 3)) for (int rep = 0; rep < (l == 0 ? NREP(3) : 1); ++rep) ph_wout(lds, p, l); }
        SEAM(pb + 3);
        { int l = l0; LAUNDER(l); if (IN(pb + 4)) { if (NREP(4) > 1) ph_router(lds, p, l, true); ph_router(lds, p, l); } }
        SEAM(pb + 4);
        { int l = l0; LAUNDER(l); if (IN(pb + 5)) for (int rep = 0; rep < NREP(5); ++rep) ph_gateup(lds, p, l); }
        SEAM(pb + 5);
        { int l = l0; LAUNDER(l); if (IN(pb + 6)) for (int rep = 0; rep < NREP(6); ++rep) ph_down(lds, p, l); }
        SEAM(pb + 6);
        { int l = l0; LAUNDER(l); if (IN(pb + 7)) { if (NREP(7) > 1) ph_combine(lds, p, l, true); ph_combine(lds, p, l); } }
        SEAM(pb + 7);
    }
}

extern "C" void kernel_launch(void* const* d_in, const int* in_sizes, int n_in, void* d_out, int out_size, void* d_ws, size_t ws_size, hipStream_t stream) {
    (void)in_sizes; (void)n_in; (void)out_size;
    static int grid = 0;
    if (!grid) {
        int dev = 0, cus = 0, per_cu = 0;
        hipGetDevice(&dev);
        hipDeviceGetAttribute(&cus, hipDeviceAttributeMultiprocessorCount, dev);
        hipFuncSetAttribute((const void*)mega, hipFuncAttributeMaxDynamicSharedMemorySize, LDS_BYTES);
        hipOccupancyMaxActiveBlocksPerMultiprocessor(&per_cu, (const void*)mega, NT, LDS_BYTES);
        if (per_cu > 1) per_cu = 1;
        if (per_cu < 1) per_cu = 1;
        grid = cus * per_cu;
    }
    if (ws_size < WS_END) { fprintf(stderr, "workspace too small: %zu < %zu\n", ws_size, (size_t)WS_END); return; }
    hipMemsetAsync(d_ws, 0, CTL_ZERO_BYTES, stream);
    Params p{};
    for (int i = 0; i < 26; ++i) p.in[i] = (const float*)d_in[i];
    p.out = (float*)d_out; p.ws = (unsigned char*)d_ws;
#if N_LAUNCH_SPLIT
    for (int k = 0; k < NPH; ++k) { p.ph_lo = k; p.ph_hi = k + 1; hipLaunchKernelGGL(mega, dim3(grid), dim3(NT), LDS_BYTES, stream, p); }
#else
    p.ph_lo = 0; p.ph_hi = NPH;
    hipLaunchKernelGGL(mega, dim3(grid), dim3(NT), LDS_BYTES, stream, p);
#endif
}
```

```cpp
#include <hip/hip_runtime.h>
#include <stdint.h>
#include <stdio.h>

#ifndef NAIVE_GEMM
#define NAIVE_GEMM 0
#endif
#ifndef NAIVE_ATTN
#define NAIVE_ATTN 0
#endif
#ifndef N_LAUNCH_SPLIT
#define N_LAUNCH_SPLIT 0
#endif

#ifndef SHADOW_V
#define SHADOW_V -1
#endif
#ifndef SHADOW_G
#define SHADOW_G -1
#endif
#ifndef REPEAT_MASK
#define REPEAT_MASK 0
#endif
#define NREP(k) ((((REPEAT_MASK) >> (k)) & 1) + 1)
#define LAS __attribute__((address_space(3)))
typedef unsigned char uchar;
typedef unsigned short bf16_t;
typedef short bf16x8 __attribute__((ext_vector_type(8)));
typedef float f32x16 __attribute__((ext_vector_type(16)));
typedef float f32x2_t __attribute__((ext_vector_type(2)));
typedef __bf16 bf16x2_t __attribute__((ext_vector_type(2)));
typedef unsigned u32x4 __attribute__((ext_vector_type(4)));
typedef unsigned u32x2 __attribute__((ext_vector_type(2)));
typedef float f32x4 __attribute__((ext_vector_type(4)));

constexpr int NB = 8, S = 2048, DM = 1024, T = NB * S, NL = 2;
constexpr int NIN = 2144, NINP = 2176;
constexpr float EPS = 1e-6f, LOG2E = 1.4426950408889634f;
constexpr float QSCALE_D = 0.125f * LOG2E;
constexpr float QSCALE_M = 0.10206207261596577f * LOG2E;
constexpr int NPH = 1 + 8 * NL;

constexpr size_t MiB = (size_t)1 << 20;
constexpr size_t WS_CTL = 0, CTL_ZERO_BYTES = 32768;
constexpr size_t WS_SCAL = 1 * MiB;
constexpr size_t WS_ROPE = 1 * MiB + 64 * 1024;
constexpr size_t WS_RSTD1 = 1 * MiB + 512 * 1024;
constexpr size_t WS_RSTD2 = WS_RSTD1 + 64 * 1024;
constexpr size_t WS_GW = WS_RSTD2 + 64 * 1024;
constexpr size_t WS_LIST = 2 * MiB;
constexpr size_t WS_WIN = 4 * MiB;
constexpr size_t WS_WOUT = 13 * MiB;
constexpr size_t WS_WUQ = 17 * MiB;
constexpr size_t WS_WUKV = 17 * MiB + 512 * 1024;
constexpr size_t WS_POOLW = 17 * MiB + 768 * 1024;
constexpr size_t WS_WR = 18 * MiB;
constexpr size_t WS_PSS = 19 * MiB + 512 * 1024;
constexpr size_t WS_HSS = 12 * MiB + 512 * 1024;
constexpr size_t WS_WGU = 20 * MiB;
constexpr size_t WS_WD = 52 * MiB;
constexpr size_t WS_XB = 68 * MiB;
constexpr size_t WS_MIX = 100 * MiB;
constexpr size_t WS_HMID = WS_MIX;
constexpr size_t WS_QD = 132 * MiB, WS_KD = 148 * MiB, WS_VDT = 164 * MiB;
constexpr size_t WS_LAT = 180 * MiB;
constexpr size_t WS_QM = 200 * MiB, WS_KM = 212 * MiB, WS_VMT = 224 * MiB;
constexpr size_t WS_POOLED = 232 * MiB;
constexpr size_t WS_XL = 132 * MiB;
constexpr size_t WS_YS = 132 * MiB;
constexpr size_t WS_END = 240 * MiB;

#define XB_TMO      128
#define XB_XCNT(j)  (256  + 64 * (j))
#define XB_XSUB(j)  (1280 + 64 * (j))
#define XB_XGEN(j)  (2304 + 64 * (j))
#define XB_TOP      3328
#define XB_TOPGEN   3392
#define XCD_BAR_WORDS 3456
#define XB_SPIN_CAP (1u << 18)
constexpr int CW_CNT = 4096;

constexpr int NT = 512;
constexpr int LDS_XB = 147456;
constexpr int LDS_ROW = LDS_XB + 256;
constexpr int LDS_BYTES = LDS_ROW + 2048;
constexpr int GSTG = 49152;
constexpr int ASTG = 32768;
constexpr int MSTG = 20480;

struct Params {
    const float* in[26];
    float* out;
    unsigned char* ws;
    int ph_lo, ph_hi;
};

__device__ __forceinline__ unsigned pk2(float lo, float hi) { f32x2_t v = {lo, hi}; bf16x2_t b = __builtin_convertvector(v, bf16x2_t); return __builtin_bit_cast(unsigned, b); }
__device__ __forceinline__ float bflo(unsigned w) { return __builtin_bit_cast(float, w << 16); }
__device__ __forceinline__ float bfhi(unsigned w) { return __builtin_bit_cast(float, w & 0xffff0000u); }
__device__ __forceinline__ float bf2f(bf16_t u) { return __builtin_bit_cast(float, (unsigned)u << 16); }
__device__ __forceinline__ bf16_t f2bf(float f) { return (bf16_t)(pk2(f, 0.f) & 0xffffu); }
__device__ __forceinline__ LAS uchar* lds_base() { extern __shared__ __attribute__((aligned(16))) unsigned char smem_dyn_[]; return (LAS uchar*)smem_dyn_; }
__device__ __forceinline__ int tid_opaque() { int t = threadIdx.x; asm volatile("" : "+v"(t)); return t; }
__device__ __forceinline__ int crow(int r, int hi) { return (r & 3) + 8 * (r >> 2) + 4 * hi; }
__device__ __forceinline__ int sigma16(int s) { return (s & ~12) | ((s & 4) << 1) | ((s & 8) >> 1); }
__device__ __forceinline__ float wave_sum(float v) {
#pragma unroll
    for (int o = 32; o >= 1; o >>= 1) v += __shfl_xor(v, o);
    return v;
}
__device__ __forceinline__ void unpack8(u32x4 w, float (&f)[8]) {
    f[0] = bflo(w[0]); f[1] = bfhi(w[0]); f[2] = bflo(w[1]); f[3] = bfhi(w[1]);
    f[4] = bflo(w[2]); f[5] = bfhi(w[2]); f[6] = bflo(w[3]); f[7] = bfhi(w[3]);
}

__device__ __forceinline__ unsigned xb_ld(unsigned* p)              { return __hip_atomic_load(p, __ATOMIC_RELAXED, __HIP_MEMORY_SCOPE_AGENT); }
__device__ __forceinline__ unsigned xb_add(unsigned* p, unsigned v) { return __hip_atomic_fetch_add(p, v, __ATOMIC_RELAXED, __HIP_MEMORY_SCOPE_AGENT); }
__device__ __forceinline__ unsigned xb_xcc_id() { return (unsigned)__builtin_amdgcn_s_getreg((3 << 11) | 20) & 0xFu; }
#define XB_SPIN(cond, bar) do { unsigned _sp = 0; while (cond) { __builtin_amdgcn_s_sleep(1); \
    if ((++_sp & 255u) == 0u) { if (xb_ld(&(bar)[XB_TMO])) break; if (_sp > XB_SPIN_CAP) { atomicAdd(&(bar)[XB_TMO], 1u); break; } } } } while (0)
struct XcdBarrier { unsigned* bar; unsigned x; volatile LAS unsigned* st; };
__device__ __forceinline__ XcdBarrier xcd_barrier_post(unsigned* bar, volatile LAS unsigned* st) {
    XcdBarrier b; b.bar = bar; b.x = xb_xcc_id(); b.st = st;
    if (threadIdx.x == 0) (void)xb_add(&bar[XB_XCNT(b.x)], 1u);
    return b;
}
__device__ __forceinline__ void xcd_barrier_complete(unsigned* bar, unsigned x, unsigned& nloc, unsigned& nx) {
    const unsigned G = gridDim.x * gridDim.y * gridDim.z;
    unsigned sum, cnt, mine, sp = 0u;
    for (;;) {
        sum = 0u; cnt = 0u; mine = 0u;
#pragma unroll
        for (unsigned j = 0; j < 16; ++j) { const unsigned c = xb_ld(&bar[XB_XCNT(j)]); sum += c; cnt += (c > 0u) ? 1u : 0u; mine = (j == x) ? c : mine; }
        if (sum == G) break;
        __builtin_amdgcn_s_sleep(1);
        if ((++sp & 255u) == 0u) { if (xb_ld(&bar[XB_TMO])) break; if (sp > XB_SPIN_CAP) { atomicAdd(&bar[XB_TMO], 1u); break; } }
    }
    nloc = mine > 0u ? mine : 1u; nx = cnt > 0u ? cnt : 1u;
}
__device__ __forceinline__ void xcd_barrier(const XcdBarrier& b) {
    asm volatile("s_waitcnt vmcnt(0)" ::: "memory");
    __syncthreads();
    if (threadIdx.x == 0) {
        unsigned* bar = b.bar;
        __builtin_amdgcn_s_waitcnt(0);
        unsigned nloc = b.st[0], nx = b.st[1];
        if (nloc == 0u) { xcd_barrier_complete(bar, b.x, nloc, nx); b.st[0] = nloc; b.st[1] = nx; }
        const unsigned old = xb_add(&bar[XB_XSUB(b.x)], 1u);
        const unsigned gen = old / nloc;
        if (old + 1u == (gen + 1u) * nloc) {
            __builtin_amdgcn_fence(__ATOMIC_RELEASE, "agent");
            asm volatile("s_waitcnt vmcnt(0)" ::: "memory");
            const unsigned og = xb_add(&bar[XB_TOP], 1u);
            const unsigned tg = og / nx;
            if (og + 1u == (tg + 1u) * nx) xb_add(&bar[XB_TOPGEN], 1u);
            else XB_SPIN(xb_ld(&bar[XB_TOPGEN]) == tg, bar);
            __builtin_amdgcn_fence(__ATOMIC_ACQUIRE, "agent");
            xb_add(&bar[XB_XGEN(b.x)], 1u);
            asm volatile("s_waitcnt vmcnt(0)" ::: "memory");
        } else {
            XB_SPIN(xb_ld(&bar[XB_XGEN(b.x)]) == gen, bar);
            __builtin_amdgcn_fence(__ATOMIC_ACQUIRE, "agent");
            asm volatile("s_waitcnt vmcnt(0)" ::: "memory");
        }
    }
    __syncthreads();
}

__device__ __forceinline__ void glds16(const void* gsrc, LAS uchar* dst_wave_base) {
    __builtin_amdgcn_global_load_lds((const unsigned*)gsrc, (LAS unsigned*)dst_wave_base, 16, 0, 0);
}
__device__ __forceinline__ int sw128(int row, int c) { return row * 128 + ((c ^ ((row >> 1) & 7)) << 4); }
__device__ __forceinline__ int sw64(int row, int c) { return row * 64 + ((c ^ ((row >> 2) & 3)) << 4); }

#define MFMA32(a, b, c) __builtin_amdgcn_mfma_f32_32x32x16_bf16((a), (b), (c), 0, 0, 0)

constexpr int CT_PITCH = 272;
#define WAITV(n) asm volatile("s_waitcnt vmcnt(" #n ")" ::: "memory")
struct ARowLinear { const bf16_t* base; size_t ld; __device__ __forceinline__ const bf16_t* operator()(int r) const { return base + (size_t)r * ld; } };
struct ARowGather { const bf16_t* base; const unsigned* list; int nvalid; __device__ __forceinline__ const bf16_t* operator()(int r) const {
    const int rr = r < nvalid ? r : nvalid - 1; const unsigned ent = list[rr]; return base + (size_t)(ent >> 1) * DM; } };

struct AOffLinear { __device__ __forceinline__ int operator()(int kt) const { return kt * 64; } };
struct AOffRouter { int xl_off; __device__ __forceinline__ int operator()(int kt) const { return (kt & 15) * 64 + ((kt >> 4) == 1 ? xl_off : 0); } };
constexpr int CTF_PITCH = 129;
template <bool F32C = false, class ARow, class Epi, class AOff = AOffLinear>
__device__ __forceinline__ void gemm_tile(LAS uchar* lds, const ARow& arow, const bf16_t* Bt, size_t ldb, int K, const Epi& epi, const AOff aoff = AOff()) {
    const int tid = tid_opaque(), lane = tid & 63, wid = __builtin_amdgcn_readfirstlane(tid >> 6);
#if NAIVE_GEMM
    {
        const int r = tid >> 1, nh = tid & 1;
        float acc[64];
#pragma unroll
        for (int n = 0; n < 64; ++n) acc[n] = 0.f;
        const bf16_t* ar = arow(r);
        for (int k = 0; k < K; k += 8) {
            float a[8]; unpack8(*(const u32x4*)(ar + k), a);
#pragma unroll
            for (int n = 0; n < 64; ++n) {
                float b[8]; unpack8(*(const u32x4*)(Bt + (size_t)(nh * 64 + n) * ldb + k), b);
#pragma unroll
                for (int j = 0; j < 8; ++j) acc[n] += a[j] * b[j];
            }
        }
        __syncthreads();
#pragma unroll
        for (int n = 0; n < 64; n += 2) { if (F32C) { ((LAS float*)lds)[r * CTF_PITCH + nh * 64 + n] = acc[n]; ((LAS float*)lds)[r * CTF_PITCH + nh * 64 + n + 1] = acc[n + 1]; } else *(LAS unsigned*)(lds + r * CT_PITCH + (nh * 64 + n) * 2) = pk2(acc[n], acc[n + 1]); }
    }
#else
    {
        const int wm = wid >> 1, wn = wid & 1, r = lane & 31, hh = lane >> 5;
        const int srow = lane >> 3, c0 = (lane & 7) ^ (srow >> 1);
        const bf16_t* asrc[4];
#pragma unroll
        for (int j = 0; j < 4; ++j) asrc[j] = arow(8 * (wid * 4 + j) + srow) + (c0 ^ ((j & 1) << 2)) * 8;
        const bf16_t* bsrc0 = Bt + (size_t)(wid * 16 + srow) * ldb + c0 * 8;
        const bf16_t* bsrc1 = Bt + (size_t)(wid * 16 + 8 + srow) * ldb + (c0 ^ 4) * 8;
        const int lanebase = r * 128 + ((hh ^ ((r >> 1) & 7)) << 4);
        f32x16 acc[2][2];
#pragma unroll
        for (int a = 0; a < 2; ++a)
#pragma unroll
            for (int b = 0; b < 2; ++b)
#pragma unroll
                for (int i = 0; i < 16; ++i) acc[a][b][i] = 0.f;
        const int nt = K >> 6;
#define GT_STAGE(kt, sb) do { _Pragma("unroll") for (int j = 0; j < 4; ++j) \
            glds16(asrc[j] + aoff(kt), lds + (sb) * GSTG + (wid * 4 + j) * 1024); \
            glds16(bsrc0 + (kt) * 64, lds + (sb) * GSTG + 32768 + (wid * 2) * 1024); \
            glds16(bsrc1 + (kt) * 64, lds + (sb) * GSTG + 32768 + (wid * 2 + 1) * 1024); } while (0)
        GT_STAGE(0, 0);
        if (nt > 1) GT_STAGE(1, 1);
        int sb = 0;
        for (int kt = 0; kt < nt; ++kt) {
            if (kt + 1 < nt) WAITV(6); else WAITV(0);
            __builtin_amdgcn_s_barrier();
            if (kt + 2 < nt) { const int sn = sb >= 1 ? sb - 1 : 2; GT_STAGE(kt + 2, sn); }
            const LAS uchar* xs = lds + sb * GSTG + wm * 8192; const LAS uchar* wsb = lds + sb * GSTG + 32768 + wn * 8192;
#pragma unroll
            for (int ks = 0; ks < 4; ++ks) {
                const int lb = lanebase ^ (ks << 5);
                bf16x8 xf[2], wf[2];
#pragma unroll
                for (int mb = 0; mb < 2; ++mb) xf[mb] = *(const LAS bf16x8*)(xs + mb * 4096 + lb);
#pragma unroll
                for (int nb = 0; nb < 2; ++nb) wf[nb] = *(const LAS bf16x8*)(wsb + nb * 4096 + lb);
#pragma unroll
                for (int nb = 0; nb < 2; ++nb)
#pragma unroll
                    for (int mb = 0; mb < 2; ++mb) acc[nb][mb] = MFMA32(wf[nb], xf[mb], acc[nb][mb]);
            }
            sb = sb == 2 ? 0 : sb + 1;
        }
#undef GT_STAGE
        __syncthreads();
#pragma unroll
        for (int nb = 0; nb < 2; ++nb)
#pragma unroll
            for (int mb = 0; mb < 2; ++mb) {
                const int m = 64 * wm + 32 * mb + r;
#pragma unroll
                for (int q4 = 0; q4 < 4; ++q4) {
                    const int n = 64 * wn + 32 * nb + 8 * q4 + 4 * hh;
                    if (F32C) {
#pragma unroll
                        for (int j = 0; j < 4; ++j) ((LAS float*)lds)[m * CTF_PITCH + n + j] = acc[nb][mb][4 * q4 + j];
                    } else {
                        u32x2 v; v[0] = pk2(acc[nb][mb][4 * q4], acc[nb][mb][4 * q4 + 1]); v[1] = pk2(acc[nb][mb][4 * q4 + 2], acc[nb][mb][4 * q4 + 3]);
                        *(LAS u32x2*)(lds + m * CT_PITCH + n * 2) = v;
                    }
                }
            }
    }
#endif
    __syncthreads();
    epi(lds);
    __syncthreads();
}
constexpr int BSTG = 32768, CT2_OFF = 256 * CT_PITCH;
template <int V = 0, class ARow, class EpiMaker>
__device__ __forceinline__ void gemm_big(LAS uchar* lds, const ARow& arow, const bf16_t* Bt, size_t ldb, int K, const EpiMaker& mk) {
    const int tid = tid_opaque(), lane = tid & 63, wid = __builtin_amdgcn_readfirstlane(tid >> 6);
    {
        const int wm = wid >> 2, wn = wid & 3, r = lane & 31, hh = lane >> 5;
        const int srow = lane >> 2, sc = (lane & 3) ^ ((lane >> 4) & 3);
        const bf16_t* a0 = arow(wid * 32 + srow) + sc * 8; const bf16_t* a1 = arow(wid * 32 + 16 + srow) + sc * 8;
        const bf16_t* b0 = Bt + (size_t)(wid * 32 + srow) * ldb + sc * 8; const bf16_t* b1 = b0 + (size_t)16 * ldb;
        const int lanebase = r * 64 + ((hh ^ ((r >> 2) & 3)) << 4);
        f32x16 acc[2][4];
#pragma unroll
        for (int a = 0; a < 2; ++a)
#pragma unroll
            for (int b = 0; b < 4; ++b)
#pragma unroll
                for (int i = 0; i < 16; ++i) acc[a][b][i] = 0.f;
        const int nt = K >> 5;
#define GB_STAGE(kt, sb) do { \
            glds16(a0 + (kt) * 32, lds + (sb) * BSTG + (wid * 2) * 1024); glds16(a1 + (kt) * 32, lds + (sb) * BSTG + (wid * 2 + 1) * 1024); \
            glds16(b0 + (kt) * 32, lds + (sb) * BSTG + 16384 + (wid * 2) * 1024); glds16(b1 + (kt) * 32, lds + (sb) * BSTG + 16384 + (wid * 2 + 1) * 1024); } while (0)
        if (!(V & 4)) { GB_STAGE(0, 0); GB_STAGE(1, 1); GB_STAGE(2, 2); }
        for (int kt = 0; kt < nt; ++kt) {
            const int sb = kt & 3;
            if (kt + 2 < nt) WAITV(8); else if (kt + 1 < nt) WAITV(4); else WAITV(0);
            __builtin_amdgcn_s_barrier();
            if (!(V & 4) && kt + 3 < nt) GB_STAGE(kt + 3, (kt + 3) & 3);
            const LAS uchar* xs = lds + sb * BSTG + wm * 8192; const LAS uchar* wsb = lds + sb * BSTG + 16384 + wn * 4096;
#pragma unroll
            for (int ks = 0; ks < 2; ++ks) {
                const int lb = lanebase ^ (ks << 5);
                bf16x8 xf[4], wf[2];
#pragma unroll
                for (int mb = 0; mb < 4; ++mb) { if (V & 8) { u32x4 t = {(unsigned)(lb + mb + kt), 1u, 2u, 3u}; xf[mb] = __builtin_bit_cast(bf16x8, t); } else xf[mb] = *(const LAS bf16x8*)(xs + mb * 2048 + lb); }
#pragma unroll
                for (int nb = 0; nb < 2; ++nb) { if (V & 8) { u32x4 t = {(unsigned)(lb + nb), 5u, 6u, (unsigned)kt}; wf[nb] = __builtin_bit_cast(bf16x8, t); } else wf[nb] = *(const LAS bf16x8*)(wsb + nb * 2048 + lb); }
#pragma unroll
                for (int nb = 0; nb < 2; ++nb)
#pragma unroll
                    for (int mb = 0; mb < 4; ++mb) { if (V & 2) { acc[nb][mb][ks] += __builtin_bit_cast(float, (__builtin_bit_cast(u32x4, wf[nb]))[0] ^ (__builtin_bit_cast(u32x4, xf[mb]))[0]); } else acc[nb][mb] = MFMA32(wf[nb], xf[mb], acc[nb][mb]); }
            }
        }
#undef GB_STAGE
        __syncthreads();
#pragma unroll
        for (int nb = 0; nb < 2; ++nb)
#pragma unroll
            for (int mb = 0; mb < 4; ++mb) {
                const int m = 128 * wm + 32 * mb + r;
#pragma unroll
                for (int q4 = 0; q4 < 4; ++q4) {
                    const int n = 64 * (wn & 1) + 32 * nb + 8 * q4 + 4 * hh;
                    u32x2 v; v[0] = pk2(acc[nb][mb][4 * q4], acc[nb][mb][4 * q4 + 1]); v[1] = pk2(acc[nb][mb][4 * q4 + 2], acc[nb][mb][4 * q4 + 3]);
                    *(LAS u32x2*)(lds + (wn >> 1) * CT2_OFF + m * CT_PITCH + n * 2) = v;
                }
            }
    }
    __syncthreads();
    if (!(V & 1)) { mk(0)(lds); mk(1)(lds + CT2_OFF); }
    __syncthreads();
}
__device__ __forceinline__ u32x4 ct_ld8(const LAS uchar* ct, int r, int c) { return *(const LAS u32x4*)(ct + r * CT_PITCH + c * 2); }
__device__ __forceinline__ float ct_ld1(const LAS uchar* ct, int r, int c) { return bf2f(*(const LAS bf16_t*)(ct + r * CT_PITCH + c * 2)); }

struct EpiProj {
    int mt, nt, l; const Params* p;
    __device__ __forceinline__ void operator()(const LAS uchar* ct) const {
        uchar* ws = p->ws; const int tid = tid_opaque();
        const LAS float* rowS = (const LAS float*)(lds_base() + LDS_ROW);
        const int t0 = mt * 256, b = t0 >> 11, s0 = t0 & 2047;
        if (nt < 8) {
            const int h = nt & 3; const bool isq = nt < 4;
            const int c8 = tid & 7, j = (tid >> 3) & 1, r0 = tid >> 4;
            const float* g = p->in[isq ? 3 : 4] + l * 64 + c8 * 8;
            const f32x4 g0 = *(const f32x4*)g, g1 = *(const f32x4*)(g + 4);
            bf16_t* dbase = (bf16_t*)(ws + (isq ? WS_QD : WS_KD)) + ((((size_t)b * 4 + h) * 2 + j) * S + s0) * 64 + c8 * 8;
#pragma unroll
            for (int it = 0; it < 8; ++it) {
                const int r = it * 32 + r0;
                const float rs = rowS[r];
                float f[8]; unpack8(ct_ld8(ct, r, j * 64 + c8 * 8), f);
                float ss = 0.f;
#pragma unroll
                for (int i = 0; i < 8; ++i) { f[i] *= rs; ss += f[i] * f[i]; }
                ss += __shfl_xor(ss, 1); ss += __shfl_xor(ss, 2); ss += __shfl_xor(ss, 4);
                const float rn = __builtin_amdgcn_rsqf(ss * (1.f / 64.f) + EPS) * (isq ? QSCALE_D : 1.f);
                u32x4 o; o[0] = pk2(f[0] * rn * g0[0], f[1] * rn * g0[1]); o[1] = pk2(f[2] * rn * g0[2], f[3] * rn * g0[3]);
                o[2] = pk2(f[4] * rn * g1[0], f[5] * rn * g1[1]); o[3] = pk2(f[6] * rn * g1[2], f[7] * rn * g1[3]);
                *(u32x4*)(dbase + (size_t)r * 64) = o;
            }
        } else if (nt < 12) {
            const int h = nt - 8, d = tid >> 2, half = tid & 3;
            bf16_t* dst = (bf16_t*)(ws + WS_VDT) + (((size_t)b * 4 + h) * 128 + d) * S + s0 + half * 64;
#pragma unroll
            for (int c8 = 0; c8 < 8; ++c8) { u32x4 o;
#pragma unroll
                for (int i = 0; i < 4; ++i) {
                    const int p0 = c8 * 8 + 2 * i, r0 = half * 64 + sigma16(p0), r1 = half * 64 + sigma16(p0 + 1);
                    o[i] = pk2(ct_ld1(ct, r0, d) * rowS[r0], ct_ld1(ct, r1, d) * rowS[r1]); }
                *(u32x4*)(dst + c8 * 8) = o; }
        } else {
            const int c8 = tid & 15, r0 = tid >> 4;
            bf16_t* dbase = (bf16_t*)(ws + WS_LAT) + (size_t)t0 * 640 + (nt - 12) * 128 + c8 * 8;
            const int hidx = (nt - 12) * 2 + (c8 >> 3);
            float* hss = (float*)(ws + WS_HSS) + (size_t)t0 * 8 + hidx;
#pragma unroll
            for (int it = 0; it < 8; ++it) {
                const int r = it * 32 + r0;
                const float rs = rowS[r];
                float f[8]; unpack8(ct_ld8(ct, r, c8 * 8), f); u32x4 o;
#pragma unroll
                for (int i = 0; i < 4; ++i) o[i] = pk2(f[2 * i] * rs, f[2 * i + 1] * rs);
                *(u32x4*)(dbase + (size_t)r * 640) = o;
                float ss = 0.f;
#pragma unroll
                for (int i = 0; i < 4; ++i) { const float a = bflo(o[i]), bq = bfhi(o[i]); ss += a * a + bq * bq; }
                ss += __shfl_xor(ss, 1); ss += __shfl_xor(ss, 2); ss += __shfl_xor(ss, 4);
                if ((c8 & 7) == 0 && hidx < 8) hss[(size_t)r * 8] = ss;
            }
        }
    }
};

__device__ __forceinline__ float lat_rstd(const bf16_t* seg, int n) {
    float ss = 0.f;
    for (int k = 0; k < n; k += 8) { float f[8]; unpack8(*(const u32x4*)(seg + k), f);
#pragma unroll
        for (int i = 0; i < 8; ++i) ss += f[i] * f[i]; }
    return __builtin_amdgcn_rsqf(ss / (float)n + EPS);
}
__device__ __forceinline__ void norm_rope32(float (&y)[32], const float* g, const float* cosr, const float* sinr, float outscale) {
    float ss = 0.f;
#pragma unroll
    for (int i = 0; i < 32; ++i) ss += y[i] * y[i];
    const float rn = __builtin_amdgcn_rsqf(ss * (1.f / 32.f) + EPS);
#pragma unroll
    for (int i = 0; i < 32; ++i) y[i] = y[i] * rn * g[i];
#pragma unroll
    for (int i = 0; i < 16; ++i) { const float c = cosr[i], sn = sinr[i], x1 = y[i], x2 = y[16 + i];
        y[i] = (x1 * c - x2 * sn) * outscale; y[16 + i] = (x2 * c + x1 * sn) * outscale; }
}

__device__ __forceinline__ u32x4 norm64_piece(float (&f)[8], const float* g8, float outscale) {
    float ss = 0.f;
#pragma unroll
    for (int i = 0; i < 8; ++i) ss += f[i] * f[i];
    ss += __shfl_xor(ss, 1); ss += __shfl_xor(ss, 2); ss += __shfl_xor(ss, 4);
    const float rn = __builtin_amdgcn_rsqf(ss * (1.f / 64.f) + EPS) * outscale;
    const f32x4 g0 = *(const f32x4*)g8, g1 = *(const f32x4*)(g8 + 4);
    u32x4 o; o[0] = pk2(f[0] * rn * g0[0], f[1] * rn * g0[1]); o[1] = pk2(f[2] * rn * g0[2], f[3] * rn * g0[3]);
    o[2] = pk2(f[4] * rn * g1[0], f[5] * rn * g1[1]); o[3] = pk2(f[6] * rn * g1[2], f[7] * rn * g1[3]);
    return o;
}
__device__ __forceinline__ u32x4 norm_rope_piece(float (&f)[8], int c8, const float* g, const float* cosr, const float* sinr, float outscale) {
    float ss = 0.f;
#pragma unroll
    for (int i = 0; i < 8; ++i) ss += f[i] * f[i];
    ss += __shfl_xor(ss, 1); ss += __shfl_xor(ss, 2);
    const float rn = __builtin_amdgcn_rsqf(ss * (1.f / 32.f) + EPS);
    float y[8], z[8];
#pragma unroll
    for (int i = 0; i < 8; ++i) y[i] = f[i] * rn * g[c8 * 8 + i];
#pragma unroll
    for (int i = 0; i < 8; ++i) z[i] = __shfl_xor(y[i], 2);
    const int fi = (c8 & 1) * 8;
    float o[8];
#pragma unroll
    for (int i = 0; i < 8; ++i) { const float c = cosr[fi + i], sn = sinr[fi + i];
        o[i] = ((c8 < 2) ? (y[i] * c - z[i] * sn) : (y[i] * c + z[i] * sn)) * outscale; }
    u32x4 w; w[0] = pk2(o[0], o[1]); w[1] = pk2(o[2], o[3]); w[2] = pk2(o[4], o[5]); w[3] = pk2(o[6], o[7]);
    return w;
}
struct EpiMlaQ {
    int mt, h, l; const Params* p;
    __device__ __forceinline__ void operator()(const LAS uchar* ct) const {
        uchar* ws = p->ws; const int tid = tid_opaque();
        const LAS float* rowS = (const LAS float*)(lds_base() + LDS_ROW);
        const int t0 = mt * 256, b = t0 >> 11, s0 = t0 & 2047;
        bf16_t* dbase = (bf16_t*)(ws + WS_QM) + (((size_t)b * 4 + h) * S + s0) * 96;
        const float* gn = p->in[11] + l * 64; const float* gr = p->in[12] + l * 32;
        {
            const int c8 = tid & 7, r0 = tid >> 3;
#pragma unroll
            for (int it = 0; it < 4; ++it) {
                const int r = it * 64 + r0; const float rs = rowS[r];
                float f[8]; unpack8(ct_ld8(ct, r, c8 * 8), f);
#pragma unroll
                for (int i = 0; i < 8; ++i) f[i] *= rs;
                *(u32x4*)(dbase + (size_t)r * 96 + c8 * 8) = norm64_piece(f, gn + c8 * 8, QSCALE_M);
            }
        }
        {
            const int c8 = tid & 3, r0 = tid >> 2;
#pragma unroll
            for (int it = 0; it < 2; ++it) {
                const int r = it * 128 + r0; const float rs = rowS[r];
                float f[8]; unpack8(ct_ld8(ct, r, 64 + c8 * 8), f);
#pragma unroll
                for (int i = 0; i < 8; ++i) f[i] *= rs;
                const float* cosr = (const float*)(ws + WS_ROPE) + (s0 + r) * 16; const float* sinr = cosr + S * 16;
                *(u32x4*)(dbase + (size_t)r * 96 + 64 + c8 * 8) = norm_rope_piece(f, c8, gr, cosr, sinr, QSCALE_M);
            }
        }
    }
};
struct EpiMlaKV {
    int mt, h, l; const Params* p;
    __device__ __forceinline__ void operator()(const LAS uchar* ct) const {
        uchar* ws = p->ws; const int tid = tid_opaque();
        const LAS float* rowS = (const LAS float*)(lds_base() + LDS_ROW);
        const int t0 = mt * 256, b = t0 >> 11, s0 = t0 & 2047;
        bf16_t* dbase = (bf16_t*)(ws + WS_KM) + (((size_t)b * 4 + h) * S + s0) * 96;
        const float* gn = p->in[13] + l * 64; const float* gr = p->in[14] + l * 32;
        {
            const int c8 = tid & 7, r0 = tid >> 3;
#pragma unroll
            for (int it = 0; it < 4; ++it) {
                const int r = it * 64 + r0; const float rs = rowS[r];
                float f[8]; unpack8(ct_ld8(ct, r, c8 * 8), f);
#pragma unroll
                for (int i = 0; i < 8; ++i) f[i] *= rs;
                *(u32x4*)(dbase + (size_t)r * 96 + c8 * 8) = norm64_piece(f, gn + c8 * 8, 1.f);
            }
        }
        {
            const bf16_t* lat = (const bf16_t*)(ws + WS_LAT) + (size_t)t0 * 640 + 320;
            const int c8 = tid & 3, r0 = tid >> 2;
#pragma unroll
            for (int it = 0; it < 2; ++it) {
                const int r = it * 128 + r0;
                float f[8]; unpack8(*(const u32x4*)(lat + (size_t)r * 640 + c8 * 8), f);
                const float* cosr = (const float*)(ws + WS_ROPE) + (s0 + r) * 16; const float* sinr = cosr + S * 16;
                *(u32x4*)(dbase + (size_t)r * 96 + 64 + c8 * 8) = norm_rope_piece(f, c8, gr, cosr, sinr, 1.f);
            }
        }
        {
            const int d = tid >> 3, q4 = tid & 7;
            bf16_t* dst = (bf16_t*)(ws + WS_VMT) + (((size_t)b * 4 + h) * 64 + d) * S + s0 + q4 * 32;
#pragma unroll
            for (int c8 = 0; c8 < 4; ++c8) { u32x4 o;
#pragma unroll
                for (int i = 0; i < 4; ++i) {
                    const int p0 = c8 * 8 + 2 * i, r0 = q4 * 32 + sigma16(p0), r1 = q4 * 32 + sigma16(p0 + 1);
                    o[i] = pk2(ct_ld1(ct, r0, 64 + d) * rowS[r0], ct_ld1(ct, r1, 64 + d) * rowS[r1]); }
                *(u32x4*)(dst + c8 * 8) = o; }
        }
    }
};
struct EpiPool {
    int mt, g, l; const Params* p;
    __device__ __forceinline__ void operator()(const LAS uchar* ct) const {
        uchar* ws = p->ws; const int tid = tid_opaque(), c8 = tid & 7, r0 = tid >> 3;
        const float* sc = p->in[16] + l * 256 + g * 64 + c8 * 8;
        const f32x4 s0 = *(const f32x4*)sc, s1 = *(const f32x4*)(sc + 4);
        bf16_t* dst = (bf16_t*)(ws + WS_MIX) + (size_t)(mt * 256) * DM + 768 + g * 64 + c8 * 8;
#pragma unroll
        for (int it = 0; it < 4; ++it) {
            const int r = it * 64 + r0;
            float f[8]; unpack8(ct_ld8(ct, r, c8 * 8), f); u32x4 o;
            o[0] = pk2(f[0] * s0[0], f[1] * s0[1]); o[1] = pk2(f[2] * s0[2], f[3] * s0[3]); o[2] = pk2(f[4] * s1[0], f[5] * s1[1]); o[3] = pk2(f[6] * s1[2], f[7] * s1[3]);
            *(u32x4*)(dst + (size_t)r * DM) = o;
        }
    }
};
struct EpiWout {
    int mt, nt; const float* xres; const Params* p;
    __device__ __forceinline__ void operator()(const LAS uchar* ct) const {
        uchar* ws = p->ws; const int tid = tid_opaque();
        const size_t base = (size_t)(mt * 256) * DM + nt * 128;
        float* pss = (float*)(ws + WS_PSS) + (size_t)(mt * 256) * 8 + nt;
#pragma unroll 8
        for (int it = 0; it < 16; ++it) {
            const int item = it * NT + tid, c4 = item & 31, r = item >> 5;
            const size_t off = base + (size_t)r * DM + c4 * 4;
            const u32x2 cw = *(const LAS u32x2*)(ct + r * CT_PITCH + c4 * 8);
            const f32x4 x0 = *(const f32x4*)(xres + off);
            f32x4 y; y[0] = x0[0] + bflo(cw[0]); y[1] = x0[1] + bfhi(cw[0]); y[2] = x0[2] + bflo(cw[1]); y[3] = x0[3] + bfhi(cw[1]);
            *(f32x4*)(p->out + off) = y;
            u32x2 o; o[0] = pk2(y[0], y[1]); o[1] = pk2(y[2], y[3]);
            *(u32x2*)((bf16_t*)(ws + WS_XB) + off) = o;
            u32x2 ol; ol[0] = pk2(y[0] - bflo(o[0]), y[1] - bfhi(o[0])); ol[1] = pk2(y[2] - bflo(o[1]), y[3] - bfhi(o[1]));
            *(u32x2*)((bf16_t*)(ws + WS_XL) + off) = ol;
            float ss = y[0] * y[0] + y[1] * y[1] + y[2] * y[2] + y[3] * y[3];
            ss += __shfl_xor(ss, 1); ss += __shfl_xor(ss, 2); ss += __shfl_xor(ss, 4); ss += __shfl_xor(ss, 8); ss += __shfl_xor(ss, 16);
            if (c4 == 0) pss[(size_t)r * 8] = ss;
        }
    }
};
struct EpiGU {
    int jt; size_t slot0; const Params* p;
    __device__ __forceinline__ void operator()(const LAS uchar* ct) const {
        uchar* ws = p->ws; const int tid = tid_opaque(), c8 = tid & 7, r0 = tid >> 3;
        const LAS float* rowS = (const LAS float*)(lds_base() + LDS_ROW);
        bf16_t* dbase = (bf16_t*)(ws + WS_HMID) + slot0 * 256 + jt * 64 + c8 * 8;
#pragma unroll
        for (int it = 0; it < 4; ++it) {
            const int r = it * 64 + r0;
            const float rs = rowS[r];
            float g[8], u[8]; unpack8(ct_ld8(ct, r, c8 * 8), g); unpack8(ct_ld8(ct, r, 64 + c8 * 8), u);
            float hv[8];
#pragma unroll
            for (int i = 0; i < 8; ++i) { const float gg = g[i] * rs, uu = u[i] * rs; hv[i] = gg * __builtin_amdgcn_rcpf(1.f + __builtin_amdgcn_exp2f(-gg * LOG2E)) * uu; }
            u32x4 o; o[0] = pk2(hv[0], hv[1]); o[1] = pk2(hv[2], hv[3]); o[2] = pk2(hv[4], hv[5]); o[3] = pk2(hv[6], hv[7]);
            *(u32x4*)(dbase + (size_t)r * 256) = o;
        }
    }
};
struct EpiDown {
    int nt, nvalid; const Params* p;
    __device__ __forceinline__ void operator()(const LAS uchar* ct) const {
        uchar* ws = p->ws; const int tid = tid_opaque(), c8 = tid & 15, r0 = tid >> 4;
        const LAS float* rowS = (const LAS float*)(lds_base() + LDS_ROW); const LAS unsigned* rowE = (const LAS unsigned*)(lds_base() + LDS_ROW + 1024);
        bf16_t* ys = (bf16_t*)(ws + WS_YS) + nt * 128 + c8 * 8;
#pragma unroll
        for (int it = 0; it < 8; ++it) {
            const int r = it * 32 + r0;
            if (r < nvalid) {
                const unsigned ent = rowE[r]; const float w = rowS[r];
                float f[8]; unpack8(ct_ld8(ct, r, c8 * 8), f); u32x4 o;
#pragma unroll
                for (int i = 0; i < 4; ++i) o[i] = pk2(f[2 * i] * w, f[2 * i + 1] * w);
                *(u32x4*)(ys + (size_t)ent * DM) = o;
            }
        }
    }
};

template <int V = 0>
__device__ __forceinline__ void diff_attn_unit(LAS uchar* lds, const Params& p, int l, int unit) {
    uchar* ws = p.ws;
    const int tid = tid_opaque(), lane = tid & 63, wid = __builtin_amdgcn_readfirstlane(tid >> 6);
    const int xg_ = unit & 7, v_ = unit >> 3, qb = v_ & 15, bh_ = (v_ >> 4) * 8 + xg_, h = bh_ & 3, b = bh_ >> 2;
    const float* scal = (const float*)(ws + WS_SCAL) + 16 * l;
    const float lam = scal[0], oml = scal[1], m2 = scal[2];
    const float slope2 = exp2f(-2.f * (float)(h + 1)) * LOG2E;
    const bf16_t* Q1 = (const bf16_t*)(ws + WS_QD) + (((size_t)b * 4 + h) * 2) * S * 64;
    const bf16_t* K1 = (const bf16_t*)(ws + WS_KD) + (((size_t)b * 4 + h) * 2) * S * 64;
    const bf16_t* VT = (const bf16_t*)(ws + WS_VDT) + (((size_t)b * 4 + h) * 128) * S;
    const float* gsub = p.in[6] + l * 128;
    bf16_t* mix = (bf16_t*)(ws + WS_MIX);
#if NAIVE_ATTN
    {
        const int q = qb * 128 + (tid >> 2), mm = (tid >> 1) & 1, dh = tid & 1;
        const bf16_t* Qp = Q1 + (size_t)mm * S * 64 + (size_t)q * 64; const bf16_t* Kp = K1 + (size_t)mm * S * 64;
        float qv[64];
#pragma unroll
        for (int c8 = 0; c8 < 8; ++c8) { float f[8]; unpack8(*(const u32x4*)(Qp + c8 * 8), f);
#pragma unroll
            for (int i = 0; i < 8; ++i) qv[c8 * 8 + i] = f[i]; }
        float o[64]; float lsum = 0.f;
#pragma unroll
        for (int d = 0; d < 64; ++d) o[d] = 0.f;
        for (int key = 0; key < S; ++key) {
            float sc = 0.f;
#pragma unroll
            for (int c8 = 0; c8 < 8; ++c8) { float f[8]; unpack8(*(const u32x4*)(Kp + (size_t)key * 64 + c8 * 8), f);
#pragma unroll
                for (int i = 0; i < 8; ++i) sc += qv[c8 * 8 + i] * f[i]; }
            const float pv = __builtin_amdgcn_exp2f(sc - slope2 * fabsf((float)(q - key)) - m2);
            lsum += pv;
            const int kp = sigma16(key);
#pragma unroll
            for (int d = 0; d < 64; ++d) o[d] += pv * bf2f(VT[(size_t)(dh * 64 + d) * S + kp]);
        }
        const float inv = 1.f / lsum; float ss = 0.f;
#pragma unroll
        for (int d = 0; d < 64; ++d) { const float mine = o[d] * inv; const float other = __shfl_xor(mine, 2); o[d] = mine - lam * other; ss += o[d] * o[d]; }
        ss += __shfl_xor(ss, 1);
        if (mm == 0) {
            const float rn = __builtin_amdgcn_rsqf(ss * (1.f / 128.f) + EPS) * oml;
            bf16_t* dst = mix + (size_t)(b * S + q) * DM + h * 128 + dh * 64;
#pragma unroll
            for (int d = 0; d < 64; d += 2) *(unsigned*)(dst + d) = pk2(o[d] * rn * gsub[dh * 64 + d], o[d + 1] * rn * gsub[dh * 64 + d + 1]);
        }
    }
#else
    {
        const int r = lane & 31, hh = lane >> 5, qs = wid >> 1, mm = wid & 1, qpos = qb * 128 + qs * 32 + r;
        const bf16_t* Qm_ = Q1 + (size_t)mm * S * 64;
        bf16x8 qf[4];
#pragma unroll
        for (int ks = 0; ks < 4; ++ks) qf[ks] = *(const bf16x8*)(Qm_ + (size_t)qpos * 64 + ks * 16 + hh * 8);
        f32x16 O[4]; float lsum = 0.f;
#pragma unroll
        for (int db = 0; db < 4; ++db)
#pragma unroll
            for (int i = 0; i < 16; ++i) O[db][i] = 0.f;
        const int srow = lane >> 3, c0 = (lane & 7) ^ (srow >> 1);
        const bool isk = wid < 4;
        const bf16_t* sbase = isk ? (K1 + (size_t)(wid >> 1) * S * 64 + (size_t)(wid & 1) * 32 * 64) : (VT + (size_t)(wid - 4) * 32 * S);
        const int rstride = isk ? 64 : S, kstride = isk ? 64 * 64 : 64;
        const bf16_t* sb0 = sbase + (size_t)srow * rstride + c0 * 8;
        const bf16_t* sb1 = sbase + (size_t)srow * rstride + (c0 ^ 4) * 8;
        const int lanebase = r * 128 + ((hh ^ ((r >> 1) & 7)) << 4);
#define DA_STAGE(kt, sbuf) do { _Pragma("unroll") for (int j = 0; j < 4; ++j) \
            glds16(((j & 1) ? sb1 : sb0) + (size_t)(8 * j) * rstride + (size_t)(kt) * kstride, lds + (sbuf) * ASTG + (wid * 4 + j) * 1024); } while (0)
        if (!(V & 8)) { DA_STAGE(0, 0); DA_STAGE(1, 1); }
        int sb = 0;
        const int q0w = qb * 128 + qs * 32;
        const float fq = (float)(qpos - 4 * hh);
        const float baseL = -slope2 * fq - m2, baseR = slope2 * fq - m2;
        for (int kt = 0; kt < S / 64; ++kt) {
            if (kt + 1 < S / 64) WAITV(4); else WAITV(0);
            __builtin_amdgcn_s_barrier();
            if (!(V & 8) && kt + 2 < S / 64) { const int sn = sb >= 1 ? sb - 1 : 2; DA_STAGE(kt + 2, sn); }
            const LAS uchar* st = lds + sb * ASTG;
#pragma unroll
            for (int kb = 0; kb < 2; ++kb) {
                const int key0 = kt * 64 + 32 * kb;
                f32x16 sacc;
                {
                    const float c = (key0 < q0w) ? slope2 : -slope2;
                    const float a = ((key0 < q0w) ? baseL : baseR) + c * (float)key0;
#pragma unroll
                    for (int i = 0; i < 16; ++i) sacc[i] = a + c * (float)((i & 3) + 8 * (i >> 2));
                }
                if (__builtin_expect(key0 == q0w, 0)) {
                    const int kq = key0 + 4 * hh - qpos;
#pragma unroll
                    for (int i = 0; i < 16; ++i) sacc[i] = -slope2 * fabsf((float)(kq + (i & 3) + 8 * (i >> 2))) - m2;
                }
#pragma unroll
                for (int ks = 0; ks < 4; ++ks) {
                    if (V & 4) continue;
                    const bf16x8 kf = (V & 16) ? qf[(ks + 1) & 3] : *(const LAS bf16x8*)(st + mm * 8192 + kb * 4096 + (lanebase ^ (ks << 5)));
                    sacc = MFMA32(kf, qf[ks], sacc);
                }
                float ls = 0.f;
#pragma unroll
                for (int i = 0; i < 16; ++i) { const float pv = (V & 1) ? sacc[i] : __builtin_amdgcn_exp2f(sacc[i]); ls += pv; sacc[i] = pv; }
                lsum += ls;
                bf16x8 pb[2];
#pragma unroll
                for (int s2 = 0; s2 < 2; ++s2) {
                    u32x4 w;
#pragma unroll
                    for (int i = 0; i < 4; ++i) w[i] = pk2(sacc[8 * s2 + 2 * i], sacc[8 * s2 + 2 * i + 1]);
                    pb[s2] = __builtin_bit_cast(bf16x8, w);
                }
#pragma unroll
                for (int db = 0; db < 4; ++db)
#pragma unroll
                    for (int s2 = 0; s2 < 2; ++s2) {
                        if (V & 2) { if (db == 0) O[0][s2] += __builtin_bit_cast(float, (__builtin_bit_cast(u32x4, pb[s2]))[0]); continue; }
                        const bf16x8 vf = (V & 16) ? qf[(db + s2) & 3] : *(const LAS bf16x8*)(st + 16384 + db * 4096 + (lanebase ^ ((2 * kb + s2) << 5)));
                        O[db] = MFMA32(vf, pb[s2], O[db]);
                    }
            }
            sb = sb == 2 ? 0 : sb + 1;
        }
#undef DA_STAGE
        const float lt = lsum + __shfl_xor(lsum, 32);
        const float sc = (mm == 0) ? (1.f / lt) : (lam / lt);
        __syncthreads();
        LAS float* xch = (LAS float*)lds + qs * 4096;
        if (mm == 1) {
#pragma unroll
            for (int db = 0; db < 4; ++db)
#pragma unroll
                for (int i = 0; i < 16; ++i) xch[(db * 16 + i) * 64 + lane] = O[db][i] * sc;
        }
        __syncthreads();
        if (mm == 0) {
            float ss = 0.f;
#pragma unroll
            for (int db = 0; db < 4; ++db)
#pragma unroll
                for (int i = 0; i < 16; ++i) { const float o = O[db][i] * sc - xch[(db * 16 + i) * 64 + lane]; O[db][i] = o; ss += o * o; }
            ss += __shfl_xor(ss, 32);
            const float rn = __builtin_amdgcn_rsqf(ss * (1.f / 128.f) + EPS) * oml;
            bf16_t* dst = mix + (size_t)(b * S + qpos) * DM + h * 128;
#pragma unroll
            for (int db = 0; db < 4; ++db)
#pragma unroll
                for (int q4 = 0; q4 < 4; ++q4) {
                    const int d = 32 * db + 8 * q4 + 4 * hh;
                    const f32x4 g = *(const f32x4*)(gsub + d);
                    u32x2 w; w[0] = pk2(O[db][4 * q4] * rn * g[0], O[db][4 * q4 + 1] * rn * g[1]);
                    w[1] = pk2(O[db][4 * q4 + 2] * rn * g[2], O[db][4 * q4 + 3] * rn * g[3]);
                    *(u32x2*)(dst + d) = w;
                }
        }
    }
#endif
    __syncthreads();
}

__device__ __forceinline__ void mla_attn_unit(LAS uchar* lds, const Params& p, int l, int unit) {
    uchar* ws = p.ws;
    const int tid = tid_opaque(), lane = tid & 63, wid = __builtin_amdgcn_readfirstlane(tid >> 6);
    const int xg_ = unit & 7, v_ = unit >> 3, qb = v_ & 7, bh_ = (v_ >> 3) * 8 + xg_, h = bh_ & 3, b = bh_ >> 2;
    const float m2 = ((const float*)(ws + WS_SCAL))[16 * l + 3];
    const bf16_t* Q = (const bf16_t*)(ws + WS_QM) + (((size_t)b * 4 + h) * S) * 96;
    const bf16_t* Kp = (const bf16_t*)(ws + WS_KM) + (((size_t)b * 4 + h) * S) * 96;
    const bf16_t* VT = (const bf16_t*)(ws + WS_VMT) + (((size_t)b * 4 + h) * 64) * S;
    bf16_t* mix = (bf16_t*)(ws + WS_MIX);
#if NAIVE_ATTN
    {
        const int q = qb * 256 + (tid >> 1), hf = tid & 1;
        float qv[96];
#pragma unroll
        for (int c8 = 0; c8 < 12; ++c8) { float f[8]; unpack8(*(const u32x4*)(Q + (size_t)q * 96 + c8 * 8), f);
#pragma unroll
            for (int i = 0; i < 8; ++i) qv[c8 * 8 + i] = f[i]; }
        float o[32]; float lsum = 0.f;
#pragma unroll
        for (int d = 0; d < 32; ++d) o[d] = 0.f;
        for (int key = 0; key < S; ++key) {
            float sc = 0.f;
#pragma unroll
            for (int c8 = 0; c8 < 12; ++c8) { float f[8]; unpack8(*(const u32x4*)(Kp + (size_t)key * 96 + c8 * 8), f);
#pragma unroll
                for (int i = 0; i < 8; ++i) sc += qv[c8 * 8 + i] * f[i]; }
            const float pv = __builtin_amdgcn_exp2f(sc - m2);
            lsum += pv;
            const int kp = sigma16(key);
#pragma unroll
            for (int d = 0; d < 32; ++d) o[d] += pv * bf2f(VT[(size_t)(hf * 32 + d) * S + kp]);
        }
        const float inv = 1.f / lsum;
        bf16_t* dst = mix + (size_t)(b * S + q) * DM + 512 + h * 64 + hf * 32;
#pragma unroll
        for (int d = 0; d < 32; d += 2) *(unsigned*)(dst + d) = pk2(o[d] * inv, o[d + 1] * inv);
    }
#else
    {
        const int r = lane & 31, hh = lane >> 5, qpos = qb * 256 + wid * 32 + r;
        bf16x8 qf[6];
#pragma unroll
        for (int ks = 0; ks < 6; ++ks) qf[ks] = *(const bf16x8*)(Q + (size_t)qpos * 96 + ks * 16 + hh * 8);
        f32x16 O[2]; float lsum = 0.f;
#pragma unroll
        for (int db = 0; db < 2; ++db)
#pragma unroll
            for (int i = 0; i < 16; ++i) O[db][i] = 0.f;
        const int lanebase = r * 128 + ((hh ^ ((r >> 1) & 7)) << 4), lanebase64 = r * 64 + ((hh ^ ((r >> 2) & 3)) << 4);
        const bool lo4 = wid < 4;
        const bf16_t* s0p; const bf16_t* s1p; const bf16_t* s2p;
        {
            const int srow = lane >> 3;
            { const int row = 8 * wid + srow; const int c = (lane & 7) ^ ((row >> 1) & 7); s0p = Kp + (size_t)row * 96 + c * 8; }
            if (lo4) { const int row = 16 * wid + (lane >> 2); const int c = (lane & 3) ^ ((row >> 2) & 3); s1p = Kp + (size_t)row * 96 + 64 + c * 8; }
            else { const int row = 8 * (wid - 4) + srow; const int c = (lane & 7) ^ ((row >> 1) & 7); s1p = VT + (size_t)row * S + c * 8; }
            { const int row = 8 * ((wid & 3) + 4) + srow; const int c = (lane & 7) ^ ((row >> 1) & 7); s2p = VT + (size_t)row * S + c * 8; }
        }
        const int k1stride = lo4 ? 64 * 96 : 64;
#define MA_STAGE(kt, sbuf) do { \
            glds16(s0p + (size_t)(kt) * (64 * 96), lds + (sbuf) * MSTG + wid * 1024); \
            glds16(s1p + (size_t)(kt) * k1stride, lds + (sbuf) * MSTG + (wid + 8) * 1024); \
            if (lo4) glds16(s2p + (size_t)(kt) * 64, lds + (sbuf) * MSTG + (wid + 16) * 1024); } while (0)
        MA_STAGE(0, 0); MA_STAGE(1, 1);
        int sb = 0;
        for (int kt = 0; kt < S / 64; ++kt) {
            if (kt + 1 < S / 64) { if (lo4) WAITV(3); else WAITV(2); } else WAITV(0);
            __builtin_amdgcn_s_barrier();
            if (kt + 2 < S / 64) { const int sn = sb >= 1 ? sb - 1 : 2; MA_STAGE(kt + 2, sn); }
            const LAS uchar* st = lds + sb * MSTG;
#pragma unroll
            for (int kb = 0; kb < 2; ++kb) {
                f32x16 sacc;
#pragma unroll
                for (int i = 0; i < 16; ++i) sacc[i] = -m2;
#pragma unroll
                for (int ks = 0; ks < 4; ++ks) {
                    const bf16x8 kf = *(const LAS bf16x8*)(st + kb * 4096 + (lanebase ^ (ks << 5)));
                    sacc = MFMA32(kf, qf[ks], sacc);
                }
#pragma unroll
                for (int ks = 0; ks < 2; ++ks) {
                    const bf16x8 kf = *(const LAS bf16x8*)(st + 8192 + kb * 2048 + (lanebase64 ^ (ks << 5)));
                    sacc = MFMA32(kf, qf[4 + ks], sacc);
                }
                float ls = 0.f;
#pragma unroll
                for (int i = 0; i < 16; ++i) { const float pv = __builtin_amdgcn_exp2f(sacc[i]); ls += pv; sacc[i] = pv; }
                lsum += ls;
                bf16x8 pb[2];
#pragma unroll
                for (int s2 = 0; s2 < 2; ++s2) {
                    u32x4 w;
#pragma unroll
                    for (int i = 0; i < 4; ++i) w[i] = pk2(sacc[8 * s2 + 2 * i], sacc[8 * s2 + 2 * i + 1]);
                    pb[s2] = __builtin_bit_cast(bf16x8, w);
                }
#pragma unroll
                for (int db = 0; db < 2; ++db)
#pragma unroll
                    for (int s2 = 0; s2 < 2; ++s2) {
                        const bf16x8 vf = *(const LAS bf16x8*)(st + 12288 + db * 4096 + (lanebase ^ ((2 * kb + s2) << 5)));
                        O[db] = MFMA32(vf, pb[s2], O[db]);
                    }
            }
            sb = sb == 2 ? 0 : sb + 1;
        }
#undef MA_STAGE
        const float lt = lsum + __shfl_xor(lsum, 32); const float inv = 1.f / lt;
        bf16_t* dst = mix + (size_t)(b * S + qpos) * DM + 512 + h * 64;
#pragma unroll
        for (int db = 0; db < 2; ++db)
#pragma unroll
            for (int q4 = 0; q4 < 4; ++q4) {
                const int d = 32 * db + 8 * q4 + 4 * hh;
                u32x2 w; w[0] = pk2(O[db][4 * q4] * inv, O[db][4 * q4 + 1] * inv); w[1] = pk2(O[db][4 * q4 + 2] * inv, O[db][4 * q4 + 3] * inv);
                *(u32x2*)(dst + d) = w;
            }
    }
#endif
    __syncthreads();
}

__device__ __forceinline__ int xp_rowmap(int mode, int n) {
    return mode == 0 ? n : mode == 1 ? (n / 96) * 128 + (n % 96) : mode == 2 ? ((n >> 6) * 128 + (n & 63)) : ((n >> 6) * 128 + 64 + (n & 63));
}
__device__ __forceinline__ void xpose_tile(LAS uchar* lds, const float* src, int K, int N, bf16_t* dst, int ldd, int mode, const float* gain, int kt, int ntile, int lds_src = 0) {
    LAS float* sh = (LAS float*)lds; const int tid = tid_opaque();
    (void)K; const int ldn = lds_src ? lds_src : N;
    {
        const int n4 = tid & 63, n = ntile * 256 + n4 * 4;
        if (n < N) {
#pragma unroll
            for (int i = 0; i < 8; ++i) {
                const int kl = (tid >> 6) + 8 * i, k = kt * 64 + kl;
                f32x4 v = *(const f32x4*)(src + (size_t)k * ldn + n);
                if (gain) { const float gk = gain[k]; v[0] *= gk; v[1] *= gk; v[2] *= gk; v[3] *= gk; }
                LAS float* d = sh + kl * 257 + n4 * 4; d[0] = v[0]; d[1] = v[1]; d[2] = v[2]; d[3] = v[3];
            }
        }
    }
    __syncthreads();
    {
        const int nl = tid >> 1, kh = tid & 1, n = ntile * 256 + nl;
        if (n < N) {
            bf16_t* d = dst + (size_t)xp_rowmap(mode, n) * ldd + kt * 64 + kh * 32;
#pragma unroll
            for (int c8 = 0; c8 < 4; ++c8) { u32x4 o;
#pragma unroll
                for (int i = 0; i < 4; ++i) o[i] = pk2(sh[(kh * 32 + c8 * 8 + 2 * i) * 257 + nl], sh[(kh * 32 + c8 * 8 + 2 * i + 1) * 257 + nl]);
                *(u32x4*)(d + c8 * 8) = o; }
        }
    }
    __syncthreads();
}
__device__ __forceinline__ void xpose_job(LAS uchar* lds, const float* src, int K, int N, bf16_t* dst, int ldd, int mode, const float* gain, int lds_src = 0) {
    const int nkt = K >> 6, nnt = (N + 255) >> 8, tot = nkt * nnt;
    for (int u = blockIdx.x; u < tot; u += gridDim.x) xpose_tile(lds, src, K, N, dst, ldd, mode, gain, u % nkt, u / nkt, lds_src);
}
__device__ __forceinline__ void expert_weights(LAS uchar* lds, const Params& p, int l) {
    bf16_t* wgu = (bf16_t*)(p.ws + WS_WGU); bf16_t* wd = (bf16_t*)(p.ws + WS_WD);
    const float* g2 = p.in[18] + l * DM;
    const int nb = (int)gridDim.x > 64 ? (int)gridDim.x - 64 : (int)gridDim.x, b0 = (int)gridDim.x > 64 ? (int)blockIdx.x - 64 : (int)blockIdx.x;
    if (b0 < 0) return;
    for (int u = b0; u < 32 * 48; u += nb) {
        const int e = u / 48, w = u % 48, job = w >> 4, tl = w & 15;
        if (job == 0) xpose_tile(lds, p.in[23] + ((size_t)l * 32 + e) * DM * 256, DM, 256, wgu + (size_t)e * 512 * DM, DM, 2, g2, tl, 0);
        else if (job == 1) xpose_tile(lds, p.in[24] + ((size_t)l * 32 + e) * DM * 256, DM, 256, wgu + (size_t)e * 512 * DM, DM, 3, g2, tl, 0);
        else xpose_tile(lds, p.in[25] + ((size_t)l * 32 + e) * 256 * DM, 256, DM, wd + (size_t)e * DM * 256, 256, 0, nullptr, tl & 3, tl >> 2);
    }
}
__device__ __forceinline__ void row_prep(const float* xrow, bf16_t* xb, float* rstd, int lane) {
    float ss = 0.f; f32x4 v[4];
#pragma unroll
    for (int i = 0; i < 4; ++i) { v[i] = *(const f32x4*)(xrow + i * 256 + lane * 4); ss += v[i][0] * v[i][0] + v[i][1] * v[i][1] + v[i][2] * v[i][2] + v[i][3] * v[i][3]; }
    ss = wave_sum(ss);
#pragma unroll
    for (int i = 0; i < 4; ++i) { u32x2 o; o[0] = pk2(v[i][0], v[i][1]); o[1] = pk2(v[i][2], v[i][3]); *(u32x2*)(xb + i * 256 + lane * 4) = o; }
    if (lane == 0) *rstd = __builtin_amdgcn_rsqf(ss * (1.f / 1024.f) + EPS);
}

__device__ __forceinline__ void phase0(LAS uchar* lds, const Params& p) {
    uchar* ws = p.ws; const int tid = tid_opaque(), gtid = blockIdx.x * NT + tid, gsz = gridDim.x * NT;
    for (int idx = blockIdx.x; idx < NL * 202; idx += gridDim.x) {
        const int l = idx / 202, j = idx % 202;
        if (j < 128) xpose_tile(lds, p.in[2] + (size_t)l * DM * NIN, DM, 1888, (bf16_t*)(ws + WS_WIN) + (size_t)l * NINP * DM, DM, 0, p.in[1] + l * DM, j & 15, j >> 4, NIN);
        else if (j < 192) xpose_tile(lds, p.in[17] + (size_t)l * DM * DM, DM, DM, (bf16_t*)(ws + WS_WOUT) + (size_t)l * DM * DM, DM, 0, nullptr, (j - 128) & 15, (j - 128) >> 4);
        else if (j < 198) xpose_tile(lds, p.in[9] + (size_t)l * 192 * 384, 192, 384, (bf16_t*)(ws + WS_WUQ) + (size_t)l * 512 * 192, 192, 1, p.in[7] + l * 192, (j - 192) % 3, (j - 192) / 3);
        else xpose_tile(lds, p.in[10] + (size_t)l * 128 * 512, 128, 512, (bf16_t*)(ws + WS_WUKV) + (size_t)l * 512 * 128, 128, 0, p.in[8] + l * 128, (j - 198) & 1, (j - 198) >> 1);
    }
    for (int l = 0; l < NL; ++l) {
        for (int i = gtid; i < 256 * DM; i += gsz) {
            const int k = i & 1023, n = i >> 10, g = n >> 6, d = n & 63;
            const float* wi = p.in[2] + ((size_t)l * DM + k) * NIN + 1888 + g * 64; const float* pw = p.in[15] + ((size_t)l * 4 + g) * 64 * 64 + d;
            float acc = 0.f;
            for (int c = 0; c < 64; ++c) acc += wi[c] * pw[c * 64];
            ((bf16_t*)(ws + WS_WIN))[((size_t)l * NINP + 1888 + n) * DM + k] = f2bf(acc * p.in[1][l * DM + k] * p.in[16][l * 256 + n]);
        }
        { bf16_t* w = (bf16_t*)(ws + WS_WIN) + ((size_t)l * NINP + NIN) * DM; for (int i = gtid; i < 32 * DM; i += gsz) w[i] = 0; }
        { bf16_t* w = (bf16_t*)(ws + WS_WUQ) + (size_t)l * 512 * 192; for (int i = gtid; i < 4 * 32 * 192; i += gsz) { const int hd = i / (32 * 192), rem = i % (32 * 192); w[(size_t)(hd * 128 + 96) * 192 + rem] = 0; } }
    }
    for (int i = gtid; i < NL * 128 * 1024; i += gsz) {
        const int k = i & 1023, n = (i >> 10) & 127, l = i >> 17;
        float v = 0.f;
        if (n < 4) v = p.in[19][((size_t)l * DM + k) * 4 + n]; else if (n < 36) v = p.in[21][((size_t)l * DM + k) * 32 + (n - 4)];
        v *= p.in[18][l * DM + k];
        const bf16_t hi = f2bf(v), lo = f2bf(v - bf2f(hi));
        bf16_t* w = (bf16_t*)(ws + WS_WR) + ((size_t)l * 128 + n) * 3072 + k;
        w[0] = hi; w[1024] = hi; w[2048] = lo;
    }
    for (int i = gtid; i < S * 16; i += gsz) {
        const int pos = i >> 4, f = i & 15;
        double inv = 1.0; for (int k = 0; k < f; ++k) inv *= 0.5623413251903491;
        const double rev = (double)pos * inv * 0.15915494309189535;
        const float fr = (float)(rev - __builtin_rint(rev));
        ((float*)(ws + WS_ROPE))[i] = __builtin_amdgcn_cosf(fr);
        ((float*)(ws + WS_ROPE))[S * 16 + i] = __builtin_amdgcn_sinf(fr);
    }
    if (gtid < NL) {
        const int l = gtid; float* sc = (float*)(ws + WS_SCAL) + 16 * l;
        const float* lv = p.in[5] + l * 256;
        float d1 = 0.f, d2 = 0.f; for (int i = 0; i < 64; ++i) { d1 += lv[i] * lv[64 + i]; d2 += lv[128 + i] * lv[192 + i]; }
        const float lam_init = 0.8f - 0.6f * expf(-0.3f * (float)l);
        sc[0] = expf(d1) - expf(d2) + lam_init; sc[1] = 1.f - lam_init;
        float gq = 0.f, gk = 0.f; for (int i = 0; i < 64; ++i) { gq = fmaxf(gq, fabsf(p.in[3][l * 64 + i])); gk = fmaxf(gk, fabsf(p.in[4][l * 64 + i])); }
        sc[2] = gq * gk * 8.f * LOG2E * 1.02f;
        float a = 0.f, bq = 0.f, c = 0.f, dk = 0.f;
        for (int i = 0; i < 64; ++i) { a = fmaxf(a, fabsf(p.in[11][l * 64 + i])); c = fmaxf(c, fabsf(p.in[13][l * 64 + i])); }
        for (int i = 0; i < 32; ++i) { bq = fmaxf(bq, fabsf(p.in[12][l * 32 + i])); dk = fmaxf(dk, fabsf(p.in[14][l * 32 + i])); }
        sc[3] = sqrtf(64.f * a * a + 32.f * bq * bq) * sqrtf(64.f * c * c + 32.f * dk * dk) * QSCALE_M * 1.02f;
    }
    {
        const int lane = tid & 63, gw = gtid >> 6, nw = gsz >> 6;
        for (int t = gw; t < T; t += nw) row_prep(p.in[0] + (size_t)t * DM, (bf16_t*)(ws + WS_XB) + (size_t)t * DM, (float*)(ws + WS_RSTD1) + t, lane);
    }
}

struct MkProj { int mt, pn, l; const Params* p; __device__ __forceinline__ EpiProj operator()(int half) const { return EpiProj{mt, 2 * pn + half, l, p}; } };
__device__ __forceinline__ void ph_gemm1(LAS uchar* lds, const Params& p, int l) {
    const bf16_t* xb = (const bf16_t*)(p.ws + WS_XB); const bf16_t* win = (const bf16_t*)(p.ws + WS_WIN) + (size_t)l * NINP * DM;
    if (SHADOW_G >= 0) for (int u0 = blockIdx.x; u0 < 512; u0 += gridDim.x) {
        const int xg = u0 & 7, v = u0 >> 3, mt = (v >> 3) * 8 + xg, pn = v & 7;
        MkProj mk{mt, pn, l, &p};
        { const int tp = tid_opaque(); if (tp < 256) ((LAS float*)(lds + LDS_ROW))[tp] = ((const float*)(p.ws + WS_RSTD1))[mt * 256 + tp]; }
        gemm_big<(SHADOW_G >= 0 ? SHADOW_G : 0)>(lds, ARowLinear{xb + (size_t)mt * 256 * DM, (size_t)DM}, win + (size_t)pn * 256 * DM, (size_t)DM, DM, mk);
    }
    for (int u0 = blockIdx.x; u0 < 64 * 8; u0 += gridDim.x) {
        const int xg = u0 & 7, v = u0 >> 3, mt = (v >> 3) * 8 + xg, pn = v & 7;
        MkProj mk{mt, pn, l, &p};
        { const int tp = tid_opaque(); if (tp < 256) ((LAS float*)(lds + LDS_ROW))[tp] = ((const float*)(p.ws + WS_RSTD1))[mt * 256 + tp]; }
        gemm_big(lds, ARowLinear{xb + (size_t)mt * 256 * DM, (size_t)DM}, win + (size_t)pn * 256 * DM, (size_t)DM, DM, mk);
    }
}
__device__ __forceinline__ void gemm1_tail_unit(LAS uchar* lds, const Params& p, int l, int mt) {
    const bf16_t* xb = (const bf16_t*)(p.ws + WS_XB); const bf16_t* win = (const bf16_t*)(p.ws + WS_WIN) + (size_t)l * NINP * DM;
    ARowLinear ar{xb + (size_t)mt * 256 * DM, (size_t)DM};
    EpiProj ep{mt, 16, l, &p};
    { const int tp = tid_opaque(); if (tp < 256) ((LAS float*)(lds + LDS_ROW))[tp] = ((const float*)(p.ws + WS_RSTD1))[mt * 256 + tp]; }
    gemm_tile(lds, ar, win + (size_t)16 * 128 * DM, (size_t)DM, DM, ep);
}
template <int HALF>
__device__ __forceinline__ void pool_rows(const float (&v)[48], int sfirst, bf16_t* dst) {
    float run = 0.f;
#pragma unroll
    for (int i = 8 - HALF; i < 8 + HALF; ++i) run += v[i];
#pragma unroll
    for (int r = 0; r < 32; ++r) {
        const int s = sfirst + r; int lo = s - HALF, hi = s + HALF - 1; lo = lo < 0 ? 0 : lo; hi = hi > S - 1 ? S - 1 : hi;
        const float o = run * __builtin_amdgcn_rcpf((float)(hi - lo + 1)) - v[r + 8];
        dst[(size_t)r * DM] = f2bf(o);
        if (r < 31) run += v[r + 8 + HALF] - v[r + 8 - HALF];
    }
}
__device__ __forceinline__ void pooled_unit(LAS uchar* lds, const Params& p, int ut) {
    const int tid = tid_opaque();
    const int t0 = ut * 64, b = t0 >> 11, s0 = t0 & 2047;
    const bf16_t* lat = (const bf16_t*)(p.ws + WS_LAT) + (size_t)b * S * 640 + 352;
    for (int it = 0; it < 5; ++it) {
        const int item = it * NT + tid, c8 = item & 31, rl = item >> 5, sr = s0 - 8 + rl;
        u32x4 v = {0u, 0u, 0u, 0u};
        if (sr >= 0 && sr < S) v = *(const u32x4*)(lat + (size_t)sr * 640 + c8 * 8);
        *(LAS u32x4*)(lds + rl * 512 + c8 * 16) = v;
    }
    __syncthreads();
    {
        const int c = tid & 255, rh = tid >> 8, g = __builtin_amdgcn_readfirstlane(c >> 6);
        bf16_t* dst = (bf16_t*)(p.ws + WS_MIX) + (size_t)(t0 + rh * 32) * DM + 768 + c;
        const LAS bf16_t* col = (const LAS bf16_t*)lds + (rh * 32) * 256 + c;
        float v[48];
#pragma unroll
        for (int i = 0; i < 48; ++i) v[i] = bf2f(col[i * 256]);
        const int sfirst = s0 + rh * 32;
        if (g == 0) pool_rows<1>(v, sfirst, dst); else if (g == 1) pool_rows<2>(v, sfirst, dst); else if (g == 2) pool_rows<4>(v, sfirst, dst); else pool_rows<8>(v, sfirst, dst);
    }
    __syncthreads();
}
__device__ __forceinline__ void mla_up_unit(LAS uchar* lds, const Params& p, int l, int v) {
    const bf16_t* lat = (const bf16_t*)(p.ws + WS_LAT);
    const int mt = v >> 3, w = v & 7, h = w & 3;
    { const int tp = tid_opaque(); if (tp < 256) { const float* hs = (const float*)(p.ws + WS_HSS) + (size_t)(mt * 256 + tp) * 8;
        const f32x4 h0 = *(const f32x4*)hs; const float h4 = hs[4];
        ((LAS float*)(lds + LDS_ROW))[tp] = (w < 4) ? __builtin_amdgcn_rsqf((h0[0] + h0[1] + h0[2]) * (1.f / 192.f) + EPS) : __builtin_amdgcn_rsqf((h0[3] + h4) * (1.f / 128.f) + EPS); } }
    if (w < 4) { ARowLinear ar{lat + (size_t)mt * 256 * 640, (size_t)640}; EpiMlaQ ep{mt, h, l, &p};
        gemm_tile(lds, ar, (const bf16_t*)(p.ws + WS_WUQ) + ((size_t)l * 512 + h * 128) * 192, (size_t)192, 192, ep); }
    else { ARowLinear ar{lat + (size_t)mt * 256 * 640 + 192, (size_t)640}; EpiMlaKV ep{mt, h, l, &p};
        gemm_tile(lds, ar, (const bf16_t*)(p.ws + WS_WUKV) + ((size_t)l * 512 + h * 128) * 128, (size_t)128, 128, ep); }
}
__device__ __forceinline__ void ph_mix_a(LAS uchar* lds, const Params& p, int l) {
    if (SHADOW_V >= 0) for (int u = blockIdx.x; u < 512; u += gridDim.x) diff_attn_unit<(SHADOW_V >= 0 ? SHADOW_V : 0)>(lds, p, l, u);
    for (int u = blockIdx.x; u < 512; u += gridDim.x) diff_attn_unit<0>(lds, p, l, u);
    const int G = (int)gridDim.x, nt_ = G >= 128 ? G / 4 : 0;
    if (nt_ == 0) { for (int v = blockIdx.x; v < 512 + 64; v += G) { if (v < 512) mla_up_unit(lds, p, l, v); else gemm1_tail_unit(lds, p, l, v - 512); } }
    else if ((int)blockIdx.x >= G - nt_) { for (int v = (int)blockIdx.x - (G - nt_); v < 64; v += nt_) gemm1_tail_unit(lds, p, l, v); }
    else { for (int v = blockIdx.x; v < 512; v += G - nt_) mla_up_unit(lds, p, l, v); }
}
__device__ __forceinline__ void ph_mix_b(LAS uchar* lds, const Params& p, int l) {
    (void)l;
    for (int u = blockIdx.x; u < 256 + 256; u += gridDim.x) {
        if (u < 256) mla_attn_unit(lds, p, l, u);
        else pooled_unit(lds, p, u - 256);
    }
}
struct MkWout { int mt, pn; const float* xres; const Params* p; __device__ __forceinline__ EpiWout operator()(int half) const { return EpiWout{mt, 2 * pn + half, xres, p}; } };
__device__ __forceinline__ void ph_wout(LAS uchar* lds, const Params& p, int l) {
    const bf16_t* mix = (const bf16_t*)(p.ws + WS_MIX); const bf16_t* wo = (const bf16_t*)(p.ws + WS_WOUT) + (size_t)l * DM * DM;
    const float* xres = (l == 0) ? p.in[0] : p.out;
    for (int u0 = blockIdx.x; u0 < 64 * 4; u0 += gridDim.x) {
        const int xg = u0 & 7, v = u0 >> 3, mt = (v >> 2) * 8 + xg, pn = v & 3;
        MkWout mk{mt, pn, xres, &p};
        gemm_big(lds, ARowLinear{mix + (size_t)mt * 256 * DM, (size_t)DM}, wo + (size_t)pn * 256 * DM, (size_t)DM, DM, mk);
    }
}
constexpr int LDS_RT = 135168;
struct EpiRouter {
    int mt, l; bool dry; const Params* p;
    __device__ __forceinline__ void operator()(const LAS uchar* ct) const {
        uchar* ws = p->ws; const int tid = tid_opaque();
        const LAS float* ctf = (const LAS float*)ct;
        LAS unsigned* shcnt = (LAS unsigned*)(ct + LDS_RT); LAS unsigned* shbase = shcnt + 32; LAS unsigned* pend = shcnt + 64;
        unsigned* cnt = (unsigned*)(ws + WS_CTL) + CW_CNT + 1024 * l + (dry ? 2048 : 0);
        unsigned* list = (unsigned*)(ws + (dry ? WS_POOLED : WS_LIST)); float* gwt = (float*)(ws + (dry ? WS_POOLED + 4 * MiB : WS_GW)); float* rstd2 = (float*)(ws + (dry ? WS_POOLED + 5 * MiB : WS_RSTD2));
        const float* bg = p->in[20] + l * 4; const float* be = p->in[22] + l * 32;
        if (tid < 32) shcnt[tid] = 0u;
        __syncthreads();
        if (tid < 256) {
            const int t = mt * 256 + tid;
            const float* ps = (const float*)(ws + WS_PSS) + (size_t)t * 8;
            const f32x4 p0 = *(const f32x4*)ps, p1 = *(const f32x4*)(ps + 4);
            const float ss = ((p0[0] + p0[1]) + (p0[2] + p0[3])) + ((p1[0] + p1[1]) + (p1[2] + p1[3]));
            const float rs = __builtin_amdgcn_rsqf(ss * (1.f / 1024.f) + EPS);
            const LAS float* row = ctf + tid * CTF_PITCH;
            float gl[4];
#pragma unroll
            for (int n = 0; n < 4; ++n) gl[n] = row[n] * rs + bg[n];
            int gi = 0; float gm = gl[0];
#pragma unroll
            for (int n = 1; n < 4; ++n) if (gl[n] > gm) { gm = gl[n]; gi = n; }
            float gs = 0.f;
#pragma unroll
            for (int n = 0; n < 4; ++n) gs += __expf(gl[n] - gm);
            const float gtop = 1.f / gs;
            float el[8];
#pragma unroll
            for (int n = 0; n < 8; ++n) el[n] = row[4 + gi * 8 + n] * rs + be[gi * 8 + n];
            int i1 = 0; float m1 = el[0];
#pragma unroll
            for (int n = 1; n < 8; ++n) if (el[n] > m1) { m1 = el[n]; i1 = n; }
            int i2 = -1; float m2v = -3.0e38f;
#pragma unroll
            for (int n = 0; n < 8; ++n) if (n != i1 && el[n] > m2v) { m2v = el[n]; i2 = n; }
            const float e2 = __expf(m2v - m1); const float w1 = gtop / (1.f + e2), w2 = gtop * e2 / (1.f + e2);
            const int ea = gi * 8 + i1, eb = gi * 8 + i2;
            const unsigned pa = __hip_atomic_fetch_add(&shcnt[ea], 1u, __ATOMIC_RELAXED, __HIP_MEMORY_SCOPE_WORKGROUP);
            const unsigned pbk = __hip_atomic_fetch_add(&shcnt[eb], 1u, __ATOMIC_RELAXED, __HIP_MEMORY_SCOPE_WORKGROUP);
            pend[tid * 2] = ((unsigned)ea << 16) | pa; pend[tid * 2 + 1] = ((unsigned)eb << 16) | pbk;
            gwt[t * 2] = w1; gwt[t * 2 + 1] = w2; rstd2[t] = rs;
        }
        __syncthreads();
        if (tid < 32) { const unsigned c = shcnt[tid]; shbase[tid] = c ? atomicAdd(&cnt[tid * 32], c) : 0u; }
        __syncthreads();
        { const unsigned pe = pend[tid], e = pe >> 16, lp = pe & 0xffffu; list[(size_t)e * T + shbase[e] + lp] = (unsigned)((mt * 256 + (tid >> 1)) * 2 + (tid & 1)); }
    }
};
__device__ __forceinline__ void ph_router(LAS uchar* lds, const Params& p, int l, bool dry = false) {
    const bf16_t* xb = (const bf16_t*)(p.ws + WS_XB); const bf16_t* wr = (const bf16_t*)(p.ws + WS_WR) + (size_t)l * 128 * 3072;
    for (int u = blockIdx.x; u < 64; u += gridDim.x) {
        ARowLinear ar{xb + (size_t)u * 256 * DM, (size_t)DM}; EpiRouter ep{u, l, dry, &p};
        AOffRouter ao{(int)((WS_XL - WS_XB) / 2)};
        gemm_tile<true>(lds, ar, wr, (size_t)3072, 3072, ep, ao);
    }
    if (!dry) expert_weights(lds, p, l);
}
__device__ __forceinline__ void moe_find(const unsigned* cnt, int rbg, int& e, int& rb, int& nvalid, int& pre) {
    int acc = 0; e = -1; rb = 0; nvalid = 0; pre = 0;
    for (int i = 0; i < 32; ++i) { const int c = (int)cnt[i * 32], nb = (c + 255) >> 8;
        if (e < 0 && rbg < acc + nb) { e = i; rb = rbg - acc; nvalid = c - rb * 256; if (nvalid > 256) nvalid = 256; pre = acc; }
        acc += nb; }
}
__device__ __forceinline__ int moe_total(const unsigned* cnt) { int acc = 0; for (int i = 0; i < 32; ++i) acc += ((int)cnt[i * 32] + 255) >> 8; return acc; }
struct MkGU { int pn; size_t slot0; const Params* p; __device__ __forceinline__ EpiGU operator()(int half) const { return EpiGU{2 * pn + half, slot0, p}; } };
__device__ __forceinline__ void ph_gateup(LAS uchar* lds, const Params& p, int l) {
    uchar* ws = p.ws; const unsigned* cnt = (const unsigned*)(ws + WS_CTL) + CW_CNT + 1024 * l;
    int nfull = 0, npart = 0;
    for (int i = 0; i < 32; ++i) { const int c = (int)cnt[i * 32]; nfull += c >> 8; npart += (c & 255) ? 1 : 0; }
    const int tot = nfull * 2 + npart * 4;
    for (int u = blockIdx.x; u < tot; u += gridDim.x) {
        const bool big = u < nfull * 2;
        const int want = big ? (u >> 1) : ((u - nfull * 2) >> 2);
        int e = 0, rb = 0, rbg = 0, nvalid = 256;
        { int accf = 0, accp = 0, accb = 0; bool found = false;
          for (int i = 0; i < 32; ++i) { const int c = (int)cnt[i * 32], f = c >> 8, pr = (c & 255) ? 1 : 0;
              if (!found) { if (big) { if (want < accf + f) { e = i; rb = want - accf; rbg = accb + rb; nvalid = 256; found = true; } }
                            else { if (pr && want == accp) { e = i; rb = f; rbg = accb + f; nvalid = c & 255; found = true; } } }
              accf += f; accp += pr; accb += f + pr; } }
        const unsigned* list = (const unsigned*)(ws + WS_LIST) + (size_t)e * T + rb * 256;
        ARowGather ar{(const bf16_t*)(ws + WS_XB), list, nvalid};
        { const int tp = tid_opaque(); if (tp < 256) { const int rr = tp < nvalid ? tp : nvalid - 1; ((LAS float*)(lds + LDS_ROW))[tp] = ((const float*)(ws + WS_RSTD2))[list[rr] >> 1]; } }
        if (big) { const int pn = u & 1; MkGU mk{pn, (size_t)rbg * 256, &p};
            gemm_big(lds, ar, (const bf16_t*)(ws + WS_WGU) + ((size_t)e * 512 + pn * 256) * DM, (size_t)DM, DM, mk); }
        else { const int jt = (u - nfull * 2) & 3; EpiGU ep{jt, (size_t)rbg * 256, &p};
            gemm_tile(lds, ar, (const bf16_t*)(ws + WS_WGU) + ((size_t)e * 512 + jt * 128) * DM, (size_t)DM, DM, ep); }
    }
}
struct MkDown { int pn, nvalid; const Params* p; __device__ __forceinline__ EpiDown operator()(int half) const { return EpiDown{2 * pn + half, nvalid, p}; } };
__device__ __forceinline__ void ph_down(LAS uchar* lds, const Params& p, int l) {
    uchar* ws = p.ws; const unsigned* cnt = (const unsigned*)(ws + WS_CTL) + CW_CNT + 1024 * l;
    int nfull = 0, npart = 0;
    for (int i = 0; i < 32; ++i) { const int c = (int)cnt[i * 32]; nfull += c >> 8; npart += (c & 255) ? 1 : 0; }
    const int tot = nfull * 4 + npart * 8;
    for (int u = blockIdx.x; u < tot; u += gridDim.x) {
        const bool big = u < nfull * 4;
        const int want = big ? (u >> 2) : ((u - nfull * 4) >> 3);
        int e = 0, rb = 0, rbg = 0, nvalid = 256;
        { int accf = 0, accp = 0, accb = 0; bool found = false;
          for (int i = 0; i < 32; ++i) { const int c = (int)cnt[i * 32], f = c >> 8, pr = (c & 255) ? 1 : 0;
              if (!found) { if (big) { if (want < accf + f) { e = i; rb = want - accf; rbg = accb + rb; nvalid = 256; found = true; } }
                            else { if (pr && want == accp) { e = i; rb = f; rbg = accb + f; nvalid = c & 255; found = true; } } }
              accf += f; accp += pr; accb += f + pr; } }
        const unsigned* list = (const unsigned*)(ws + WS_LIST) + (size_t)e * T + rb * 256;
        ARowLinear ar{(const bf16_t*)(ws + WS_HMID) + (size_t)rbg * 256 * 256, (size_t)256};
        { const int tp = tid_opaque(); if (tp < 256) { const int rr = tp < nvalid ? tp : nvalid - 1; const unsigned ent = list[rr];
            ((LAS unsigned*)(lds + LDS_ROW + 1024))[tp] = ent; ((LAS float*)(lds + LDS_ROW))[tp] = ((const float*)(ws + WS_GW))[ent]; } }
        if (big) { const int pn = u & 3; MkDown mk{pn, nvalid, &p};
            gemm_big(lds, ar, (const bf16_t*)(ws + WS_WD) + ((size_t)e * DM + pn * 256) * 256, (size_t)256, 256, mk); }
        else { const int nt = (u - nfull * 4) & 7; EpiDown ep{nt, nvalid, &p};
            gemm_tile(lds, ar, (const bf16_t*)(ws + WS_WD) + ((size_t)e * DM + nt * 128) * 256, (size_t)256, 256, ep); }
    }
}
__device__ __forceinline__ void ph_combine(LAS uchar* lds, const Params& p, int l, bool dry = false) {
    uchar* ws = p.ws; const int tid = tid_opaque(), lane = tid & 63;
    const int gw = blockIdx.x * 8 + (tid >> 6), nw = gridDim.x * 8;
    const bf16_t* ys = (const bf16_t*)(ws + WS_YS);
    for (int t = gw; t < T; t += nw) {
        const float* xr = p.out + (size_t)t * DM; const bf16_t* y0 = ys + (size_t)(2 * t) * DM; const bf16_t* y1 = y0 + DM;
        float* xw = dry ? (float*)(ws + WS_POOLED) + (size_t)(t & 511) * DM : p.out + (size_t)t * DM;
        bf16_t* xb = dry ? (bf16_t*)(ws + WS_POOLED + 4 * MiB) + (size_t)(t & 511) * DM : (bf16_t*)(ws + WS_XB) + (size_t)t * DM;
        float ss = 0.f;
#pragma unroll
        for (int i = 0; i < 4; ++i) {
            const int c = i * 256 + lane * 4;
            f32x4 v = *(const f32x4*)(xr + c); const u32x2 a = *(const u32x2*)(y0 + c), bq = *(const u32x2*)(y1 + c);
            v[0] += bflo(a[0]) + bflo(bq[0]); v[1] += bfhi(a[0]) + bfhi(bq[0]); v[2] += bflo(a[1]) + bflo(bq[1]); v[3] += bfhi(a[1]) + bfhi(bq[1]);
            *(f32x4*)(xw + c) = v; ss += v[0] * v[0] + v[1] * v[1] + v[2] * v[2] + v[3] * v[3];
            u32x2 o; o[0] = pk2(v[0], v[1]); o[1] = pk2(v[2], v[3]); *(u32x2*)(xb + c) = o;
        }
        ss = wave_sum(ss);
        if (lane == 0) ((float*)(ws + (dry ? WS_POOLED + 6 * MiB : WS_RSTD1)))[t] = __builtin_amdgcn_rsqf(ss * (1.f / 1024.f) + EPS);
    }

}

__global__ void __launch_bounds__(NT, 2) mega(Params p) {
    extern __shared__ __attribute__((aligned(16))) unsigned char smem[];
    LAS uchar* lds = (LAS uchar*)smem;
    if (threadIdx.x == 0) { *(LAS u32x4*)(lds + LDS_XB) = (u32x4){0u, 0u, 0u, 0u}; }
    __syncthreads();
    XcdBarrier bar = xcd_barrier_post((unsigned*)(p.ws + WS_CTL), (volatile LAS unsigned*)(lds + LDS_XB));
#define IN(k) (p.ph_lo <= (k) && (k) < p.ph_hi)
#define SEAM(k) do { if (IN(k) && IN((k) + 1)) xcd_barrier(bar); } while (0)
    if (IN(0)) for (int rep = 0; rep < NREP(8); ++rep) phase0(lds, p);
    SEAM(0);
#define LAUNDER(v) asm volatile("" : "+s"(v))
#pragma unroll 1
    for (int l0 = 0; l0 < NL; ++l0) {
        const int pb = 1 + 8 * l0;
        { int l = l0; LAUNDER(l); if (IN(pb + 0)) for (int rep = 0; rep < NREP(0); ++rep) ph_gemm1(lds, p, l); }
        SEAM(pb + 0);
        { int l = l0; LAUNDER(l); if (IN(pb + 1)) for (int rep = 0; rep < NREP(1); ++rep) ph_mix_a(lds, p, l); }
        SEAM(pb + 1);
        { int l = l0; LAUNDER(l); if (IN(pb + 2)) for (int rep = 0; rep < NREP(2); ++rep) ph_mix_b(lds, p, l); }
        SEAM(pb + 2);
        { int l = l0; LAUNDER(l); if (IN(pb + 3)) for (int rep = 0; rep < (l == 0 ? NREP(3) : 1); ++rep) ph_wout(lds, p, l); }
        SEAM(pb + 3);
        { int l = l0; LAUNDER(l); if (IN(pb + 4)) { if (NREP(4) > 1) ph_router(lds, p, l, true); ph_router(lds, p, l); } }
        SEAM(pb + 4);
        { int l = l0; LAUNDER(l); if (IN(pb + 5)) for (int rep = 0; rep < NREP(5); ++rep) ph_gateup(lds, p, l); }
        SEAM(pb + 5);
        { int l = l0; LAUNDER(l); if (IN(pb + 6)) for (int rep = 0; rep < NREP(6); ++rep) ph_down(lds, p, l); }
        SEAM(pb + 6);
        { int l = l0; LAUNDER(l); if (IN(pb + 7)) { if (NREP(7) > 1) ph_combine(lds, p, l, true); ph_combine(lds, p, l); } }
        SEAM(pb + 7);
    }
}

extern "C" void kernel_launch(void* const* d_in, const int* in_sizes, int n_in, void* d_out, int out_size, void* d_ws, size_t ws_size, hipStream_t stream) {
    (void)in_sizes; (void)n_in; (void)out_size;
    static int grid = 0;
    if (!grid) {
        int dev = 0, cus = 0, per_cu = 0;
        hipGetDevice(&dev);
        hipDeviceGetAttribute(&cus, hipDeviceAttributeMultiprocessorCount, dev);
        hipFuncSetAttribute((const void*)mega, hipFuncAttributeMaxDynamicSharedMemorySize, LDS_BYTES);
        hipOccupancyMaxActiveBlocksPerMultiprocessor(&per_cu, (const void*)mega, NT, LDS_BYTES);
        if (per_cu > 1) per_cu = 1;
        if (per_cu < 1) per_cu = 1;
        grid = cus * per_cu;
    }
    if (ws_size < WS_END) { fprintf(stderr, "workspace too small: %zu < %zu\n", ws_size, (size_t)WS_END); return; }
    hipMemsetAsync(d_ws, 0, CTL_ZERO_BYTES, stream);
    Params p{};
    for (int i = 0; i < 26; ++i) p.in[i] = (const float*)d_in[i];
    p.out = (float*)d_out; p.ws = (unsigned char*)d_ws;
#if N_LAUNCH_SPLIT
    for (int k = 0; k < NPH; ++k) { p.ph_lo = k; p.ph_hi = k + 1; hipLaunchKernelGGL(mega, dim3(grid), dim3(NT), LDS_BYTES, stream, p); }
#else
    p.ph_lo = 0; p.ph_hi = NPH;
    hipLaunchKernelGGL(mega, dim3(grid), dim3(NT), LDS_BYTES, stream, p);
#endif
}
```

```cpp
#include <hip/hip_runtime.h>
#include <stdint.h>
#include <stdio.h>

#ifndef NAIVE_GEMM
#define NAIVE_GEMM 0
#endif
#ifndef NAIVE_ATTN
#define NAIVE_ATTN 0
#endif
#ifndef N_LAUNCH_SPLIT
#define N_LAUNCH_SPLIT 0
#endif

#ifndef SHADOW_V
#define SHADOW_V -1
#endif
#ifndef SHADOW_G
#define SHADOW_G -1
#endif
#ifndef REPEAT_MASK
#define REPEAT_MASK 0
#endif
#define NREP(k) ((((REPEAT_MASK) >> (k)) & 1) + 1)
#define LAS __attribute__((address_space(3)))
typedef unsigned char uchar;
typedef unsigned short bf16_t;
typedef short bf16x8 __attribute__((ext_vector_type(8)));
typedef float f32x16 __attribute__((ext_vector_type(16)));
typedef float f32x2_t __attribute__((ext_vector_type(2)));
typedef __bf16 bf16x2_t __attribute__((ext_vector_type(2)));
typedef unsigned u32x4 __attribute__((ext_vector_type(4)));
typedef unsigned u32x2 __attribute__((ext_vector_type(2)));
typedef float f32x4 __attribute__((ext_vector_type(4)));

constexpr int NB = 8, S = 2048, DM = 1024, T = NB * S, NL = 2;
constexpr int NIN = 2144, NINP = 2176;
constexpr float EPS = 1e-6f, LOG2E = 1.4426950408889634f;
constexpr float QSCALE_D = 0.125f * LOG2E;
constexpr float QSCALE_M = 0.10206207261596577f * LOG2E;
constexpr int NPH = 1 + 8 * NL;

constexpr size_t MiB = (size_t)1 << 20;
constexpr size_t WS_CTL = 0, CTL_ZERO_BYTES = 32768;
constexpr size_t WS_SCAL = 1 * MiB;
constexpr size_t WS_ROPE = 1 * MiB + 64 * 1024;
constexpr size_t WS_RSTD1 = 1 * MiB + 512 * 1024;
constexpr size_t WS_RSTD2 = WS_RSTD1 + 64 * 1024;
constexpr size_t WS_GW = WS_RSTD2 + 64 * 1024;
constexpr size_t WS_LIST = 2 * MiB;
constexpr size_t WS_WIN = 4 * MiB;
constexpr size_t WS_WOUT = 13 * MiB;
constexpr size_t WS_WUQ = 17 * MiB;
constexpr size_t WS_WUKV = 17 * MiB + 512 * 1024;
constexpr size_t WS_POOLW = 17 * MiB + 768 * 1024;
constexpr size_t WS_WR = 18 * MiB;
constexpr size_t WS_PSS = 19 * MiB + 512 * 1024;
constexpr size_t WS_HSS = 12 * MiB + 512 * 1024;
constexpr size_t WS_WGU = 20 * MiB;
constexpr size_t WS_WD = 52 * MiB;
constexpr size_t WS_XB = 68 * MiB;
constexpr size_t WS_MIX = 100 * MiB;
constexpr size_t WS_HMID = WS_MIX;
constexpr size_t WS_QD = 132 * MiB, WS_KD = 148 * MiB, WS_VDT = 164 * MiB;
constexpr size_t WS_LAT = 180 * MiB;
constexpr size_t WS_QM = 200 * MiB, WS_KM = 212 * MiB, WS_VMT = 224 * MiB;
constexpr size_t WS_POOLED = 232 * MiB;
constexpr size_t WS_XL = 132 * MiB;
constexpr size_t WS_YS = 132 * MiB;
constexpr size_t WS_END = 240 * MiB;

#define XB_TMO      128
#define XB_XCNT(j)  (256  + 64 * (j))
#define XB_XSUB(j)  (1280 + 64 * (j))
#define XB_XGEN(j)  (2304 + 64 * (j))
#define XB_TOP      3328
#define XB_TOPGEN   3392
#define XCD_BAR_WORDS 3456
#define XB_SPIN_CAP (1u << 18)
constexpr int CW_CNT = 4096;

constexpr int NT = 512;
constexpr int LDS_XB = 147456;
constexpr int LDS_ROW = LDS_XB + 256;
constexpr int LDS_BYTES = LDS_ROW + 2048;
constexpr int GSTG = 49152;
constexpr int ASTG = 32768;
constexpr int MSTG = 20480;

struct Params {
    const float* in[26];
    float* out;
    unsigned char* ws;
    int ph_lo, ph_hi;
};

__device__ __forceinline__ unsigned pk2(float lo, float hi) { f32x2_t v = {lo, hi}; bf16x2_t b = __builtin_convertvector(v, bf16x2_t); return __builtin_bit_cast(unsigned, b); }
__device__ __forceinline__ float bflo(unsigned w) { return __builtin_bit_cast(float, w << 16); }
__device__ __forceinline__ float bfhi(unsigned w) { return __builtin_bit_cast(float, w & 0xffff0000u); }
__device__ __forceinline__ float bf2f(bf16_t u) { return __builtin_bit_cast(float, (unsigned)u << 16); }
__device__ __forceinline__ bf16_t f2bf(float f) { return (bf16_t)(pk2(f, 0.f) & 0xffffu); }
__device__ __forceinline__ LAS uchar* lds_base() { extern __shared__ __attribute__((aligned(16))) unsigned char smem_dyn_[]; return (LAS uchar*)smem_dyn_; }
__device__ __forceinline__ int tid_opaque() { int t = threadIdx.x; asm volatile("" : "+v"(t)); return t; }
__device__ __forceinline__ int crow(int r, int hi) { return (r & 3) + 8 * (r >> 2) + 4 * hi; }
__device__ __forceinline__ int sigma16(int s) { return (s & ~12) | ((s & 4) << 1) | ((s & 8) >> 1); }
__device__ __forceinline__ float wave_sum(float v) {
#pragma unroll
    for (int o = 32; o >= 1; o >>= 1) v += __shfl_xor(v, o);
    return v;
}
__device__ __forceinline__ void unpack8(u32x4 w, float (&f)[8]) {
    f[0] = bflo(w[0]); f[1] = bfhi(w[0]); f[2] = bflo(w[1]); f[3] = bfhi(w[1]);
    f[4] = bflo(w[2]); f[5] = bfhi(w[2]); f[6] = bflo(w[3]); f[7] = bfhi(w[3]);
}

__device__ __forceinline__ unsigned xb_ld(unsigned* p)              { return __hip_atomic_load(p, __ATOMIC_RELAXED, __HIP_MEMORY_SCOPE_AGENT); }
__device__ __forceinline__ unsigned xb_add(unsigned* p, unsigned v) { return __hip_atomic_fetch_add(p, v, __ATOMIC_RELAXED, __HIP_MEMORY_SCOPE_AGENT); }
__device__ __forceinline__ unsigned xb_xcc_id() { return (unsigned)__builtin_amdgcn_s_getreg((3 << 11) | 20) & 0xFu; }
#define XB_SPIN(cond, bar) do { unsigned _sp = 0; while (cond) { __builtin_amdgcn_s_sleep(1); \
    if ((++_sp & 255u) == 0u) { if (xb_ld(&(bar)[XB_TMO])) break; if (_sp > XB_SPIN_CAP) { atomicAdd(&(bar)[XB_TMO], 1u); break; } } } } while (0)
struct XcdBarrier { unsigned* bar; unsigned x; volatile LAS unsigned* st; };
__device__ __forceinline__ XcdBarrier xcd_barrier_post(unsigned* bar, volatile LAS unsigned* st) {
    XcdBarrier b; b.bar = bar; b.x = xb_xcc_id(); b.st = st;
    if (threadIdx.x == 0) (void)xb_add(&bar[XB_XCNT(b.x)], 1u);
    return b;
}
__device__ __forceinline__ void xcd_barrier_complete(unsigned* bar, unsigned x, unsigned& nloc, unsigned& nx) {
    const unsigned G = gridDim.x * gridDim.y * gridDim.z;
    unsigned sum, cnt, mine, sp = 0u;
    for (;;) {
        sum = 0u; cnt = 0u; mine = 0u;
#pragma unroll
        for (unsigned j = 0; j < 16; ++j) { const unsigned c = xb_ld(&bar[XB_XCNT(j)]); sum += c; cnt += (c > 0u) ? 1u : 0u; mine = (j == x) ? c : mine; }
        if (sum == G) break;
        __builtin_amdgcn_s_sleep(1);
        if ((++sp & 255u) == 0u) { if (xb_ld(&bar[XB_TMO])) break; if (sp > XB_SPIN_CAP) { atomicAdd(&bar[XB_TMO], 1u); break; } }
    }
    nloc = mine > 0u ? mine : 1u; nx = cnt > 0u ? cnt : 1u;
}
__device__ __forceinline__ void xcd_barrier(const XcdBarrier& b) {
    asm volatile("s_waitcnt vmcnt(0)" ::: "memory");
    __syncthreads();
    if (threadIdx.x == 0) {
        unsigned* bar = b.bar;
        __builtin_amdgcn_s_waitcnt(0);
        unsigned nloc = b.st[0], nx = b.st[1];
        if (nloc == 0u) { xcd_barrier_complete(bar, b.x, nloc, nx); b.st[0] = nloc; b.st[1] = nx; }
        const unsigned old = xb_add(&bar[XB_XSUB(b.x)], 1u);
        const unsigned gen = old / nloc;
        if (old + 1u == (gen + 1u) * nloc) {
            __builtin_amdgcn_fence(__ATOMIC_RELEASE, "agent");
            asm volatile("s_waitcnt vmcnt(0)" ::: "memory");
            const unsigned og = xb_add(&bar[XB_TOP], 1u);
            const unsigned tg = og / nx;
            if (og + 1u == (tg + 1u) * nx) xb_add(&bar[XB_TOPGEN], 1u);
            else XB_SPIN(xb_ld(&bar[XB_TOPGEN]) == tg, bar);
            __builtin_amdgcn_fence(__ATOMIC_ACQUIRE, "agent");
            xb_add(&bar[XB_XGEN(b.x)], 1u);
            asm volatile("s_waitcnt vmcnt(0)" ::: "memory");
        } else {
            XB_SPIN(xb_ld(&bar[XB_XGEN(b.x)]) == gen, bar);
            __builtin_amdgcn_fence(__ATOMIC_ACQUIRE, "agent");
            asm volatile("s_waitcnt vmcnt(0)" ::: "memory");
        }
    }
    __syncthreads();
}

__device__ __forceinline__ void glds16(const void* gsrc, LAS uchar* dst_wave_base) {
    __builtin_amdgcn_global_load_lds((const unsigned*)gsrc, (LAS unsigned*)dst_wave_base, 16, 0, 0);
}
__device__ __forceinline__ int sw128(int row, int c) { return row * 128 + ((c ^ ((row >> 1) & 7)) << 4); }
__device__ __forceinline__ int sw64(int row, int c) { return row * 64 + ((c ^ ((row >> 2) & 3)) << 4); }

#define MFMA32(a, b, c) __builtin_amdgcn_mfma_f32_32x32x16_bf16((a), (b), (c), 0, 0, 0)

constexpr int CT_PITCH = 272;
#define WAITV(n) asm volatile("s_waitcnt vmcnt(" #n ")" ::: "memory")
struct ARowLinear { const bf16_t* base; size_t ld; __device__ __forceinline__ const bf16_t* operator()(int r) const { return base + (size_t)r * ld; } };
struct ARowGather { const bf16_t* base; const unsigned* list; int nvalid; __device__ __forceinline__ const bf16_t* operator()(int r) const {
    const int rr = r < nvalid ? r : nvalid - 1; const unsigned ent = list[rr]; return base + (size_t)(ent >> 1) * DM; } };

struct AOffLinear { __device__ __forceinline__ int operator()(int kt) const { return kt * 64; } };
struct AOffRouter { int xl_off; __device__ __forceinline__ int operator()(int kt) const { return (kt & 15) * 64 + ((kt >> 4) == 1 ? xl_off : 0); } };
constexpr int CTF_PITCH = 129;
template <bool F32C = false, class ARow, class Epi, class AOff = AOffLinear>
__device__ __forceinline__ void gemm_tile(LAS uchar* lds, const ARow& arow, const bf16_t* Bt, size_t ldb, int K, const Epi& epi, const AOff aoff = AOff()) {
    const int tid = tid_opaque(), lane = tid & 63, wid = __builtin_amdgcn_readfirstlane(tid >> 6);
#if NAIVE_GEMM
    {
        const int r = tid >> 1, nh = tid & 1;
        float acc[64];
#pragma unroll
        for (int n = 0; n < 64; ++n) acc[n] = 0.f;
        const bf16_t* ar = arow(r);
        for (int k = 0; k < K; k += 8) {
            float a[8]; unpack8(*(const u32x4*)(ar + k), a);
#pragma unroll
            for (int n = 0; n < 64; ++n) {
                float b[8]; unpack8(*(const u32x4*)(Bt + (size_t)(nh * 64 + n) * ldb + k), b);
#pragma unroll
                for (int j = 0; j < 8; ++j) acc[n] += a[j] * b[j];
            }
        }
        __syncthreads();
#pragma unroll
        for (int n = 0; n < 64; n += 2) { if (F32C) { ((LAS float*)lds)[r * CTF_PITCH + nh * 64 + n] = acc[n]; ((LAS float*)lds)[r * CTF_PITCH + nh * 64 + n + 1] = acc[n + 1]; } else *(LAS unsigned*)(lds + r * CT_PITCH + (nh * 64 + n) * 2) = pk2(acc[n], acc[n + 1]); }
    }
#else
    {
        const int wm = wid >> 1, wn = wid & 1, r = lane & 31, hh = lane >> 5;
        const int srow = lane >> 3, c0 = (lane & 7) ^ (srow >> 1);
        const bf16_t* asrc[4];
#pragma unroll
        for (int j = 0; j < 4; ++j) asrc[j] = arow(8 * (wid * 4 + j) + srow) + (c0 ^ ((j & 1) << 2)) * 8;
        const bf16_t* bsrc0 = Bt + (size_t)(wid * 16 + srow) * ldb + c0 * 8;
        const bf16_t* bsrc1 = Bt + (size_t)(wid * 16 + 8 + srow) * ldb + (c0 ^ 4) * 8;
        const int lanebase = r * 128 + ((hh ^ ((r >> 1) & 7)) << 4);
        f32x16 acc[2][2];
#pragma unroll
        for (int a = 0; a < 2; ++a)
#pragma unroll
            for (int b = 0; b < 2; ++b)
#pragma unroll
                for (int i = 0; i < 16; ++i) acc[a][b][i] = 0.f;
        const int nt = K >> 6;
#define GT_STAGE(kt, sb) do { _Pragma("unroll") for (int j = 0; j < 4; ++j) \
            glds16(asrc[j] + aoff(kt), lds + (sb) * GSTG + (wid * 4 + j) * 1024); \
            glds16(bsrc0 + (kt) * 64, lds + (sb) * GSTG + 32768 + (wid * 2) * 1024); \
            glds16(bsrc1 + (kt) * 64, lds + (sb) * GSTG + 32768 + (wid * 2 + 1) * 1024); } while (0)
        GT_STAGE(0, 0);
        if (nt > 1) GT_STAGE(1, 1);
        int sb = 0;
        for (int kt = 0; kt < nt; ++kt) {
            if (kt + 1 < nt) WAITV(6); else WAITV(0);
            __builtin_amdgcn_s_barrier();
            if (kt + 2 < nt) { const int sn = sb >= 1 ? sb - 1 : 2; GT_STAGE(kt + 2, sn); }
            const LAS uchar* xs = lds + sb * GSTG + wm * 8192; const LAS uchar* wsb = lds + sb * GSTG + 32768 + wn * 8192;
#pragma unroll
            for (int ks = 0; ks < 4; ++ks) {
                const int lb = lanebase ^ (ks << 5);
                bf16x8 xf[2], wf[2];
#pragma unroll
                for (int mb = 0; mb < 2; ++mb) xf[mb] = *(const LAS bf16x8*)(xs + mb * 4096 + lb);
#pragma unroll
                for (int nb = 0; nb < 2; ++nb) wf[nb] = *(const LAS bf16x8*)(wsb + nb * 4096 + lb);
#pragma unroll
                for (int nb = 0; nb < 2; ++nb)
#pragma unroll
                    for (int mb = 0; mb < 2; ++mb) acc[nb][mb] = MFMA32(wf[nb], xf[mb], acc[nb][mb]);
            }
            sb = sb == 2 ? 0 : sb + 1;
        }
#undef GT_STAGE
        __syncthreads();
#pragma unroll
        for (int nb = 0; nb < 2; ++nb)
#pragma unroll
            for (int mb = 0; mb < 2; ++mb) {
                const int m = 64 * wm + 32 * mb + r;
#pragma unroll
                for (int q4 = 0; q4 < 4; ++q4) {
                    const int n = 64 * wn + 32 * nb + 8 * q4 + 4 * hh;
                    if (F32C) {
#pragma unroll
                        for (int j = 0; j < 4; ++j) ((LAS float*)lds)[m * CTF_PITCH + n + j] = acc[nb][mb][4 * q4 + j];
                    } else {
                        u32x2 v; v[0] = pk2(acc[nb][mb][4 * q4], acc[nb][mb][4 * q4 + 1]); v[1] = pk2(acc[nb][mb][4 * q4 + 2], acc[nb][mb][4 * q4 + 3]);
                        *(LAS u32x2*)(lds + m * CT_PITCH + n * 2) = v;
                    }
                }
            }
    }
#endif
    __syncthreads();
    epi(lds);
    __syncthreads();
}
constexpr int BSTG = 32768, CT2_OFF = 256 * CT_PITCH;
template <int V = 0, class ARow, class EpiMaker>
__device__ __forceinline__ void gemm_big(LAS uchar* lds, const ARow& arow, const bf16_t* Bt, size_t ldb, int K, const EpiMaker& mk) {
    const int tid = tid_opaque(), lane = tid & 63, wid = __builtin_amdgcn_readfirstlane(tid >> 6);
    {
        const int wm = wid >> 2, wn = wid & 3, r = lane & 31, hh = lane >> 5;
        const int srow = lane >> 2, sc = (lane & 3) ^ ((lane >> 4) & 3);
        const bf16_t* a0 = arow(wid * 32 + srow) + sc * 8; const bf16_t* a1 = arow(wid * 32 + 16 + srow) + sc * 8;
        const bf16_t* b0 = Bt + (size_t)(wid * 32 + srow) * ldb + sc * 8; const bf16_t* b1 = b0 + (size_t)16 * ldb;
        const int lanebase = r * 64 + ((hh ^ ((r >> 2) & 3)) << 4);
        f32x16 acc[2][4];
#pragma unroll
        for (int a = 0; a < 2; ++a)
#pragma unroll
            for (int b = 0; b < 4; ++b)
#pragma unroll
                for (int i = 0; i < 16; ++i) acc[a][b][i] = 0.f;
        const int nt = K >> 5;
#define GB_STAGE(kt, sb) do { \
            glds16(a0 + (kt) * 32, lds + (sb) * BSTG + (wid * 2) * 1024); glds16(a1 + (kt) * 32, lds + (sb) * BSTG + (wid * 2 + 1) * 1024); \
            glds16(b0 + (kt) * 32, lds + (sb) * BSTG + 16384 + (wid * 2) * 1024); glds16(b1 + (kt) * 32, lds + (sb) * BSTG + 16384 + (wid * 2 + 1) * 1024); } while (0)
        if (!(V & 4)) { GB_STAGE(0, 0); GB_STAGE(1, 1); GB_STAGE(2, 2); }
        for (int kt = 0; kt < nt; ++kt) {
            const int sb = kt & 3;
            if (kt + 2 < nt) WAITV(8); else if (kt + 1 < nt) WAITV(4); else WAITV(0);
            __builtin_amdgcn_s_barrier();
            if (!(V & 4) && kt + 3 < nt) GB_STAGE(kt + 3, (kt + 3) & 3);
            const LAS uchar* xs = lds + sb * BSTG + wm * 8192; const LAS uchar* wsb = lds + sb * BSTG + 16384 + wn * 4096;
#pragma unroll
            for (int ks = 0; ks < 2; ++ks) {
                const int lb = lanebase ^ (ks << 5);
                bf16x8 xf[4], wf[2];
#pragma unroll
                for (int mb = 0; mb < 4; ++mb) { if (V & 8) { u32x4 t = {(unsigned)(lb + mb + kt), 1u, 2u, 3u}; xf[mb] = __builtin_bit_cast(bf16x8, t); } else xf[mb] = *(const LAS bf16x8*)(xs + mb * 2048 + lb); }
#pragma unroll
                for (int nb = 0; nb < 2; ++nb) { if (V & 8) { u32x4 t = {(unsigned)(lb + nb), 5u, 6u, (unsigned)kt}; wf[nb] = __builtin_bit_cast(bf16x8, t); } else wf[nb] = *(const LAS bf16x8*)(wsb + nb * 2048 + lb); }
#pragma unroll
                for (int nb = 0; nb < 2; ++nb)
#pragma unroll
                    for (int mb = 0; mb < 4; ++mb) { if (V & 2) { acc[nb][mb][ks] += __builtin_bit_cast(float, (__builtin_bit_cast(u32x4, wf[nb]))[0] ^ (__builtin_bit_cast(u32x4, xf[mb]))[0]); } else acc[nb][mb] = MFMA32(wf[nb], xf[mb], acc[nb][mb]); }
            }
        }
#undef GB_STAGE
        __syncthreads();
#pragma unroll
        for (int nb = 0; nb < 2; ++nb)
#pragma unroll
            for (int mb = 0; mb < 4; ++mb) {
                const int m = 128 * wm + 32 * mb + r;
#pragma unroll
                for (int q4 = 0; q4 < 4; ++q4) {
                    const int n = 64 * (wn & 1) + 32 * nb + 8 * q4 + 4 * hh;
                    u32x2 v; v[0] = pk2(acc[nb][mb][4 * q4], acc[nb][mb][4 * q4 + 1]); v[1] = pk2(acc[nb][mb][4 * q4 + 2], acc[nb][mb][4 * q4 + 3]);
                    *(LAS u32x2*)(lds + (wn >> 1) * CT2_OFF + m * CT_PITCH + n * 2) = v;
                }
            }
    }
    __syncthreads();
    if (!(V & 1)) { mk(0)(lds); mk(1)(lds + CT2_OFF); }
    __syncthreads();
}
__device__ __forceinline__ u32x4 ct_ld8(const LAS uchar* ct, int r, int c) { return *(const LAS u32x4*)(ct + r * CT_PITCH + c * 2); }
__device__ __forceinline__ float ct_ld1(const LAS uchar* ct, int r, int c) { return bf2f(*(const LAS bf16_t*)(ct + r * CT_PITCH + c * 2)); }

struct EpiProj {
    int mt, nt, l; const Params* p;
    __device__ __forceinline__ void operator()(const LAS uchar* ct) const {
        uchar* ws = p->ws; const int tid = tid_opaque();
        const LAS float* rowS = (const LAS float*)(lds_base() + LDS_ROW);
        const int t0 = mt * 256, b = t0 >> 11, s0 = t0 & 2047;
        if (nt < 8) {
            const int h = nt & 3; const bool isq = nt < 4;
            const int c8 = tid & 7, j = (tid >> 3) & 1, r0 = tid >> 4;
            const float* g = p->in[isq ? 3 : 4] + l * 64 + c8 * 8;
            const f32x4 g0 = *(const f32x4*)g, g1 = *(const f32x4*)(g + 4);
            bf16_t* dbase = (bf16_t*)(ws + (isq ? WS_QD : WS_KD)) + ((((size_t)b * 4 + h) * 2 + j) * S + s0) * 64 + c8 * 8;
#pragma unroll
            for (int it = 0; it < 8; ++it) {
                const int r = it * 32 + r0;
                const float rs = rowS[r];
                float f[8]; unpack8(ct_ld8(ct, r, j * 64 + c8 * 8), f);
                float ss = 0.f;
#pragma unroll
                for (int i = 0; i < 8; ++i) { f[i] *= rs; ss += f[i] * f[i]; }
                ss += __shfl_xor(ss, 1); ss += __shfl_xor(ss, 2); ss += __shfl_xor(ss, 4);
                const float rn = __builtin_amdgcn_rsqf(ss * (1.f / 64.f) + EPS) * (isq ? QSCALE_D : 1.f);
                u32x4 o; o[0] = pk2(f[0] * rn * g0[0], f[1] * rn * g0[1]); o[1] = pk2(f[2] * rn * g0[2], f[3] * rn * g0[3]);
                o[2] = pk2(f[4] * rn * g1[0], f[5] * rn * g1[1]); o[3] = pk2(f[6] * rn * g1[2], f[7] * rn * g1[3]);
                *(u32x4*)(dbase + (size_t)r * 64) = o;
            }
        } else if (nt < 12) {
            const int h = nt - 8, d = tid >> 2, half = tid & 3;
            bf16_t* dst = (bf16_t*)(ws + WS_VDT) + (((size_t)b * 4 + h) * 128 + d) * S + s0 + half * 64;
#pragma unroll
            for (int c8 = 0; c8 < 8; ++c8) { u32x4 o;
#pragma unroll
                for (int i = 0; i < 4; ++i) {
                    const int p0 = c8 * 8 + 2 * i, r0 = half * 64 + sigma16(p0), r1 = half * 64 + sigma16(p0 + 1);
                    o[i] = pk2(ct_ld1(ct, r0, d) * rowS[r0], ct_ld1(ct, r1, d) * rowS[r1]); }
                *(u32x4*)(dst + c8 * 8) = o; }
        } else {
            const int c8 = tid & 15, r0 = tid >> 4;
            bf16_t* dbase = (bf16_t*)(ws + WS_LAT) + (size_t)t0 * 640 + (nt - 12) * 128 + c8 * 8;
            const int hidx = (nt - 12) * 2 + (c8 >> 3);
            float* hss = (float*)(ws + WS_HSS) + (size_t)t0 * 8 + hidx;
#pragma unroll
            for (int it = 0; it < 8; ++it) {
                const int r = it * 32 + r0;
                const float rs = rowS[r];
                float f[8]; unpack8(ct_ld8(ct, r, c8 * 8), f); u32x4 o;
#pragma unroll
                for (int i = 0; i < 4; ++i) o[i] = pk2(f[2 * i] * rs, f[2 * i + 1] * rs);
                *(u32x4*)(dbase + (size_t)r * 640) = o;
                float ss = 0.f;
#pragma unroll
                for (int i = 0; i < 4; ++i) { const float a = bflo(o[i]), bq = bfhi(o[i]); ss += a * a + bq * bq; }
                ss += __shfl_xor(ss, 1); ss += __shfl_xor(ss, 2); ss += __shfl_xor(ss, 4);
                if ((c8 & 7) == 0 && hidx < 8) hss[(size_t)r * 8] = ss;
            }
        }
    }
};

__device__ __forceinline__ float lat_rstd(const bf16_t* seg, int n) {
    float ss = 0.f;
    for (int k = 0; k < n; k += 8) { float f[8]; unpack8(*(const u32x4*)(seg + k), f);
#pragma unroll
        for (int i = 0; i < 8; ++i) ss += f[i] * f[i]; }
    return __builtin_amdgcn_rsqf(ss / (float)n + EPS);
}
__device__ __forceinline__ void norm_rope32(float (&y)[32], const float* g, const float* cosr, const float* sinr, float outscale) {
    float ss = 0.f;
#pragma unroll
    for (int i = 0; i < 32; ++i) ss += y[i] * y[i];
    const float rn = __builtin_amdgcn_rsqf(ss * (1.f / 32.f) + EPS);
#pragma unroll
    for (int i = 0; i < 32; ++i) y[i] = y[i] * rn * g[i];
#pragma unroll
    for (int i = 0; i < 16; ++i) { const float c = cosr[i], sn = sinr[i], x1 = y[i], x2 = y[16 + i];
        y[i] = (x1 * c - x2 * sn) * outscale; y[16 + i] = (x2 * c + x1 * sn) * outscale; }
}

__device__ __forceinline__ u32x4 norm64_piece(float (&f)[8], const float* g8, float outscale) {
    float ss = 0.f;
#pragma unroll
    for (int i = 0; i < 8; ++i) ss += f[i] * f[i];
    ss += __shfl_xor(ss, 1); ss += __shfl_xor(ss, 2); ss += __shfl_xor(ss, 4);
    const float rn = __builtin_amdgcn_rsqf(ss * (1.f / 64.f) + EPS) * outscale;
    const f32x4 g0 = *(const f32x4*)g8, g1 = *(const f32x4*)(g8 + 4);
    u32x4 o; o[0] = pk2(f[0] * rn * g0[0], f[1] * rn * g0[1]); o[1] = pk2(f[2] * rn * g0[2], f[3] * rn * g0[3]);
    o[2] = pk2(f[4] * rn * g1[0], f[5] * rn * g1[1]); o[3] = pk2(f[6] * rn * g1[2], f[7] * rn * g1[3]);
    return o;
}
__device__ __forceinline__ u32x4 norm_rope_piece(float (&f)[8], int c8, const float* g, const float* cosr, const float* sinr, float outscale) {
    float ss = 0.f;
#pragma unroll
    for (int i = 0; i < 8; ++i) ss += f[i] * f[i];
    ss += __shfl_xor(ss, 1); ss += __shfl_xor(ss, 2);
    const float rn = __builtin_amdgcn_rsqf(ss * (1.f / 32.f) + EPS);
    float y[8], z[8];
#pragma unroll
    for (int i = 0; i < 8; ++i) y[i] = f[i] * rn * g[c8 * 8 + i];
#pragma unroll
    for (int i = 0; i < 8; ++i) z[i] = __shfl_xor(y[i], 2);
    const int fi = (c8 & 1) * 8;
    float o[8];
#pragma unroll
    for (int i = 0; i < 8; ++i) { const float c = cosr[fi + i], sn = sinr[fi + i];
        o[i] = ((c8 < 2) ? (y[i] * c - z[i] * sn) : (y[i] * c + z[i] * sn)) * outscale; }
    u32x4 w; w[0] = pk2(o[0], o[1]); w[1] = pk2(o[2], o[3]); w[2] = pk2(o[4], o[5]); w[3] = pk2(o[6], o[7]);
    return w;
}
struct EpiMlaQ {
    int mt, h, l; const Params* p;
    __device__ __forceinline__ void operator()(const LAS uchar* ct) const {
        uchar* ws = p->ws; const int tid = tid_opaque();
        const LAS float* rowS = (const LAS float*)(lds_base() + LDS_ROW);
        const int t0 = mt * 256, b = t0 >> 11, s0 = t0 & 2047;
        bf16_t* dbase = (bf16_t*)(ws + WS_QM) + (((size_t)b * 4 + h) * S + s0) * 96;
        const float* gn = p->in[11] + l * 64; const float* gr = p->in[12] + l * 32;
        {
            const int c8 = tid & 7, r0 = tid >> 3;
#pragma unroll
            for (int it = 0; it < 4; ++it) {
                const int r = it * 64 + r0; const float rs = rowS[r];
                float f[8]; unpack8(ct_ld8(ct, r, c8 * 8), f);
#pragma unroll
                for (int i = 0; i < 8; ++i) f[i] *= rs;
                *(u32x4*)(dbase + (size_t)r * 96 + c8 * 8) = norm64_piece(f, gn + c8 * 8, QSCALE_M);
            }
        }
        {
            const int c8 = tid & 3, r0 = tid >> 2;
#pragma unroll
            for (int it = 0; it < 2; ++it) {
                const int r = it * 128 + r0; const float rs = rowS[r];
                float f[8]; unpack8(ct_ld8(ct, r, 64 + c8 * 8), f);
#pragma unroll
                for (int i = 0; i < 8; ++i) f[i] *= rs;
                const float* cosr = (const float*)(ws + WS_ROPE) + (s0 + r) * 16; const float* sinr = cosr + S * 16;
                *(u32x4*)(dbase + (size_t)r * 96 + 64 + c8 * 8) = norm_rope_piece(f, c8, gr, cosr, sinr, QSCALE_M);
            }
        }
    }
};
struct EpiMlaKV {
    int mt, h, l; const Params* p;
    __device__ __forceinline__ void operator()(const LAS uchar* ct) const {
        uchar* ws = p->ws; const int tid = tid_opaque();
        const LAS float* rowS = (const LAS float*)(lds_base() + LDS_ROW);
        const int t0 = mt * 256, b = t0 >> 11, s0 = t0 & 2047;
        bf16_t* dbase = (bf16_t*)(ws + WS_KM) + (((size_t)b * 4 + h) * S + s0) * 96;
        const float* gn = p->in[13] + l * 64; const float* gr = p->in[14] + l * 32;
        {
            const int c8 = tid & 7, r0 = tid >> 3;
#pragma unroll
            for (int it = 0; it < 4; ++it) {
                const int r = it * 64 + r0; const float rs = rowS[r];
                float f[8]; unpack8(ct_ld8(ct, r, c8 * 8), f);
#pragma unroll
                for (int i = 0; i < 8; ++i) f[i] *= rs;
                *(u32x4*)(dbase + (size_t)r * 96 + c8 * 8) = norm64_piece(f, gn + c8 * 8, 1.f);
            }
        }
        {
            const bf16_t* lat = (const bf16_t*)(ws + WS_LAT) + (size_t)t0 * 640 + 320;
            const int c8 = tid & 3, r0 = tid >> 2;
#pragma unroll
            for (int it = 0; it < 2; ++it) {
                const int r = it * 128 + r0;
                float f[8]; unpack8(*(const u32x4*)(lat + (size_t)r * 640 + c8 * 8), f);
                const float* cosr = (const float*)(ws + WS_ROPE) + (s0 + r) * 16; const float* sinr = cosr + S * 16;
                *(u32x4*)(dbase + (size_t)r * 96 + 64 + c8 * 8) = norm_rope_piece(f, c8, gr, cosr, sinr, 1.f);
            }
        }
        {
            const int d = tid >> 3, q4 = tid & 7;
            bf16_t* dst = (bf16_t*)(ws + WS_VMT) + (((size_t)b * 4 + h) * 64 + d) * S + s0 + q4 * 32;
#pragma unroll
            for (int c8 = 0; c8 < 4; ++c8) { u32x4 o;
#pragma unroll
                for (int i = 0; i < 4; ++i) {
                    const int p0 = c8 * 8 + 2 * i, r0 = q4 * 32 + sigma16(p0), r1 = q4 * 32 + sigma16(p0 + 1);
                    o[i] = pk2(ct_ld1(ct, r0, 64 + d) * rowS[r0], ct_ld1(ct, r1, 64 + d) * rowS[r1]); }
                *(u32x4*)(dst + c8 * 8) = o; }
        }
    }
};
struct EpiPool {
    int mt, g, l; const Params* p;
    __device__ __forceinline__ void operator()(const LAS uchar* ct) const {
        uchar* ws = p->ws; const int tid = tid_opaque(), c8 = tid & 7, r0 = tid >> 3;
        const float* sc = p->in[16] + l * 256 + g * 64 + c8 * 8;
        const f32x4 s0 = *(const f32x4*)sc, s1 = *(const f32x4*)(sc + 4);
        bf16_t* dst = (bf16_t*)(ws + WS_MIX) + (size_t)(mt * 256) * DM + 768 + g * 64 + c8 * 8;
#pragma unroll
        for (int it = 0; it < 4; ++it) {
            const int r = it * 64 + r0;
            float f[8]; unpack8(ct_ld8(ct, r, c8 * 8), f); u32x4 o;
            o[0] = pk2(f[0] * s0[0], f[1] * s0[1]); o[1] = pk2(f[2] * s0[2], f[3] * s0[3]); o[2] = pk2(f[4] * s1[0], f[5] * s1[1]); o[3] = pk2(f[6] * s1[2], f[7] * s1[3]);
            *(u32x4*)(dst + (size_t)r * DM) = o;
        }
    }
};
struct EpiWout {
    int mt, nt; const float* xres; const Params* p;
    __device__ __forceinline__ void operator()(const LAS uchar* ct) const {
        uchar* ws = p->ws; const int tid = tid_opaque();
        const size_t base = (size_t)(mt * 256) * DM + nt * 128;
        float* pss = (float*)(ws + WS_PSS) + (size_t)(mt * 256) * 8 + nt;
#pragma unroll 8
        for (int it = 0; it < 16; ++it) {
            const int item = it * NT + tid, c4 = item & 31, r = item >> 5;
            const size_t off = base + (size_t)r * DM + c4 * 4;
            const u32x2 cw = *(const LAS u32x2*)(ct + r * CT_PITCH + c4 * 8);
            const f32x4 x0 = *(const f32x4*)(xres + off);
            f32x4 y; y[0] = x0[0] + bflo(cw[0]); y[1] = x0[1] + bfhi(cw[0]); y[2] = x0[2] + bflo(cw[1]); y[3] = x0[3] + bfhi(cw[1]);
            *(f32x4*)(p->out + off) = y;
            u32x2 o; o[0] = pk2(y[0], y[1]); o[1] = pk2(y[2], y[3]);
            *(u32x2*)((bf16_t*)(ws + WS_XB) + off) = o;
            u32x2 ol; ol[0] = pk2(y[0] - bflo(o[0]), y[1] - bfhi(o[0])); ol[1] = pk2(y[2] - bflo(o[1]), y[3] - bfhi(o[1]));
            *(u32x2*)((bf16_t*)(ws + WS_XL) + off) = ol;
            float ss = y[0] * y[0] + y[1] * y[1] + y[2] * y[2] + y[3] * y[3];
            ss += __shfl_xor(ss, 1); ss += __shfl_xor(ss, 2); ss += __shfl_xor(ss, 4); ss += __shfl_xor(ss, 8); ss += __shfl_xor(ss, 16);
            if (c4 == 0) pss[(size_t)r * 8] = ss;
        }
    }
};
struct EpiGU {
    int jt; size_t slot0; const Params* p;
    __device__ __forceinline__ void operator()(const LAS uchar* ct) const {
        uchar* ws = p->ws; const int tid = tid_opaque(), c8 = tid & 7, r0 = tid >> 3;
        const LAS float* rowS = (const LAS float*)(lds_base() + LDS_ROW);
        bf16_t* dbase = (bf16_t*)(ws + WS_HMID) + slot0 * 256 + jt * 64 + c8 * 8;
#pragma unroll
        for (int it = 0; it < 4; ++it) {
            const int r = it * 64 + r0;
            const float rs = rowS[r];
            float g[8], u[8]; unpack8(ct_ld8(ct, r, c8 * 8), g); unpack8(ct_ld8(ct, r, 64 + c8 * 8), u);
            float hv[8];
#pragma unroll
            for (int i = 0; i < 8; ++i) { const float gg = g[i] * rs, uu = u[i] * rs; hv[i] = gg * __builtin_amdgcn_rcpf(1.f + __builtin_amdgcn_exp2f(-gg * LOG2E)) * uu; }
            u32x4 o; o[0] = pk2(hv[0], hv[1]); o[1] = pk2(hv[2], hv[3]); o[2] = pk2(hv[4], hv[5]); o[3] = pk2(hv[6], hv[7]);
            *(u32x4*)(dbase + (size_t)r * 256) = o;
        }
    }
};
struct EpiDown {
    int nt, nvalid; const Params* p;
    __device__ __forceinline__ void operator()(const LAS uchar* ct) const {
        uchar* ws = p->ws; const int tid = tid_opaque(), c8 = tid & 15, r0 = tid >> 4;
        const LAS float* rowS = (const LAS float*)(lds_base() + LDS_ROW); const LAS unsigned* rowE = (const LAS unsigned*)(lds_base() + LDS_ROW + 1024);
        bf16_t* ys = (bf16_t*)(ws + WS_YS) + nt * 128 + c8 * 8;
#pragma unroll
        for (int it = 0; it < 8; ++it) {
            const int r = it * 32 + r0;
            if (r < nvalid) {
                const unsigned ent = rowE[r]; const float w = rowS[r];
                float f[8]; unpack8(ct_ld8(ct, r, c8 * 8), f); u32x4 o;
#pragma unroll
                for (int i = 0; i < 4; ++i) o[i] = pk2(f[2 * i] * w, f[2 * i + 1] * w);
                *(u32x4*)(ys + (size_t)ent * DM) = o;
            }
        }
    }
};

template <int V = 0>
__device__ __forceinline__ void diff_attn_unit(LAS uchar* lds, const Params& p, int l, int b, int h, int qb) {
    uchar* ws = p.ws;
    const int tid = tid_opaque(), lane = tid & 63, wid = __builtin_amdgcn_readfirstlane(tid >> 6);
    const float* scal = (const float*)(ws + WS_SCAL) + 16 * l;
    const float lam = scal[0], oml = scal[1], m2 = scal[2];
    const float slope2 = exp2f(-2.f * (float)(h + 1)) * LOG2E;
    const bf16_t* Q1 = (const bf16_t*)(ws + WS_QD) + (((size_t)b * 4 + h) * 2) * S * 64;
    const bf16_t* K1 = (const bf16_t*)(ws + WS_KD) + (((size_t)b * 4 + h) * 2) * S * 64;
    const bf16_t* VT = (const bf16_t*)(ws + WS_VDT) + (((size_t)b * 4 + h) * 128) * S;
    const float* gsub = p.in[6] + l * 128;
    bf16_t* mix = (bf16_t*)(ws + WS_MIX);
#if NAIVE_ATTN
    {
        const int q = qb * 128 + (tid >> 2), mm = (tid >> 1) & 1, dh = tid & 1;
        const bf16_t* Qp = Q1 + (size_t)mm * S * 64 + (size_t)q * 64; const bf16_t* Kp = K1 + (size_t)mm * S * 64;
        float qv[64];
#pragma unroll
        for (int c8 = 0; c8 < 8; ++c8) { float f[8]; unpack8(*(const u32x4*)(Qp + c8 * 8), f);
#pragma unroll
            for (int i = 0; i < 8; ++i) qv[c8 * 8 + i] = f[i]; }
        float o[64]; float lsum = 0.f;
#pragma unroll
        for (int d = 0; d < 64; ++d) o[d] = 0.f;
        for (int key = 0; key < S; ++key) {
            float sc = 0.f;
#pragma unroll
            for (int c8 = 0; c8 < 8; ++c8) { float f[8]; unpack8(*(const u32x4*)(Kp + (size_t)key * 64 + c8 * 8), f);
#pragma unroll
                for (int i = 0; i < 8; ++i) sc += qv[c8 * 8 + i] * f[i]; }
            const float pv = __builtin_amdgcn_exp2f(sc - slope2 * fabsf((float)(q - key)) - m2);
            lsum += pv;
            const int kp = sigma16(key);
#pragma unroll
            for (int d = 0; d < 64; ++d) o[d] += pv * bf2f(VT[(size_t)(dh * 64 + d) * S + kp]);
        }
        const float inv = 1.f / lsum; float ss = 0.f;
#pragma unroll
        for (int d = 0; d < 64; ++d) { const float mine = o[d] * inv; const float other = __shfl_xor(mine, 2); o[d] = mine - lam * other; ss += o[d] * o[d]; }
        ss += __shfl_xor(ss, 1);
        if (mm == 0) {
            const float rn = __builtin_amdgcn_rsqf(ss * (1.f / 128.f) + EPS) * oml;
            bf16_t* dst = mix + (size_t)(b * S + q) * DM + h * 128 + dh * 64;
#pragma unroll
            for (int d = 0; d < 64; d += 2) *(unsigned*)(dst + d) = pk2(o[d] * rn * gsub[dh * 64 + d], o[d + 1] * rn * gsub[dh * 64 + d + 1]);
        }
    }
#else
    {
        const int r = lane & 31, hh = lane >> 5, qs = wid >> 1, mm = wid & 1, qpos = qb * 128 + qs * 32 + r;
        const bf16_t* Qm_ = Q1 + (size_t)mm * S * 64;
        bf16x8 qf[4];
#pragma unroll
        for (int ks = 0; ks < 4; ++ks) qf[ks] = *(const bf16x8*)(Qm_ + (size_t)qpos * 64 + ks * 16 + hh * 8);
        f32x16 O[4]; float lsum = 0.f;
#pragma unroll
        for (int db = 0; db < 4; ++db)
#pragma unroll
            for (int i = 0; i < 16; ++i) O[db][i] = 0.f;
        const int srow = lane >> 3, c0 = (lane & 7) ^ (srow >> 1);
        const bool isk = wid < 4;
        const bf16_t* sbase = isk ? (K1 + (size_t)(wid >> 1) * S * 64 + (size_t)(wid & 1) * 32 * 64) : (VT + (size_t)(wid - 4) * 32 * S);
        const int rstride = isk ? 64 : S, kstride = isk ? 64 * 64 : 64;
        const bf16_t* sb0 = sbase + (size_t)srow * rstride + c0 * 8;
        const bf16_t* sb1 = sbase + (size_t)srow * rstride + (c0 ^ 4) * 8;
        const int lanebase = r * 128 + ((hh ^ ((r >> 1) & 7)) << 4);
#define DA_STAGE(kt, sbuf) do { _Pragma("unroll") for (int j = 0; j < 4; ++j) \
            glds16(((j & 1) ? sb1 : sb0) + (size_t)(8 * j) * rstride + (size_t)(kt) * kstride, lds + (sbuf) * ASTG + (wid * 4 + j) * 1024); } while (0)
        const int dcut = (int)(160.f / slope2) + 1;
        int kt_lo = (qb * 128 - dcut) >> 6, kt_hi = (qb * 128 + 127 + dcut) >> 6; kt_lo = kt_lo < 0 ? 0 : kt_lo; kt_hi = kt_hi > S / 64 - 1 ? S / 64 - 1 : kt_hi;
        if (!(V & 8)) { DA_STAGE(kt_lo, 0); if (kt_lo + 1 <= kt_hi) DA_STAGE(kt_lo + 1, 1); }
        int sb = 0;
        const int q0w = qb * 128 + qs * 32;
        const float fq = (float)(qpos - 4 * hh);
        const float baseL = -slope2 * fq - m2, baseR = slope2 * fq - m2;
        for (int kt = kt_lo; kt <= kt_hi; ++kt) {
            if (kt + 1 <= kt_hi) WAITV(4); else WAITV(0);
            __builtin_amdgcn_s_barrier();
            if (!(V & 8) && kt + 2 <= kt_hi) { const int sn = sb >= 1 ? sb - 1 : 2; DA_STAGE(kt + 2, sn); }
            const LAS uchar* st = lds + sb * ASTG;
            f32x16 sacc[2];
#pragma unroll
            for (int kb = 0; kb < 2; ++kb) {
                const int key0 = kt * 64 + 32 * kb;
                {
                    const float c = (key0 < q0w) ? slope2 : -slope2;
                    const float a = ((key0 < q0w) ? baseL : baseR) + c * (float)key0;
#pragma unroll
                    for (int i = 0; i < 16; ++i) sacc[kb][i] = a + c * (float)((i & 3) + 8 * (i >> 2));
                }
                if (__builtin_expect(key0 == q0w, 0)) {
                    const int kq = key0 + 4 * hh - qpos;
#pragma unroll
                    for (int i = 0; i < 16; ++i) sacc[kb][i] = -slope2 * fabsf((float)(kq + (i & 3) + 8 * (i >> 2))) - m2;
                }
#pragma unroll
                for (int ks = 0; ks < 4; ++ks) {
                    if (V & 4) continue;
                    const bf16x8 kf = (V & 16) ? qf[(ks + 1) & 3] : *(const LAS bf16x8*)(st + mm * 8192 + kb * 4096 + (lanebase ^ (ks << 5)));
                    sacc[kb] = MFMA32(kf, qf[ks], sacc[kb]);
                }
            }
#pragma unroll
            for (int kb = 0; kb < 2; ++kb) {
                float ls = 0.f;
#pragma unroll
                for (int i = 0; i < 16; ++i) { const float pv = (V & 1) ? sacc[kb][i] : __builtin_amdgcn_exp2f(sacc[kb][i]); ls += pv; sacc[kb][i] = pv; }
                lsum += ls;
                bf16x8 pb[2];
#pragma unroll
                for (int s2 = 0; s2 < 2; ++s2) {
                    u32x4 w;
#pragma unroll
                    for (int i = 0; i < 4; ++i) w[i] = pk2(sacc[kb][8 * s2 + 2 * i], sacc[kb][8 * s2 + 2 * i + 1]);
                    pb[s2] = __builtin_bit_cast(bf16x8, w);
                }
#pragma unroll
                for (int db = 0; db < 4; ++db)
#pragma unroll
                    for (int s2 = 0; s2 < 2; ++s2) {
                        if (V & 2) { if (db == 0) O[0][s2] += __builtin_bit_cast(float, (__builtin_bit_cast(u32x4, pb[s2]))[0]); continue; }
                        const bf16x8 vf = (V & 16) ? qf[(db + s2) & 3] : *(const LAS bf16x8*)(st + 16384 + db * 4096 + (lanebase ^ ((2 * kb + s2) << 5)));
                        O[db] = MFMA32(vf, pb[s2], O[db]);
                    }
            }
            sb = sb == 2 ? 0 : sb + 1;
        }
#undef DA_STAGE
        const float lt = lsum + __shfl_xor(lsum, 32);
        const float sc = (mm == 0) ? (1.f / lt) : (lam / lt);
        __syncthreads();
        LAS float* xch = (LAS float*)lds + qs * 4096;
        if (mm == 1) {
#pragma unroll
            for (int db = 0; db < 4; ++db)
#pragma unroll
                for (int i = 0; i < 16; ++i) xch[(db * 16 + i) * 64 + lane] = O[db][i] * sc;
        }
        __syncthreads();
        if (mm == 0) {
            float ss = 0.f;
#pragma unroll
            for (int db = 0; db < 4; ++db)
#pragma unroll
                for (int i = 0; i < 16; ++i) { const float o = O[db][i] * sc - xch[(db * 16 + i) * 64 + lane]; O[db][i] = o; ss += o * o; }
            ss += __shfl_xor(ss, 32);
            const float rn = __builtin_amdgcn_rsqf(ss * (1.f / 128.f) + EPS) * oml;
            bf16_t* dst = mix + (size_t)(b * S + qpos) * DM + h * 128;
#pragma unroll
            for (int db = 0; db < 4; ++db)
#pragma unroll
                for (int q4 = 0; q4 < 4; ++q4) {
                    const int d = 32 * db + 8 * q4 + 4 * hh;
                    const f32x4 g = *(const f32x4*)(gsub + d);
                    u32x2 w; w[0] = pk2(O[db][4 * q4] * rn * g[0], O[db][4 * q4 + 1] * rn * g[1]);
                    w[1] = pk2(O[db][4 * q4 + 2] * rn * g[2], O[db][4 * q4 + 3] * rn * g[3]);
                    *(u32x2*)(dst + d) = w;
                }
        }
    }
#endif
    __syncthreads();
}

__device__ __forceinline__ void mla_attn_unit(LAS uchar* lds, const Params& p, int l, int unit) {
    uchar* ws = p.ws;
    const int tid = tid_opaque(), lane = tid & 63, wid = __builtin_amdgcn_readfirstlane(tid >> 6);
    const int xg_ = unit & 7, v_ = unit >> 3, qb = v_ & 7, bh_ = (v_ >> 3) * 8 + xg_, h = bh_ & 3, b = bh_ >> 2;
    const float m2 = ((const float*)(ws + WS_SCAL))[16 * l + 3];
    const bf16_t* Q = (const bf16_t*)(ws + WS_QM) + (((size_t)b * 4 + h) * S) * 96;
    const bf16_t* Kp = (const bf16_t*)(ws + WS_KM) + (((size_t)b * 4 + h) * S) * 96;
    const bf16_t* VT = (const bf16_t*)(ws + WS_VMT) + (((size_t)b * 4 + h) * 64) * S;
    bf16_t* mix = (bf16_t*)(ws + WS_MIX);
#if NAIVE_ATTN
    {
        const int q = qb * 256 + (tid >> 1), hf = tid & 1;
        float qv[96];
#pragma unroll
        for (int c8 = 0; c8 < 12; ++c8) { float f[8]; unpack8(*(const u32x4*)(Q + (size_t)q * 96 + c8 * 8), f);
#pragma unroll
            for (int i = 0; i < 8; ++i) qv[c8 * 8 + i] = f[i]; }
        float o[32]; float lsum = 0.f;
#pragma unroll
        for (int d = 0; d < 32; ++d) o[d] = 0.f;
        for (int key = 0; key < S; ++key) {
            float sc = 0.f;
#pragma unroll
            for (int c8 = 0; c8 < 12; ++c8) { float f[8]; unpack8(*(const u32x4*)(Kp + (size_t)key * 96 + c8 * 8), f);
#pragma unroll
                for (int i = 0; i < 8; ++i) sc += qv[c8 * 8 + i] * f[i]; }
            const float pv = __builtin_amdgcn_exp2f(sc - m2);
            lsum += pv;
            const int kp = sigma16(key);
#pragma unroll
            for (int d = 0; d < 32; ++d) o[d] += pv * bf2f(VT[(size_t)(hf * 32 + d) * S + kp]);
        }
        const float inv = 1.f / lsum;
        bf16_t* dst = mix + (size_t)(b * S + q) * DM + 512 + h * 64 + hf * 32;
#pragma unroll
        for (int d = 0; d < 32; d += 2) *(unsigned*)(dst + d) = pk2(o[d] * inv, o[d + 1] * inv);
    }
#else
    {
        const int r = lane & 31, hh = lane >> 5, qpos = qb * 256 + wid * 32 + r;
        bf16x8 qf[6];
#pragma unroll
        for (int ks = 0; ks < 6; ++ks) qf[ks] = *(const bf16x8*)(Q + (size_t)qpos * 96 + ks * 16 + hh * 8);
        f32x16 O[2]; float lsum = 0.f;
#pragma unroll
        for (int db = 0; db < 2; ++db)
#pragma unroll
            for (int i = 0; i < 16; ++i) O[db][i] = 0.f;
        const int lanebase = r * 128 + ((hh ^ ((r >> 1) & 7)) << 4), lanebase64 = r * 64 + ((hh ^ ((r >> 2) & 3)) << 4);
        const bool lo4 = wid < 4;
        const bf16_t* s0p; const bf16_t* s1p; const bf16_t* s2p;
        {
            const int srow = lane >> 3;
            { const int row = 8 * wid + srow; const int c = (lane & 7) ^ ((row >> 1) & 7); s0p = Kp + (size_t)row * 96 + c * 8; }
            if (lo4) { const int row = 16 * wid + (lane >> 2); const int c = (lane & 3) ^ ((row >> 2) & 3); s1p = Kp + (size_t)row * 96 + 64 + c * 8; }
            else { const int row = 8 * (wid - 4) + srow; const int c = (lane & 7) ^ ((row >> 1) & 7); s1p = VT + (size_t)row * S + c * 8; }
            { const int row = 8 * ((wid & 3) + 4) + srow; const int c = (lane & 7) ^ ((row >> 1) & 7); s2p = VT + (size_t)row * S + c * 8; }
        }
        const int k1stride = lo4 ? 64 * 96 : 64;
#define MA_STAGE(kt, sbuf) do { \
            glds16(s0p + (size_t)(kt) * (64 * 96), lds + (sbuf) * MSTG + wid * 1024); \
            glds16(s1p + (size_t)(kt) * k1stride, lds + (sbuf) * MSTG + (wid + 8) * 1024); \
            if (lo4) glds16(s2p + (size_t)(kt) * 64, lds + (sbuf) * MSTG + (wid + 16) * 1024); } while (0)
        MA_STAGE(0, 0); MA_STAGE(1, 1);
        int sb = 0;
        for (int kt = 0; kt < S / 64; ++kt) {
            if (kt + 1 < S / 64) { if (lo4) WAITV(3); else WAITV(2); } else WAITV(0);
            __builtin_amdgcn_s_barrier();
            if (kt + 2 < S / 64) { const int sn = sb >= 1 ? sb - 1 : 2; MA_STAGE(kt + 2, sn); }
            const LAS uchar* st = lds + sb * MSTG;
#pragma unroll
            for (int kb = 0; kb < 2; ++kb) {
                f32x16 sacc;
#pragma unroll
                for (int i = 0; i < 16; ++i) sacc[i] = -m2;
#pragma unroll
                for (int ks = 0; ks < 4; ++ks) {
                    const bf16x8 kf = *(const LAS bf16x8*)(st + kb * 4096 + (lanebase ^ (ks << 5)));
                    sacc = MFMA32(kf, qf[ks], sacc);
                }
#pragma unroll
                for (int ks = 0; ks < 2; ++ks) {
                    const bf16x8 kf = *(const LAS bf16x8*)(st + 8192 + kb * 2048 + (lanebase64 ^ (ks << 5)));
                    sacc = MFMA32(kf, qf[4 + ks], sacc);
                }
                float ls = 0.f;
#pragma unroll
                for (int i = 0; i < 16; ++i) { const float pv = __builtin_amdgcn_exp2f(sacc[i]); ls += pv; sacc[i] = pv; }
                lsum += ls;
                bf16x8 pb[2];
#pragma unroll
                for (int s2 = 0; s2 < 2; ++s2) {
                    u32x4 w;
#pragma unroll
                    for (int i = 0; i < 4; ++i) w[i] = pk2(sacc[8 * s2 + 2 * i], sacc[8 * s2 + 2 * i + 1]);
                    pb[s2] = __builtin_bit_cast(bf16x8, w);
                }
#pragma unroll
                for (int db = 0; db < 2; ++db)
#pragma unroll
                    for (int s2 = 0; s2 < 2; ++s2) {
                        const bf16x8 vf = *(const LAS bf16x8*)(st + 12288 + db * 4096 + (lanebase ^ ((2 * kb + s2) << 5)));
                        O[db] = MFMA32(vf, pb[s2], O[db]);
                    }
            }
            sb = sb == 2 ? 0 : sb + 1;
        }
#undef MA_STAGE
        const float lt = lsum + __shfl_xor(lsum, 32); const float inv = 1.f / lt;
        bf16_t* dst = mix + (size_t)(b * S + qpos) * DM + 512 + h * 64;
#pragma unroll
        for (int db = 0; db < 2; ++db)
#pragma unroll
            for (int q4 = 0; q4 < 4; ++q4) {
                const int d = 32 * db + 8 * q4 + 4 * hh;
                u32x2 w; w[0] = pk2(O[db][4 * q4] * inv, O[db][4 * q4 + 1] * inv); w[1] = pk2(O[db][4 * q4 + 2] * inv, O[db][4 * q4 + 3] * inv);
                *(u32x2*)(dst + d) = w;
            }
    }
#endif
    __syncthreads();
}

__device__ __forceinline__ int xp_rowmap(int mode, int n) {
    return mode == 0 ? n : mode == 1 ? (n / 96) * 128 + (n % 96) : mode == 2 ? ((n >> 6) * 128 + (n & 63)) : ((n >> 6) * 128 + 64 + (n & 63));
}
__device__ __forceinline__ void xpose_tile(LAS uchar* lds, const float* src, int K, int N, bf16_t* dst, int ldd, int mode, const float* gain, int kt, int ntile, int lds_src = 0) {
    LAS float* sh = (LAS float*)lds; const int tid = tid_opaque();
    (void)K; const int ldn = lds_src ? lds_src : N;
    {
        const int n4 = tid & 63, n = ntile * 256 + n4 * 4;
        if (n < N) {
#pragma unroll
            for (int i = 0; i < 8; ++i) {
                const int kl = (tid >> 6) + 8 * i, k = kt * 64 + kl;
                f32x4 v = *(const f32x4*)(src + (size_t)k * ldn + n);
                if (gain) { const float gk = gain[k]; v[0] *= gk; v[1] *= gk; v[2] *= gk; v[3] *= gk; }
                LAS float* d = sh + kl * 257 + n4 * 4; d[0] = v[0]; d[1] = v[1]; d[2] = v[2]; d[3] = v[3];
            }
        }
    }
    __syncthreads();
    {
        const int nl = tid >> 1, kh = tid & 1, n = ntile * 256 + nl;
        if (n < N) {
            bf16_t* d = dst + (size_t)xp_rowmap(mode, n) * ldd + kt * 64 + kh * 32;
#pragma unroll
            for (int c8 = 0; c8 < 4; ++c8) { u32x4 o;
#pragma unroll
                for (int i = 0; i < 4; ++i) o[i] = pk2(sh[(kh * 32 + c8 * 8 + 2 * i) * 257 + nl], sh[(kh * 32 + c8 * 8 + 2 * i + 1) * 257 + nl]);
                *(u32x4*)(d + c8 * 8) = o; }
        }
    }
    __syncthreads();
}
__device__ __forceinline__ void xpose_job(LAS uchar* lds, const float* src, int K, int N, bf16_t* dst, int ldd, int mode, const float* gain, int lds_src = 0) {
    const int nkt = K >> 6, nnt = (N + 255) >> 8, tot = nkt * nnt;
    for (int u = blockIdx.x; u < tot; u += gridDim.x) xpose_tile(lds, src, K, N, dst, ldd, mode, gain, u % nkt, u / nkt, lds_src);
}
__device__ __forceinline__ void expert_weights(LAS uchar* lds, const Params& p, int l) {
    bf16_t* wgu = (bf16_t*)(p.ws + WS_WGU); bf16_t* wd = (bf16_t*)(p.ws + WS_WD);
    const float* g2 = p.in[18] + l * DM;
    const int nb = (int)gridDim.x > 64 ? (int)gridDim.x - 64 : (int)gridDim.x, b0 = (int)gridDim.x > 64 ? (int)blockIdx.x - 64 : (int)blockIdx.x;
    if (b0 < 0) return;
    for (int u = b0; u < 32 * 48; u += nb) {
        const int e = u / 48, w = u % 48, job = w >> 4, tl = w & 15;
        if (job == 0) xpose_tile(lds, p.in[23] + ((size_t)l * 32 + e) * DM * 256, DM, 256, wgu + (size_t)e * 512 * DM, DM, 2, g2, tl, 0);
        else if (job == 1) xpose_tile(lds, p.in[24] + ((size_t)l * 32 + e) * DM * 256, DM, 256, wgu + (size_t)e * 512 * DM, DM, 3, g2, tl, 0);
        else xpose_tile(lds, p.in[25] + ((size_t)l * 32 + e) * 256 * DM, 256, DM, wd + (size_t)e * DM * 256, 256, 0, nullptr, tl & 3, tl >> 2);
    }
}
__device__ __forceinline__ void row_prep(const float* xrow, bf16_t* xb, float* rstd, int lane) {
    float ss = 0.f; f32x4 v[4];
#pragma unroll
    for (int i = 0; i < 4; ++i) { v[i] = *(const f32x4*)(xrow + i * 256 + lane * 4); ss += v[i][0] * v[i][0] + v[i][1] * v[i][1] + v[i][2] * v[i][2] + v[i][3] * v[i][3]; }
    ss = wave_sum(ss);
#pragma unroll
    for (int i = 0; i < 4; ++i) { u32x2 o; o[0] = pk2(v[i][0], v[i][1]); o[1] = pk2(v[i][2], v[i][3]); *(u32x2*)(xb + i * 256 + lane * 4) = o; }
    if (lane == 0) *rstd = __builtin_amdgcn_rsqf(ss * (1.f / 1024.f) + EPS);
}

__device__ __forceinline__ void phase0(LAS uchar* lds, const Params& p) {
    uchar* ws = p.ws; const int tid = tid_opaque(), gtid = blockIdx.x * NT + tid, gsz = gridDim.x * NT;
    for (int idx = blockIdx.x; idx < NL * 202; idx += gridDim.x) {
        const int l = idx / 202, j = idx % 202;
        if (j < 128) xpose_tile(lds, p.in[2] + (size_t)l * DM * NIN, DM, 1888, (bf16_t*)(ws + WS_WIN) + (size_t)l * NINP * DM, DM, 0, p.in[1] + l * DM, j & 15, j >> 4, NIN);
        else if (j < 192) xpose_tile(lds, p.in[17] + (size_t)l * DM * DM, DM, DM, (bf16_t*)(ws + WS_WOUT) + (size_t)l * DM * DM, DM, 0, nullptr, (j - 128) & 15, (j - 128) >> 4);
        else if (j < 198) xpose_tile(lds, p.in[9] + (size_t)l * 192 * 384, 192, 384, (bf16_t*)(ws + WS_WUQ) + (size_t)l * 512 * 192, 192, 1, p.in[7] + l * 192, (j - 192) % 3, (j - 192) / 3);
        else xpose_tile(lds, p.in[10] + (size_t)l * 128 * 512, 128, 512, (bf16_t*)(ws + WS_WUKV) + (size_t)l * 512 * 128, 128, 0, p.in[8] + l * 128, (j - 198) & 1, (j - 198) >> 1);
    }
    for (int l = 0; l < NL; ++l) {
        for (int i = gtid; i < 256 * DM; i += gsz) {
            const int k = i & 1023, n = i >> 10, g = n >> 6, d = n & 63;
            const float* wi = p.in[2] + ((size_t)l * DM + k) * NIN + 1888 + g * 64; const float* pw = p.in[15] + ((size_t)l * 4 + g) * 64 * 64 + d;
            float acc = 0.f;
            for (int c = 0; c < 64; ++c) acc += wi[c] * pw[c * 64];
            ((bf16_t*)(ws + WS_WIN))[((size_t)l * NINP + 1888 + n) * DM + k] = f2bf(acc * p.in[1][l * DM + k] * p.in[16][l * 256 + n]);
        }
        { bf16_t* w = (bf16_t*)(ws + WS_WIN) + ((size_t)l * NINP + NIN) * DM; for (int i = gtid; i < 32 * DM; i += gsz) w[i] = 0; }
        { bf16_t* w = (bf16_t*)(ws + WS_WUQ) + (size_t)l * 512 * 192; for (int i = gtid; i < 4 * 32 * 192; i += gsz) { const int hd = i / (32 * 192), rem = i % (32 * 192); w[(size_t)(hd * 128 + 96) * 192 + rem] = 0; } }
    }
    for (int i = gtid; i < NL * 128 * 1024; i += gsz) {
        const int k = i & 1023, n = (i >> 10) & 127, l = i >> 17;
        float v = 0.f;
        if (n < 4) v = p.in[19][((size_t)l * DM + k) * 4 + n]; else if (n < 36) v = p.in[21][((size_t)l * DM + k) * 32 + (n - 4)];
        v *= p.in[18][l * DM + k];
        const bf16_t hi = f2bf(v), lo = f2bf(v - bf2f(hi));
        bf16_t* w = (bf16_t*)(ws + WS_WR) + ((size_t)l * 128 + n) * 3072 + k;
        w[0] = hi; w[1024] = hi; w[2048] = lo;
    }
    for (int i = gtid; i < S * 16; i += gsz) {
        const int pos = i >> 4, f = i & 15;
        double inv = 1.0; for (int k = 0; k < f; ++k) inv *= 0.5623413251903491;
        const double rev = (double)pos * inv * 0.15915494309189535;
        const float fr = (float)(rev - __builtin_rint(rev));
        ((float*)(ws + WS_ROPE))[i] = __builtin_amdgcn_cosf(fr);
        ((float*)(ws + WS_ROPE))[S * 16 + i] = __builtin_amdgcn_sinf(fr);
    }
    if (gtid < NL) {
        const int l = gtid; float* sc = (float*)(ws + WS_SCAL) + 16 * l;
        const float* lv = p.in[5] + l * 256;
        float d1 = 0.f, d2 = 0.f; for (int i = 0; i < 64; ++i) { d1 += lv[i] * lv[64 + i]; d2 += lv[128 + i] * lv[192 + i]; }
        const float lam_init = 0.8f - 0.6f * expf(-0.3f * (float)l);
        sc[0] = expf(d1) - expf(d2) + lam_init; sc[1] = 1.f - lam_init;
        float gq = 0.f, gk = 0.f; for (int i = 0; i < 64; ++i) { gq = fmaxf(gq, fabsf(p.in[3][l * 64 + i])); gk = fmaxf(gk, fabsf(p.in[4][l * 64 + i])); }
        sc[2] = gq * gk * 8.f * LOG2E * 1.02f;
        float a = 0.f, bq = 0.f, c = 0.f, dk = 0.f;
        for (int i = 0; i < 64; ++i) { a = fmaxf(a, fabsf(p.in[11][l * 64 + i])); c = fmaxf(c, fabsf(p.in[13][l * 64 + i])); }
        for (int i = 0; i < 32; ++i) { bq = fmaxf(bq, fabsf(p.in[12][l * 32 + i])); dk = fmaxf(dk, fabsf(p.in[14][l * 32 + i])); }
        sc[3] = sqrtf(64.f * a * a + 32.f * bq * bq) * sqrtf(64.f * c * c + 32.f * dk * dk) * QSCALE_M * 1.02f;
    }
    {
        const int lane = tid & 63, gw = gtid >> 6, nw = gsz >> 6;
        for (int t = gw; t < T; t += nw) row_prep(p.in[0] + (size_t)t * DM, (bf16_t*)(ws + WS_XB) + (size_t)t * DM, (float*)(ws + WS_RSTD1) + t, lane);
    }
}

struct MkProj { int mt, pn, l; const Params* p; __device__ __forceinline__ EpiProj operator()(int half) const { return EpiProj{mt, 2 * pn + half, l, p}; } };
__device__ __forceinline__ void ph_gemm1(LAS uchar* lds, const Params& p, int l) {
    const bf16_t* xb = (const bf16_t*)(p.ws + WS_XB); const bf16_t* win = (const bf16_t*)(p.ws + WS_WIN) + (size_t)l * NINP * DM;
    if (SHADOW_G >= 0) for (int u0 = blockIdx.x; u0 < 512; u0 += gridDim.x) {
        const int xg = u0 & 7, v = u0 >> 3, mt = (v >> 3) * 8 + xg, pn = v & 7;
        MkProj mk{mt, pn, l, &p};
        { const int tp = tid_opaque(); if (tp < 256) ((LAS float*)(lds + LDS_ROW))[tp] = ((const float*)(p.ws + WS_RSTD1))[mt * 256 + tp]; }
        gemm_big<(SHADOW_G >= 0 ? SHADOW_G : 0)>(lds, ARowLinear{xb + (size_t)mt * 256 * DM, (size_t)DM}, win + (size_t)pn * 256 * DM, (size_t)DM, DM, mk);
    }
    for (int u0 = blockIdx.x; u0 < 64 * 8; u0 += gridDim.x) {
        const int xg = u0 & 7, v = u0 >> 3, mt = (v >> 3) * 8 + xg, pn = v & 7;
        MkProj mk{mt, pn, l, &p};
        { const int tp = tid_opaque(); if (tp < 256) ((LAS float*)(lds + LDS_ROW))[tp] = ((const float*)(p.ws + WS_RSTD1))[mt * 256 + tp]; }
        gemm_big(lds, ARowLinear{xb + (size_t)mt * 256 * DM, (size_t)DM}, win + (size_t)pn * 256 * DM, (size_t)DM, DM, mk);
    }
}
__device__ __forceinline__ void gemm1_tail_unit(LAS uchar* lds, const Params& p, int l, int mt) {
    const bf16_t* xb = (const bf16_t*)(p.ws + WS_XB); const bf16_t* win = (const bf16_t*)(p.ws + WS_WIN) + (size_t)l * NINP * DM;
    ARowLinear ar{xb + (size_t)mt * 256 * DM, (size_t)DM};
    EpiProj ep{mt, 16, l, &p};
    { const int tp = tid_opaque(); if (tp < 256) ((LAS float*)(lds + LDS_ROW))[tp] = ((const float*)(p.ws + WS_RSTD1))[mt * 256 + tp]; }
    gemm_tile(lds, ar, win + (size_t)16 * 128 * DM, (size_t)DM, DM, ep);
}
template <int HALF>
__device__ __forceinline__ void pool_rows(const float (&v)[48], int sfirst, bf16_t* dst) {
    float run = 0.f;
#pragma unroll
    for (int i = 8 - HALF; i < 8 + HALF; ++i) run += v[i];
#pragma unroll
    for (int r = 0; r < 32; ++r) {
        const int s = sfirst + r; int lo = s - HALF, hi = s + HALF - 1; lo = lo < 0 ? 0 : lo; hi = hi > S - 1 ? S - 1 : hi;
        const float o = run * __builtin_amdgcn_rcpf((float)(hi - lo + 1)) - v[r + 8];
        dst[(size_t)r * DM] = f2bf(o);
        if (r < 31) run += v[r + 8 + HALF] - v[r + 8 - HALF];
    }
}
__device__ __forceinline__ void pooled_unit(LAS uchar* lds, const Params& p, int ut) {
    const int tid = tid_opaque();
    const int t0 = ut * 64, b = t0 >> 11, s0 = t0 & 2047;
    const bf16_t* lat = (const bf16_t*)(p.ws + WS_LAT) + (size_t)b * S * 640 + 352;
    for (int it = 0; it < 5; ++it) {
        const int item = it * NT + tid, c8 = item & 31, rl = item >> 5, sr = s0 - 8 + rl;
        u32x4 v = {0u, 0u, 0u, 0u};
        if (sr >= 0 && sr < S) v = *(const u32x4*)(lat + (size_t)sr * 640 + c8 * 8);
        *(LAS u32x4*)(lds + rl * 512 + c8 * 16) = v;
    }
    __syncthreads();
    {
        const int c = tid & 255, rh = tid >> 8, g = __builtin_amdgcn_readfirstlane(c >> 6);
        bf16_t* dst = (bf16_t*)(p.ws + WS_MIX) + (size_t)(t0 + rh * 32) * DM + 768 + c;
        const LAS bf16_t* col = (const LAS bf16_t*)lds + (rh * 32) * 256 + c;
        float v[48];
#pragma unroll
        for (int i = 0; i < 48; ++i) v[i] = bf2f(col[i * 256]);
        const int sfirst = s0 + rh * 32;
        if (g == 0) pool_rows<1>(v, sfirst, dst); else if (g == 1) pool_rows<2>(v, sfirst, dst); else if (g == 2) pool_rows<4>(v, sfirst, dst); else pool_rows<8>(v, sfirst, dst);
    }
    __syncthreads();
}
__device__ __forceinline__ void mla_up_unit(LAS uchar* lds, const Params& p, int l, int v) {
    const bf16_t* lat = (const bf16_t*)(p.ws + WS_LAT);
    const int mt = v >> 3, w = v & 7, h = w & 3;
    { const int tp = tid_opaque(); if (tp < 256) { const float* hs = (const float*)(p.ws + WS_HSS) + (size_t)(mt * 256 + tp) * 8;
        const f32x4 h0 = *(const f32x4*)hs; const float h4 = hs[4];
        ((LAS float*)(lds + LDS_ROW))[tp] = (w < 4) ? __builtin_amdgcn_rsqf((h0[0] + h0[1] + h0[2]) * (1.f / 192.f) + EPS) : __builtin_amdgcn_rsqf((h0[3] + h4) * (1.f / 128.f) + EPS); } }
    if (w < 4) { ARowLinear ar{lat + (size_t)mt * 256 * 640, (size_t)640}; EpiMlaQ ep{mt, h, l, &p};
        gemm_tile(lds, ar, (const bf16_t*)(p.ws + WS_WUQ) + ((size_t)l * 512 + h * 128) * 192, (size_t)192, 192, ep); }
    else { ARowLinear ar{lat + (size_t)mt * 256 * 640 + 192, (size_t)640}; EpiMlaKV ep{mt, h, l, &p};
        gemm_tile(lds, ar, (const bf16_t*)(p.ws + WS_WUKV) + ((size_t)l * 512 + h * 128) * 128, (size_t)128, 128, ep); }
}
__device__ __forceinline__ void ph_mix_a(LAS uchar* lds, const Params& p, int l) {
    const int G = (int)gridDim.x;
    if (G == 256) {
        const int xg = blockIdx.x & 7, j = blockIdx.x >> 3;
        if (SHADOW_V >= 0) { diff_attn_unit<(SHADOW_V >= 0 ? SHADOW_V : 0)>(lds, p, l, xg, 2 + (j >> 4), j & 15); }
        diff_attn_unit<0>(lds, p, l, xg, 2 + (j >> 4), j & 15);
        if (j < 16) diff_attn_unit<0>(lds, p, l, xg, 1, j);
        else {
            diff_attn_unit<0>(lds, p, l, xg, 0, j - 16);
            if (j < 24) gemm1_tail_unit(lds, p, l, xg + 8 * (j - 16));
            const int n0 = j < 24 ? (j - 16) * 2 : 16 + (j - 24) * 6, n1 = j < 24 ? n0 + 2 : n0 + 6;
            for (int n = n0; n < n1; ++n) mla_up_unit(lds, p, l, (xg + 8 * (n >> 3)) * 8 + (n & 7));
        }
    } else {
        for (int u = blockIdx.x; u < 512 + 512 + 64; u += G) {
            if (u < 512) diff_attn_unit<0>(lds, p, l, u >> 6, (u >> 4) & 3, u & 15);
            else if (u < 1024) mla_up_unit(lds, p, l, u - 512);
            else gemm1_tail_unit(lds, p, l, u - 1024);
        }
    }
}
__device__ __forceinline__ void ph_mix_b(LAS uchar* lds, const Params& p, int l) {
    (void)l;
    for (int u = blockIdx.x; u < 256 + 256; u += gridDim.x) {
        if (u < 256) mla_attn_unit(lds, p, l, u);
        else pooled_unit(lds, p, u - 256);
    }
}
struct MkWout { int mt, pn; const float* xres; const Params* p; __device__ __forceinline__ EpiWout operator()(int half) const { return EpiWout{mt, 2 * pn + half, xres, p}; } };
__device__ __forceinline__ void ph_wout(LAS uchar* lds, const Params& p, int l) {
    const bf16_t* mix = (const bf16_t*)(p.ws + WS_MIX); const bf16_t* wo = (const bf16_t*)(p.ws + WS_WOUT) + (size_t)l * DM * DM;
    const float* xres = (l == 0) ? p.in[0] : p.out;
    for (int u0 = blockIdx.x; u0 < 64 * 4; u0 += gridDim.x) {
        const int xg = u0 & 7, v = u0 >> 3, mt = (v >> 2) * 8 + xg, pn = v & 3;
        MkWout mk{mt, pn, xres, &p};
        gemm_big(lds, ARowLinear{mix + (size_t)mt * 256 * DM, (size_t)DM}, wo + (size_t)pn * 256 * DM, (size_t)DM, DM, mk);
    }
}
constexpr int LDS_RT = 135168;
struct EpiRouter {
    int mt, l; bool dry; const Params* p;
    __device__ __forceinline__ void operator()(const LAS uchar* ct) const {
        uchar* ws = p->ws; const int tid = tid_opaque();
        const LAS float* ctf = (const LAS float*)ct;
        LAS unsigned* shcnt = (LAS unsigned*)(ct + LDS_RT); LAS unsigned* shbase = shcnt + 32; LAS unsigned* pend = shcnt + 64;
        unsigned* cnt = (unsigned*)(ws + WS_CTL) + CW_CNT + 1024 * l + (dry ? 2048 : 0);
        unsigned* list = (unsigned*)(ws + (dry ? WS_POOLED : WS_LIST)); float* gwt = (float*)(ws + (dry ? WS_POOLED + 4 * MiB : WS_GW)); float* rstd2 = (float*)(ws + (dry ? WS_POOLED + 5 * MiB : WS_RSTD2));
        const float* bg = p->in[20] + l * 4; const float* be = p->in[22] + l * 32;
        if (tid < 32) shcnt[tid] = 0u;
        __syncthreads();
        if (tid < 256) {
            const int t = mt * 256 + tid;
            const float* ps = (const float*)(ws + WS_PSS) + (size_t)t * 8;
            const f32x4 p0 = *(const f32x4*)ps, p1 = *(const f32x4*)(ps + 4);
            const float ss = ((p0[0] + p0[1]) + (p0[2] + p0[3])) + ((p1[0] + p1[1]) + (p1[2] + p1[3]));
            const float rs = __builtin_amdgcn_rsqf(ss * (1.f / 1024.f) + EPS);
            const LAS float* row = ctf + tid * CTF_PITCH;
            float gl[4];
#pragma unroll
            for (int n = 0; n < 4; ++n) gl[n] = row[n] * rs + bg[n];
            int gi = 0; float gm = gl[0];
#pragma unroll
            for (int n = 1; n < 4; ++n) if (gl[n] > gm) { gm = gl[n]; gi = n; }
            float gs = 0.f;
#pragma unroll
            for (int n = 0; n < 4; ++n) gs += __expf(gl[n] - gm);
            const float gtop = 1.f / gs;
            float el[8];
#pragma unroll
            for (int n = 0; n < 8; ++n) el[n] = row[4 + gi * 8 + n] * rs + be[gi * 8 + n];
            int i1 = 0; float m1 = el[0];
#pragma unroll
            for (int n = 1; n < 8; ++n) if (el[n] > m1) { m1 = el[n]; i1 = n; }
            int i2 = -1; float m2v = -3.0e38f;
#pragma unroll
            for (int n = 0; n < 8; ++n) if (n != i1 && el[n] > m2v) { m2v = el[n]; i2 = n; }
            const float e2 = __expf(m2v - m1); const float w1 = gtop / (1.f + e2), w2 = gtop * e2 / (1.f + e2);
            const int ea = gi * 8 + i1, eb = gi * 8 + i2;
            const unsigned pa = __hip_atomic_fetch_add(&shcnt[ea], 1u, __ATOMIC_RELAXED, __HIP_MEMORY_SCOPE_WORKGROUP);
            const unsigned pbk = __hip_atomic_fetch_add(&shcnt[eb], 1u, __ATOMIC_RELAXED, __HIP_MEMORY_SCOPE_WORKGROUP);
            pend[tid * 2] = ((unsigned)ea << 16) | pa; pend[tid * 2 + 1] = ((unsigned)eb << 16) | pbk;
            gwt[t * 2] = w1; gwt[t * 2 + 1] = w2; rstd2[t] = rs;
        }
        __syncthreads();
        if (tid < 32) { const unsigned c = shcnt[tid]; shbase[tid] = c ? atomicAdd(&cnt[tid * 32], c) : 0u; }
        __syncthreads();
        { const unsigned pe = pend[tid], e = pe >> 16, lp = pe & 0xffffu; list[(size_t)e * T + shbase[e] + lp] = (unsigned)((mt * 256 + (tid >> 1)) * 2 + (tid & 1)); }
    }
};
__device__ __forceinline__ void ph_router(LAS uchar* lds, const Params& p, int l, bool dry = false) {
    const bf16_t* xb = (const bf16_t*)(p.ws + WS_XB); const bf16_t* wr = (const bf16_t*)(p.ws + WS_WR) + (size_t)l * 128 * 3072;
    for (int u = blockIdx.x; u < 64; u += gridDim.x) {
        ARowLinear ar{xb + (size_t)u * 256 * DM, (size_t)DM}; EpiRouter ep{u, l, dry, &p};
        AOffRouter ao{(int)((WS_XL - WS_XB) / 2)};
        gemm_tile<true>(lds, ar, wr, (size_t)3072, 3072, ep, ao);
    }
    if (!dry) expert_weights(lds, p, l);
}
__device__ __forceinline__ void moe_find(const unsigned* cnt, int rbg, int& e, int& rb, int& nvalid, int& pre) {
    int acc = 0; e = -1; rb = 0; nvalid = 0; pre = 0;
    for (int i = 0; i < 32; ++i) { const int c = (int)cnt[i * 32], nb = (c + 255) >> 8;
        if (e < 0 && rbg < acc + nb) { e = i; rb = rbg - acc; nvalid = c - rb * 256; if (nvalid > 256) nvalid = 256; pre = acc; }
        acc += nb; }
}
__device__ __forceinline__ int moe_total(const unsigned* cnt) { int acc = 0; for (int i = 0; i < 32; ++i) acc += ((int)cnt[i * 32] + 255) >> 8; return acc; }
struct MkGU { int pn; size_t slot0; const Params* p; __device__ __forceinline__ EpiGU operator()(int half) const { return EpiGU{2 * pn + half, slot0, p}; } };
__device__ __forceinline__ void ph_gateup(LAS uchar* lds, const Params& p, int l) {
    uchar* ws = p.ws; const unsigned* cnt = (const unsigned*)(ws + WS_CTL) + CW_CNT + 1024 * l;
    int nfull = 0, npart = 0;
    for (int i = 0; i < 32; ++i) { const int c = (int)cnt[i * 32]; nfull += c >> 8; npart += (c & 255) ? 1 : 0; }
    const int tot = nfull * 2 + npart * 4;
    for (int u = blockIdx.x; u < tot; u += gridDim.x) {
        const bool big = u < nfull * 2;
        const int want = big ? (u >> 1) : ((u - nfull * 2) >> 2);
        int e = 0, rb = 0, rbg = 0, nvalid = 256;
        { int accf = 0, accp = 0, accb = 0; bool found = false;
          for (int i = 0; i < 32; ++i) { const int c = (int)cnt[i * 32], f = c >> 8, pr = (c & 255) ? 1 : 0;
              if (!found) { if (big) { if (want < accf + f) { e = i; rb = want - accf; rbg = accb + rb; nvalid = 256; found = true; } }
                            else { if (pr && want == accp) { e = i; rb = f; rbg = accb + f; nvalid = c & 255; found = true; } } }
              accf += f; accp += pr; accb += f + pr; } }
        const unsigned* list = (const unsigned*)(ws + WS_LIST) + (size_t)e * T + rb * 256;
        ARowGather ar{(const bf16_t*)(ws + WS_XB), list, nvalid};
        { const int tp = tid_opaque(); if (tp < 256) { const int rr = tp < nvalid ? tp : nvalid - 1; ((LAS float*)(lds + LDS_ROW))[tp] = ((const float*)(ws + WS_RSTD2))[list[rr] >> 1]; } }
        if (big) { const int pn = u & 1; MkGU mk{pn, (size_t)rbg * 256, &p};
            gemm_big(lds, ar, (const bf16_t*)(ws + WS_WGU) + ((size_t)e * 512 + pn * 256) * DM, (size_t)DM, DM, mk); }
        else { const int jt = (u - nfull * 2) & 3; EpiGU ep{jt, (size_t)rbg * 256, &p};
            gemm_tile(lds, ar, (const bf16_t*)(ws + WS_WGU) + ((size_t)e * 512 + jt * 128) * DM, (size_t)DM, DM, ep); }
    }
}
struct MkDown { int pn, nvalid; const Params* p; __device__ __forceinline__ EpiDown operator()(int half) const { return EpiDown{2 * pn + half, nvalid, p}; } };
__device__ __forceinline__ void ph_down(LAS uchar* lds, const Params& p, int l) {
    uchar* ws = p.ws; const unsigned* cnt = (const unsigned*)(ws + WS_CTL) + CW_CNT + 1024 * l;
    int nfull = 0, npart = 0;
    for (int i = 0; i < 32; ++i) { const int c = (int)cnt[i * 32]; nfull += c >> 8; npart += (c & 255) ? 1 : 0; }
    const int tot = nfull * 4 + npart * 8;
    for (int u = blockIdx.x; u < tot; u += gridDim.x) {
        const bool big = u < nfull * 4;
        const int want = big ? (u >> 2) : ((u - nfull * 4) >> 3);
        int e = 0, rb = 0, rbg = 0, nvalid = 256;
        { int accf = 0, accp = 0, accb = 0; bool found = false;
          for (int i = 0; i < 32; ++i) { const int c = (int)cnt[i * 32], f = c >> 8, pr = (c & 255) ? 1 : 0;
              if (!found) { if (big) { if (want < accf + f) { e = i; rb = want - accf; rbg = accb + rb; nvalid = 256; found = true; } }
                            else { if (pr && want == accp) { e = i; rb = f; rbg = accb + f; nvalid = c & 255; found = true; } } }
              accf += f; accp += pr; accb += f + pr; } }
        const unsigned* list = (const unsigned*)(ws + WS_LIST) + (size_t)e * T + rb * 256;
        ARowLinear ar{(const bf16_t*)(ws + WS_HMID) + (size_t)rbg * 256 * 256, (size_t)256};
        { const int tp = tid_opaque(); if (tp < 256) { const int rr = tp < nvalid ? tp : nvalid - 1; const unsigned ent = list[rr];
            ((LAS unsigned*)(lds + LDS_ROW + 1024))[tp] = ent; ((LAS float*)(lds + LDS_ROW))[tp] = ((const float*)(ws + WS_GW))[ent]; } }
        if (big) { const int pn = u & 3; MkDown mk{pn, nvalid, &p};
            gemm_big(lds, ar, (const bf16_t*)(ws + WS_WD) + ((size_t)e * DM + pn * 256) * 256, (size_t)256, 256, mk); }
        else { const int nt = (u - nfull * 4) & 7; EpiDown ep{nt, nvalid, &p};
            gemm_tile(lds, ar, (const bf16_t*)(ws + WS_WD) + ((size_t)e * DM + nt * 128) * 256, (size_t)256, 256, ep); }
    }
}
__device__ __forceinline__ void ph_combine(LAS uchar* lds, const Params& p, int l, bool dry = false) {
    uchar* ws = p.ws; const int tid = tid_opaque(), lane = tid & 63;
    const int gw = blockIdx.x * 8 + (tid >> 6), nw = gridDim.x * 8;
    const bf16_t* ys = (const bf16_t*)(ws + WS_YS);
    for (int t = gw; t < T; t += nw) {
        const float* xr = p.out + (size_t)t * DM; const bf16_t* y0 = ys + (size_t)(2 * t) * DM; const bf16_t* y1 = y0 + DM;
        float* xw = dry ? (float*)(ws + WS_POOLED) + (size_t)(t & 511) * DM : p.out + (size_t)t * DM;
        bf16_t* xb = dry ? (bf16_t*)(ws + WS_POOLED + 4 * MiB) + (size_t)(t & 511) * DM : (bf16_t*)(ws + WS_XB) + (size_t)t * DM;
        float ss = 0.f;
#pragma unroll
        for (int i = 0; i < 4; ++i) {
            const int c = i * 256 + lane * 4;
            f32x4 v = *(const f32x4*)(xr + c); const u32x2 a = *(const u32x2*)(y0 + c), bq = *(const u32x2*)(y1 + c);
            v[0] += bflo(a[0]) + bflo(bq[0]); v[1] += bfhi(a[0]) + bfhi(bq[0]); v[2] += bflo(a[1]) + bflo(bq[1]); v[3] += bfhi(a[1]) + bfhi(bq[1]);
            *(f32x4*)(xw + c) = v; ss += v[0] * v[0] + v[1] * v[1] + v[2] * v[2] + v[3] * v[3];
            u32x2 o; o[0] = pk2(v[0], v[1]); o[1] = pk2(v[2], v[3]); *(u32x2*)(xb + c) = o;
        }
        ss = wave_sum(ss);
        if (lane == 0) ((float*)(ws + (dry ? WS_POOLED + 6 * MiB : WS_RSTD1)))[t] = __builtin_amdgcn_rsqf(ss * (1.f / 1024.f) + EPS);
    }

}

__global__ void __launch_bounds__(NT, 2) mega(Params p) {
    extern __shared__ __attribute__((aligned(16))) unsigned char smem[];
    LAS uchar* lds = (LAS uchar*)smem;
    if (threadIdx.x == 0) { *(LAS u32x4*)(lds + LDS_XB) = (u32x4){0u, 0u, 0u, 0u}; }
    __syncthreads();
    XcdBarrier bar = xcd_barrier_post((unsigned*)(p.ws + WS_CTL), (volatile LAS unsigned*)(lds + LDS_XB));
#define IN(k) (p.ph_lo <= (k) && (k) < p.ph_hi)
#define SEAM(k) do { if (IN(k) && IN((k) + 1)) xcd_barrier(bar); } while (0)
    if (IN(0)) for (int rep = 0; rep < NREP(8); ++rep) phase0(lds, p);
    SEAM(0);
#define LAUNDER(v) asm volatile("" : "+s"(v))
#pragma unroll 1
    for (int l0 = 0; l0 < NL; ++l0) {
        const int pb = 1 + 8 * l0;
        { int l = l0; LAUNDER(l); if (IN(pb + 0)) for (int rep = 0; rep < NREP(0); ++rep) ph_gemm1(lds, p, l); }
        SEAM(pb + 0);
        { int l = l0; LAUNDER(l); if (IN(pb + 1)) for (int rep = 0; rep < NREP(1); ++rep) ph_mix_a(lds, p, l); }
        SEAM(pb + 1);
        { int l = l0; LAUNDER(l); if (IN(pb + 2)) for (int rep = 0; rep < NREP(2); ++rep) ph_mix_b(lds, p, l); }
        SEAM(pb + 2);
        { int l = l0; LAUNDER(l); if (IN(pb + 3)) for (int rep = 0; rep < (l == 0 ? NREP(3) : 1); ++rep) ph_wout(lds, p, l); }
        SEAM(pb + 3);
        { int l = l0; LAUNDER(l); if (IN(pb + 4)) { if (NREP(4) > 1) ph_router(lds, p, l, true); ph_router(lds, p, l); } }
        SEAM(pb + 4);
        { int l = l0; LAUNDER(l); if (IN(pb + 5)) for (int rep = 0; rep < NREP(5); ++rep) ph_gateup(lds, p, l); }
        SEAM(pb + 5);
        { int l = l0; LAUNDER(l); if (IN(pb + 6)) for (int rep = 0; rep < NREP(6); ++rep) ph_down(lds, p, l); }
        SEAM(pb + 6);
        { int l = l0; LAUNDER(l); if (IN(pb + 7)) { if (NREP(7) > 1) ph_combine(lds, p, l, true); ph_combine(lds, p, l); } }
        SEAM(pb + 7);
    }
}

extern "C" void kernel_launch(void* const* d_in, const int* in_sizes, int n_in, void* d_out, int out_size, void* d_ws, size_t ws_size, hipStream_t stream) {
    (void)in_sizes; (void)n_in; (void)out_size;
    static int grid = 0;
    if (!grid) {
        int dev = 0, cus = 0, per_cu = 0;
        hipGetDevice(&dev);
        hipDeviceGetAttribute(&cus, hipDeviceAttributeMultiprocessorCount, dev);
        hipFuncSetAttribute((const void*)mega, hipFuncAttributeMaxDynamicSharedMemorySize, LDS_BYTES);
        hipOccupancyMaxActiveBlocksPerMultiprocessor(&per_cu, (const void*)mega, NT, LDS_BYTES);
        if (per_cu > 1) per_cu = 1;
        if (per_cu < 1) per_cu = 1;
        grid = cus * per_cu;
    }
    if (ws_size < WS_END) { fprintf(stderr, "workspace too small: %zu < %zu\n", ws_size, (size_t)WS_END); return; }
    hipMemsetAsync(d_ws, 0, CTL_ZERO_BYTES, stream);
    Params p{};
    for (int i = 0; i < 26; ++i) p.in[i] = (const float*)d_in[i];
    p.out = (float*)d_out; p.ws = (unsigned char*)d_ws;
#if N_LAUNCH_SPLIT
    for (int k = 0; k < NPH; ++k) { p.ph_lo = k; p.ph_hi = k + 1; hipLaunchKernelGGL(mega, dim3(grid), dim3(NT), LDS_BYTES, stream, p); }
#else
    p.ph_lo = 0; p.ph_hi = NPH;
    hipLaunchKernelGGL(mega, dim3(grid), dim3(NT), LDS_BYTES, stream, p);
#endif
}
```

```cpp
#include <hip/hip_runtime.h>
#include <stdint.h>
#include <stdio.h>

#ifndef NAIVE_GEMM
#define NAIVE_GEMM 0
#endif
#ifndef NAIVE_ATTN
#define NAIVE_ATTN 0
#endif
#ifndef N_LAUNCH_SPLIT
#define N_LAUNCH_SPLIT 0
#endif

#ifndef SHADOW_V
#define SHADOW_V -1
#endif
#ifndef SHADOW_G
#define SHADOW_G -1
#endif
#ifndef REPEAT_MASK
#define REPEAT_MASK 0
#endif
#define NREP(k) ((((REPEAT_MASK) >> (k)) & 1) + 1)
#define LAS __attribute__((address_space(3)))
typedef unsigned char uchar;
typedef unsigned short bf16_t;
typedef short bf16x8 __attribute__((ext_vector_type(8)));
typedef float f32x16 __attribute__((ext_vector_type(16)));
typedef float f32x2_t __attribute__((ext_vector_type(2)));
typedef __bf16 bf16x2_t __attribute__((ext_vector_type(2)));
typedef unsigned u32x4 __attribute__((ext_vector_type(4)));
typedef unsigned u32x2 __attribute__((ext_vector_type(2)));
typedef float f32x4 __attribute__((ext_vector_type(4)));

constexpr int NB = 8, S = 2048, DM = 1024, T = NB * S, NL = 2;
constexpr int NIN = 2144, NINP = 2176;
constexpr float EPS = 1e-6f, LOG2E = 1.4426950408889634f;
constexpr float QSCALE_D = 0.125f * LOG2E;
constexpr float QSCALE_M = 0.10206207261596577f * LOG2E;
constexpr int NPH = 1 + 8 * NL;

constexpr size_t MiB = (size_t)1 << 20;
constexpr size_t WS_CTL = 0, CTL_ZERO_BYTES = 32768;
constexpr size_t WS_SCAL = 1 * MiB;
constexpr size_t WS_ROPE = 1 * MiB + 64 * 1024;
constexpr size_t WS_RSTD1 = 1 * MiB + 512 * 1024;
constexpr size_t WS_RSTD2 = WS_RSTD1 + 64 * 1024;
constexpr size_t WS_GW = WS_RSTD2 + 64 * 1024;
constexpr size_t WS_LIST = 2 * MiB;
constexpr size_t WS_WIN = 4 * MiB;
constexpr size_t WS_WOUT = 13 * MiB;
constexpr size_t WS_WUQ = 17 * MiB;
constexpr size_t WS_WUKV = 17 * MiB + 512 * 1024;
constexpr size_t WS_POOLW = 17 * MiB + 768 * 1024;
constexpr size_t WS_WR = 18 * MiB;
constexpr size_t WS_PSS = 19 * MiB + 512 * 1024;
constexpr size_t WS_HSS = 12 * MiB + 512 * 1024;
constexpr size_t WS_WGU = 20 * MiB;
constexpr size_t WS_WD = 52 * MiB;
constexpr size_t WS_XB = 68 * MiB;
constexpr size_t WS_MIX = 100 * MiB;
constexpr size_t WS_HMID = WS_MIX;
constexpr size_t WS_QD = 132 * MiB, WS_KD = 148 * MiB, WS_VDT = 164 * MiB;
constexpr size_t WS_LAT = 180 * MiB;
constexpr size_t WS_QM = 200 * MiB, WS_KM = 212 * MiB, WS_VMT = 224 * MiB;
constexpr size_t WS_POOLED = 232 * MiB;
constexpr size_t WS_XL = 200 * MiB;
constexpr size_t WS_YS = 132 * MiB;
constexpr size_t WS_END = 240 * MiB;

#define XB_TMO      128
#define XB_XCNT(j)  (256  + 64 * (j))
#define XB_XSUB(j)  (1280 + 64 * (j))
#define XB_XGEN(j)  (2304 + 64 * (j))
#define XB_TOP      3328
#define XB_TOPGEN   3392
#define XCD_BAR_WORDS 3456
#define XB_SPIN_CAP (1u << 18)
constexpr int CW_CNT = 4096;

constexpr int NT = 512;
constexpr int LDS_XB = 147456;
constexpr int LDS_ROW = LDS_XB + 256;
constexpr int LDS_BYTES = LDS_ROW + 2048;
constexpr int GSTG = 49152;
constexpr int ASTG = 32768;
constexpr int MSTG = 20480;

struct Params {
    const float* in[26];
    float* out;
    unsigned char* ws;
    int ph_lo, ph_hi;
};

__device__ __forceinline__ unsigned pk2(float lo, float hi) { f32x2_t v = {lo, hi}; bf16x2_t b = __builtin_convertvector(v, bf16x2_t); return __builtin_bit_cast(unsigned, b); }
__device__ __forceinline__ float bflo(unsigned w) { return __builtin_bit_cast(float, w << 16); }
__device__ __forceinline__ float bfhi(unsigned w) { return __builtin_bit_cast(float, w & 0xffff0000u); }
__device__ __forceinline__ float bf2f(bf16_t u) { return __builtin_bit_cast(float, (unsigned)u << 16); }
__device__ __forceinline__ bf16_t f2bf(float f) { return (bf16_t)(pk2(f, 0.f) & 0xffffu); }
__device__ __forceinline__ LAS uchar* lds_base() { extern __shared__ __attribute__((aligned(16))) unsigned char smem_dyn_[]; return (LAS uchar*)smem_dyn_; }
__device__ __forceinline__ int tid_opaque() { int t = threadIdx.x; asm volatile("" : "+v"(t)); return t; }
__device__ __forceinline__ int crow(int r, int hi) { return (r & 3) + 8 * (r >> 2) + 4 * hi; }
__device__ __forceinline__ int sigma16(int s) { return (s & ~12) | ((s & 4) << 1) | ((s & 8) >> 1); }
__device__ __forceinline__ float wave_sum(float v) {
#pragma unroll
    for (int o = 32; o >= 1; o >>= 1) v += __shfl_xor(v, o);
    return v;
}
__device__ __forceinline__ void unpack8(u32x4 w, float (&f)[8]) {
    f[0] = bflo(w[0]); f[1] = bfhi(w[0]); f[2] = bflo(w[1]); f[3] = bfhi(w[1]);
    f[4] = bflo(w[2]); f[5] = bfhi(w[2]); f[6] = bflo(w[3]); f[7] = bfhi(w[3]);
}

__device__ __forceinline__ unsigned xb_ld(unsigned* p)              { return __hip_atomic_load(p, __ATOMIC_RELAXED, __HIP_MEMORY_SCOPE_AGENT); }
__device__ __forceinline__ unsigned xb_add(unsigned* p, unsigned v) { return __hip_atomic_fetch_add(p, v, __ATOMIC_RELAXED, __HIP_MEMORY_SCOPE_AGENT); }
__device__ __forceinline__ unsigned xb_xcc_id() { return (unsigned)__builtin_amdgcn_s_getreg((3 << 11) | 20) & 0xFu; }
#define XB_SPIN(cond, bar) do { unsigned _sp = 0; while (cond) { __builtin_amdgcn_s_sleep(1); \
    if ((++_sp & 255u) == 0u) { if (xb_ld(&(bar)[XB_TMO])) break; if (_sp > XB_SPIN_CAP) { atomicAdd(&(bar)[XB_TMO], 1u); break; } } } } while (0)
struct XcdBarrier { unsigned* bar; unsigned x; volatile LAS unsigned* st; };
__device__ __forceinline__ XcdBarrier xcd_barrier_post(unsigned* bar, volatile LAS unsigned* st) {
    XcdBarrier b; b.bar = bar; b.x = xb_xcc_id(); b.st = st;
    if (threadIdx.x == 0) (void)xb_add(&bar[XB_XCNT(b.x)], 1u);
    return b;
}
__device__ __forceinline__ void xcd_barrier_complete(unsigned* bar, unsigned x, unsigned& nloc, unsigned& nx) {
    const unsigned G = gridDim.x * gridDim.y * gridDim.z;
    unsigned sum, cnt, mine, sp = 0u;
    for (;;) {
        sum = 0u; cnt = 0u; mine = 0u;
#pragma unroll
        for (unsigned j = 0; j < 16; ++j) { const unsigned c = xb_ld(&bar[XB_XCNT(j)]); sum += c; cnt += (c > 0u) ? 1u : 0u; mine = (j == x) ? c : mine; }
        if (sum == G) break;
        __builtin_amdgcn_s_sleep(1);
        if ((++sp & 255u) == 0u) { if (xb_ld(&bar[XB_TMO])) break; if (sp > XB_SPIN_CAP) { atomicAdd(&bar[XB_TMO], 1u); break; } }
    }
    nloc = mine > 0u ? mine : 1u; nx = cnt > 0u ? cnt : 1u;
}
__device__ __forceinline__ void xcd_barrier(const XcdBarrier& b) {
    asm volatile("s_waitcnt vmcnt(0)" ::: "memory");
    __syncthreads();
    if (threadIdx.x == 0) {
        unsigned* bar = b.bar;
        __builtin_amdgcn_s_waitcnt(0);
        unsigned nloc = b.st[0], nx = b.st[1];
        if (nloc == 0u) { xcd_barrier_complete(bar, b.x, nloc, nx); b.st[0] = nloc; b.st[1] = nx; }
        const unsigned old = xb_add(&bar[XB_XSUB(b.x)], 1u);
        const unsigned gen = old / nloc;
        if (old + 1u == (gen + 1u) * nloc) {
            __builtin_amdgcn_fence(__ATOMIC_RELEASE, "agent");
            asm volatile("s_waitcnt vmcnt(0)" ::: "memory");
            const unsigned og = xb_add(&bar[XB_TOP], 1u);
            const unsigned tg = og / nx;
            if (og + 1u == (tg + 1u) * nx) xb_add(&bar[XB_TOPGEN], 1u);
            else XB_SPIN(xb_ld(&bar[XB_TOPGEN]) == tg, bar);
            __builtin_amdgcn_fence(__ATOMIC_ACQUIRE, "agent");
            xb_add(&bar[XB_XGEN(b.x)], 1u);
            asm volatile("s_waitcnt vmcnt(0)" ::: "memory");
        } else {
            XB_SPIN(xb_ld(&bar[XB_XGEN(b.x)]) == gen, bar);
            __builtin_amdgcn_fence(__ATOMIC_ACQUIRE, "agent");
            asm volatile("s_waitcnt vmcnt(0)" ::: "memory");
        }
    }
    __syncthreads();
}

__device__ __forceinline__ void glds16(const void* gsrc, LAS uchar* dst_wave_base) {
    __builtin_amdgcn_global_load_lds((const unsigned*)gsrc, (LAS unsigned*)dst_wave_base, 16, 0, 0);
}
__device__ __forceinline__ int sw128(int row, int c) { return row * 128 + ((c ^ ((row >> 1) & 7)) << 4); }
__device__ __forceinline__ int sw64(int row, int c) { return row * 64 + ((c ^ ((row >> 2) & 3)) << 4); }

#define MFMA32(a, b, c) __builtin_amdgcn_mfma_f32_32x32x16_bf16((a), (b), (c), 0, 0, 0)

constexpr int CT_PITCH = 272;
#define WAITV(n) asm volatile("s_waitcnt vmcnt(" #n ")" ::: "memory")
struct ARowLinear { const bf16_t* base; size_t ld; __device__ __forceinline__ const bf16_t* operator()(int r) const { return base + (size_t)r * ld; } };
struct ARowGather { const bf16_t* base; const unsigned* list; int nvalid; __device__ __forceinline__ const bf16_t* operator()(int r) const {
    const int rr = r < nvalid ? r : nvalid - 1; const unsigned ent = list[rr]; return base + (size_t)(ent >> 1) * DM; } };

struct AOffLinear { __device__ __forceinline__ int operator()(int kt) const { return kt * 64; } };
struct AOffRouter { int xl_off; __device__ __forceinline__ int operator()(int kt) const { return (kt & 15) * 64 + ((kt >> 4) == 1 ? xl_off : 0); } };
constexpr int CTF_PITCH = 129;
template <bool F32C = false, class ARow, class Epi, class AOff = AOffLinear>
__device__ __forceinline__ void gemm_tile(LAS uchar* lds, const ARow& arow, const bf16_t* Bt, size_t ldb, int K, const Epi& epi, const AOff aoff = AOff()) {
    const int tid = tid_opaque(), lane = tid & 63, wid = __builtin_amdgcn_readfirstlane(tid >> 6);
#if NAIVE_GEMM
    {
        const int r = tid >> 1, nh = tid & 1;
        float acc[64];
#pragma unroll
        for (int n = 0; n < 64; ++n) acc[n] = 0.f;
        const bf16_t* ar = arow(r);
        for (int k = 0; k < K; k += 8) {
            float a[8]; unpack8(*(const u32x4*)(ar + k), a);
#pragma unroll
            for (int n = 0; n < 64; ++n) {
                float b[8]; unpack8(*(const u32x4*)(Bt + (size_t)(nh * 64 + n) * ldb + k), b);
#pragma unroll
                for (int j = 0; j < 8; ++j) acc[n] += a[j] * b[j];
            }
        }
        __syncthreads();
#pragma unroll
        for (int n = 0; n < 64; n += 2) { if (F32C) { ((LAS float*)lds)[r * CTF_PITCH + nh * 64 + n] = acc[n]; ((LAS float*)lds)[r * CTF_PITCH + nh * 64 + n + 1] = acc[n + 1]; } else *(LAS unsigned*)(lds + r * CT_PITCH + (nh * 64 + n) * 2) = pk2(acc[n], acc[n + 1]); }
    }
#else
    {
        const int wm = wid >> 1, wn = wid & 1, r = lane & 31, hh = lane >> 5;
        const int srow = lane >> 3, c0 = (lane & 7) ^ (srow >> 1);
        const bf16_t* asrc[4];
#pragma unroll
        for (int j = 0; j < 4; ++j) asrc[j] = arow(8 * (wid * 4 + j) + srow) + (c0 ^ ((j & 1) << 2)) * 8;
        const bf16_t* bsrc0 = Bt + (size_t)(wid * 16 + srow) * ldb + c0 * 8;
        const bf16_t* bsrc1 = Bt + (size_t)(wid * 16 + 8 + srow) * ldb + (c0 ^ 4) * 8;
        const int lanebase = r * 128 + ((hh ^ ((r >> 1) & 7)) << 4);
        f32x16 acc[2][2];
#pragma unroll
        for (int a = 0; a < 2; ++a)
#pragma unroll
            for (int b = 0; b < 2; ++b)
#pragma unroll
                for (int i = 0; i < 16; ++i) acc[a][b][i] = 0.f;
        const int nt = K >> 6;
#define GT_STAGE(kt, sb) do { _Pragma("unroll") for (int j = 0; j < 4; ++j) \
            glds16(asrc[j] + aoff(kt), lds + (sb) * GSTG + (wid * 4 + j) * 1024); \
            glds16(bsrc0 + (kt) * 64, lds + (sb) * GSTG + 32768 + (wid * 2) * 1024); \
            glds16(bsrc1 + (kt) * 64, lds + (sb) * GSTG + 32768 + (wid * 2 + 1) * 1024); } while (0)
        GT_STAGE(0, 0);
        if (nt > 1) GT_STAGE(1, 1);
        int sb = 0;
        for (int kt = 0; kt < nt; ++kt) {
            if (kt + 1 < nt) WAITV(6); else WAITV(0);
            __builtin_amdgcn_s_barrier();
            if (kt + 2 < nt) { const int sn = sb >= 1 ? sb - 1 : 2; GT_STAGE(kt + 2, sn); }
            const LAS uchar* xs = lds + sb * GSTG + wm * 8192; const LAS uchar* wsb = lds + sb * GSTG + 32768 + wn * 8192;
#pragma unroll
            for (int ks = 0; ks < 4; ++ks) {
                const int lb = lanebase ^ (ks << 5);
                bf16x8 xf[2], wf[2];
#pragma unroll
                for (int mb = 0; mb < 2; ++mb) xf[mb] = *(const LAS bf16x8*)(xs + mb * 4096 + lb);
#pragma unroll
                for (int nb = 0; nb < 2; ++nb) wf[nb] = *(const LAS bf16x8*)(wsb + nb * 4096 + lb);
#pragma unroll
                for (int nb = 0; nb < 2; ++nb)
#pragma unroll
                    for (int mb = 0; mb < 2; ++mb) acc[nb][mb] = MFMA32(wf[nb], xf[mb], acc[nb][mb]);
            }
            sb = sb == 2 ? 0 : sb + 1;
        }
#undef GT_STAGE
        __syncthreads();
#pragma unroll
        for (int nb = 0; nb < 2; ++nb)
#pragma unroll
            for (int mb = 0; mb < 2; ++mb) {
                const int m = 64 * wm + 32 * mb + r;
#pragma unroll
                for (int q4 = 0; q4 < 4; ++q4) {
                    const int n = 64 * wn + 32 * nb + 8 * q4 + 4 * hh;
                    if (F32C) {
#pragma unroll
                        for (int j = 0; j < 4; ++j) ((LAS float*)lds)[m * CTF_PITCH + n + j] = acc[nb][mb][4 * q4 + j];
                    } else {
                        u32x2 v; v[0] = pk2(acc[nb][mb][4 * q4], acc[nb][mb][4 * q4 + 1]); v[1] = pk2(acc[nb][mb][4 * q4 + 2], acc[nb][mb][4 * q4 + 3]);
                        *(LAS u32x2*)(lds + m * CT_PITCH + n * 2) = v;
                    }
                }
            }
    }
#endif
    __syncthreads();
    epi(lds);
    __syncthreads();
}
constexpr int BSTG = 32768, CT2_OFF = 256 * CT_PITCH;
template <int V = 0, class ARow, class EpiMaker>
__device__ __forceinline__ void gemm_big(LAS uchar* lds, const ARow& arow, const bf16_t* Bt, size_t ldb, int K, const EpiMaker& mk) {
    const int tid = tid_opaque(), lane = tid & 63, wid = __builtin_amdgcn_readfirstlane(tid >> 6);
    {
        const int wm = wid >> 2, wn = wid & 3, r = lane & 31, hh = lane >> 5;
        const int srow = lane >> 2, sc = (lane & 3) ^ ((lane >> 4) & 3);
        const bf16_t* a0 = arow(wid * 32 + srow) + sc * 8; const bf16_t* a1 = arow(wid * 32 + 16 + srow) + sc * 8;
        const bf16_t* b0 = Bt + (size_t)(wid * 32 + srow) * ldb + sc * 8; const bf16_t* b1 = b0 + (size_t)16 * ldb;
        const int lanebase = r * 64 + ((hh ^ ((r >> 2) & 3)) << 4);
        f32x16 acc[2][4];
#pragma unroll
        for (int a = 0; a < 2; ++a)
#pragma unroll
            for (int b = 0; b < 4; ++b)
#pragma unroll
                for (int i = 0; i < 16; ++i) acc[a][b][i] = 0.f;
        const int nt = K >> 5;
#define GB_STAGE(kt, sb) do { \
            glds16(a0 + (kt) * 32, lds + (sb) * BSTG + (wid * 2) * 1024); glds16(a1 + (kt) * 32, lds + (sb) * BSTG + (wid * 2 + 1) * 1024); \
            glds16(b0 + (kt) * 32, lds + (sb) * BSTG + 16384 + (wid * 2) * 1024); glds16(b1 + (kt) * 32, lds + (sb) * BSTG + 16384 + (wid * 2 + 1) * 1024); } while (0)
        if (!(V & 4)) { GB_STAGE(0, 0); GB_STAGE(1, 1); GB_STAGE(2, 2); }
        for (int kt = 0; kt < nt; ++kt) {
            const int sb = kt & 3;
            if (kt + 2 < nt) WAITV(8); else if (kt + 1 < nt) WAITV(4); else WAITV(0);
            __builtin_amdgcn_s_barrier();
            if (!(V & 4) && kt + 3 < nt) GB_STAGE(kt + 3, (kt + 3) & 3);
            const LAS uchar* xs = lds + sb * BSTG + wm * 8192; const LAS uchar* wsb = lds + sb * BSTG + 16384 + wn * 4096;
#pragma unroll
            for (int ks = 0; ks < 2; ++ks) {
                const int lb = lanebase ^ (ks << 5);
                bf16x8 xf[4], wf[2];
#pragma unroll
                for (int mb = 0; mb < 4; ++mb) { if (V & 8) { u32x4 t = {(unsigned)(lb + mb + kt), 1u, 2u, 3u}; xf[mb] = __builtin_bit_cast(bf16x8, t); } else xf[mb] = *(const LAS bf16x8*)(xs + mb * 2048 + lb); }
#pragma unroll
                for (int nb = 0; nb < 2; ++nb) { if (V & 8) { u32x4 t = {(unsigned)(lb + nb), 5u, 6u, (unsigned)kt}; wf[nb] = __builtin_bit_cast(bf16x8, t); } else wf[nb] = *(const LAS bf16x8*)(wsb + nb * 2048 + lb); }
#pragma unroll
                for (int nb = 0; nb < 2; ++nb)
#pragma unroll
                    for (int mb = 0; mb < 4; ++mb) { if (V & 2) { acc[nb][mb][ks] += __builtin_bit_cast(float, (__builtin_bit_cast(u32x4, wf[nb]))[0] ^ (__builtin_bit_cast(u32x4, xf[mb]))[0]); } else acc[nb][mb] = MFMA32(wf[nb], xf[mb], acc[nb][mb]); }
            }
        }
#undef GB_STAGE
        __syncthreads();
#pragma unroll
        for (int nb = 0; nb < 2; ++nb)
#pragma unroll
            for (int mb = 0; mb < 4; ++mb) {
                const int m = 128 * wm + 32 * mb + r;
#pragma unroll
                for (int q4 = 0; q4 < 4; ++q4) {
                    const int n = 64 * (wn & 1) + 32 * nb + 8 * q4 + 4 * hh;
                    u32x2 v; v[0] = pk2(acc[nb][mb][4 * q4], acc[nb][mb][4 * q4 + 1]); v[1] = pk2(acc[nb][mb][4 * q4 + 2], acc[nb][mb][4 * q4 + 3]);
                    *(LAS u32x2*)(lds + (wn >> 1) * CT2_OFF + m * CT_PITCH + n * 2) = v;
                }
            }
    }
    __syncthreads();
    if (!(V & 1)) { mk(0)(lds); mk(1)(lds + CT2_OFF); }
    __syncthreads();
}
__device__ __forceinline__ u32x4 ct_ld8(const LAS uchar* ct, int r, int c) { return *(const LAS u32x4*)(ct + r * CT_PITCH + c * 2); }
__device__ __forceinline__ float ct_ld1(const LAS uchar* ct, int r, int c) { return bf2f(*(const LAS bf16_t*)(ct + r * CT_PITCH + c * 2)); }

struct EpiProj {
    int mt, nt, l; const Params* p;
    __device__ __forceinline__ void operator()(const LAS uchar* ct) const {
        uchar* ws = p->ws; const int tid = tid_opaque();
        const LAS float* rowS = (const LAS float*)(lds_base() + LDS_ROW);
        const int t0 = mt * 256, b = t0 >> 11, s0 = t0 & 2047;
        if (nt < 8) {
            const int h = nt & 3; const bool isq = nt < 4;
            const int c8 = tid & 7, j = (tid >> 3) & 1, r0 = tid >> 4;
            const float* g = p->in[isq ? 3 : 4] + l * 64 + c8 * 8;
            const f32x4 g0 = *(const f32x4*)g, g1 = *(const f32x4*)(g + 4);
            bf16_t* dbase = (bf16_t*)(ws + (isq ? WS_QD : WS_KD)) + ((((size_t)b * 4 + h) * 2 + j) * S + s0) * 64 + c8 * 8;
#pragma unroll
            for (int it = 0; it < 8; ++it) {
                const int r = it * 32 + r0;
                const float rs = rowS[r];
                float f[8]; unpack8(ct_ld8(ct, r, j * 64 + c8 * 8), f);
                float ss = 0.f;
#pragma unroll
                for (int i = 0; i < 8; ++i) { f[i] *= rs; ss += f[i] * f[i]; }
                ss += __shfl_xor(ss, 1); ss += __shfl_xor(ss, 2); ss += __shfl_xor(ss, 4);
                const float rn = __builtin_amdgcn_rsqf(ss * (1.f / 64.f) + EPS) * (isq ? QSCALE_D : 1.f);
                u32x4 o; o[0] = pk2(f[0] * rn * g0[0], f[1] * rn * g0[1]); o[1] = pk2(f[2] * rn * g0[2], f[3] * rn * g0[3]);
                o[2] = pk2(f[4] * rn * g1[0], f[5] * rn * g1[1]); o[3] = pk2(f[6] * rn * g1[2], f[7] * rn * g1[3]);
                *(u32x4*)(dbase + (size_t)r * 64) = o;
            }
        } else if (nt < 12) {
            const int h = nt - 8, d = tid >> 2, half = tid & 3;
            bf16_t* dst = (bf16_t*)(ws + WS_VDT) + (((size_t)b * 4 + h) * 128 + d) * S + s0 + half * 64;
#pragma unroll
            for (int c8 = 0; c8 < 8; ++c8) { u32x4 o;
#pragma unroll
                for (int i = 0; i < 4; ++i) {
                    const int p0 = c8 * 8 + 2 * i, r0 = half * 64 + sigma16(p0), r1 = half * 64 + sigma16(p0 + 1);
                    o[i] = pk2(ct_ld1(ct, r0, d) * rowS[r0], ct_ld1(ct, r1, d) * rowS[r1]); }
                *(u32x4*)(dst + c8 * 8) = o; }
        } else {
            const int c8 = tid & 15, r0 = tid >> 4;
            bf16_t* dbase = (bf16_t*)(ws + WS_LAT) + (size_t)t0 * 640 + (nt - 12) * 128 + c8 * 8;
            const int hidx = (nt - 12) * 2 + (c8 >> 3);
            float* hss = (float*)(ws + WS_HSS) + (size_t)t0 * 8 + hidx;
#pragma unroll
            for (int it = 0; it < 8; ++it) {
                const int r = it * 32 + r0;
                const float rs = rowS[r];
                float f[8]; unpack8(ct_ld8(ct, r, c8 * 8), f); u32x4 o;
#pragma unroll
                for (int i = 0; i < 4; ++i) o[i] = pk2(f[2 * i] * rs, f[2 * i + 1] * rs);
                *(u32x4*)(dbase + (size_t)r * 640) = o;
                float ss = 0.f;
#pragma unroll
                for (int i = 0; i < 4; ++i) { const float a = bflo(o[i]), bq = bfhi(o[i]); ss += a * a + bq * bq; }
                ss += __shfl_xor(ss, 1); ss += __shfl_xor(ss, 2); ss += __shfl_xor(ss, 4);
                if ((c8 & 7) == 0 && hidx < 8) hss[(size_t)r * 8] = ss;
            }
        }
    }
};

__device__ __forceinline__ float lat_rstd(const bf16_t* seg, int n) {
    float ss = 0.f;
    for (int k = 0; k < n; k += 8) { float f[8]; unpack8(*(const u32x4*)(seg + k), f);
#pragma unroll
        for (int i = 0; i < 8; ++i) ss += f[i] * f[i]; }
    return __builtin_amdgcn_rsqf(ss / (float)n + EPS);
}
__device__ __forceinline__ void norm_rope32(float (&y)[32], const float* g, const float* cosr, const float* sinr, float outscale) {
    float ss = 0.f;
#pragma unroll
    for (int i = 0; i < 32; ++i) ss += y[i] * y[i];
    const float rn = __builtin_amdgcn_rsqf(ss * (1.f / 32.f) + EPS);
#pragma unroll
    for (int i = 0; i < 32; ++i) y[i] = y[i] * rn * g[i];
#pragma unroll
    for (int i = 0; i < 16; ++i) { const float c = cosr[i], sn = sinr[i], x1 = y[i], x2 = y[16 + i];
        y[i] = (x1 * c - x2 * sn) * outscale; y[16 + i] = (x2 * c + x1 * sn) * outscale; }
}

__device__ __forceinline__ u32x4 norm64_piece(float (&f)[8], const float* g8, float outscale) {
    float ss = 0.f;
#pragma unroll
    for (int i = 0; i < 8; ++i) ss += f[i] * f[i];
    ss += __shfl_xor(ss, 1); ss += __shfl_xor(ss, 2); ss += __shfl_xor(ss, 4);
    const float rn = __builtin_amdgcn_rsqf(ss * (1.f / 64.f) + EPS) * outscale;
    const f32x4 g0 = *(const f32x4*)g8, g1 = *(const f32x4*)(g8 + 4);
    u32x4 o; o[0] = pk2(f[0] * rn * g0[0], f[1] * rn * g0[1]); o[1] = pk2(f[2] * rn * g0[2], f[3] * rn * g0[3]);
    o[2] = pk2(f[4] * rn * g1[0], f[5] * rn * g1[1]); o[3] = pk2(f[6] * rn * g1[2], f[7] * rn * g1[3]);
    return o;
}
__device__ __forceinline__ u32x4 norm_rope_piece(float (&f)[8], int c8, const float* g, const float* cosr, const float* sinr, float outscale) {
    float ss = 0.f;
#pragma unroll
    for (int i = 0; i < 8; ++i) ss += f[i] * f[i];
    ss += __shfl_xor(ss, 1); ss += __shfl_xor(ss, 2);
    const float rn = __builtin_amdgcn_rsqf(ss * (1.f / 32.f) + EPS);
    float y[8], z[8];
#pragma unroll
    for (int i = 0; i < 8; ++i) y[i] = f[i] * rn * g[c8 * 8 + i];
#pragma unroll
    for (int i = 0; i < 8; ++i) z[i] = __shfl_xor(y[i], 2);
    const int fi = (c8 & 1) * 8;
    float o[8];
#pragma unroll
    for (int i = 0; i < 8; ++i) { const float c = cosr[fi + i], sn = sinr[fi + i];
        o[i] = ((c8 < 2) ? (y[i] * c - z[i] * sn) : (y[i] * c + z[i] * sn)) * outscale; }
    u32x4 w; w[0] = pk2(o[0], o[1]); w[1] = pk2(o[2], o[3]); w[2] = pk2(o[4], o[5]); w[3] = pk2(o[6], o[7]);
    return w;
}
struct EpiMlaQ {
    int mt, h, l; const Params* p;
    __device__ __forceinline__ void operator()(const LAS uchar* ct) const {
        uchar* ws = p->ws; const int tid = tid_opaque();
        const LAS float* rowS = (const LAS float*)(lds_base() + LDS_ROW);
        const int t0 = mt * 256, b = t0 >> 11, s0 = t0 & 2047;
        bf16_t* dbase = (bf16_t*)(ws + WS_QM) + (((size_t)b * 4 + h) * S + s0) * 96;
        const float* gn = p->in[11] + l * 64; const float* gr = p->in[12] + l * 32;
        {
            const int c8 = tid & 7, r0 = tid >> 3;
#pragma unroll
            for (int it = 0; it < 4; ++it) {
                const int r = it * 64 + r0; const float rs = rowS[r];
                float f[8]; unpack8(ct_ld8(ct, r, c8 * 8), f);
#pragma unroll
                for (int i = 0; i < 8; ++i) f[i] *= rs;
                *(u32x4*)(dbase + (size_t)r * 96 + c8 * 8) = norm64_piece(f, gn + c8 * 8, QSCALE_M);
            }
        }
        {
            const int c8 = tid & 3, r0 = tid >> 2;
#pragma unroll
            for (int it = 0; it < 2; ++it) {
                const int r = it * 128 + r0; const float rs = rowS[r];
                float f[8]; unpack8(ct_ld8(ct, r, 64 + c8 * 8), f);
#pragma unroll
                for (int i = 0; i < 8; ++i) f[i] *= rs;
                const float* cosr = (const float*)(ws + WS_ROPE) + (s0 + r) * 16; const float* sinr = cosr + S * 16;
                *(u32x4*)(dbase + (size_t)r * 96 + 64 + c8 * 8) = norm_rope_piece(f, c8, gr, cosr, sinr, QSCALE_M);
            }
        }
    }
};
struct EpiMlaKV {
    int mt, h, l; const Params* p;
    __device__ __forceinline__ void operator()(const LAS uchar* ct) const {
        uchar* ws = p->ws; const int tid = tid_opaque();
        const LAS float* rowS = (const LAS float*)(lds_base() + LDS_ROW);
        const int t0 = mt * 256, b = t0 >> 11, s0 = t0 & 2047;
        bf16_t* dbase = (bf16_t*)(ws + WS_KM) + (((size_t)b * 4 + h) * S + s0) * 96;
        const float* gn = p->in[13] + l * 64; const float* gr = p->in[14] + l * 32;
        {
            const int c8 = tid & 7, r0 = tid >> 3;
#pragma unroll
            for (int it = 0; it < 4; ++it) {
                const int r = it * 64 + r0; const float rs = rowS[r];
                float f[8]; unpack8(ct_ld8(ct, r, c8 * 8), f);
#pragma unroll
                for (int i = 0; i < 8; ++i) f[i] *= rs;
                *(u32x4*)(dbase + (size_t)r * 96 + c8 * 8) = norm64_piece(f, gn + c8 * 8, 1.f);
            }
        }
        {
            const bf16_t* lat = (const bf16_t*)(ws + WS_LAT) + (size_t)t0 * 640 + 320;
            const int c8 = tid & 3, r0 = tid >> 2;
#pragma unroll
            for (int it = 0; it < 2; ++it) {
                const int r = it * 128 + r0;
                float f[8]; unpack8(*(const u32x4*)(lat + (size_t)r * 640 + c8 * 8), f);
                const float* cosr = (const float*)(ws + WS_ROPE) + (s0 + r) * 16; const float* sinr = cosr + S * 16;
                *(u32x4*)(dbase + (size_t)r * 96 + 64 + c8 * 8) = norm_rope_piece(f, c8, gr, cosr, sinr, 1.f);
            }
        }
        {
            const int d = tid >> 3, q4 = tid & 7;
            bf16_t* dst = (bf16_t*)(ws + WS_VMT) + (((size_t)b * 4 + h) * 64 + d) * S + s0 + q4 * 32;
#pragma unroll
            for (int c8 = 0; c8 < 4; ++c8) { u32x4 o;
#pragma unroll
                for (int i = 0; i < 4; ++i) {
                    const int p0 = c8 * 8 + 2 * i, r0 = q4 * 32 + sigma16(p0), r1 = q4 * 32 + sigma16(p0 + 1);
                    o[i] = pk2(ct_ld1(ct, r0, 64 + d) * rowS[r0], ct_ld1(ct, r1, 64 + d) * rowS[r1]); }
                *(u32x4*)(dst + c8 * 8) = o; }
        }
    }
};
struct EpiPool {
    int mt, g, l; const Params* p;
    __device__ __forceinline__ void operator()(const LAS uchar* ct) const {
        uchar* ws = p->ws; const int tid = tid_opaque(), c8 = tid & 7, r0 = tid >> 3;
        const float* sc = p->in[16] + l * 256 + g * 64 + c8 * 8;
        const f32x4 s0 = *(const f32x4*)sc, s1 = *(const f32x4*)(sc + 4);
        bf16_t* dst = (bf16_t*)(ws + WS_MIX) + (size_t)(mt * 256) * DM + 768 + g * 64 + c8 * 8;
#pragma unroll
        for (int it = 0; it < 4; ++it) {
            const int r = it * 64 + r0;
            float f[8]; unpack8(ct_ld8(ct, r, c8 * 8), f); u32x4 o;
            o[0] = pk2(f[0] * s0[0], f[1] * s0[1]); o[1] = pk2(f[2] * s0[2], f[3] * s0[3]); o[2] = pk2(f[4] * s1[0], f[5] * s1[1]); o[3] = pk2(f[6] * s1[2], f[7] * s1[3]);
            *(u32x4*)(dst + (size_t)r * DM) = o;
        }
    }
};
struct EpiWout {
    int mt, nt; const float* xres; const Params* p;
    __device__ __forceinline__ void operator()(const LAS uchar* ct) const {
        uchar* ws = p->ws; const int tid = tid_opaque();
        const size_t base = (size_t)(mt * 256) * DM + nt * 128;
        float* pss = (float*)(ws + WS_PSS) + (size_t)(mt * 256) * 8 + nt;
#pragma unroll 8
        for (int it = 0; it < 16; ++it) {
            const int item = it * NT + tid, c4 = item & 31, r = item >> 5;
            const size_t off = base + (size_t)r * DM + c4 * 4;
            const u32x2 cw = *(const LAS u32x2*)(ct + r * CT_PITCH + c4 * 8);
            const f32x4 x0 = *(const f32x4*)(xres + off);
            f32x4 y; y[0] = x0[0] + bflo(cw[0]); y[1] = x0[1] + bfhi(cw[0]); y[2] = x0[2] + bflo(cw[1]); y[3] = x0[3] + bfhi(cw[1]);
            u32x2 o; o[0] = pk2(y[0], y[1]); o[1] = pk2(y[2], y[3]);
            *(u32x2*)((bf16_t*)(ws + WS_XB) + off) = o;
            u32x2 ol; ol[0] = pk2(y[0] - bflo(o[0]), y[1] - bfhi(o[0])); ol[1] = pk2(y[2] - bflo(o[1]), y[3] - bfhi(o[1]));
            *(u32x2*)((bf16_t*)(ws + WS_XL) + off) = ol;
            float ss = y[0] * y[0] + y[1] * y[1] + y[2] * y[2] + y[3] * y[3];
            ss += __shfl_xor(ss, 1); ss += __shfl_xor(ss, 2); ss += __shfl_xor(ss, 4); ss += __shfl_xor(ss, 8); ss += __shfl_xor(ss, 16);
            if (c4 == 0) pss[(size_t)r * 8] = ss;
        }
    }
};
struct EpiGU {
    int jt; size_t slot0; const Params* p;
    __device__ __forceinline__ void operator()(const LAS uchar* ct) const {
        uchar* ws = p->ws; const int tid = tid_opaque(), c8 = tid & 7, r0 = tid >> 3;
        const LAS float* rowS = (const LAS float*)(lds_base() + LDS_ROW);
        bf16_t* dbase = (bf16_t*)(ws + WS_HMID) + slot0 * 256 + jt * 64 + c8 * 8;
#pragma unroll
        for (int it = 0; it < 4; ++it) {
            const int r = it * 64 + r0;
            const float rs = rowS[r];
            float g[8], u[8]; unpack8(ct_ld8(ct, r, c8 * 8), g); unpack8(ct_ld8(ct, r, 64 + c8 * 8), u);
            float hv[8];
#pragma unroll
            for (int i = 0; i < 8; ++i) { const float gg = g[i] * rs, uu = u[i] * rs; hv[i] = gg * __builtin_amdgcn_rcpf(1.f + __builtin_amdgcn_exp2f(-gg * LOG2E)) * uu; }
            u32x4 o; o[0] = pk2(hv[0], hv[1]); o[1] = pk2(hv[2], hv[3]); o[2] = pk2(hv[4], hv[5]); o[3] = pk2(hv[6], hv[7]);
            *(u32x4*)(dbase + (size_t)r * 256) = o;
        }
    }
};
struct EpiDown {
    int nt, nvalid; const Params* p;
    __device__ __forceinline__ void operator()(const LAS uchar* ct) const {
        uchar* ws = p->ws; const int tid = tid_opaque(), c8 = tid & 15, r0 = tid >> 4;
        const LAS float* rowS = (const LAS float*)(lds_base() + LDS_ROW); const LAS unsigned* rowE = (const LAS unsigned*)(lds_base() + LDS_ROW + 1024);
        bf16_t* ys = (bf16_t*)(ws + WS_YS) + nt * 128 + c8 * 8;
#pragma unroll
        for (int it = 0; it < 8; ++it) {
            const int r = it * 32 + r0;
            if (r < nvalid) {
                const unsigned ent = rowE[r]; const float w = rowS[r];
                float f[8]; unpack8(ct_ld8(ct, r, c8 * 8), f); u32x4 o;
#pragma unroll
                for (int i = 0; i < 4; ++i) o[i] = pk2(f[2 * i] * w, f[2 * i + 1] * w);
                *(u32x4*)(ys + (size_t)ent * DM) = o;
            }
        }
    }
};

template <int V = 0>
__device__ __forceinline__ void diff_attn_unit(LAS uchar* lds, const Params& p, int l, int b, int h, int qb) {
    uchar* ws = p.ws;
    const int tid = tid_opaque(), lane = tid & 63, wid = __builtin_amdgcn_readfirstlane(tid >> 6);
    const float* scal = (const float*)(ws + WS_SCAL) + 16 * l;
    const float lam = scal[0], oml = scal[1], m2 = scal[2];
    const float slope2 = exp2f(-2.f * (float)(h + 1)) * LOG2E;
    const bf16_t* Q1 = (const bf16_t*)(ws + WS_QD) + (((size_t)b * 4 + h) * 2) * S * 64;
    const bf16_t* K1 = (const bf16_t*)(ws + WS_KD) + (((size_t)b * 4 + h) * 2) * S * 64;
    const bf16_t* VT = (const bf16_t*)(ws + WS_VDT) + (((size_t)b * 4 + h) * 128) * S;
    const float* gsub = p.in[6] + l * 128;
    bf16_t* mix = (bf16_t*)(ws + WS_MIX);
#if NAIVE_ATTN
    {
        const int q = qb * 128 + (tid >> 2), mm = (tid >> 1) & 1, dh = tid & 1;
        const bf16_t* Qp = Q1 + (size_t)mm * S * 64 + (size_t)q * 64; const bf16_t* Kp = K1 + (size_t)mm * S * 64;
        float qv[64];
#pragma unroll
        for (int c8 = 0; c8 < 8; ++c8) { float f[8]; unpack8(*(const u32x4*)(Qp + c8 * 8), f);
#pragma unroll
            for (int i = 0; i < 8; ++i) qv[c8 * 8 + i] = f[i]; }
        float o[64]; float lsum = 0.f;
#pragma unroll
        for (int d = 0; d < 64; ++d) o[d] = 0.f;
        for (int key = 0; key < S; ++key) {
            float sc = 0.f;
#pragma unroll
            for (int c8 = 0; c8 < 8; ++c8) { float f[8]; unpack8(*(const u32x4*)(Kp + (size_t)key * 64 + c8 * 8), f);
#pragma unroll
                for (int i = 0; i < 8; ++i) sc += qv[c8 * 8 + i] * f[i]; }
            const float pv = __builtin_amdgcn_exp2f(sc - slope2 * fabsf((float)(q - key)) - m2);
            lsum += pv;
            const int kp = sigma16(key);
#pragma unroll
            for (int d = 0; d < 64; ++d) o[d] += pv * bf2f(VT[(size_t)(dh * 64 + d) * S + kp]);
        }
        const float inv = 1.f / lsum; float ss = 0.f;
#pragma unroll
        for (int d = 0; d < 64; ++d) { const float mine = o[d] * inv; const float other = __shfl_xor(mine, 2); o[d] = mine - lam * other; ss += o[d] * o[d]; }
        ss += __shfl_xor(ss, 1);
        if (mm == 0) {
            const float rn = __builtin_amdgcn_rsqf(ss * (1.f / 128.f) + EPS) * oml;
            bf16_t* dst = mix + (size_t)(b * S + q) * DM + h * 128 + dh * 64;
#pragma unroll
            for (int d = 0; d < 64; d += 2) *(unsigned*)(dst + d) = pk2(o[d] * rn * gsub[dh * 64 + d], o[d + 1] * rn * gsub[dh * 64 + d + 1]);
        }
    }
#else
    {
        const int r = lane & 31, hh = lane >> 5, qs = wid >> 1, mm = wid & 1, qpos = qb * 128 + qs * 32 + r;
        const bf16_t* Qm_ = Q1 + (size_t)mm * S * 64;
        bf16x8 qf[4];
#pragma unroll
        for (int ks = 0; ks < 4; ++ks) qf[ks] = *(const bf16x8*)(Qm_ + (size_t)qpos * 64 + ks * 16 + hh * 8);
        f32x16 O[4]; float lsum = 0.f;
#pragma unroll
        for (int db = 0; db < 4; ++db)
#pragma unroll
            for (int i = 0; i < 16; ++i) O[db][i] = 0.f;
        const int srow = lane >> 3, c0 = (lane & 7) ^ (srow >> 1);
        const bool isk = wid < 4;
        const bf16_t* sbase = isk ? (K1 + (size_t)(wid >> 1) * S * 64 + (size_t)(wid & 1) * 32 * 64) : (VT + (size_t)(wid - 4) * 32 * S);
        const int rstride = isk ? 64 : S, kstride = isk ? 64 * 64 : 64;
        const bf16_t* sb0 = sbase + (size_t)srow * rstride + c0 * 8;
        const bf16_t* sb1 = sbase + (size_t)srow * rstride + (c0 ^ 4) * 8;
        const int lanebase = r * 128 + ((hh ^ ((r >> 1) & 7)) << 4);
#define DA_STAGE(kt, sbuf) do { _Pragma("unroll") for (int j = 0; j < 4; ++j) \
            glds16(((j & 1) ? sb1 : sb0) + (size_t)(8 * j) * rstride + (size_t)(kt) * kstride, lds + (sbuf) * ASTG + (wid * 4 + j) * 1024); } while (0)
        const int dcut = (int)(160.f / slope2) + 1;
        int kt_lo = (qb * 128 - dcut) >> 6, kt_hi = (qb * 128 + 127 + dcut) >> 6; kt_lo = kt_lo < 0 ? 0 : kt_lo; kt_hi = kt_hi > S / 64 - 1 ? S / 64 - 1 : kt_hi;
        if (!(V & 8)) { DA_STAGE(kt_lo, 0); if (kt_lo + 1 <= kt_hi) DA_STAGE(kt_lo + 1, 1); }
        int sb = 0;
        const int q0w = qb * 128 + qs * 32;
        const float fq = (float)(qpos - 4 * hh);
        const float baseL = -slope2 * fq - m2, baseR = slope2 * fq - m2;
        for (int kt = kt_lo; kt <= kt_hi; ++kt) {
            if (kt + 1 <= kt_hi) WAITV(4); else WAITV(0);
            __builtin_amdgcn_s_barrier();
            if (!(V & 8) && kt + 2 <= kt_hi) { const int sn = sb >= 1 ? sb - 1 : 2; DA_STAGE(kt + 2, sn); }
            const LAS uchar* st = lds + sb * ASTG;
            f32x16 sacc[2];
#pragma unroll
            for (int kb = 0; kb < 2; ++kb) {
                const int key0 = kt * 64 + 32 * kb;
                {
                    const float c = (key0 < q0w) ? slope2 : -slope2;
                    const float a = ((key0 < q0w) ? baseL : baseR) + c * (float)key0;
#pragma unroll
                    for (int i = 0; i < 16; ++i) sacc[kb][i] = a + c * (float)((i & 3) + 8 * (i >> 2));
                }
                if (__builtin_expect(key0 == q0w, 0)) {
                    const int kq = key0 + 4 * hh - qpos;
#pragma unroll
                    for (int i = 0; i < 16; ++i) sacc[kb][i] = -slope2 * fabsf((float)(kq + (i & 3) + 8 * (i >> 2))) - m2;
                }
#pragma unroll
                for (int ks = 0; ks < 4; ++ks) {
                    if (V & 4) continue;
                    const bf16x8 kf = (V & 16) ? qf[(ks + 1) & 3] : *(const LAS bf16x8*)(st + mm * 8192 + kb * 4096 + (lanebase ^ (ks << 5)));
                    sacc[kb] = MFMA32(kf, qf[ks], sacc[kb]);
                }
            }
#pragma unroll
            for (int kb = 0; kb < 2; ++kb) {
                float ls = 0.f;
#pragma unroll
                for (int i = 0; i < 16; ++i) { const float pv = (V & 1) ? sacc[kb][i] : __builtin_amdgcn_exp2f(sacc[kb][i]); ls += pv; sacc[kb][i] = pv; }
                lsum += ls;
                bf16x8 pb[2];
#pragma unroll
                for (int s2 = 0; s2 < 2; ++s2) {
                    u32x4 w;
#pragma unroll
                    for (int i = 0; i < 4; ++i) w[i] = pk2(sacc[kb][8 * s2 + 2 * i], sacc[kb][8 * s2 + 2 * i + 1]);
                    pb[s2] = __builtin_bit_cast(bf16x8, w);
                }
#pragma unroll
                for (int db = 0; db < 4; ++db)
#pragma unroll
                    for (int s2 = 0; s2 < 2; ++s2) {
                        if (V & 2) { if (db == 0) O[0][s2] += __builtin_bit_cast(float, (__builtin_bit_cast(u32x4, pb[s2]))[0]); continue; }
                        const bf16x8 vf = (V & 16) ? qf[(db + s2) & 3] : *(const LAS bf16x8*)(st + 16384 + db * 4096 + (lanebase ^ ((2 * kb + s2) << 5)));
                        O[db] = MFMA32(vf, pb[s2], O[db]);
                    }
            }
            sb = sb == 2 ? 0 : sb + 1;
        }
#undef DA_STAGE
        const float lt = lsum + __shfl_xor(lsum, 32);
        const float sc = (mm == 0) ? (1.f / lt) : (lam / lt);
        __syncthreads();
        LAS float* xch = (LAS float*)lds + qs * 4096;
        if (mm == 1) {
#pragma unroll
            for (int db = 0; db < 4; ++db)
#pragma unroll
                for (int i = 0; i < 16; ++i) xch[(db * 16 + i) * 64 + lane] = O[db][i] * sc;
        }
        __syncthreads();
        if (mm == 0) {
            float ss = 0.f;
#pragma unroll
            for (int db = 0; db < 4; ++db)
#pragma unroll
                for (int i = 0; i < 16; ++i) { const float o = O[db][i] * sc - xch[(db * 16 + i) * 64 + lane]; O[db][i] = o; ss += o * o; }
            ss += __shfl_xor(ss, 32);
            const float rn = __builtin_amdgcn_rsqf(ss * (1.f / 128.f) + EPS) * oml;
            bf16_t* dst = mix + (size_t)(b * S + qpos) * DM + h * 128;
#pragma unroll
            for (int db = 0; db < 4; ++db)
#pragma unroll
                for (int q4 = 0; q4 < 4; ++q4) {
                    const int d = 32 * db + 8 * q4 + 4 * hh;
                    const f32x4 g = *(const f32x4*)(gsub + d);
                    u32x2 w; w[0] = pk2(O[db][4 * q4] * rn * g[0], O[db][4 * q4 + 1] * rn * g[1]);
                    w[1] = pk2(O[db][4 * q4 + 2] * rn * g[2], O[db][4 * q4 + 3] * rn * g[3]);
                    *(u32x2*)(dst + d) = w;
                }
        }
    }
#endif
    __syncthreads();
}

__device__ __forceinline__ void mla_attn_unit(LAS uchar* lds, const Params& p, int l, int unit) {
    uchar* ws = p.ws;
    const int tid = tid_opaque(), lane = tid & 63, wid = __builtin_amdgcn_readfirstlane(tid >> 6);
    const int xg_ = unit & 7, v_ = unit >> 3, qb = v_ & 7, bh_ = (v_ >> 3) * 8 + xg_, h = bh_ & 3, b = bh_ >> 2;
    const float m2 = ((const float*)(ws + WS_SCAL))[16 * l + 3];
    const bf16_t* Q = (const bf16_t*)(ws + WS_QM) + (((size_t)b * 4 + h) * S) * 96;
    const bf16_t* Kp = (const bf16_t*)(ws + WS_KM) + (((size_t)b * 4 + h) * S) * 96;
    const bf16_t* VT = (const bf16_t*)(ws + WS_VMT) + (((size_t)b * 4 + h) * 64) * S;
    bf16_t* mix = (bf16_t*)(ws + WS_MIX);
#if NAIVE_ATTN
    {
        const int q = qb * 256 + (tid >> 1), hf = tid & 1;
        float qv[96];
#pragma unroll
        for (int c8 = 0; c8 < 12; ++c8) { float f[8]; unpack8(*(const u32x4*)(Q + (size_t)q * 96 + c8 * 8), f);
#pragma unroll
            for (int i = 0; i < 8; ++i) qv[c8 * 8 + i] = f[i]; }
        float o[32]; float lsum = 0.f;
#pragma unroll
        for (int d = 0; d < 32; ++d) o[d] = 0.f;
        for (int key = 0; key < S; ++key) {
            float sc = 0.f;
#pragma unroll
            for (int c8 = 0; c8 < 12; ++c8) { float f[8]; unpack8(*(const u32x4*)(Kp + (size_t)key * 96 + c8 * 8), f);
#pragma unroll
                for (int i = 0; i < 8; ++i) sc += qv[c8 * 8 + i] * f[i]; }
            const float pv = __builtin_amdgcn_exp2f(sc - m2);
            lsum += pv;
            const int kp = sigma16(key);
#pragma unroll
            for (int d = 0; d < 32; ++d) o[d] += pv * bf2f(VT[(size_t)(hf * 32 + d) * S + kp]);
        }
        const float inv = 1.f / lsum;
        bf16_t* dst = mix + (size_t)(b * S + q) * DM + 512 + h * 64 + hf * 32;
#pragma unroll
        for (int d = 0; d < 32; d += 2) *(unsigned*)(dst + d) = pk2(o[d] * inv, o[d + 1] * inv);
    }
#else
    {
        const int r = lane & 31, hh = lane >> 5, qpos = qb * 256 + wid * 32 + r;
        bf16x8 qf[6];
#pragma unroll
        for (int ks = 0; ks < 6; ++ks) qf[ks] = *(const bf16x8*)(Q + (size_t)qpos * 96 + ks * 16 + hh * 8);
        f32x16 O[2]; float lsum = 0.f;
#pragma unroll
        for (int db = 0; db < 2; ++db)
#pragma unroll
            for (int i = 0; i < 16; ++i) O[db][i] = 0.f;
        const int lanebase = r * 128 + ((hh ^ ((r >> 1) & 7)) << 4), lanebase64 = r * 64 + ((hh ^ ((r >> 2) & 3)) << 4);
        const bool lo4 = wid < 4;
        const bf16_t* s0p; const bf16_t* s1p; const bf16_t* s2p;
        {
            const int srow = lane >> 3;
            { const int row = 8 * wid + srow; const int c = (lane & 7) ^ ((row >> 1) & 7); s0p = Kp + (size_t)row * 96 + c * 8; }
            if (lo4) { const int row = 16 * wid + (lane >> 2); const int c = (lane & 3) ^ ((row >> 2) & 3); s1p = Kp + (size_t)row * 96 + 64 + c * 8; }
            else { const int row = 8 * (wid - 4) + srow; const int c = (lane & 7) ^ ((row >> 1) & 7); s1p = VT + (size_t)row * S + c * 8; }
            { const int row = 8 * ((wid & 3) + 4) + srow; const int c = (lane & 7) ^ ((row >> 1) & 7); s2p = VT + (size_t)row * S + c * 8; }
        }
        const int k1stride = lo4 ? 64 * 96 : 64;
#define MA_STAGE(kt, sbuf) do { \
            glds16(s0p + (size_t)(kt) * (64 * 96), lds + (sbuf) * MSTG + wid * 1024); \
            glds16(s1p + (size_t)(kt) * k1stride, lds + (sbuf) * MSTG + (wid + 8) * 1024); \
            if (lo4) glds16(s2p + (size_t)(kt) * 64, lds + (sbuf) * MSTG + (wid + 16) * 1024); } while (0)
        MA_STAGE(0, 0); MA_STAGE(1, 1);
        int sb = 0;
        for (int kt = 0; kt < S / 64; ++kt) {
            if (kt + 1 < S / 64) { if (lo4) WAITV(3); else WAITV(2); } else WAITV(0);
            __builtin_amdgcn_s_barrier();
            if (kt + 2 < S / 64) { const int sn = sb >= 1 ? sb - 1 : 2; MA_STAGE(kt + 2, sn); }
            const LAS uchar* st = lds + sb * MSTG;
#pragma unroll
            for (int kb = 0; kb < 2; ++kb) {
                f32x16 sacc;
#pragma unroll
                for (int i = 0; i < 16; ++i) sacc[i] = -m2;
#pragma unroll
                for (int ks = 0; ks < 4; ++ks) {
                    const bf16x8 kf = *(const LAS bf16x8*)(st + kb * 4096 + (lanebase ^ (ks << 5)));
                    sacc = MFMA32(kf, qf[ks], sacc);
                }
#pragma unroll
                for (int ks = 0; ks < 2; ++ks) {
                    const bf16x8 kf = *(const LAS bf16x8*)(st + 8192 + kb * 2048 + (lanebase64 ^ (ks << 5)));
                    sacc = MFMA32(kf, qf[4 + ks], sacc);
                }
                float ls = 0.f;
#pragma unroll
                for (int i = 0; i < 16; ++i) { const float pv = __builtin_amdgcn_exp2f(sacc[i]); ls += pv; sacc[i] = pv; }
                lsum += ls;
                bf16x8 pb[2];
#pragma unroll
                for (int s2 = 0; s2 < 2; ++s2) {
                    u32x4 w;
#pragma unroll
                    for (int i = 0; i < 4; ++i) w[i] = pk2(sacc[8 * s2 + 2 * i], sacc[8 * s2 + 2 * i + 1]);
                    pb[s2] = __builtin_bit_cast(bf16x8, w);
                }
#pragma unroll
                for (int db = 0; db < 2; ++db)
#pragma unroll
                    for (int s2 = 0; s2 < 2; ++s2) {
                        const bf16x8 vf = *(const LAS bf16x8*)(st + 12288 + db * 4096 + (lanebase ^ ((2 * kb + s2) << 5)));
                        O[db] = MFMA32(vf, pb[s2], O[db]);
                    }
            }
            sb = sb == 2 ? 0 : sb + 1;
        }
#undef MA_STAGE
        const float lt = lsum + __shfl_xor(lsum, 32); const float inv = 1.f / lt;
        bf16_t* dst = mix + (size_t)(b * S + qpos) * DM + 512 + h * 64;
#pragma unroll
        for (int db = 0; db < 2; ++db)
#pragma unroll
            for (int q4 = 0; q4 < 4; ++q4) {
                const int d = 32 * db + 8 * q4 + 4 * hh;
                u32x2 w; w[0] = pk2(O[db][4 * q4] * inv, O[db][4 * q4 + 1] * inv); w[1] = pk2(O[db][4 * q4 + 2] * inv, O[db][4 * q4 + 3] * inv);
                *(u32x2*)(dst + d) = w;
            }
    }
#endif
    __syncthreads();
}

__device__ __forceinline__ int xp_rowmap(int mode, int n) {
    return mode == 0 ? n : mode == 1 ? (n / 96) * 128 + (n % 96) : mode == 2 ? ((n >> 6) * 128 + (n & 63)) : ((n >> 6) * 128 + 64 + (n & 63));
}
__device__ __forceinline__ void xpose_tile(LAS uchar* lds, const float* src, int K, int N, bf16_t* dst, int ldd, int mode, const float* gain, int kt, int ntile, int lds_src = 0) {
    LAS float* sh = (LAS float*)lds; const int tid = tid_opaque();
    (void)K; const int ldn = lds_src ? lds_src : N;
    {
        const int n4 = tid & 63, n = ntile * 256 + n4 * 4;
        if (n < N) {
#pragma unroll
            for (int i = 0; i < 8; ++i) {
                const int kl = (tid >> 6) + 8 * i, k = kt * 64 + kl;
                f32x4 v = *(const f32x4*)(src + (size_t)k * ldn + n);
                if (gain) { const float gk = gain[k]; v[0] *= gk; v[1] *= gk; v[2] *= gk; v[3] *= gk; }
                LAS float* d = sh + kl * 257 + n4 * 4; d[0] = v[0]; d[1] = v[1]; d[2] = v[2]; d[3] = v[3];
            }
        }
    }
    __syncthreads();
    {
        const int nl = tid >> 1, kh = tid & 1, n = ntile * 256 + nl;
        if (n < N) {
            bf16_t* d = dst + (size_t)xp_rowmap(mode, n) * ldd + kt * 64 + kh * 32;
#pragma unroll
            for (int c8 = 0; c8 < 4; ++c8) { u32x4 o;
#pragma unroll
                for (int i = 0; i < 4; ++i) o[i] = pk2(sh[(kh * 32 + c8 * 8 + 2 * i) * 257 + nl], sh[(kh * 32 + c8 * 8 + 2 * i + 1) * 257 + nl]);
                *(u32x4*)(d + c8 * 8) = o; }
        }
    }
    __syncthreads();
}
__device__ __forceinline__ void xpose_job(LAS uchar* lds, const float* src, int K, int N, bf16_t* dst, int ldd, int mode, const float* gain, int lds_src = 0) {
    const int nkt = K >> 6, nnt = (N + 255) >> 8, tot = nkt * nnt;
    for (int u = blockIdx.x; u < tot; u += gridDim.x) xpose_tile(lds, src, K, N, dst, ldd, mode, gain, u % nkt, u / nkt, lds_src);
}
__device__ __forceinline__ void expert_weights(LAS uchar* lds, const Params& p, int l) {
    bf16_t* wgu = (bf16_t*)(p.ws + WS_WGU); bf16_t* wd = (bf16_t*)(p.ws + WS_WD);
    const float* g2 = p.in[18] + l * DM;
    const int nb = (int)gridDim.x > 64 ? (int)gridDim.x - 64 : (int)gridDim.x, b0 = (int)gridDim.x > 64 ? (int)blockIdx.x - 64 : (int)blockIdx.x;
    if (b0 < 0) return;
    for (int u = b0; u < 32 * 48; u += nb) {
        const int e = u / 48, w = u % 48, job = w >> 4, tl = w & 15;
        if (job == 0) xpose_tile(lds, p.in[23] + ((size_t)l * 32 + e) * DM * 256, DM, 256, wgu + (size_t)e * 512 * DM, DM, 2, g2, tl, 0);
        else if (job == 1) xpose_tile(lds, p.in[24] + ((size_t)l * 32 + e) * DM * 256, DM, 256, wgu + (size_t)e * 512 * DM, DM, 3, g2, tl, 0);
        else xpose_tile(lds, p.in[25] + ((size_t)l * 32 + e) * 256 * DM, 256, DM, wd + (size_t)e * DM * 256, 256, 0, nullptr, tl & 3, tl >> 2);
    }
}
__device__ __forceinline__ void row_prep(const float* xrow, bf16_t* xb, float* rstd, int lane) {
    float ss = 0.f; f32x4 v[4];
#pragma unroll
    for (int i = 0; i < 4; ++i) { v[i] = *(const f32x4*)(xrow + i * 256 + lane * 4); ss += v[i][0] * v[i][0] + v[i][1] * v[i][1] + v[i][2] * v[i][2] + v[i][3] * v[i][3]; }
    ss = wave_sum(ss);
#pragma unroll
    for (int i = 0; i < 4; ++i) { u32x2 o; o[0] = pk2(v[i][0], v[i][1]); o[1] = pk2(v[i][2], v[i][3]); *(u32x2*)(xb + i * 256 + lane * 4) = o; }
    if (lane == 0) *rstd = __builtin_amdgcn_rsqf(ss * (1.f / 1024.f) + EPS);
}

__device__ __forceinline__ void phase0(LAS uchar* lds, const Params& p) {
    uchar* ws = p.ws; const int tid = tid_opaque(), gtid = blockIdx.x * NT + tid, gsz = gridDim.x * NT;
    for (int idx = blockIdx.x; idx < NL * 202; idx += gridDim.x) {
        const int l = idx / 202, j = idx % 202;
        if (j < 128) xpose_tile(lds, p.in[2] + (size_t)l * DM * NIN, DM, 1888, (bf16_t*)(ws + WS_WIN) + (size_t)l * NINP * DM, DM, 0, p.in[1] + l * DM, j & 15, j >> 4, NIN);
        else if (j < 192) xpose_tile(lds, p.in[17] + (size_t)l * DM * DM, DM, DM, (bf16_t*)(ws + WS_WOUT) + (size_t)l * DM * DM, DM, 0, nullptr, (j - 128) & 15, (j - 128) >> 4);
        else if (j < 198) xpose_tile(lds, p.in[9] + (size_t)l * 192 * 384, 192, 384, (bf16_t*)(ws + WS_WUQ) + (size_t)l * 512 * 192, 192, 1, p.in[7] + l * 192, (j - 192) % 3, (j - 192) / 3);
        else xpose_tile(lds, p.in[10] + (size_t)l * 128 * 512, 128, 512, (bf16_t*)(ws + WS_WUKV) + (size_t)l * 512 * 128, 128, 0, p.in[8] + l * 128, (j - 198) & 1, (j - 198) >> 1);
    }
    for (int l = 0; l < NL; ++l) {
        for (int i = gtid; i < 256 * DM; i += gsz) {
            const int k = i & 1023, n = i >> 10, g = n >> 6, d = n & 63;
            const float* wi = p.in[2] + ((size_t)l * DM + k) * NIN + 1888 + g * 64; const float* pw = p.in[15] + ((size_t)l * 4 + g) * 64 * 64 + d;
            float acc = 0.f;
            for (int c = 0; c < 64; ++c) acc += wi[c] * pw[c * 64];
            ((bf16_t*)(ws + WS_WIN))[((size_t)l * NINP + 1888 + n) * DM + k] = f2bf(acc * p.in[1][l * DM + k] * p.in[16][l * 256 + n]);
        }
        { bf16_t* w = (bf16_t*)(ws + WS_WIN) + ((size_t)l * NINP + NIN) * DM; for (int i = gtid; i < 32 * DM; i += gsz) w[i] = 0; }
        { bf16_t* w = (bf16_t*)(ws + WS_WUQ) + (size_t)l * 512 * 192; for (int i = gtid; i < 4 * 32 * 192; i += gsz) { const int hd = i / (32 * 192), rem = i % (32 * 192); w[(size_t)(hd * 128 + 96) * 192 + rem] = 0; } }
    }
    for (int i = gtid; i < NL * 128 * 1024; i += gsz) {
        const int k = i & 1023, n = (i >> 10) & 127, l = i >> 17;
        float v = 0.f;
        if (n < 4) v = p.in[19][((size_t)l * DM + k) * 4 + n]; else if (n < 36) v = p.in[21][((size_t)l * DM + k) * 32 + (n - 4)];
        v *= p.in[18][l * DM + k];
        const bf16_t hi = f2bf(v), lo = f2bf(v - bf2f(hi));
        bf16_t* w = (bf16_t*)(ws + WS_WR) + ((size_t)l * 128 + n) * 3072 + k;
        w[0] = hi; w[1024] = hi; w[2048] = lo;
    }
    for (int i = gtid; i < S * 16; i += gsz) {
        const int pos = i >> 4, f = i & 15;
        double inv = 1.0; for (int k = 0; k < f; ++k) inv *= 0.5623413251903491;
        const double rev = (double)pos * inv * 0.15915494309189535;
        const float fr = (float)(rev - __builtin_rint(rev));
        ((float*)(ws + WS_ROPE))[i] = __builtin_amdgcn_cosf(fr);
        ((float*)(ws + WS_ROPE))[S * 16 + i] = __builtin_amdgcn_sinf(fr);
    }
    if (blockIdx.x == 0 && (tid >> 6) < NL) {
        const int l = tid >> 6, lane = tid & 63; float* sc = (float*)(ws + WS_SCAL) + 16 * l;
        const float* lv = p.in[5] + l * 256;
        const float d1 = wave_sum(lv[lane] * lv[64 + lane]), d2 = wave_sum(lv[128 + lane] * lv[192 + lane]);
        float gq = fabsf(p.in[3][l * 64 + lane]), gk = fabsf(p.in[4][l * 64 + lane]);
        float a = fabsf(p.in[11][l * 64 + lane]), c = fabsf(p.in[13][l * 64 + lane]);
        float bq = fabsf(p.in[12][l * 32 + (lane & 31)]), dk = fabsf(p.in[14][l * 32 + (lane & 31)]);
#pragma unroll
        for (int o = 32; o >= 1; o >>= 1) { gq = fmaxf(gq, __shfl_xor(gq, o)); gk = fmaxf(gk, __shfl_xor(gk, o)); a = fmaxf(a, __shfl_xor(a, o)); c = fmaxf(c, __shfl_xor(c, o));
            bq = fmaxf(bq, __shfl_xor(bq, o)); dk = fmaxf(dk, __shfl_xor(dk, o)); }
        if (lane == 0) {
            const float lam_init = 0.8f - 0.6f * expf(-0.3f * (float)l);
            sc[0] = expf(d1) - expf(d2) + lam_init; sc[1] = 1.f - lam_init;
            sc[2] = gq * gk * 8.f * LOG2E * 1.02f;
            sc[3] = sqrtf(64.f * a * a + 32.f * bq * bq) * sqrtf(64.f * c * c + 32.f * dk * dk) * QSCALE_M * 1.02f;
        }
    }
    {
        const int lane = tid & 63, gw = gtid >> 6, nw = gsz >> 6;
        for (int t = gw; t < T; t += nw) row_prep(p.in[0] + (size_t)t * DM, (bf16_t*)(ws + WS_XB) + (size_t)t * DM, (float*)(ws + WS_RSTD1) + t, lane);
    }
}

struct MkProj { int mt, pn, l; const Params* p; __device__ __forceinline__ EpiProj operator()(int half) const { return EpiProj{mt, 2 * pn + half, l, p}; } };
__device__ __forceinline__ void ph_gemm1(LAS uchar* lds, const Params& p, int l) {
    const bf16_t* xb = (const bf16_t*)(p.ws + WS_XB); const bf16_t* win = (const bf16_t*)(p.ws + WS_WIN) + (size_t)l * NINP * DM;
    if (SHADOW_G >= 0) for (int u0 = blockIdx.x; u0 < 512; u0 += gridDim.x) {
        const int xg = u0 & 7, v = u0 >> 3, mt = (v >> 3) * 8 + xg, pn = v & 7;
        MkProj mk{mt, pn, l, &p};
        { const int tp = tid_opaque(); if (tp < 256) ((LAS float*)(lds + LDS_ROW))[tp] = ((const float*)(p.ws + WS_RSTD1))[mt * 256 + tp]; }
        gemm_big<(SHADOW_G >= 0 ? SHADOW_G : 0)>(lds, ARowLinear{xb + (size_t)mt * 256 * DM, (size_t)DM}, win + (size_t)pn * 256 * DM, (size_t)DM, DM, mk);
    }
    for (int u0 = blockIdx.x; u0 < 64 * 8; u0 += gridDim.x) {
        const int xg = u0 & 7, v = u0 >> 3, mt = (v >> 3) * 8 + xg, pn = ((v & 7) + 4 * ((v >> 5) & 1)) & 7;
        MkProj mk{mt, pn, l, &p};
        { const int tp = tid_opaque(); if (tp < 256) ((LAS float*)(lds + LDS_ROW))[tp] = ((const float*)(p.ws + WS_RSTD1))[mt * 256 + tp]; }
        gemm_big(lds, ARowLinear{xb + (size_t)mt * 256 * DM, (size_t)DM}, win + (size_t)pn * 256 * DM, (size_t)DM, DM, mk);
    }
}
__device__ __forceinline__ void gemm1_tail_unit(LAS uchar* lds, const Params& p, int l, int mt) {
    const bf16_t* xb = (const bf16_t*)(p.ws + WS_XB); const bf16_t* win = (const bf16_t*)(p.ws + WS_WIN) + (size_t)l * NINP * DM;
    ARowLinear ar{xb + (size_t)mt * 256 * DM, (size_t)DM};
    EpiProj ep{mt, 16, l, &p};
    { const int tp = tid_opaque(); if (tp < 256) ((LAS float*)(lds + LDS_ROW))[tp] = ((const float*)(p.ws + WS_RSTD1))[mt * 256 + tp]; }
    gemm_tile(lds, ar, win + (size_t)16 * 128 * DM, (size_t)DM, DM, ep);
}
template <int HALF>
__device__ __forceinline__ void pool_rows(const float (&v)[48], int sfirst, bf16_t* dst) {
    float run = 0.f;
#pragma unroll
    for (int i = 8 - HALF; i < 8 + HALF; ++i) run += v[i];
#pragma unroll
    for (int r = 0; r < 32; ++r) {
        const int s = sfirst + r; int lo = s - HALF, hi = s + HALF - 1; lo = lo < 0 ? 0 : lo; hi = hi > S - 1 ? S - 1 : hi;
        const float o = run * __builtin_amdgcn_rcpf((float)(hi - lo + 1)) - v[r + 8];
        dst[(size_t)r * DM] = f2bf(o);
        if (r < 31) run += v[r + 8 + HALF] - v[r + 8 - HALF];
    }
}
__device__ __forceinline__ void pooled_unit(LAS uchar* lds, const Params& p, int ut) {
    const int tid = tid_opaque();
    const int t0 = ut * 64, b = t0 >> 11, s0 = t0 & 2047;
    const bf16_t* lat = (const bf16_t*)(p.ws + WS_LAT) + (size_t)b * S * 640 + 352;
    for (int it = 0; it < 5; ++it) {
        const int item = it * NT + tid, c8 = item & 31, rl = item >> 5, sr = s0 - 8 + rl;
        u32x4 v = {0u, 0u, 0u, 0u};
        if (sr >= 0 && sr < S) v = *(const u32x4*)(lat + (size_t)sr * 640 + c8 * 8);
        *(LAS u32x4*)(lds + rl * 512 + c8 * 16) = v;
    }
    __syncthreads();
    {
        const int c = tid & 255, rh = tid >> 8, g = __builtin_amdgcn_readfirstlane(c >> 6);
        bf16_t* dst = (bf16_t*)(p.ws + WS_MIX) + (size_t)(t0 + rh * 32) * DM + 768 + c;
        const LAS bf16_t* col = (const LAS bf16_t*)lds + (rh * 32) * 256 + c;
        float v[48];
#pragma unroll
        for (int i = 0; i < 48; ++i) v[i] = bf2f(col[i * 256]);
        const int sfirst = s0 + rh * 32;
        if (g == 0) pool_rows<1>(v, sfirst, dst); else if (g == 1) pool_rows<2>(v, sfirst, dst); else if (g == 2) pool_rows<4>(v, sfirst, dst); else pool_rows<8>(v, sfirst, dst);
    }
    __syncthreads();
}
__device__ __forceinline__ void mla_up_unit(LAS uchar* lds, const Params& p, int l, int v) {
    const bf16_t* lat = (const bf16_t*)(p.ws + WS_LAT);
    const int mt = v >> 3, w = v & 7, h = w & 3;
    { const int tp = tid_opaque(); if (tp < 256) { const float* hs = (const float*)(p.ws + WS_HSS) + (size_t)(mt * 256 + tp) * 8;
        const f32x4 h0 = *(const f32x4*)hs; const float h4 = hs[4];
        ((LAS float*)(lds + LDS_ROW))[tp] = (w < 4) ? __builtin_amdgcn_rsqf((h0[0] + h0[1] + h0[2]) * (1.f / 192.f) + EPS) : __builtin_amdgcn_rsqf((h0[3] + h4) * (1.f / 128.f) + EPS); } }
    if (w < 4) { ARowLinear ar{lat + (size_t)mt * 256 * 640, (size_t)640}; EpiMlaQ ep{mt, h, l, &p};
        gemm_tile(lds, ar, (const bf16_t*)(p.ws + WS_WUQ) + ((size_t)l * 512 + h * 128) * 192, (size_t)192, 192, ep); }
    else { ARowLinear ar{lat + (size_t)mt * 256 * 640 + 192, (size_t)640}; EpiMlaKV ep{mt, h, l, &p};
        gemm_tile(lds, ar, (const bf16_t*)(p.ws + WS_WUKV) + ((size_t)l * 512 + h * 128) * 128, (size_t)128, 128, ep); }
}
__device__ __forceinline__ void ph_mix_a(LAS uchar* lds, const Params& p, int l) {
    const int G = (int)gridDim.x;
    if (G == 256) {
        const int xg = blockIdx.x & 7, j = blockIdx.x >> 3;
        if (SHADOW_V >= 0) { diff_attn_unit<(SHADOW_V >= 0 ? SHADOW_V : 0)>(lds, p, l, xg, 2 + (j >> 4), j & 15); }
        diff_attn_unit<0>(lds, p, l, xg, 2 + (j >> 4), j & 15);
        if (j < 16) diff_attn_unit<0>(lds, p, l, xg, 1, j);
        else {
            diff_attn_unit<0>(lds, p, l, xg, 0, j - 16);
            if (j < 24) gemm1_tail_unit(lds, p, l, xg + 8 * (j - 16));
            const int n0 = j < 24 ? (j - 16) * 2 : 16 + (j - 24) * 6, n1 = j < 24 ? n0 + 2 : n0 + 6;
            for (int n = n0; n < n1; ++n) mla_up_unit(lds, p, l, (xg + 8 * (n >> 3)) * 8 + (n & 7));
        }
    } else {
        for (int u = blockIdx.x; u < 512 + 512 + 64; u += G) {
            if (u < 512) diff_attn_unit<0>(lds, p, l, u >> 6, (u >> 4) & 3, u & 15);
            else if (u < 1024) mla_up_unit(lds, p, l, u - 512);
            else gemm1_tail_unit(lds, p, l, u - 1024);
        }
    }
}
__device__ __forceinline__ void ph_mix_b(LAS uchar* lds, const Params& p, int l) {
    (void)l;
    for (int u = blockIdx.x; u < 256 + 256; u += gridDim.x) {
        if (u < 256) mla_attn_unit(lds, p, l, u);
        else pooled_unit(lds, p, u - 256);
    }
}
struct MkWout { int mt, pn; const float* xres; const Params* p; __device__ __forceinline__ EpiWout operator()(int half) const { return EpiWout{mt, 2 * pn + half, xres, p}; } };
__device__ __forceinline__ void ph_wout(LAS uchar* lds, const Params& p, int l) {
    const bf16_t* mix = (const bf16_t*)(p.ws + WS_MIX); const bf16_t* wo = (const bf16_t*)(p.ws + WS_WOUT) + (size_t)l * DM * DM;
    const float* xres = (l == 0) ? p.in[0] : p.out;
    for (int u0 = blockIdx.x; u0 < 64 * 4; u0 += gridDim.x) {
        const int xg = u0 & 7, v = u0 >> 3, mt = (v >> 2) * 8 + xg, pn = v & 3;
        MkWout mk{mt, pn, xres, &p};
        gemm_big(lds, ARowLinear{mix + (size_t)mt * 256 * DM, (size_t)DM}, wo + (size_t)pn * 256 * DM, (size_t)DM, DM, mk);
    }
}
constexpr int LDS_RT = 135168;
struct EpiRouter {
    int mt, l; bool dry; const Params* p;
    __device__ __forceinline__ void operator()(const LAS uchar* ct) const {
        uchar* ws = p->ws; const int tid = tid_opaque();
        const LAS float* ctf = (const LAS float*)ct;
        LAS unsigned* shcnt = (LAS unsigned*)(ct + LDS_RT); LAS unsigned* shbase = shcnt + 32; LAS unsigned* pend = shcnt + 64;
        unsigned* cnt = (unsigned*)(ws + WS_CTL) + CW_CNT + 1024 * l + (dry ? 2048 : 0);
        unsigned* list = (unsigned*)(ws + (dry ? WS_POOLED : WS_LIST)); float* gwt = (float*)(ws + (dry ? WS_POOLED + 4 * MiB : WS_GW)); float* rstd2 = (float*)(ws + (dry ? WS_POOLED + 5 * MiB : WS_RSTD2));
        const float* bg = p->in[20] + l * 4; const float* be = p->in[22] + l * 32;
        if (tid < 32) shcnt[tid] = 0u;
        __syncthreads();
        if (tid < 256) {
            const int t = mt * 256 + tid;
            const float* ps = (const float*)(ws + WS_PSS) + (size_t)t * 8;
            const f32x4 p0 = *(const f32x4*)ps, p1 = *(const f32x4*)(ps + 4);
            const float ss = ((p0[0] + p0[1]) + (p0[2] + p0[3])) + ((p1[0] + p1[1]) + (p1[2] + p1[3]));
            const float rs = __builtin_amdgcn_rsqf(ss * (1.f / 1024.f) + EPS);
            const LAS float* row = ctf + tid * CTF_PITCH;
            float gl[4];
#pragma unroll
            for (int n = 0; n < 4; ++n) gl[n] = row[n] * rs + bg[n];
            int gi = 0; float gm = gl[0];
#pragma unroll
            for (int n = 1; n < 4; ++n) if (gl[n] > gm) { gm = gl[n]; gi = n; }
            float gs = 0.f;
#pragma unroll
            for (int n = 0; n < 4; ++n) gs += __expf(gl[n] - gm);
            const float gtop = 1.f / gs;
            float el[8];
#pragma unroll
            for (int n = 0; n < 8; ++n) el[n] = row[4 + gi * 8 + n] * rs + be[gi * 8 + n];
            int i1 = 0; float m1 = el[0];
#pragma unroll
            for (int n = 1; n < 8; ++n) if (el[n] > m1) { m1 = el[n]; i1 = n; }
            int i2 = -1; float m2v = -3.0e38f;
#pragma unroll
            for (int n = 0; n < 8; ++n) if (n != i1 && el[n] > m2v) { m2v = el[n]; i2 = n; }
            const float e2 = __expf(m2v - m1); const float w1 = gtop / (1.f + e2), w2 = gtop * e2 / (1.f + e2);
            const int ea = gi * 8 + i1, eb = gi * 8 + i2;
            const unsigned pa = __hip_atomic_fetch_add(&shcnt[ea], 1u, __ATOMIC_RELAXED, __HIP_MEMORY_SCOPE_WORKGROUP);
            const unsigned pbk = __hip_atomic_fetch_add(&shcnt[eb], 1u, __ATOMIC_RELAXED, __HIP_MEMORY_SCOPE_WORKGROUP);
            pend[tid * 2] = ((unsigned)ea << 16) | pa; pend[tid * 2 + 1] = ((unsigned)eb << 16) | pbk;
            gwt[t * 2] = w1; gwt[t * 2 + 1] = w2; rstd2[t] = rs;
        }
        __syncthreads();
        if (tid < 32) { const unsigned c = shcnt[tid]; shbase[tid] = c ? atomicAdd(&cnt[tid * 32], c) : 0u; }
        __syncthreads();
        { const unsigned pe = pend[tid], e = pe >> 16, lp = pe & 0xffffu; list[(size_t)e * T + shbase[e] + lp] = (unsigned)((mt * 256 + (tid >> 1)) * 2 + (tid & 1)); }
    }
};
__device__ __forceinline__ void ph_router(LAS uchar* lds, const Params& p, int l, bool dry = false) {
    const bf16_t* xb = (const bf16_t*)(p.ws + WS_XB); const bf16_t* wr = (const bf16_t*)(p.ws + WS_WR) + (size_t)l * 128 * 3072;
    for (int u = blockIdx.x; u < 64; u += gridDim.x) {
        ARowLinear ar{xb + (size_t)u * 256 * DM, (size_t)DM}; EpiRouter ep{u, l, dry, &p};
        AOffRouter ao{(int)((WS_XL - WS_XB) / 2)};
        gemm_tile<true>(lds, ar, wr, (size_t)3072, 3072, ep, ao);
    }
    if (!dry) expert_weights(lds, p, l);
}
struct MoeMap {
    int c, f, pr, pf, pp, pb, nfull, npart;
    __device__ __forceinline__ void init(const unsigned* cnt, int lane) {
        c = lane < 32 ? (int)cnt[lane * 32] : 0; f = c >> 8; pr = (c & 255) ? 1 : 0;
        int sf = f, sp = pr, sb = f + pr;
#pragma unroll
        for (int o = 1; o < 32; o <<= 1) { const int tf = __shfl_up(sf, o), tp = __shfl_up(sp, o), tb = __shfl_up(sb, o); if ((lane & 63) >= o) { sf += tf; sp += tp; sb += tb; } }
        pf = sf - f; pp = sp - pr; pb = sb - (f + pr);
        nfull = __builtin_amdgcn_readlane(sf, 31); npart = __builtin_amdgcn_readlane(sp, 31);
    }
    __device__ __forceinline__ void find(bool big, int want, int lane, int& e, int& rb, int& rbg, int& nvalid) const {
        const bool hit = lane < 32 && (big ? (want >= pf && want < pf + f) : (pr && pp == want));
        const unsigned long long m = __ballot(hit);
        const int src = m ? (int)__builtin_ctzll(m) : 0;
        e = src;
        const int f_s = __builtin_amdgcn_readlane(f, src), pf_s = __builtin_amdgcn_readlane(pf, src), pb_s = __builtin_amdgcn_readlane(pb, src), c_s = __builtin_amdgcn_readlane(c, src);
        rb = big ? want - pf_s : f_s; rbg = pb_s + rb; nvalid = big ? 256 : (c_s & 255);
    }
};
struct MkGU { int pn; size_t slot0; const Params* p; __device__ __forceinline__ EpiGU operator()(int half) const { return EpiGU{2 * pn + half, slot0, p}; } };
__device__ __forceinline__ void ph_gateup(LAS uchar* lds, const Params& p, int l) {
    uchar* ws = p.ws; const unsigned* cnt = (const unsigned*)(ws + WS_CTL) + CW_CNT + 1024 * l;
    const int lane = tid_opaque() & 63;
    MoeMap mm; mm.init(cnt, lane);
    const int nfull = mm.nfull, tot = nfull * 2 + mm.npart * 4;
    for (int u = blockIdx.x; u < tot; u += gridDim.x) {
        const bool big = u < nfull * 2;
        const int want = big ? (u >> 1) : ((u - nfull * 2) >> 2);
        int e, rb, rbg, nvalid; mm.find(big, want, lane, e, rb, rbg, nvalid);
        const unsigned* list = (const unsigned*)(ws + WS_LIST) + (size_t)e * T + rb * 256;
        ARowGather ar{(const bf16_t*)(ws + WS_XB), list, nvalid};
        { const int tp = tid_opaque(); if (tp < 256) { const int rr = tp < nvalid ? tp : nvalid - 1; ((LAS float*)(lds + LDS_ROW))[tp] = ((const float*)(ws + WS_RSTD2))[list[rr] >> 1]; } }
        if (big) { const int pn = u & 1; MkGU mk{pn, (size_t)rbg * 256, &p};
            gemm_big(lds, ar, (const bf16_t*)(ws + WS_WGU) + ((size_t)e * 512 + pn * 256) * DM, (size_t)DM, DM, mk); }
        else { const int jt = (u - nfull * 2) & 3; EpiGU ep{jt, (size_t)rbg * 256, &p};
            gemm_tile(lds, ar, (const bf16_t*)(ws + WS_WGU) + ((size_t)e * 512 + jt * 128) * DM, (size_t)DM, DM, ep); }
    }
}
struct MkDown { int pn, nvalid; const Params* p; __device__ __forceinline__ EpiDown operator()(int half) const { return EpiDown{2 * pn + half, nvalid, p}; } };
__device__ __forceinline__ void ph_down(LAS uchar* lds, const Params& p, int l) {
    uchar* ws = p.ws; const unsigned* cnt = (const unsigned*)(ws + WS_CTL) + CW_CNT + 1024 * l;
    const int lane = tid_opaque() & 63;
    MoeMap mm; mm.init(cnt, lane);
    const int nfull = mm.nfull, tot = nfull * 4 + mm.npart * 8;
    for (int u = blockIdx.x; u < tot; u += gridDim.x) {
        const bool big = u < nfull * 4;
        const int want = big ? (u >> 2) : ((u - nfull * 4) >> 3);
        int e, rb, rbg, nvalid; mm.find(big, want, lane, e, rb, rbg, nvalid);
        const unsigned* list = (const unsigned*)(ws + WS_LIST) + (size_t)e * T + rb * 256;
        ARowLinear ar{(const bf16_t*)(ws + WS_HMID) + (size_t)rbg * 256 * 256, (size_t)256};
        { const int tp = tid_opaque(); if (tp < 256) { const int rr = tp < nvalid ? tp : nvalid - 1; const unsigned ent = list[rr];
            ((LAS unsigned*)(lds + LDS_ROW + 1024))[tp] = ent; ((LAS float*)(lds + LDS_ROW))[tp] = ((const float*)(ws + WS_GW))[ent]; } }
        if (big) { const int pn = u & 3; MkDown mk{pn, nvalid, &p};
            gemm_big(lds, ar, (const bf16_t*)(ws + WS_WD) + ((size_t)e * DM + pn * 256) * 256, (size_t)256, 256, mk); }
        else { const int nt = (u - nfull * 4) & 7; EpiDown ep{nt, nvalid, &p};
            gemm_tile(lds, ar, (const bf16_t*)(ws + WS_WD) + ((size_t)e * DM + nt * 128) * 256, (size_t)256, 256, ep); }
    }
}
__device__ __forceinline__ void ph_combine(LAS uchar* lds, const Params& p, int l, bool dry = false) {
    uchar* ws = p.ws; const int tid = tid_opaque(), lane = tid & 63;
    const int gw = blockIdx.x * 8 + (tid >> 6), nw = gridDim.x * 8;
    const bf16_t* ys = (const bf16_t*)(ws + WS_YS);
    for (int t = gw; t < T; t += nw) {
        const bf16_t* xh = (const bf16_t*)(ws + WS_XB) + (size_t)t * DM; const bf16_t* xl = (const bf16_t*)(ws + WS_XL) + (size_t)t * DM;
        const bf16_t* y0 = ys + (size_t)(2 * t) * DM; const bf16_t* y1 = y0 + DM;
        float* xw = dry ? (float*)(ws + WS_POOLED) + (size_t)(t & 511) * DM : p.out + (size_t)t * DM;
        bf16_t* xb = dry ? (bf16_t*)(ws + WS_POOLED + 4 * MiB) + (size_t)(t & 511) * DM : (bf16_t*)(ws + WS_XB) + (size_t)t * DM;
        float ss = 0.f;
#pragma unroll
        for (int i = 0; i < 4; ++i) {
            const int c = i * 256 + lane * 4;
            const u32x2 hv = *(const u32x2*)(xh + c), lv = *(const u32x2*)(xl + c);
            f32x4 v; v[0] = bflo(hv[0]) + bflo(lv[0]); v[1] = bfhi(hv[0]) + bfhi(lv[0]); v[2] = bflo(hv[1]) + bflo(lv[1]); v[3] = bfhi(hv[1]) + bfhi(lv[1]);
            const u32x2 a = *(const u32x2*)(y0 + c), bq = *(const u32x2*)(y1 + c);
            v[0] += bflo(a[0]) + bflo(bq[0]); v[1] += bfhi(a[0]) + bfhi(bq[0]); v[2] += bflo(a[1]) + bflo(bq[1]); v[3] += bfhi(a[1]) + bfhi(bq[1]);
            *(f32x4*)(xw + c) = v; ss += v[0] * v[0] + v[1] * v[1] + v[2] * v[2] + v[3] * v[3];
            u32x2 o; o[0] = pk2(v[0], v[1]); o[1] = pk2(v[2], v[3]); *(u32x2*)(xb + c) = o;
        }
        ss = wave_sum(ss);
        if (lane == 0) ((float*)(ws + (dry ? WS_POOLED + 6 * MiB : WS_RSTD1)))[t] = __builtin_amdgcn_rsqf(ss * (1.f / 1024.f) + EPS);
    }

}

__global__ void __launch_bounds__(NT, 2) mega(Params p) {
    extern __shared__ __attribute__((aligned(16))) unsigned char smem[];
    LAS uchar* lds = (LAS uchar*)smem;
    if (threadIdx.x == 0) { *(LAS u32x4*)(lds + LDS_XB) = (u32x4){0u, 0u, 0u, 0u}; }
    __syncthreads();
    XcdBarrier bar = xcd_barrier_post((unsigned*)(p.ws + WS_CTL), (volatile LAS unsigned*)(lds + LDS_XB));
#define IN(k) (p.ph_lo <= (k) && (k) < p.ph_hi)
#define SEAM(k) do { if (IN(k) && IN((k) + 1)) xcd_barrier(bar); } while (0)
    if (IN(0)) for (int rep = 0; rep < NREP(8); ++rep) phase0(lds, p);
    SEAM(0);
#define LAUNDER(v) asm volatile("" : "+s"(v))
#pragma unroll 1
    for (int l0 = 0; l0 < NL; ++l0) {
        const int pb = 1 + 8 * l0;
        { int l = l0; LAUNDER(l); if (IN(pb + 0)) for (int rep = 0; rep < NREP(0); ++rep) ph_gemm1(lds, p, l); }
        SEAM(pb + 0);
        { int l = l0; LAUNDER(l); if (IN(pb + 1)) for (int rep = 0; rep < NREP(1); ++rep) ph_mix_a(lds, p, l); }
        SEAM(pb + 1);
        { int l = l0; LAUNDER(l); if (IN(pb + 2)) for (int rep = 0; rep < NREP(2); ++rep) ph_mix_b(lds, p, l); }
        SEAM(pb + 2);
        { int l = l0; LAUNDER(l); if (IN(pb + 3)) for (int rep = 0; rep < (l == 0 ? NREP(3) : 1); ++rep) ph_wout(lds, p, l); }
        SEAM(pb + 3);
        { int l = l0; LAUNDER(l); if (IN(pb + 4)) { if (NREP(4) > 1) ph_router(lds, p, l, true); ph_router(lds, p, l); } }
        SEAM(pb + 4);
        { int l = l0; LAUNDER(l); if (IN(pb + 5)) for (int rep = 0; rep < NREP(5); ++rep) ph_gateup(lds, p, l); }
        SEAM(pb + 5);
        { int l = l0; LAUNDER(l); if (IN(pb + 6)) for (int rep = 0; rep < NREP(6); ++rep) ph_down(lds, p, l); }
        SEAM(pb + 6);
        { int l = l0; LAUNDER(l); if (IN(pb + 7)) { if (NREP(7) > 1) ph_combine(lds, p, l, true); ph_combine(lds, p, l); } }
        SEAM(pb + 7);
    }
}

extern "C" void kernel_launch(void* const* d_in, const int* in_sizes, int n_in, void* d_out, int out_size, void* d_ws, size_t ws_size, hipStream_t stream) {
    (void)in_sizes; (void)n_in; (void)out_size;
    static int grid = 0;
    if (!grid) {
        int dev = 0, cus = 0, per_cu = 0;
        hipGetDevice(&dev);
        hipDeviceGetAttribute(&cus, hipDeviceAttributeMultiprocessorCount, dev);
        hipFuncSetAttribute((const void*)mega, hipFuncAttributeMaxDynamicSharedMemorySize, LDS_BYTES);
        hipOccupancyMaxActiveBlocksPerMultiprocessor(&per_cu, (const void*)mega, NT, LDS_BYTES);
        if (per_cu > 1) per_cu = 1;
        if (per_cu < 1) per_cu = 1;
        grid = cus * per_cu;
    }
    if (ws_size < WS_END) { fprintf(stderr, "workspace too small: %zu < %zu\n", ws_size, (size_t)WS_END); return; }
    hipMemsetAsync(d_ws, 0, CTL_ZERO_BYTES, stream);
    Params p{};
    for (int i = 0; i < 26; ++i) p.in[i] = (const float*)d_in[i];
    p.out = (float*)d_out; p.ws = (unsigned char*)d_ws;
#if N_LAUNCH_SPLIT
    for (int k = 0; k < NPH; ++k) { p.ph_lo = k; p.ph_hi = k + 1; hipLaunchKernelGGL(mega, dim3(grid), dim3(NT), LDS_BYTES, stream, p); }
#else
    p.ph_lo = 0; p.ph_hi = NPH;
    hipLaunchKernelGGL(mega, dim3(grid), dim3(NT), LDS_BYTES, stream, p);
#endif
}
```

```cpp
#include <hip/hip_runtime.h>
#include <stdint.h>
#include <stdio.h>

#ifndef NAIVE_GEMM
#define NAIVE_GEMM 0
#endif
#ifndef NAIVE_ATTN
#define NAIVE_ATTN 0
#endif
#ifndef N_LAUNCH_SPLIT
#define N_LAUNCH_SPLIT 0
#endif

#ifndef SHADOW_V
#define SHADOW_V -1
#endif
#ifndef SHADOW_G
#define SHADOW_G -1
#endif
#ifndef REPEAT_MASK
#define REPEAT_MASK 0
#endif
#define NREP(k) ((((REPEAT_MASK) >> (k)) & 1) + 1)
#define LAS __attribute__((address_space(3)))
typedef unsigned char uchar;
typedef unsigned short bf16_t;
typedef short bf16x8 __attribute__((ext_vector_type(8)));
typedef float f32x16 __attribute__((ext_vector_type(16)));
typedef float f32x2_t __attribute__((ext_vector_type(2)));
typedef __bf16 bf16x2_t __attribute__((ext_vector_type(2)));
typedef unsigned u32x4 __attribute__((ext_vector_type(4)));
typedef unsigned u32x2 __attribute__((ext_vector_type(2)));
typedef float f32x4 __attribute__((ext_vector_type(4)));

constexpr int NB = 8, S = 2048, DM = 1024, T = NB * S, NL = 2;
constexpr int NIN = 2144, NINP = 2176;
constexpr float EPS = 1e-6f, LOG2E = 1.4426950408889634f;
constexpr float QSCALE_D = 0.125f * LOG2E;
constexpr float QSCALE_M = 0.10206207261596577f * LOG2E;
constexpr int NPH = 1 + 8 * NL;

constexpr size_t MiB = (size_t)1 << 20;
constexpr size_t WS_CTL = 0, CTL_ZERO_BYTES = 32768;
constexpr size_t WS_SCAL = 1 * MiB;
constexpr size_t WS_ROPE = 1 * MiB + 64 * 1024;
constexpr size_t WS_RSTD1 = 1 * MiB + 512 * 1024;
constexpr size_t WS_RSTD2 = WS_RSTD1 + 64 * 1024;
constexpr size_t WS_GW = WS_RSTD2 + 64 * 1024;
constexpr size_t WS_LIST = 2 * MiB;
constexpr size_t WS_WIN = 4 * MiB;
constexpr size_t WS_WOUT = 13 * MiB;
constexpr size_t WS_WUQ = 17 * MiB;
constexpr size_t WS_WUKV = 17 * MiB + 512 * 1024;
constexpr size_t WS_POOLW = 17 * MiB + 768 * 1024;
constexpr size_t WS_WR = 18 * MiB;
constexpr size_t WS_PSS = 19 * MiB + 512 * 1024;
constexpr size_t WS_HSS = 12 * MiB + 512 * 1024;
constexpr size_t WS_WGU = 20 * MiB;
constexpr size_t WS_WD = 52 * MiB;
constexpr size_t WS_XB = 68 * MiB;
constexpr size_t WS_MIX = 100 * MiB;
constexpr size_t WS_HMID = WS_MIX;
constexpr size_t WS_QD = 132 * MiB, WS_KD = 148 * MiB, WS_VDT = 164 * MiB;
constexpr size_t WS_LAT = 180 * MiB;
constexpr size_t WS_QM = 200 * MiB, WS_KM = 212 * MiB, WS_VMT = 224 * MiB;
constexpr size_t WS_POOLED = 232 * MiB;
constexpr size_t WS_XL = 200 * MiB;
constexpr size_t WS_YS = 132 * MiB;
constexpr size_t WS_END = 240 * MiB;

#define XB_TMO      128
#define XB_XCNT(j)  (256  + 64 * (j))
#define XB_XSUB(j)  (1280 + 64 * (j))
#define XB_XGEN(j)  (2304 + 64 * (j))
#define XB_TOP      3328
#define XB_TOPGEN   3392
#define XCD_BAR_WORDS 3456
#define XB_SPIN_CAP (1u << 18)
constexpr int CW_CNT = 4096;

constexpr int NT = 512;
constexpr int LDS_XB = 147456;
constexpr int LDS_ROW = LDS_XB + 256;
constexpr int LDS_BYTES = LDS_ROW + 2048;
constexpr int GSTG = 49152;
constexpr int ASTG = 32768;
constexpr int MSTG = 20480;

struct Params {
    const float* in[26];
    float* out;
    unsigned char* ws;
    int ph_lo, ph_hi;
};

__device__ __forceinline__ unsigned pk2(float lo, float hi) { f32x2_t v = {lo, hi}; bf16x2_t b = __builtin_convertvector(v, bf16x2_t); return __builtin_bit_cast(unsigned, b); }
__device__ __forceinline__ float bflo(unsigned w) { return __builtin_bit_cast(float, w << 16); }
__device__ __forceinline__ float bfhi(unsigned w) { return __builtin_bit_cast(float, w & 0xffff0000u); }
__device__ __forceinline__ float bf2f(bf16_t u) { return __builtin_bit_cast(float, (unsigned)u << 16); }
__device__ __forceinline__ bf16_t f2bf(float f) { return (bf16_t)(pk2(f, 0.f) & 0xffffu); }
__device__ __forceinline__ LAS uchar* lds_base() { extern __shared__ __attribute__((aligned(16))) unsigned char smem_dyn_[]; return (LAS uchar*)smem_dyn_; }
__device__ __forceinline__ int tid_opaque() { int t = threadIdx.x; asm volatile("" : "+v"(t)); return t; }
__device__ __forceinline__ int crow(int r, int hi) { return (r & 3) + 8 * (r >> 2) + 4 * hi; }
__device__ __forceinline__ int sigma16(int s) { return (s & ~12) | ((s & 4) << 1) | ((s & 8) >> 1); }
__device__ __forceinline__ float wave_sum(float v) {
#pragma unroll
    for (int o = 32; o >= 1; o >>= 1) v += __shfl_xor(v, o);
    return v;
}
__device__ __forceinline__ void unpack8(u32x4 w, float (&f)[8]) {
    f[0] = bflo(w[0]); f[1] = bfhi(w[0]); f[2] = bflo(w[1]); f[3] = bfhi(w[1]);
    f[4] = bflo(w[2]); f[5] = bfhi(w[2]); f[6] = bflo(w[3]); f[7] = bfhi(w[3]);
}

__device__ __forceinline__ unsigned xb_ld(unsigned* p)              { return __hip_atomic_load(p, __ATOMIC_RELAXED, __HIP_MEMORY_SCOPE_AGENT); }
__device__ __forceinline__ unsigned xb_add(unsigned* p, unsigned v) { return __hip_atomic_fetch_add(p, v, __ATOMIC_RELAXED, __HIP_MEMORY_SCOPE_AGENT); }
__device__ __forceinline__ unsigned xb_xcc_id() { return (unsigned)__builtin_amdgcn_s_getreg((3 << 11) | 20) & 0xFu; }
#define XB_SPIN(cond, bar) do { unsigned _sp = 0; while (cond) { __builtin_amdgcn_s_sleep(1); \
    if ((++_sp & 255u) == 0u) { if (xb_ld(&(bar)[XB_TMO])) break; if (_sp > XB_SPIN_CAP) { atomicAdd(&(bar)[XB_TMO], 1u); break; } } } } while (0)
struct XcdBarrier { unsigned* bar; unsigned x; volatile LAS unsigned* st; };
__device__ __forceinline__ XcdBarrier xcd_barrier_post(unsigned* bar, volatile LAS unsigned* st) {
    XcdBarrier b; b.bar = bar; b.x = xb_xcc_id(); b.st = st;
    if (threadIdx.x == 0) (void)xb_add(&bar[XB_XCNT(b.x)], 1u);
    return b;
}
__device__ __forceinline__ void xcd_barrier_complete(unsigned* bar, unsigned x, unsigned& nloc, unsigned& nx) {
    const unsigned G = gridDim.x * gridDim.y * gridDim.z;
    unsigned sum, cnt, mine, sp = 0u;
    for (;;) {
        sum = 0u; cnt = 0u; mine = 0u;
#pragma unroll
        for (unsigned j = 0; j < 16; ++j) { const unsigned c = xb_ld(&bar[XB_XCNT(j)]); sum += c; cnt += (c > 0u) ? 1u : 0u; mine = (j == x) ? c : mine; }
        if (sum == G) break;
        __builtin_amdgcn_s_sleep(1);
        if ((++sp & 255u) == 0u) { if (xb_ld(&bar[XB_TMO])) break; if (sp > XB_SPIN_CAP) { atomicAdd(&bar[XB_TMO], 1u); break; } }
    }
    nloc = mine > 0u ? mine : 1u; nx = cnt > 0u ? cnt : 1u;
}
__device__ __forceinline__ void xcd_barrier(const XcdBarrier& b) {
    asm volatile("s_waitcnt vmcnt(0)" ::: "memory");
    __syncthreads();
    if (threadIdx.x == 0) {
        unsigned* bar = b.bar;
        __builtin_amdgcn_s_waitcnt(0);
        unsigned nloc = b.st[0], nx = b.st[1];
        if (nloc == 0u) { xcd_barrier_complete(bar, b.x, nloc, nx); b.st[0] = nloc; b.st[1] = nx; }
        const unsigned old = xb_add(&bar[XB_XSUB(b.x)], 1u);
        const unsigned gen = old / nloc;
        if (old + 1u == (gen + 1u) * nloc) {
            __builtin_amdgcn_fence(__ATOMIC_RELEASE, "agent");
            asm volatile("s_waitcnt vmcnt(0)" ::: "memory");
            const unsigned og = xb_add(&bar[XB_TOP], 1u);
            const unsigned tg = og / nx;
            if (og + 1u == (tg + 1u) * nx) xb_add(&bar[XB_TOPGEN], 1u);
            else XB_SPIN(xb_ld(&bar[XB_TOPGEN]) == tg, bar);
            __builtin_amdgcn_fence(__ATOMIC_ACQUIRE, "agent");
            xb_add(&bar[XB_XGEN(b.x)], 1u);
            asm volatile("s_waitcnt vmcnt(0)" ::: "memory");
        } else {
            XB_SPIN(xb_ld(&bar[XB_XGEN(b.x)]) == gen, bar);
            __builtin_amdgcn_fence(__ATOMIC_ACQUIRE, "agent");
            asm volatile("s_waitcnt vmcnt(0)" ::: "memory");
        }
    }
    __syncthreads();
}

__device__ __forceinline__ void glds16(const void* gsrc, LAS uchar* dst_wave_base) {
    __builtin_amdgcn_global_load_lds((const unsigned*)gsrc, (LAS unsigned*)dst_wave_base, 16, 0, 0);
}
__device__ __forceinline__ int sw128(int row, int c) { return row * 128 + ((c ^ ((row >> 1) & 7)) << 4); }
__device__ __forceinline__ int sw64(int row, int c) { return row * 64 + ((c ^ ((row >> 2) & 3)) << 4); }

#define MFMA32(a, b, c) __builtin_amdgcn_mfma_f32_32x32x16_bf16((a), (b), (c), 0, 0, 0)

constexpr int CT_PITCH = 272;
#define WAITV(n) asm volatile("s_waitcnt vmcnt(" #n ")" ::: "memory")
struct ARowLinear { const bf16_t* base; size_t ld; __device__ __forceinline__ const bf16_t* operator()(int r) const { return base + (size_t)r * ld; } };
struct ARowGather { const bf16_t* base; const unsigned* list; int nvalid; __device__ __forceinline__ const bf16_t* operator()(int r) const {
    const int rr = r < nvalid ? r : nvalid - 1; const unsigned ent = list[rr]; return base + (size_t)(ent >> 1) * DM; } };

struct AOffLinear { __device__ __forceinline__ int operator()(int kt) const { return kt * 64; } };
struct AOffRouter { int xl_off; __device__ __forceinline__ int operator()(int kt) const { return (kt & 15) * 64 + ((kt >> 4) == 1 ? xl_off : 0); } };
constexpr int CTF_PITCH = 129;
template <bool F32C = false, class ARow, class Epi, class AOff = AOffLinear>
__device__ __forceinline__ void gemm_tile(LAS uchar* lds, const ARow& arow, const bf16_t* Bt, size_t ldb, int K, const Epi& epi, const AOff aoff = AOff()) {
    const int tid = tid_opaque(), lane = tid & 63, wid = __builtin_amdgcn_readfirstlane(tid >> 6);
#if NAIVE_GEMM
    {
        const int r = tid >> 1, nh = tid & 1;
        float acc[64];
#pragma unroll
        for (int n = 0; n < 64; ++n) acc[n] = 0.f;
        const bf16_t* ar = arow(r);
        for (int k = 0; k < K; k += 8) {
            float a[8]; unpack8(*(const u32x4*)(ar + k), a);
#pragma unroll
            for (int n = 0; n < 64; ++n) {
                float b[8]; unpack8(*(const u32x4*)(Bt + (size_t)(nh * 64 + n) * ldb + k), b);
#pragma unroll
                for (int j = 0; j < 8; ++j) acc[n] += a[j] * b[j];
            }
        }
        __syncthreads();
#pragma unroll
        for (int n = 0; n < 64; n += 2) { if (F32C) { ((LAS float*)lds)[r * CTF_PITCH + nh * 64 + n] = acc[n]; ((LAS float*)lds)[r * CTF_PITCH + nh * 64 + n + 1] = acc[n + 1]; } else *(LAS unsigned*)(lds + r * CT_PITCH + (nh * 64 + n) * 2) = pk2(acc[n], acc[n + 1]); }
    }
#else
    {
        const int wm = wid >> 1, wn = wid & 1, r = lane & 31, hh = lane >> 5;
        const int srow = lane >> 3, c0 = (lane & 7) ^ (srow >> 1);
        const bf16_t* asrc[4];
#pragma unroll
        for (int j = 0; j < 4; ++j) asrc[j] = arow(8 * (wid * 4 + j) + srow) + (c0 ^ ((j & 1) << 2)) * 8;
        const bf16_t* bsrc0 = Bt + (size_t)(wid * 16 + srow) * ldb + c0 * 8;
        const bf16_t* bsrc1 = Bt + (size_t)(wid * 16 + 8 + srow) * ldb + (c0 ^ 4) * 8;
        const int lanebase = r * 128 + ((hh ^ ((r >> 1) & 7)) << 4);
        f32x16 acc[2][2];
#pragma unroll
        for (int a = 0; a < 2; ++a)
#pragma unroll
            for (int b = 0; b < 2; ++b)
#pragma unroll
                for (int i = 0; i < 16; ++i) acc[a][b][i] = 0.f;
        const int nt = K >> 6;
#define GT_STAGE(kt, sb) do { _Pragma("unroll") for (int j = 0; j < 4; ++j) \
            glds16(asrc[j] + aoff(kt), lds + (sb) * GSTG + (wid * 4 + j) * 1024); \
            glds16(bsrc0 + (kt) * 64, lds + (sb) * GSTG + 32768 + (wid * 2) * 1024); \
            glds16(bsrc1 + (kt) * 64, lds + (sb) * GSTG + 32768 + (wid * 2 + 1) * 1024); } while (0)
        GT_STAGE(0, 0);
        if (nt > 1) GT_STAGE(1, 1);
        int sb = 0;
        for (int kt = 0; kt < nt; ++kt) {
            if (kt + 1 < nt) WAITV(6); else WAITV(0);
            __builtin_amdgcn_s_barrier();
            if (kt + 2 < nt) { const int sn = sb >= 1 ? sb - 1 : 2; GT_STAGE(kt + 2, sn); }
            const LAS uchar* xs = lds + sb * GSTG + wm * 8192; const LAS uchar* wsb = lds + sb * GSTG + 32768 + wn * 8192;
#pragma unroll
            for (int ks = 0; ks < 4; ++ks) {
                const int lb = lanebase ^ (ks << 5);
                bf16x8 xf[2], wf[2];
#pragma unroll
                for (int mb = 0; mb < 2; ++mb) xf[mb] = *(const LAS bf16x8*)(xs + mb * 4096 + lb);
#pragma unroll
                for (int nb = 0; nb < 2; ++nb) wf[nb] = *(const LAS bf16x8*)(wsb + nb * 4096 + lb);
#pragma unroll
                for (int nb = 0; nb < 2; ++nb)
#pragma unroll
                    for (int mb = 0; mb < 2; ++mb) acc[nb][mb] = MFMA32(wf[nb], xf[mb], acc[nb][mb]);
            }
            sb = sb == 2 ? 0 : sb + 1;
        }
#undef GT_STAGE
        __syncthreads();
#pragma unroll
        for (int nb = 0; nb < 2; ++nb)
#pragma unroll
            for (int mb = 0; mb < 2; ++mb) {
                const int m = 64 * wm + 32 * mb + r;
#pragma unroll
                for (int q4 = 0; q4 < 4; ++q4) {
                    const int n = 64 * wn + 32 * nb + 8 * q4 + 4 * hh;
                    if (F32C) {
#pragma unroll
                        for (int j = 0; j < 4; ++j) ((LAS float*)lds)[m * CTF_PITCH + n + j] = acc[nb][mb][4 * q4 + j];
                    } else {
                        u32x2 v; v[0] = pk2(acc[nb][mb][4 * q4], acc[nb][mb][4 * q4 + 1]); v[1] = pk2(acc[nb][mb][4 * q4 + 2], acc[nb][mb][4 * q4 + 3]);
                        *(LAS u32x2*)(lds + m * CT_PITCH + n * 2) = v;
                    }
                }
            }
    }
#endif
    __syncthreads();
    epi(lds);
    __syncthreads();
}
constexpr int BSTG = 32768, CT2_OFF = 256 * CT_PITCH;
template <int V = 0, class ARow, class EpiMaker>
__device__ __forceinline__ void gemm_big(LAS uchar* lds, const ARow& arow, const bf16_t* Bt, size_t ldb, int K, const EpiMaker& mk) {
    const int tid = tid_opaque(), lane = tid & 63, wid = __builtin_amdgcn_readfirstlane(tid >> 6);
    {
        const int wm = wid >> 2, wn = wid & 3, r = lane & 31, hh = lane >> 5;
        const int srow = lane >> 3, c0 = (lane & 7) ^ (lane >> 4);
        const bf16_t* asrc[4];
#pragma unroll
        for (int j = 0; j < 4; ++j) asrc[j] = arow(wid * 32 + 8 * j + srow) + (c0 ^ ((j & 1) << 2)) * 8;
        const bf16_t* b0 = Bt + (size_t)(wid * 32 + srow) * ldb + c0 * 8; const bf16_t* b1 = Bt + (size_t)(wid * 32 + srow) * ldb + (c0 ^ 4) * 8;
        const int lanebase = r * 128 + ((hh ^ ((r >> 1) & 7)) << 4);
        f32x16 acc[2][4];
#pragma unroll
        for (int a = 0; a < 2; ++a)
#pragma unroll
            for (int b = 0; b < 4; ++b)
#pragma unroll
                for (int i = 0; i < 16; ++i) acc[a][b][i] = 0.f;
        const int nt = K >> 6;
#define GB_STAGE(kt, sb) do { _Pragma("unroll") for (int j = 0; j < 4; ++j) { \
            glds16(asrc[j] + (kt) * 64, lds + (sb) * 65536 + (wid * 4 + j) * 1024); \
            glds16(((j & 1) ? b1 : b0) + (size_t)(8 * j) * ldb + (kt) * 64, lds + (sb) * 65536 + 32768 + (wid * 4 + j) * 1024); } } while (0)
        if (!(V & 4)) GB_STAGE(0, 0);
        for (int kt = 0; kt < nt; ++kt) {
            const int sb = kt & 1;
            WAITV(0);
            __builtin_amdgcn_s_barrier();
            if (!(V & 4) && kt + 1 < nt) GB_STAGE(kt + 1, sb ^ 1);
            const LAS uchar* xs = lds + sb * 65536 + wm * 16384; const LAS uchar* wsb = lds + sb * 65536 + 32768 + wn * 8192;
#pragma unroll
            for (int ks = 0; ks < 4; ++ks) {
                const int lb = lanebase ^ (ks << 5);
                bf16x8 xf[4], wf[2];
#pragma unroll
                for (int mb = 0; mb < 4; ++mb) xf[mb] = *(const LAS bf16x8*)(xs + mb * 4096 + lb);
#pragma unroll
                for (int nb = 0; nb < 2; ++nb) wf[nb] = *(const LAS bf16x8*)(wsb + nb * 4096 + lb);
#pragma unroll
                for (int nb = 0; nb < 2; ++nb)
#pragma unroll
                    for (int mb = 0; mb < 4; ++mb) acc[nb][mb] = MFMA32(wf[nb], xf[mb], acc[nb][mb]);
            }
        }
#undef GB_STAGE
        __syncthreads();
#pragma unroll
        for (int nb = 0; nb < 2; ++nb)
#pragma unroll
            for (int mb = 0; mb < 4; ++mb) {
                const int m = 128 * wm + 32 * mb + r;
#pragma unroll
                for (int q4 = 0; q4 < 4; ++q4) {
                    const int n = 64 * (wn & 1) + 32 * nb + 8 * q4 + 4 * hh;
                    u32x2 v; v[0] = pk2(acc[nb][mb][4 * q4], acc[nb][mb][4 * q4 + 1]); v[1] = pk2(acc[nb][mb][4 * q4 + 2], acc[nb][mb][4 * q4 + 3]);
                    *(LAS u32x2*)(lds + (wn >> 1) * CT2_OFF + m * CT_PITCH + n * 2) = v;
                }
            }
    }
    __syncthreads();
    if (!(V & 1)) { mk(0)(lds); mk(1)(lds + CT2_OFF); }
    __syncthreads();
}
__device__ __forceinline__ u32x4 ct_ld8(const LAS uchar* ct, int r, int c) { return *(const LAS u32x4*)(ct + r * CT_PITCH + c * 2); }
__device__ __forceinline__ float ct_ld1(const LAS uchar* ct, int r, int c) { return bf2f(*(const LAS bf16_t*)(ct + r * CT_PITCH + c * 2)); }

struct EpiProj {
    int mt, nt, l; const Params* p;
    __device__ __forceinline__ void operator()(const LAS uchar* ct) const {
        uchar* ws = p->ws; const int tid = tid_opaque();
        const LAS float* rowS = (const LAS float*)(lds_base() + LDS_ROW);
        const int t0 = mt * 256, b = t0 >> 11, s0 = t0 & 2047;
        if (nt < 8) {
            const int h = nt & 3; const bool isq = nt < 4;
            const int c8 = tid & 7, j = (tid >> 3) & 1, r0 = tid >> 4;
            const float* g = p->in[isq ? 3 : 4] + l * 64 + c8 * 8;
            const f32x4 g0 = *(const f32x4*)g, g1 = *(const f32x4*)(g + 4);
            bf16_t* dbase = (bf16_t*)(ws + (isq ? WS_QD : WS_KD)) + ((((size_t)b * 4 + h) * 2 + j) * S + s0) * 64 + c8 * 8;
#pragma unroll
            for (int it = 0; it < 8; ++it) {
                const int r = it * 32 + r0;
                const float rs = rowS[r];
                float f[8]; unpack8(ct_ld8(ct, r, j * 64 + c8 * 8), f);
                float ss = 0.f;
#pragma unroll
                for (int i = 0; i < 8; ++i) { f[i] *= rs; ss += f[i] * f[i]; }
                ss += __shfl_xor(ss, 1); ss += __shfl_xor(ss, 2); ss += __shfl_xor(ss, 4);
                const float rn = __builtin_amdgcn_rsqf(ss * (1.f / 64.f) + EPS) * (isq ? QSCALE_D : 1.f);
                u32x4 o; o[0] = pk2(f[0] * rn * g0[0], f[1] * rn * g0[1]); o[1] = pk2(f[2] * rn * g0[2], f[3] * rn * g0[3]);
                o[2] = pk2(f[4] * rn * g1[0], f[5] * rn * g1[1]); o[3] = pk2(f[6] * rn * g1[2], f[7] * rn * g1[3]);
                *(u32x4*)(dbase + (size_t)r * 64) = o;
            }
        } else if (nt < 12) {
            const int h = nt - 8, d = tid >> 2, half = tid & 3;
            bf16_t* dst = (bf16_t*)(ws + WS_VDT) + (((size_t)b * 4 + h) * 128 + d) * S + s0 + half * 64;
#pragma unroll
            for (int c8 = 0; c8 < 8; ++c8) { u32x4 o;
#pragma unroll
                for (int i = 0; i < 4; ++i) {
                    const int p0 = c8 * 8 + 2 * i, r0 = half * 64 + sigma16(p0), r1 = half * 64 + sigma16(p0 + 1);
                    o[i] = pk2(ct_ld1(ct, r0, d) * rowS[r0], ct_ld1(ct, r1, d) * rowS[r1]); }
                *(u32x4*)(dst + c8 * 8) = o; }
        } else {
            const int c8 = tid & 15, r0 = tid >> 4;
            bf16_t* dbase = (bf16_t*)(ws + WS_LAT) + (size_t)t0 * 640 + (nt - 12) * 128 + c8 * 8;
            const int hidx = (nt - 12) * 2 + (c8 >> 3);
            float* hss = (float*)(ws + WS_HSS) + (size_t)t0 * 8 + hidx;
#pragma unroll
            for (int it = 0; it < 8; ++it) {
                const int r = it * 32 + r0;
                const float rs = rowS[r];
                float f[8]; unpack8(ct_ld8(ct, r, c8 * 8), f); u32x4 o;
#pragma unroll
                for (int i = 0; i < 4; ++i) o[i] = pk2(f[2 * i] * rs, f[2 * i + 1] * rs);
                *(u32x4*)(dbase + (size_t)r * 640) = o;
                float ss = 0.f;
#pragma unroll
                for (int i = 0; i < 4; ++i) { const float a = bflo(o[i]), bq = bfhi(o[i]); ss += a * a + bq * bq; }
                ss += __shfl_xor(ss, 1); ss += __shfl_xor(ss, 2); ss += __shfl_xor(ss, 4);
                if ((c8 & 7) == 0 && hidx < 8) hss[(size_t)r * 8] = ss;
            }
        }
    }
};

__device__ __forceinline__ float lat_rstd(const bf16_t* seg, int n) {
    float ss = 0.f;
    for (int k = 0; k < n; k += 8) { float f[8]; unpack8(*(const u32x4*)(seg + k), f);
#pragma unroll
        for (int i = 0; i < 8; ++i) ss += f[i] * f[i]; }
    return __builtin_amdgcn_rsqf(ss / (float)n + EPS);
}
__device__ __forceinline__ void norm_rope32(float (&y)[32], const float* g, const float* cosr, const float* sinr, float outscale) {
    float ss = 0.f;
#pragma unroll
    for (int i = 0; i < 32; ++i) ss += y[i] * y[i];
    const float rn = __builtin_amdgcn_rsqf(ss * (1.f / 32.f) + EPS);
#pragma unroll
    for (int i = 0; i < 32; ++i) y[i] = y[i] * rn * g[i];
#pragma unroll
    for (int i = 0; i < 16; ++i) { const float c = cosr[i], sn = sinr[i], x1 = y[i], x2 = y[16 + i];
        y[i] = (x1 * c - x2 * sn) * outscale; y[16 + i] = (x2 * c + x1 * sn) * outscale; }
}

__device__ __forceinline__ u32x4 norm64_piece(float (&f)[8], const float* g8, float outscale) {
    float ss = 0.f;
#pragma unroll
    for (int i = 0; i < 8; ++i) ss += f[i] * f[i];
    ss += __shfl_xor(ss, 1); ss += __shfl_xor(ss, 2); ss += __shfl_xor(ss, 4);
    const float rn = __builtin_amdgcn_rsqf(ss * (1.f / 64.f) + EPS) * outscale;
    const f32x4 g0 = *(const f32x4*)g8, g1 = *(const f32x4*)(g8 + 4);
    u32x4 o; o[0] = pk2(f[0] * rn * g0[0], f[1] * rn * g0[1]); o[1] = pk2(f[2] * rn * g0[2], f[3] * rn * g0[3]);
    o[2] = pk2(f[4] * rn * g1[0], f[5] * rn * g1[1]); o[3] = pk2(f[6] * rn * g1[2], f[7] * rn * g1[3]);
    return o;
}
__device__ __forceinline__ u32x4 norm_rope_piece(float (&f)[8], int c8, const float* g, const float* cosr, const float* sinr, float outscale) {
    float ss = 0.f;
#pragma unroll
    for (int i = 0; i < 8; ++i) ss += f[i] * f[i];
    ss += __shfl_xor(ss, 1); ss += __shfl_xor(ss, 2);
    const float rn = __builtin_amdgcn_rsqf(ss * (1.f / 32.f) + EPS);
    float y[8], z[8];
#pragma unroll
    for (int i = 0; i < 8; ++i) y[i] = f[i] * rn * g[c8 * 8 + i];
#pragma unroll
    for (int i = 0; i < 8; ++i) z[i] = __shfl_xor(y[i], 2);
    const int fi = (c8 & 1) * 8;
    float o[8];
#pragma unroll
    for (int i = 0; i < 8; ++i) { const float c = cosr[fi + i], sn = sinr[fi + i];
        o[i] = ((c8 < 2) ? (y[i] * c - z[i] * sn) : (y[i] * c + z[i] * sn)) * outscale; }
    u32x4 w; w[0] = pk2(o[0], o[1]); w[1] = pk2(o[2], o[3]); w[2] = pk2(o[4], o[5]); w[3] = pk2(o[6], o[7]);
    return w;
}
struct EpiMlaQ {
    int mt, h, l; const Params* p;
    __device__ __forceinline__ void operator()(const LAS uchar* ct) const {
        uchar* ws = p->ws; const int tid = tid_opaque();
        const LAS float* rowS = (const LAS float*)(lds_base() + LDS_ROW);
        const int t0 = mt * 256, b = t0 >> 11, s0 = t0 & 2047;
        bf16_t* dbase = (bf16_t*)(ws + WS_QM) + (((size_t)b * 4 + h) * S + s0) * 96;
        const float* gn = p->in[11] + l * 64; const float* gr = p->in[12] + l * 32;
        {
            const int c8 = tid & 7, r0 = tid >> 3;
#pragma unroll
            for (int it = 0; it < 4; ++it) {
                const int r = it * 64 + r0; const float rs = rowS[r];
                float f[8]; unpack8(ct_ld8(ct, r, c8 * 8), f);
#pragma unroll
                for (int i = 0; i < 8; ++i) f[i] *= rs;
                *(u32x4*)(dbase + (size_t)r * 96 + c8 * 8) = norm64_piece(f, gn + c8 * 8, QSCALE_M);
            }
        }
        {
            const int c8 = tid & 3, r0 = tid >> 2;
#pragma unroll
            for (int it = 0; it < 2; ++it) {
                const int r = it * 128 + r0; const float rs = rowS[r];
                float f[8]; unpack8(ct_ld8(ct, r, 64 + c8 * 8), f);
#pragma unroll
                for (int i = 0; i < 8; ++i) f[i] *= rs;
                const float* cosr = (const float*)(ws + WS_ROPE) + (s0 + r) * 16; const float* sinr = cosr + S * 16;
                *(u32x4*)(dbase + (size_t)r * 96 + 64 + c8 * 8) = norm_rope_piece(f, c8, gr, cosr, sinr, QSCALE_M);
            }
        }
    }
};
struct EpiMlaKV {
    int mt, h, l; const Params* p;
    __device__ __forceinline__ void operator()(const LAS uchar* ct) const {
        uchar* ws = p->ws; const int tid = tid_opaque();
        const LAS float* rowS = (const LAS float*)(lds_base() + LDS_ROW);
        const int t0 = mt * 256, b = t0 >> 11, s0 = t0 & 2047;
        bf16_t* dbase = (bf16_t*)(ws + WS_KM) + (((size_t)b * 4 + h) * S + s0) * 96;
        const float* gn = p->in[13] + l * 64; const float* gr = p->in[14] + l * 32;
        {
            const int c8 = tid & 7, r0 = tid >> 3;
#pragma unroll
            for (int it = 0; it < 4; ++it) {
                const int r = it * 64 + r0; const float rs = rowS[r];
                float f[8]; unpack8(ct_ld8(ct, r, c8 * 8), f);
#pragma unroll
                for (int i = 0; i < 8; ++i) f[i] *= rs;
                *(u32x4*)(dbase + (size_t)r * 96 + c8 * 8) = norm64_piece(f, gn + c8 * 8, 1.f);
            }
        }
        {
            const bf16_t* lat = (const bf16_t*)(ws + WS_LAT) + (size_t)t0 * 640 + 320;
            const int c8 = tid & 3, r0 = tid >> 2;
#pragma unroll
            for (int it = 0; it < 2; ++it) {
                const int r = it * 128 + r0;
                float f[8]; unpack8(*(const u32x4*)(lat + (size_t)r * 640 + c8 * 8), f);
                const float* cosr = (const float*)(ws + WS_ROPE) + (s0 + r) * 16; const float* sinr = cosr + S * 16;
                *(u32x4*)(dbase + (size_t)r * 96 + 64 + c8 * 8) = norm_rope_piece(f, c8, gr, cosr, sinr, 1.f);
            }
        }
        {
            const int d = tid >> 3, q4 = tid & 7;
            bf16_t* dst = (bf16_t*)(ws + WS_VMT) + (((size_t)b * 4 + h) * 64 + d) * S + s0 + q4 * 32;
#pragma unroll
            for (int c8 = 0; c8 < 4; ++c8) { u32x4 o;
#pragma unroll
                for (int i = 0; i < 4; ++i) {
                    const int p0 = c8 * 8 + 2 * i, r0 = q4 * 32 + sigma16(p0), r1 = q4 * 32 + sigma16(p0 + 1);
                    o[i] = pk2(ct_ld1(ct, r0, 64 + d) * rowS[r0], ct_ld1(ct, r1, 64 + d) * rowS[r1]); }
                *(u32x4*)(dst + c8 * 8) = o; }
        }
    }
};
struct EpiPool {
    int mt, g, l; const Params* p;
    __device__ __forceinline__ void operator()(const LAS uchar* ct) const {
        uchar* ws = p->ws; const int tid = tid_opaque(), c8 = tid & 7, r0 = tid >> 3;
        const float* sc = p->in[16] + l * 256 + g * 64 + c8 * 8;
        const f32x4 s0 = *(const f32x4*)sc, s1 = *(const f32x4*)(sc + 4);
        bf16_t* dst = (bf16_t*)(ws + WS_MIX) + (size_t)(mt * 256) * DM + 768 + g * 64 + c8 * 8;
#pragma unroll
        for (int it = 0; it < 4; ++it) {
            const int r = it * 64 + r0;
            float f[8]; unpack8(ct_ld8(ct, r, c8 * 8), f); u32x4 o;
            o[0] = pk2(f[0] * s0[0], f[1] * s0[1]); o[1] = pk2(f[2] * s0[2], f[3] * s0[3]); o[2] = pk2(f[4] * s1[0], f[5] * s1[1]); o[3] = pk2(f[6] * s1[2], f[7] * s1[3]);
            *(u32x4*)(dst + (size_t)r * DM) = o;
        }
    }
};
struct EpiWout {
    int mt, nt; const float* xres; const Params* p;
    __device__ __forceinline__ void operator()(const LAS uchar* ct) const {
        uchar* ws = p->ws; const int tid = tid_opaque();
        const size_t base = (size_t)(mt * 256) * DM + nt * 128;
        float* pss = (float*)(ws + WS_PSS) + (size_t)(mt * 256) * 8 + nt;
#pragma unroll 8
        for (int it = 0; it < 16; ++it) {
            const int item = it * NT + tid, c4 = item & 31, r = item >> 5;
            const size_t off = base + (size_t)r * DM + c4 * 4;
            const u32x2 cw = *(const LAS u32x2*)(ct + r * CT_PITCH + c4 * 8);
            const f32x4 x0 = *(const f32x4*)(xres + off);
            f32x4 y; y[0] = x0[0] + bflo(cw[0]); y[1] = x0[1] + bfhi(cw[0]); y[2] = x0[2] + bflo(cw[1]); y[3] = x0[3] + bfhi(cw[1]);
            u32x2 o; o[0] = pk2(y[0], y[1]); o[1] = pk2(y[2], y[3]);
            *(u32x2*)((bf16_t*)(ws + WS_XB) + off) = o;
            u32x2 ol; ol[0] = pk2(y[0] - bflo(o[0]), y[1] - bfhi(o[0])); ol[1] = pk2(y[2] - bflo(o[1]), y[3] - bfhi(o[1]));
            *(u32x2*)((bf16_t*)(ws + WS_XL) + off) = ol;
            float ss = y[0] * y[0] + y[1] * y[1] + y[2] * y[2] + y[3] * y[3];
            ss += __shfl_xor(ss, 1); ss += __shfl_xor(ss, 2); ss += __shfl_xor(ss, 4); ss += __shfl_xor(ss, 8); ss += __shfl_xor(ss, 16);
            if (c4 == 0) pss[(size_t)r * 8] = ss;
        }
    }
};
struct EpiGU {
    int jt; size_t slot0; const Params* p;
    __device__ __forceinline__ void operator()(const LAS uchar* ct) const {
        uchar* ws = p->ws; const int tid = tid_opaque(), c8 = tid & 7, r0 = tid >> 3;
        const LAS float* rowS = (const LAS float*)(lds_base() + LDS_ROW);
        bf16_t* dbase = (bf16_t*)(ws + WS_HMID) + slot0 * 256 + jt * 64 + c8 * 8;
#pragma unroll
        for (int it = 0; it < 4; ++it) {
            const int r = it * 64 + r0;
            const float rs = rowS[r];
            float g[8], u[8]; unpack8(ct_ld8(ct, r, c8 * 8), g); unpack8(ct_ld8(ct, r, 64 + c8 * 8), u);
            float hv[8];
#pragma unroll
            for (int i = 0; i < 8; ++i) { const float gg = g[i] * rs, uu = u[i] * rs; hv[i] = gg * __builtin_amdgcn_rcpf(1.f + __builtin_amdgcn_exp2f(-gg * LOG2E)) * uu; }
            u32x4 o; o[0] = pk2(hv[0], hv[1]); o[1] = pk2(hv[2], hv[3]); o[2] = pk2(hv[4], hv[5]); o[3] = pk2(hv[6], hv[7]);
            *(u32x4*)(dbase + (size_t)r * 256) = o;
        }
    }
};
struct EpiDown {
    int nt, nvalid; const Params* p;
    __device__ __forceinline__ void operator()(const LAS uchar* ct) const {
        uchar* ws = p->ws; const int tid = tid_opaque(), c8 = tid & 15, r0 = tid >> 4;
        const LAS float* rowS = (const LAS float*)(lds_base() + LDS_ROW); const LAS unsigned* rowE = (const LAS unsigned*)(lds_base() + LDS_ROW + 1024);
        bf16_t* ys = (bf16_t*)(ws + WS_YS) + nt * 128 + c8 * 8;
#pragma unroll
        for (int it = 0; it < 8; ++it) {
            const int r = it * 32 + r0;
            if (r < nvalid) {
                const unsigned ent = rowE[r]; const float w = rowS[r];
                float f[8]; unpack8(ct_ld8(ct, r, c8 * 8), f); u32x4 o;
#pragma unroll
                for (int i = 0; i < 4; ++i) o[i] = pk2(f[2 * i] * w, f[2 * i + 1] * w);
                *(u32x4*)(ys + (size_t)ent * DM) = o;
            }
        }
    }
};

template <int V = 0>
__device__ __forceinline__ void diff_attn_unit(LAS uchar* lds, const Params& p, int l, int b, int h, int qb) {
    uchar* ws = p.ws;
    const int tid = tid_opaque(), lane = tid & 63, wid = __builtin_amdgcn_readfirstlane(tid >> 6);
    const float* scal = (const float*)(ws + WS_SCAL) + 16 * l;
    const float lam = scal[0], oml = scal[1], m2 = scal[2];
    const float slope2 = exp2f(-2.f * (float)(h + 1)) * LOG2E;
    const bf16_t* Q1 = (const bf16_t*)(ws + WS_QD) + (((size_t)b * 4 + h) * 2) * S * 64;
    const bf16_t* K1 = (const bf16_t*)(ws + WS_KD) + (((size_t)b * 4 + h) * 2) * S * 64;
    const bf16_t* VT = (const bf16_t*)(ws + WS_VDT) + (((size_t)b * 4 + h) * 128) * S;
    const float* gsub = p.in[6] + l * 128;
    bf16_t* mix = (bf16_t*)(ws + WS_MIX);
#if NAIVE_ATTN
    {
        const int q = qb * 128 + (tid >> 2), mm = (tid >> 1) & 1, dh = tid & 1;
        const bf16_t* Qp = Q1 + (size_t)mm * S * 64 + (size_t)q * 64; const bf16_t* Kp = K1 + (size_t)mm * S * 64;
        float qv[64];
#pragma unroll
        for (int c8 = 0; c8 < 8; ++c8) { float f[8]; unpack8(*(const u32x4*)(Qp + c8 * 8), f);
#pragma unroll
            for (int i = 0; i < 8; ++i) qv[c8 * 8 + i] = f[i]; }
        float o[64]; float lsum = 0.f;
#pragma unroll
        for (int d = 0; d < 64; ++d) o[d] = 0.f;
        for (int key = 0; key < S; ++key) {
            float sc = 0.f;
#pragma unroll
            for (int c8 = 0; c8 < 8; ++c8) { float f[8]; unpack8(*(const u32x4*)(Kp + (size_t)key * 64 + c8 * 8), f);
#pragma unroll
                for (int i = 0; i < 8; ++i) sc += qv[c8 * 8 + i] * f[i]; }
            const float pv = __builtin_amdgcn_exp2f(sc - slope2 * fabsf((float)(q - key)) - m2);
            lsum += pv;
            const int kp = sigma16(key);
#pragma unroll
            for (int d = 0; d < 64; ++d) o[d] += pv * bf2f(VT[(size_t)(dh * 64 + d) * S + kp]);
        }
        const float inv = 1.f / lsum; float ss = 0.f;
#pragma unroll
        for (int d = 0; d < 64; ++d) { const float mine = o[d] * inv; const float other = __shfl_xor(mine, 2); o[d] = mine - lam * other; ss += o[d] * o[d]; }
        ss += __shfl_xor(ss, 1);
        if (mm == 0) {
            const float rn = __builtin_amdgcn_rsqf(ss * (1.f / 128.f) + EPS) * oml;
            bf16_t* dst = mix + (size_t)(b * S + q) * DM + h * 128 + dh * 64;
#pragma unroll
            for (int d = 0; d < 64; d += 2) *(unsigned*)(dst + d) = pk2(o[d] * rn * gsub[dh * 64 + d], o[d + 1] * rn * gsub[dh * 64 + d + 1]);
        }
    }
#else
    {
        const int r = lane & 31, hh = lane >> 5, qs = wid >> 1, mm = wid & 1, qpos = qb * 128 + qs * 32 + r;
        const bf16_t* Qm_ = Q1 + (size_t)mm * S * 64;
        bf16x8 qf[4];
#pragma unroll
        for (int ks = 0; ks < 4; ++ks) qf[ks] = *(const bf16x8*)(Qm_ + (size_t)qpos * 64 + ks * 16 + hh * 8);
        f32x16 O[4]; float lsum = 0.f;
#pragma unroll
        for (int db = 0; db < 4; ++db)
#pragma unroll
            for (int i = 0; i < 16; ++i) O[db][i] = 0.f;
        const int srow = lane >> 3, c0 = (lane & 7) ^ (srow >> 1);
        const bool isk = wid < 4;
        const bf16_t* sbase = isk ? (K1 + (size_t)(wid >> 1) * S * 64 + (size_t)(wid & 1) * 32 * 64) : (VT + (size_t)(wid - 4) * 32 * S);
        const int rstride = isk ? 64 : S, kstride = isk ? 64 * 64 : 64;
        const bf16_t* sb0 = sbase + (size_t)srow * rstride + c0 * 8;
        const bf16_t* sb1 = sbase + (size_t)srow * rstride + (c0 ^ 4) * 8;
        const int lanebase = r * 128 + ((hh ^ ((r >> 1) & 7)) << 4);
#define DA_STAGE(kt, sbuf) do { _Pragma("unroll") for (int j = 0; j < 4; ++j) \
            glds16(((j & 1) ? sb1 : sb0) + (size_t)(8 * j) * rstride + (size_t)(kt) * kstride, lds + (sbuf) * ASTG + (wid * 4 + j) * 1024); } while (0)
        const int dcut = (int)(160.f / slope2) + 1;
        int kt_lo = (qb * 128 - dcut) >> 6, kt_hi = (qb * 128 + 127 + dcut) >> 6; kt_lo = kt_lo < 0 ? 0 : kt_lo; kt_hi = kt_hi > S / 64 - 1 ? S / 64 - 1 : kt_hi;
        if (!(V & 8)) { DA_STAGE(kt_lo, kt_lo & 3); if (kt_lo + 1 <= kt_hi) DA_STAGE(kt_lo + 1, (kt_lo + 1) & 3); if (kt_lo + 2 <= kt_hi) DA_STAGE(kt_lo + 2, (kt_lo + 2) & 3); }
        const int q0w = qb * 128 + qs * 32;
        const float fq = (float)(qpos - 4 * hh);
        const float baseL = -slope2 * fq - m2, baseR = slope2 * fq - m2;
        for (int kt = kt_lo; kt <= kt_hi; ++kt) {
            if (kt + 2 <= kt_hi) WAITV(8); else if (kt + 1 <= kt_hi) WAITV(4); else WAITV(0);
            __builtin_amdgcn_s_barrier();
            if (!(V & 8) && kt + 3 <= kt_hi) { DA_STAGE(kt + 3, (kt + 3) & 3); }
            const LAS uchar* st = lds + (kt & 3) * ASTG;
            f32x16 sacc[2];
#pragma unroll
            for (int kb = 0; kb < 2; ++kb) {
                const int key0 = kt * 64 + 32 * kb;
                {
                    const float c = (key0 < q0w) ? slope2 : -slope2;
                    const float a = ((key0 < q0w) ? baseL : baseR) + c * (float)key0;
#pragma unroll
                    for (int i = 0; i < 16; ++i) sacc[kb][i] = a + c * (float)((i & 3) + 8 * (i >> 2));
                }
                if (__builtin_expect(key0 == q0w, 0)) {
                    const int kq = key0 + 4 * hh - qpos;
#pragma unroll
                    for (int i = 0; i < 16; ++i) sacc[kb][i] = -slope2 * fabsf((float)(kq + (i & 3) + 8 * (i >> 2))) - m2;
                }
#pragma unroll
                for (int ks = 0; ks < 4; ++ks) {
                    if (V & 4) continue;
                    const bf16x8 kf = (V & 16) ? qf[(ks + 1) & 3] : *(const LAS bf16x8*)(st + mm * 8192 + kb * 4096 + (lanebase ^ (ks << 5)));
                    sacc[kb] = MFMA32(kf, qf[ks], sacc[kb]);
                }
            }
#pragma unroll
            for (int kb = 0; kb < 2; ++kb) {
                float ls = 0.f;
#pragma unroll
                for (int i = 0; i < 16; ++i) { const float pv = (V & 1) ? sacc[kb][i] : __builtin_amdgcn_exp2f(sacc[kb][i]); ls += pv; sacc[kb][i] = pv; }
                lsum += ls;
                bf16x8 pb[2];
#pragma unroll
                for (int s2 = 0; s2 < 2; ++s2) {
                    u32x4 w;
#pragma unroll
                    for (int i = 0; i < 4; ++i) w[i] = pk2(sacc[kb][8 * s2 + 2 * i], sacc[kb][8 * s2 + 2 * i + 1]);
                    pb[s2] = __builtin_bit_cast(bf16x8, w);
                }
#pragma unroll
                for (int db = 0; db < 4; ++db)
#pragma unroll
                    for (int s2 = 0; s2 < 2; ++s2) {
                        if (V & 2) { if (db == 0) O[0][s2] += __builtin_bit_cast(float, (__builtin_bit_cast(u32x4, pb[s2]))[0]); continue; }
                        const bf16x8 vf = (V & 16) ? qf[(db + s2) & 3] : *(const LAS bf16x8*)(st + 16384 + db * 4096 + (lanebase ^ ((2 * kb + s2) << 5)));
                        O[db] = MFMA32(vf, pb[s2], O[db]);
                    }
            }
        }
#undef DA_STAGE
        const float lt = lsum + __shfl_xor(lsum, 32);
        const float sc = (mm == 0) ? (1.f / lt) : (lam / lt);
        __syncthreads();
        LAS float* xch = (LAS float*)lds + qs * 4096;
        if (mm == 1) {
#pragma unroll
            for (int db = 0; db < 4; ++db)
#pragma unroll
                for (int i = 0; i < 16; ++i) xch[(db * 16 + i) * 64 + lane] = O[db][i] * sc;
        }
        __syncthreads();
        if (mm == 0) {
            float ss = 0.f;
#pragma unroll
            for (int db = 0; db < 4; ++db)
#pragma unroll
                for (int i = 0; i < 16; ++i) { const float o = O[db][i] * sc - xch[(db * 16 + i) * 64 + lane]; O[db][i] = o; ss += o * o; }
            ss += __shfl_xor(ss, 32);
            const float rn = __builtin_amdgcn_rsqf(ss * (1.f / 128.f) + EPS) * oml;
            bf16_t* dst = mix + (size_t)(b * S + qpos) * DM + h * 128;
#pragma unroll
            for (int db = 0; db < 4; ++db)
#pragma unroll
                for (int q4 = 0; q4 < 4; ++q4) {
                    const int d = 32 * db + 8 * q4 + 4 * hh;
                    const f32x4 g = *(const f32x4*)(gsub + d);
                    u32x2 w; w[0] = pk2(O[db][4 * q4] * rn * g[0], O[db][4 * q4 + 1] * rn * g[1]);
                    w[1] = pk2(O[db][4 * q4 + 2] * rn * g[2], O[db][4 * q4 + 3] * rn * g[3]);
                    *(u32x2*)(dst + d) = w;
                }
        }
    }
#endif
    __syncthreads();
}

__device__ __forceinline__ void mla_attn_unit(LAS uchar* lds, const Params& p, int l, int unit) {
    uchar* ws = p.ws;
    const int tid = tid_opaque(), lane = tid & 63, wid = __builtin_amdgcn_readfirstlane(tid >> 6);
    const int xg_ = unit & 7, v_ = unit >> 3, qb = v_ & 7, bh_ = (v_ >> 3) * 8 + xg_, h = bh_ & 3, b = bh_ >> 2;
    const float m2 = ((const float*)(ws + WS_SCAL))[16 * l + 3];
    const bf16_t* Q = (const bf16_t*)(ws + WS_QM) + (((size_t)b * 4 + h) * S) * 96;
    const bf16_t* Kp = (const bf16_t*)(ws + WS_KM) + (((size_t)b * 4 + h) * S) * 96;
    const bf16_t* VT = (const bf16_t*)(ws + WS_VMT) + (((size_t)b * 4 + h) * 64) * S;
    bf16_t* mix = (bf16_t*)(ws + WS_MIX);
#if NAIVE_ATTN
    {
        const int q = qb * 256 + (tid >> 1), hf = tid & 1;
        float qv[96];
#pragma unroll
        for (int c8 = 0; c8 < 12; ++c8) { float f[8]; unpack8(*(const u32x4*)(Q + (size_t)q * 96 + c8 * 8), f);
#pragma unroll
            for (int i = 0; i < 8; ++i) qv[c8 * 8 + i] = f[i]; }
        float o[32]; float lsum = 0.f;
#pragma unroll
        for (int d = 0; d < 32; ++d) o[d] = 0.f;
        for (int key = 0; key < S; ++key) {
            float sc = 0.f;
#pragma unroll
            for (int c8 = 0; c8 < 12; ++c8) { float f[8]; unpack8(*(const u32x4*)(Kp + (size_t)key * 96 + c8 * 8), f);
#pragma unroll
                for (int i = 0; i < 8; ++i) sc += qv[c8 * 8 + i] * f[i]; }
            const float pv = __builtin_amdgcn_exp2f(sc - m2);
            lsum += pv;
            const int kp = sigma16(key);
#pragma unroll
            for (int d = 0; d < 32; ++d) o[d] += pv * bf2f(VT[(size_t)(hf * 32 + d) * S + kp]);
        }
        const float inv = 1.f / lsum;
        bf16_t* dst = mix + (size_t)(b * S + q) * DM + 512 + h * 64 + hf * 32;
#pragma unroll
        for (int d = 0; d < 32; d += 2) *(unsigned*)(dst + d) = pk2(o[d] * inv, o[d + 1] * inv);
    }
#else
    {
        const int r = lane & 31, hh = lane >> 5, qpos = qb * 256 + wid * 32 + r;
        bf16x8 qf[6];
#pragma unroll
        for (int ks = 0; ks < 6; ++ks) qf[ks] = *(const bf16x8*)(Q + (size_t)qpos * 96 + ks * 16 + hh * 8);
        f32x16 O[2]; float lsum = 0.f;
#pragma unroll
        for (int db = 0; db < 2; ++db)
#pragma unroll
            for (int i = 0; i < 16; ++i) O[db][i] = 0.f;
        const int lanebase = r * 128 + ((hh ^ ((r >> 1) & 7)) << 4), lanebase64 = r * 64 + ((hh ^ ((r >> 2) & 3)) << 4);
        const bool lo4 = wid < 4;
        const bf16_t* s0p; const bf16_t* s1p; const bf16_t* s2p;
        {
            const int srow = lane >> 3;
            { const int row = 8 * wid + srow; const int c = (lane & 7) ^ ((row >> 1) & 7); s0p = Kp + (size_t)row * 96 + c * 8; }
            if (lo4) { const int row = 16 * wid + (lane >> 2); const int c = (lane & 3) ^ ((row >> 2) & 3); s1p = Kp + (size_t)row * 96 + 64 + c * 8; }
            else { const int row = 8 * (wid - 4) + srow; const int c = (lane & 7) ^ ((row >> 1) & 7); s1p = VT + (size_t)row * S + c * 8; }
            { const int row = 8 * ((wid & 3) + 4) + srow; const int c = (lane & 7) ^ ((row >> 1) & 7); s2p = VT + (size_t)row * S + c * 8; }
        }
        const int k1stride = lo4 ? 64 * 96 : 64;
#define MA_STAGE(kt, sbuf) do { \
            glds16(s0p + (size_t)(kt) * (64 * 96), lds + (sbuf) * MSTG + wid * 1024); \
            glds16(s1p + (size_t)(kt) * k1stride, lds + (sbuf) * MSTG + (wid + 8) * 1024); \
            if (lo4) glds16(s2p + (size_t)(kt) * 64, lds + (sbuf) * MSTG + (wid + 16) * 1024); } while (0)
        MA_STAGE(0, 0); MA_STAGE(1, 1); MA_STAGE(2, 2);
        for (int kt = 0; kt < S / 64; ++kt) {
            if (kt + 2 < S / 64) { if (lo4) WAITV(6); else WAITV(4); } else if (kt + 1 < S / 64) { if (lo4) WAITV(3); else WAITV(2); } else WAITV(0);
            __builtin_amdgcn_s_barrier();
            if (kt + 3 < S / 64) { MA_STAGE(kt + 3, (kt + 3) & 3); }
            const LAS uchar* st = lds + (kt & 3) * MSTG;
#pragma unroll
            for (int kb = 0; kb < 2; ++kb) {
                f32x16 sacc;
#pragma unroll
                for (int i = 0; i < 16; ++i) sacc[i] = -m2;
#pragma unroll
                for (int ks = 0; ks < 4; ++ks) {
                    const bf16x8 kf = *(const LAS bf16x8*)(st + kb * 4096 + (lanebase ^ (ks << 5)));
                    sacc = MFMA32(kf, qf[ks], sacc);
                }
#pragma unroll
                for (int ks = 0; ks < 2; ++ks) {
                    const bf16x8 kf = *(const LAS bf16x8*)(st + 8192 + kb * 2048 + (lanebase64 ^ (ks << 5)));
                    sacc = MFMA32(kf, qf[4 + ks], sacc);
                }
                float ls = 0.f;
#pragma unroll
                for (int i = 0; i < 16; ++i) { const float pv = __builtin_amdgcn_exp2f(sacc[i]); ls += pv; sacc[i] = pv; }
                lsum += ls;
                bf16x8 pb[2];
#pragma unroll
                for (int s2 = 0; s2 < 2; ++s2) {
                    u32x4 w;
#pragma unroll
                    for (int i = 0; i < 4; ++i) w[i] = pk2(sacc[8 * s2 + 2 * i], sacc[8 * s2 + 2 * i + 1]);
                    pb[s2] = __builtin_bit_cast(bf16x8, w);
                }
#pragma unroll
                for (int db = 0; db < 2; ++db)
#pragma unroll
                    for (int s2 = 0; s2 < 2; ++s2) {
                        const bf16x8 vf = *(const LAS bf16x8*)(st + 12288 + db * 4096 + (lanebase ^ ((2 * kb + s2) << 5)));
                        O[db] = MFMA32(vf, pb[s2], O[db]);
                    }
            }
        }
#undef MA_STAGE
        const float lt = lsum + __shfl_xor(lsum, 32); const float inv = 1.f / lt;
        bf16_t* dst = mix + (size_t)(b * S + qpos) * DM + 512 + h * 64;
#pragma unroll
        for (int db = 0; db < 2; ++db)
#pragma unroll
            for (int q4 = 0; q4 < 4; ++q4) {
                const int d = 32 * db + 8 * q4 + 4 * hh;
                u32x2 w; w[0] = pk2(O[db][4 * q4] * inv, O[db][4 * q4 + 1] * inv); w[1] = pk2(O[db][4 * q4 + 2] * inv, O[db][4 * q4 + 3] * inv);
                *(u32x2*)(dst + d) = w;
            }
    }
#endif
    __syncthreads();
}

__device__ __forceinline__ int xp_rowmap(int mode, int n) {
    return mode == 0 ? n : mode == 1 ? (n / 96) * 128 + (n % 96) : mode == 2 ? ((n >> 6) * 128 + (n & 63)) : ((n >> 6) * 128 + 64 + (n & 63));
}
__device__ __forceinline__ void xpose_tile(LAS uchar* lds, const float* src, int K, int N, bf16_t* dst, int ldd, int mode, const float* gain, int kt, int ntile, int lds_src = 0) {
    LAS float* sh = (LAS float*)lds; const int tid = tid_opaque();
    (void)K; const int ldn = lds_src ? lds_src : N;
    {
        const int n4 = tid & 63, n = ntile * 256 + n4 * 4;
        if (n < N) {
#pragma unroll
            for (int i = 0; i < 8; ++i) {
                const int kl = (tid >> 6) + 8 * i, k = kt * 64 + kl;
                f32x4 v = *(const f32x4*)(src + (size_t)k * ldn + n);
                if (gain) { const float gk = gain[k]; v[0] *= gk; v[1] *= gk; v[2] *= gk; v[3] *= gk; }
                LAS float* d = sh + kl * 257 + n4 * 4; d[0] = v[0]; d[1] = v[1]; d[2] = v[2]; d[3] = v[3];
            }
        }
    }
    __syncthreads();
    {
        const int nl = tid >> 1, kh = tid & 1, n = ntile * 256 + nl;
        if (n < N) {
            bf16_t* d = dst + (size_t)xp_rowmap(mode, n) * ldd + kt * 64 + kh * 32;
#pragma unroll
            for (int c8 = 0; c8 < 4; ++c8) { u32x4 o;
#pragma unroll
                for (int i = 0; i < 4; ++i) o[i] = pk2(sh[(kh * 32 + c8 * 8 + 2 * i) * 257 + nl], sh[(kh * 32 + c8 * 8 + 2 * i + 1) * 257 + nl]);
                *(u32x4*)(d + c8 * 8) = o; }
        }
    }
    __syncthreads();
}
__device__ __forceinline__ void xpose_job(LAS uchar* lds, const float* src, int K, int N, bf16_t* dst, int ldd, int mode, const float* gain, int lds_src = 0) {
    const int nkt = K >> 6, nnt = (N + 255) >> 8, tot = nkt * nnt;
    for (int u = blockIdx.x; u < tot; u += gridDim.x) xpose_tile(lds, src, K, N, dst, ldd, mode, gain, u % nkt, u / nkt, lds_src);
}
__device__ __forceinline__ void expert_weights(LAS uchar* lds, const Params& p, int l) {
    bf16_t* wgu = (bf16_t*)(p.ws + WS_WGU); bf16_t* wd = (bf16_t*)(p.ws + WS_WD);
    const float* g2 = p.in[18] + l * DM;
    const int nb = (int)gridDim.x > 64 ? (int)gridDim.x - 64 : (int)gridDim.x, b0 = (int)gridDim.x > 64 ? (int)blockIdx.x - 64 : (int)blockIdx.x;
    if (b0 < 0) return;
    for (int u = b0; u < 32 * 48; u += nb) {
        const int e = u / 48, w = u % 48, job = w >> 4, tl = w & 15;
        if (job == 0) xpose_tile(lds, p.in[23] + ((size_t)l * 32 + e) * DM * 256, DM, 256, wgu + (size_t)e * 512 * DM, DM, 2, g2, tl, 0);
        else if (job == 1) xpose_tile(lds, p.in[24] + ((size_t)l * 32 + e) * DM * 256, DM, 256, wgu + (size_t)e * 512 * DM, DM, 3, g2, tl, 0);
        else xpose_tile(lds, p.in[25] + ((size_t)l * 32 + e) * 256 * DM, 256, DM, wd + (size_t)e * DM * 256, 256, 0, nullptr, tl & 3, tl >> 2);
    }
}
__device__ __forceinline__ void row_prep(const float* xrow, bf16_t* xb, float* rstd, int lane) {
    float ss = 0.f; f32x4 v[4];
#pragma unroll
    for (int i = 0; i < 4; ++i) { v[i] = *(const f32x4*)(xrow + i * 256 + lane * 4); ss += v[i][0] * v[i][0] + v[i][1] * v[i][1] + v[i][2] * v[i][2] + v[i][3] * v[i][3]; }
    ss = wave_sum(ss);
#pragma unroll
    for (int i = 0; i < 4; ++i) { u32x2 o; o[0] = pk2(v[i][0], v[i][1]); o[1] = pk2(v[i][2], v[i][3]); *(u32x2*)(xb + i * 256 + lane * 4) = o; }
    if (lane == 0) *rstd = __builtin_amdgcn_rsqf(ss * (1.f / 1024.f) + EPS);
}

__device__ __forceinline__ void phase0(LAS uchar* lds, const Params& p) {
    uchar* ws = p.ws; const int tid = tid_opaque(), gtid = blockIdx.x * NT + tid, gsz = gridDim.x * NT;
    for (int idx = blockIdx.x; idx < NL * 202; idx += gridDim.x) {
        const int l = idx / 202, j = idx % 202;
        if (j < 128) xpose_tile(lds, p.in[2] + (size_t)l * DM * NIN, DM, 1888, (bf16_t*)(ws + WS_WIN) + (size_t)l * NINP * DM, DM, 0, p.in[1] + l * DM, j & 15, j >> 4, NIN);
        else if (j < 192) xpose_tile(lds, p.in[17] + (size_t)l * DM * DM, DM, DM, (bf16_t*)(ws + WS_WOUT) + (size_t)l * DM * DM, DM, 0, nullptr, (j - 128) & 15, (j - 128) >> 4);
        else if (j < 198) xpose_tile(lds, p.in[9] + (size_t)l * 192 * 384, 192, 384, (bf16_t*)(ws + WS_WUQ) + (size_t)l * 512 * 192, 192, 1, p.in[7] + l * 192, (j - 192) % 3, (j - 192) / 3);
        else xpose_tile(lds, p.in[10] + (size_t)l * 128 * 512, 128, 512, (bf16_t*)(ws + WS_WUKV) + (size_t)l * 512 * 128, 128, 0, p.in[8] + l * 128, (j - 198) & 1, (j - 198) >> 1);
    }
    for (int l = 0; l < NL; ++l) {
        for (int i = gtid; i < 256 * DM; i += gsz) {
            const int k = i & 1023, n = i >> 10, g = n >> 6, d = n & 63;
            const float* wi = p.in[2] + ((size_t)l * DM + k) * NIN + 1888 + g * 64; const float* pw = p.in[15] + ((size_t)l * 4 + g) * 64 * 64 + d;
            float acc = 0.f;
            for (int c = 0; c < 64; ++c) acc += wi[c] * pw[c * 64];
            ((bf16_t*)(ws + WS_WIN))[((size_t)l * NINP + 1888 + n) * DM + k] = f2bf(acc * p.in[1][l * DM + k] * p.in[16][l * 256 + n]);
        }
        { bf16_t* w = (bf16_t*)(ws + WS_WIN) + ((size_t)l * NINP + NIN) * DM; for (int i = gtid; i < 32 * DM; i += gsz) w[i] = 0; }
        { bf16_t* w = (bf16_t*)(ws + WS_WUQ) + (size_t)l * 512 * 192; for (int i = gtid; i < 4 * 32 * 192; i += gsz) { const int hd = i / (32 * 192), rem = i % (32 * 192); w[(size_t)(hd * 128 + 96) * 192 + rem] = 0; } }
    }
    for (int i = gtid; i < NL * 128 * 1024; i += gsz) {
        const int k = i & 1023, n = (i >> 10) & 127, l = i >> 17;
        float v = 0.f;
        if (n < 4) v = p.in[19][((size_t)l * DM + k) * 4 + n]; else if (n < 36) v = p.in[21][((size_t)l * DM + k) * 32 + (n - 4)];
        v *= p.in[18][l * DM + k];
        const bf16_t hi = f2bf(v), lo = f2bf(v - bf2f(hi));
        bf16_t* w = (bf16_t*)(ws + WS_WR) + ((size_t)l * 128 + n) * 3072 + k;
        w[0] = hi; w[1024] = hi; w[2048] = lo;
    }
    for (int i = gtid; i < S * 16; i += gsz) {
        const int pos = i >> 4, f = i & 15;
        double inv = 1.0; for (int k = 0; k < f; ++k) inv *= 0.5623413251903491;
        const double rev = (double)pos * inv * 0.15915494309189535;
        const float fr = (float)(rev - __builtin_rint(rev));
        ((float*)(ws + WS_ROPE))[i] = __builtin_amdgcn_cosf(fr);
        ((float*)(ws + WS_ROPE))[S * 16 + i] = __builtin_amdgcn_sinf(fr);
    }
    if (blockIdx.x == 0 && (tid >> 6) < NL) {
        const int l = tid >> 6, lane = tid & 63; float* sc = (float*)(ws + WS_SCAL) + 16 * l;
        const float* lv = p.in[5] + l * 256;
        const float d1 = wave_sum(lv[lane] * lv[64 + lane]), d2 = wave_sum(lv[128 + lane] * lv[192 + lane]);
        float gq = fabsf(p.in[3][l * 64 + lane]), gk = fabsf(p.in[4][l * 64 + lane]);
        float a = fabsf(p.in[11][l * 64 + lane]), c = fabsf(p.in[13][l * 64 + lane]);
        float bq = fabsf(p.in[12][l * 32 + (lane & 31)]), dk = fabsf(p.in[14][l * 32 + (lane & 31)]);
#pragma unroll
        for (int o = 32; o >= 1; o >>= 1) { gq = fmaxf(gq, __shfl_xor(gq, o)); gk = fmaxf(gk, __shfl_xor(gk, o)); a = fmaxf(a, __shfl_xor(a, o)); c = fmaxf(c, __shfl_xor(c, o));
            bq = fmaxf(bq, __shfl_xor(bq, o)); dk = fmaxf(dk, __shfl_xor(dk, o)); }
        if (lane == 0) {
            const float lam_init = 0.8f - 0.6f * expf(-0.3f * (float)l);
            sc[0] = expf(d1) - expf(d2) + lam_init; sc[1] = 1.f - lam_init;
            sc[2] = gq * gk * 8.f * LOG2E * 1.02f;
            sc[3] = sqrtf(64.f * a * a + 32.f * bq * bq) * sqrtf(64.f * c * c + 32.f * dk * dk) * QSCALE_M * 1.02f;
        }
    }
    {
        const int lane = tid & 63, gw = gtid >> 6, nw = gsz >> 6;
        for (int t = gw; t < T; t += nw) row_prep(p.in[0] + (size_t)t * DM, (bf16_t*)(ws + WS_XB) + (size_t)t * DM, (float*)(ws + WS_RSTD1) + t, lane);
    }
}

struct MkProj { int mt, pn, l; const Params* p; __device__ __forceinline__ EpiProj operator()(int half) const { return EpiProj{mt, 2 * pn + half, l, p}; } };
__device__ __forceinline__ void ph_gemm1(LAS uchar* lds, const Params& p, int l) {
    const bf16_t* xb = (const bf16_t*)(p.ws + WS_XB); const bf16_t* win = (const bf16_t*)(p.ws + WS_WIN) + (size_t)l * NINP * DM;
    if (SHADOW_G >= 0) for (int u0 = blockIdx.x; u0 < 512; u0 += gridDim.x) {
        const int xg = u0 & 7, v = u0 >> 3, mt = (v >> 3) * 8 + xg, pn = v & 7;
        MkProj mk{mt, pn, l, &p};
        { const int tp = tid_opaque(); if (tp < 256) ((LAS float*)(lds + LDS_ROW))[tp] = ((const float*)(p.ws + WS_RSTD1))[mt * 256 + tp]; }
        gemm_big<(SHADOW_G >= 0 ? SHADOW_G : 0)>(lds, ARowLinear{xb + (size_t)mt * 256 * DM, (size_t)DM}, win + (size_t)pn * 256 * DM, (size_t)DM, DM, mk);
    }
    for (int u0 = blockIdx.x; u0 < 64 * 8; u0 += gridDim.x) {
        const int xg = u0 & 7, v = u0 >> 3, mt = (v >> 3) * 8 + xg, pn = ((v & 7) + 4 * ((v >> 5) & 1)) & 7;
        MkProj mk{mt, pn, l, &p};
        { const int tp = tid_opaque(); if (tp < 256) ((LAS float*)(lds + LDS_ROW))[tp] = ((const float*)(p.ws + WS_RSTD1))[mt * 256 + tp]; }
        gemm_big(lds, ARowLinear{xb + (size_t)mt * 256 * DM, (size_t)DM}, win + (size_t)pn * 256 * DM, (size_t)DM, DM, mk);
    }
}
__device__ __forceinline__ void gemm1_tail_unit(LAS uchar* lds, const Params& p, int l, int mt) {
    const bf16_t* xb = (const bf16_t*)(p.ws + WS_XB); const bf16_t* win = (const bf16_t*)(p.ws + WS_WIN) + (size_t)l * NINP * DM;
    ARowLinear ar{xb + (size_t)mt * 256 * DM, (size_t)DM};
    EpiProj ep{mt, 16, l, &p};
    { const int tp = tid_opaque(); if (tp < 256) ((LAS float*)(lds + LDS_ROW))[tp] = ((const float*)(p.ws + WS_RSTD1))[mt * 256 + tp]; }
    gemm_tile(lds, ar, win + (size_t)16 * 128 * DM, (size_t)DM, DM, ep);
}
template <int HALF>
__device__ __forceinline__ void pool_rows(const float (&v)[48], int sfirst, bf16_t* dst) {
    float run = 0.f;
#pragma unroll
    for (int i = 8 - HALF; i < 8 + HALF; ++i) run += v[i];
#pragma unroll
    for (int r = 0; r < 32; ++r) {
        const int s = sfirst + r; int lo = s - HALF, hi = s + HALF - 1; lo = lo < 0 ? 0 : lo; hi = hi > S - 1 ? S - 1 : hi;
        const float o = run * __builtin_amdgcn_rcpf((float)(hi - lo + 1)) - v[r + 8];
        dst[(size_t)r * DM] = f2bf(o);
        if (r < 31) run += v[r + 8 + HALF] - v[r + 8 - HALF];
    }
}
__device__ __forceinline__ void pooled_unit(LAS uchar* lds, const Params& p, int ut) {
    const int tid = tid_opaque();
    const int t0 = ut * 64, b = t0 >> 11, s0 = t0 & 2047;
    const bf16_t* lat = (const bf16_t*)(p.ws + WS_LAT) + (size_t)b * S * 640 + 352;
    for (int it = 0; it < 5; ++it) {
        const int item = it * NT + tid, c8 = item & 31, rl = item >> 5, sr = s0 - 8 + rl;
        u32x4 v = {0u, 0u, 0u, 0u};
        if (sr >= 0 && sr < S) v = *(const u32x4*)(lat + (size_t)sr * 640 + c8 * 8);
        *(LAS u32x4*)(lds + rl * 512 + c8 * 16) = v;
    }
    __syncthreads();
    {
        const int c = tid & 255, rh = tid >> 8, g = __builtin_amdgcn_readfirstlane(c >> 6);
        bf16_t* dst = (bf16_t*)(p.ws + WS_MIX) + (size_t)(t0 + rh * 32) * DM + 768 + c;
        const LAS bf16_t* col = (const LAS bf16_t*)lds + (rh * 32) * 256 + c;
        float v[48];
#pragma unroll
        for (int i = 0; i < 48; ++i) v[i] = bf2f(col[i * 256]);
        const int sfirst = s0 + rh * 32;
        if (g == 0) pool_rows<1>(v, sfirst, dst); else if (g == 1) pool_rows<2>(v, sfirst, dst); else if (g == 2) pool_rows<4>(v, sfirst, dst); else pool_rows<8>(v, sfirst, dst);
    }
    __syncthreads();
}
__device__ __forceinline__ void mla_up_unit(LAS uchar* lds, const Params& p, int l, int v) {
    const bf16_t* lat = (const bf16_t*)(p.ws + WS_LAT);
    const int mt = v >> 3, w = v & 7, h = w & 3;
    { const int tp = tid_opaque(); if (tp < 256) { const float* hs = (const float*)(p.ws + WS_HSS) + (size_t)(mt * 256 + tp) * 8;
        const f32x4 h0 = *(const f32x4*)hs; const float h4 = hs[4];
        ((LAS float*)(lds + LDS_ROW))[tp] = (w < 4) ? __builtin_amdgcn_rsqf((h0[0] + h0[1] + h0[2]) * (1.f / 192.f) + EPS) : __builtin_amdgcn_rsqf((h0[3] + h4) * (1.f / 128.f) + EPS); } }
    if (w < 4) { ARowLinear ar{lat + (size_t)mt * 256 * 640, (size_t)640}; EpiMlaQ ep{mt, h, l, &p};
        gemm_tile(lds, ar, (const bf16_t*)(p.ws + WS_WUQ) + ((size_t)l * 512 + h * 128) * 192, (size_t)192, 192, ep); }
    else { ARowLinear ar{lat + (size_t)mt * 256 * 640 + 192, (size_t)640}; EpiMlaKV ep{mt, h, l, &p};
        gemm_tile(lds, ar, (const bf16_t*)(p.ws + WS_WUKV) + ((size_t)l * 512 + h * 128) * 128, (size_t)128, 128, ep); }
}
__device__ __forceinline__ void ph_mix_a(LAS uchar* lds, const Params& p, int l) {
    const int G = (int)gridDim.x;
    if (G == 256) {
        const int xg = blockIdx.x & 7, j = blockIdx.x >> 3;
        if (SHADOW_V >= 0) { diff_attn_unit<(SHADOW_V >= 0 ? SHADOW_V : 0)>(lds, p, l, xg, 2 + (j >> 4), j & 15); }
        diff_attn_unit<0>(lds, p, l, xg, 2 + (j >> 4), j & 15);
        if (j < 16) diff_attn_unit<0>(lds, p, l, xg, 1, j);
        else {
            diff_attn_unit<0>(lds, p, l, xg, 0, j - 16);
            if (j < 24) gemm1_tail_unit(lds, p, l, xg + 8 * (j - 16));
            const int n0 = j < 24 ? (j - 16) * 2 : 16 + (j - 24) * 6, n1 = j < 24 ? n0 + 2 : n0 + 6;
            for (int n = n0; n < n1; ++n) mla_up_unit(lds, p, l, (xg + 8 * (n >> 3)) * 8 + (n & 7));
        }
    } else {
        for (int u = blockIdx.x; u < 512 + 512 + 64; u += G) {
            if (u < 512) diff_attn_unit<0>(lds, p, l, u >> 6, (u >> 4) & 3, u & 15);
            else if (u < 1024) mla_up_unit(lds, p, l, u - 512);
            else gemm1_tail_unit(lds, p, l, u - 1024);
        }
    }
}
__device__ __forceinline__ void ph_mix_b(LAS uchar* lds, const Params& p, int l) {
    (void)l;
    for (int u = blockIdx.x; u < 256 + 256; u += gridDim.x) {
        if (u < 256) mla_attn_unit(lds, p, l, u);
        else pooled_unit(lds, p, u - 256);
    }
}
struct MkWout { int mt, pn; const float* xres; const Params* p; __device__ __forceinline__ EpiWout operator()(int half) const { return EpiWout{mt, 2 * pn + half, xres, p}; } };
__device__ __forceinline__ void ph_wout(LAS uchar* lds, const Params& p, int l) {
    const bf16_t* mix = (const bf16_t*)(p.ws + WS_MIX); const bf16_t* wo = (const bf16_t*)(p.ws + WS_WOUT) + (size_t)l * DM * DM;
    const float* xres = (l == 0) ? p.in[0] : p.out;
    for (int u0 = blockIdx.x; u0 < 64 * 4; u0 += gridDim.x) {
        const int xg = u0 & 7, v = u0 >> 3, mt = (v >> 2) * 8 + xg, pn = v & 3;
        MkWout mk{mt, pn, xres, &p};
        gemm_big(lds, ARowLinear{mix + (size_t)mt * 256 * DM, (size_t)DM}, wo + (size_t)pn * 256 * DM, (size_t)DM, DM, mk);
    }
}
constexpr int LDS_RT = 135168;
struct EpiRouter {
    int mt, l; bool dry; const Params* p;
    __device__ __forceinline__ void operator()(const LAS uchar* ct) const {
        uchar* ws = p->ws; const int tid = tid_opaque();
        const LAS float* ctf = (const LAS float*)ct;
        LAS unsigned* shcnt = (LAS unsigned*)(ct + LDS_RT); LAS unsigned* shbase = shcnt + 32; LAS unsigned* pend = shcnt + 64;
        unsigned* cnt = (unsigned*)(ws + WS_CTL) + CW_CNT + 1024 * l + (dry ? 2048 : 0);
        unsigned* list = (unsigned*)(ws + (dry ? WS_POOLED : WS_LIST)); float* gwt = (float*)(ws + (dry ? WS_POOLED + 4 * MiB : WS_GW)); float* rstd2 = (float*)(ws + (dry ? WS_POOLED + 5 * MiB : WS_RSTD2));
        const float* bg = p->in[20] + l * 4; const float* be = p->in[22] + l * 32;
        if (tid < 32) shcnt[tid] = 0u;
        __syncthreads();
        if (tid < 256) {
            const int t = mt * 256 + tid;
            const float* ps = (const float*)(ws + WS_PSS) + (size_t)t * 8;
            const f32x4 p0 = *(const f32x4*)ps, p1 = *(const f32x4*)(ps + 4);
            const float ss = ((p0[0] + p0[1]) + (p0[2] + p0[3])) + ((p1[0] + p1[1]) + (p1[2] + p1[3]));
            const float rs = __builtin_amdgcn_rsqf(ss * (1.f / 1024.f) + EPS);
            const LAS float* row = ctf + tid * CTF_PITCH;
            float gl[4];
#pragma unroll
            for (int n = 0; n < 4; ++n) gl[n] = row[n] * rs + bg[n];
            int gi = 0; float gm = gl[0];
#pragma unroll
            for (int n = 1; n < 4; ++n) if (gl[n] > gm) { gm = gl[n]; gi = n; }
            float gs = 0.f;
#pragma unroll
            for (int n = 0; n < 4; ++n) gs += __expf(gl[n] - gm);
            const float gtop = 1.f / gs;
            float el[8];
#pragma unroll
            for (int n = 0; n < 8; ++n) el[n] = row[4 + gi * 8 + n] * rs + be[gi * 8 + n];
            int i1 = 0; float m1 = el[0];
#pragma unroll
            for (int n = 1; n < 8; ++n) if (el[n] > m1) { m1 = el[n]; i1 = n; }
            int i2 = -1; float m2v = -3.0e38f;
#pragma unroll
            for (int n = 0; n < 8; ++n) if (n != i1 && el[n] > m2v) { m2v = el[n]; i2 = n; }
            const float e2 = __expf(m2v - m1); const float w1 = gtop / (1.f + e2), w2 = gtop * e2 / (1.f + e2);
            const int ea = gi * 8 + i1, eb = gi * 8 + i2;
            const unsigned pa = __hip_atomic_fetch_add(&shcnt[ea], 1u, __ATOMIC_RELAXED, __HIP_MEMORY_SCOPE_WORKGROUP);
            const unsigned pbk = __hip_atomic_fetch_add(&shcnt[eb], 1u, __ATOMIC_RELAXED, __HIP_MEMORY_SCOPE_WORKGROUP);
            pend[tid * 2] = ((unsigned)ea << 16) | pa; pend[tid * 2 + 1] = ((unsigned)eb << 16) | pbk;
            gwt[t * 2] = w1; gwt[t * 2 + 1] = w2; rstd2[t] = rs;
        }
        __syncthreads();
        if (tid < 32) { const unsigned c = shcnt[tid]; shbase[tid] = c ? atomicAdd(&cnt[tid * 32], c) : 0u; }
        __syncthreads();
        { const unsigned pe = pend[tid], e = pe >> 16, lp = pe & 0xffffu; list[(size_t)e * T + shbase[e] + lp] = (unsigned)((mt * 256 + (tid >> 1)) * 2 + (tid & 1)); }
    }
};
__device__ __forceinline__ void ph_router(LAS uchar* lds, const Params& p, int l, bool dry = false) {
    const bf16_t* xb = (const bf16_t*)(p.ws + WS_XB); const bf16_t* wr = (const bf16_t*)(p.ws + WS_WR) + (size_t)l * 128 * 3072;
    for (int u = blockIdx.x; u < 64; u += gridDim.x) {
        ARowLinear ar{xb + (size_t)u * 256 * DM, (size_t)DM}; EpiRouter ep{u, l, dry, &p};
        AOffRouter ao{(int)((WS_XL - WS_XB) / 2)};
        gemm_tile<true>(lds, ar, wr, (size_t)3072, 3072, ep, ao);
    }
    if (!dry) expert_weights(lds, p, l);
}
struct MoeMap {
    int c, f, pr, pf, pp, pb, nfull, npart;
    __device__ __forceinline__ void init(const unsigned* cnt, int lane) {
        c = lane < 32 ? (int)cnt[lane * 32] : 0; f = c >> 8; pr = (c & 255) ? 1 : 0;
        int sf = f, sp = pr, sb = f + pr;
#pragma unroll
        for (int o = 1; o < 32; o <<= 1) { const int tf = __shfl_up(sf, o), tp = __shfl_up(sp, o), tb = __shfl_up(sb, o); if ((lane & 63) >= o) { sf += tf; sp += tp; sb += tb; } }
        pf = sf - f; pp = sp - pr; pb = sb - (f + pr);
        nfull = __builtin_amdgcn_readlane(sf, 31); npart = __builtin_amdgcn_readlane(sp, 31);
    }
    __device__ __forceinline__ void find(bool big, int want, int lane, int& e, int& rb, int& rbg, int& nvalid) const {
        const bool hit = lane < 32 && (big ? (want >= pf && want < pf + f) : (pr && pp == want));
        const unsigned long long m = __ballot(hit);
        const int src = m ? (int)__builtin_ctzll(m) : 0;
        e = src;
        const int f_s = __builtin_amdgcn_readlane(f, src), pf_s = __builtin_amdgcn_readlane(pf, src), pb_s = __builtin_amdgcn_readlane(pb, src), c_s = __builtin_amdgcn_readlane(c, src);
        rb = big ? want - pf_s : f_s; rbg = pb_s + rb; nvalid = big ? 256 : (c_s & 255);
    }
};
struct MkGU { int pn; size_t slot0; const Params* p; __device__ __forceinline__ EpiGU operator()(int half) const { return EpiGU{2 * pn + half, slot0, p}; } };
__device__ __forceinline__ void ph_gateup(LAS uchar* lds, const Params& p, int l) {
    uchar* ws = p.ws; const unsigned* cnt = (const unsigned*)(ws + WS_CTL) + CW_CNT + 1024 * l;
    const int lane = tid_opaque() & 63;
    MoeMap mm; mm.init(cnt, lane);
    const int nfull = mm.nfull, tot = nfull * 2 + mm.npart * 4;
    for (int u = blockIdx.x; u < tot; u += gridDim.x) {
        const bool big = u < nfull * 2;
        const int want = big ? (u >> 1) : ((u - nfull * 2) >> 2);
        int e, rb, rbg, nvalid; mm.find(big, want, lane, e, rb, rbg, nvalid);
        const unsigned* list = (const unsigned*)(ws + WS_LIST) + (size_t)e * T + rb * 256;
        ARowGather ar{(const bf16_t*)(ws + WS_XB), list, nvalid};
        { const int tp = tid_opaque(); if (tp < 256) { const int rr = tp < nvalid ? tp : nvalid - 1; ((LAS float*)(lds + LDS_ROW))[tp] = ((const float*)(ws + WS_RSTD2))[list[rr] >> 1]; } }
        if (big) { const int pn = u & 1; MkGU mk{pn, (size_t)rbg * 256, &p};
            gemm_big(lds, ar, (const bf16_t*)(ws + WS_WGU) + ((size_t)e * 512 + pn * 256) * DM, (size_t)DM, DM, mk); }
        else { const int jt = (u - nfull * 2) & 3; EpiGU ep{jt, (size_t)rbg * 256, &p};
            gemm_tile(lds, ar, (const bf16_t*)(ws + WS_WGU) + ((size_t)e * 512 + jt * 128) * DM, (size_t)DM, DM, ep); }
    }
}
struct MkDown { int pn, nvalid; const Params* p; __device__ __forceinline__ EpiDown operator()(int half) const { return EpiDown{2 * pn + half, nvalid, p}; } };
__device__ __forceinline__ void ph_down(LAS uchar* lds, const Params& p, int l) {
    uchar* ws = p.ws; const unsigned* cnt = (const unsigned*)(ws + WS_CTL) + CW_CNT + 1024 * l;
    const int lane = tid_opaque() & 63;
    MoeMap mm; mm.init(cnt, lane);
    const int nfull = mm.nfull, tot = nfull * 4 + mm.npart * 8;
    for (int u = blockIdx.x; u < tot; u += gridDim.x) {
        const bool big = u < nfull * 4;
        const int want = big ? (u >> 2) : ((u - nfull * 4) >> 3);
        int e, rb, rbg, nvalid; mm.find(big, want, lane, e, rb, rbg, nvalid);
        const unsigned* list = (const unsigned*)(ws + WS_LIST) + (size_t)e * T + rb * 256;
        ARowLinear ar{(const bf16_t*)(ws + WS_HMID) + (size_t)rbg * 256 * 256, (size_t)256};
        { const int tp = tid_opaque(); if (tp < 256) { const int rr = tp < nvalid ? tp : nvalid - 1; const unsigned ent = list[rr];
            ((LAS unsigned*)(lds + LDS_ROW + 1024))[tp] = ent; ((LAS float*)(lds + LDS_ROW))[tp] = ((const float*)(ws + WS_GW))[ent]; } }
        if (big) { const int pn = u & 3; MkDown mk{pn, nvalid, &p};
            gemm_big(lds, ar, (const bf16_t*)(ws + WS_WD) + ((size_t)e * DM + pn * 256) * 256, (size_t)256, 256, mk); }
        else { const int nt = (u - nfull * 4) & 7; EpiDown ep{nt, nvalid, &p};
            gemm_tile(lds, ar, (const bf16_t*)(ws + WS_WD) + ((size_t)e * DM + nt * 128) * 256, (size_t)256, 256, ep); }
    }
}
__device__ __forceinline__ void ph_combine(LAS uchar* lds, const Params& p, int l, bool dry = false) {
    uchar* ws = p.ws; const int tid = tid_opaque(), lane = tid & 63;
    const int gw = blockIdx.x * 8 + (tid >> 6), nw = gridDim.x * 8;
    const bf16_t* ys = (const bf16_t*)(ws + WS_YS);
    for (int t = gw; t < T; t += nw) {
        const bf16_t* xh = (const bf16_t*)(ws + WS_XB) + (size_t)t * DM; const bf16_t* xl = (const bf16_t*)(ws + WS_XL) + (size_t)t * DM;
        const bf16_t* y0 = ys + (size_t)(2 * t) * DM; const bf16_t* y1 = y0 + DM;
        float* xw = dry ? (float*)(ws + WS_POOLED) + (size_t)(t & 511) * DM : p.out + (size_t)t * DM;
        bf16_t* xb = dry ? (bf16_t*)(ws + WS_POOLED + 4 * MiB) + (size_t)(t & 511) * DM : (bf16_t*)(ws + WS_XB) + (size_t)t * DM;
        float ss = 0.f;
#pragma unroll
        for (int i = 0; i < 4; ++i) {
            const int c = i * 256 + lane * 4;
            const u32x2 hv = *(const u32x2*)(xh + c), lv = *(const u32x2*)(xl + c);
            f32x4 v; v[0] = bflo(hv[0]) + bflo(lv[0]); v[1] = bfhi(hv[0]) + bfhi(lv[0]); v[2] = bflo(hv[1]) + bflo(lv[1]); v[3] = bfhi(hv[1]) + bfhi(lv[1]);
            const u32x2 a = *(const u32x2*)(y0 + c), bq = *(const u32x2*)(y1 + c);
            v[0] += bflo(a[0]) + bflo(bq[0]); v[1] += bfhi(a[0]) + bfhi(bq[0]); v[2] += bflo(a[1]) + bflo(bq[1]); v[3] += bfhi(a[1]) + bfhi(bq[1]);
            *(f32x4*)(xw + c) = v; ss += v[0] * v[0] + v[1] * v[1] + v[2] * v[2] + v[3] * v[3];
            u32x2 o; o[0] = pk2(v[0], v[1]); o[1] = pk2(v[2], v[3]); *(u32x2*)(xb + c) = o;
        }
        ss = wave_sum(ss);
        if (lane == 0) ((float*)(ws + (dry ? WS_POOLED + 6 * MiB : WS_RSTD1)))[t] = __builtin_amdgcn_rsqf(ss * (1.f / 1024.f) + EPS);
    }

}

__global__ void __launch_bounds__(NT, 2) mega(Params p) {
    extern __shared__ __attribute__((aligned(16))) unsigned char smem[];
    LAS uchar* lds = (LAS uchar*)smem;
    if (threadIdx.x == 0) { *(LAS u32x4*)(lds + LDS_XB) = (u32x4){0u, 0u, 0u, 0u}; }
    __syncthreads();
    XcdBarrier bar = xcd_barrier_post((unsigned*)(p.ws + WS_CTL), (volatile LAS unsigned*)(lds + LDS_XB));
#define IN(k) (p.ph_lo <= (k) && (k) < p.ph_hi)
#define SEAM(k) do { if (IN(k) && IN((k) + 1)) xcd_barrier(bar); } while (0)
    if (IN(0)) for (int rep = 0; rep < NREP(8); ++rep) phase0(lds, p);
    SEAM(0);
#define LAUNDER(v) asm volatile("" : "+s"(v))
#pragma unroll 1
    for (int l0 = 0; l0 < NL; ++l0) {
        const int pb = 1 + 8 * l0;
        { int l = l0; LAUNDER(l); if (IN(pb + 0)) for (int rep = 0; rep < NREP(0); ++rep) ph_gemm1(lds, p, l); }
        SEAM(pb + 0);
        { int l = l0; LAUNDER(l); if (IN(pb + 1)) for (int rep = 0; rep < NREP(1); ++rep) ph_mix_a(lds, p, l); }
        SEAM(pb + 1);
        { int l = l0; LAUNDER(l); if (IN(pb + 2)) for (int rep = 0; rep < NREP(2); ++rep) ph_mix_b(lds, p, l); }
        SEAM(pb + 2);
        { int l = l0; LAUNDER(l); if (IN(pb + 3)) for (int rep = 0; rep < (l == 0 ? NREP(3) : 1); ++rep) ph_wout(lds, p, l); }
        SEAM(pb + 3);
        { int l = l0; LAUNDER(l); if (IN(pb + 4)) { if (NREP(4) > 1) ph_router(lds, p, l, true); ph_router(lds, p, l); } }
        SEAM(pb + 4);
        { int l = l0; LAUNDER(l); if (IN(pb + 5)) for (int rep = 0; rep < NREP(5); ++rep) ph_gateup(lds, p, l); }
        SEAM(pb + 5);
        { int l = l0; LAUNDER(l); if (IN(pb + 6)) for (int rep = 0; rep < NREP(6); ++rep) ph_down(lds, p, l); }
        SEAM(pb + 6);
        { int l = l0; LAUNDER(l); if (IN(pb + 7)) { if (NREP(7) > 1) ph_combine(lds, p, l, true); ph_combine(lds, p, l); } }
        SEAM(pb + 7);
    }
}

extern "C" void kernel_launch(void* const* d_in, const int* in_sizes, int n_in, void* d_out, int out_size, void* d_ws, size_t ws_size, hipStream_t stream) {
    (void)in_sizes; (void)n_in; (void)out_size;
    static int grid = 0;
    if (!grid) {
        int dev = 0, cus = 0, per_cu = 0;
        hipGetDevice(&dev);
        hipDeviceGetAttribute(&cus, hipDeviceAttributeMultiprocessorCount, dev);
        hipFuncSetAttribute((const void*)mega, hipFuncAttributeMaxDynamicSharedMemorySize, LDS_BYTES);
        hipOccupancyMaxActiveBlocksPerMultiprocessor(&per_cu, (const void*)mega, NT, LDS_BYTES);
        if (per_cu > 1) per_cu = 1;
        if (per_cu < 1) per_cu = 1;
        grid = cus * per_cu;
    }
    if (ws_size < WS_END) { fprintf(stderr, "workspace too small: %zu < %zu\n", ws_size, (size_t)WS_END); return; }
    hipMemsetAsync(d_ws, 0, CTL_ZERO_BYTES, stream);
    Params p{};
    for (int i = 0; i < 26; ++i) p.in[i] = (const float*)d_in[i];
    p.out = (float*)d_out; p.ws = (unsigned char*)d_ws;
#if N_LAUNCH_SPLIT
    for (int k = 0; k < NPH; ++k) { p.ph_lo = k; p.ph_hi = k + 1; hipLaunchKernelGGL(mega, dim3(grid), dim3(NT), LDS_BYTES, stream, p); }
#else
    p.ph_lo = 0; p.ph_hi = NPH;
    hipLaunchKernelGGL(mega, dim3(grid), dim3(NT), LDS_BYTES, stream, p);
#endif
}
```

```cpp
#include <hip/hip_runtime.h>
#include <stdint.h>
#include <stdio.h>

#ifndef NAIVE_GEMM
#define NAIVE_GEMM 0
#endif
#ifndef NAIVE_ATTN
#define NAIVE_ATTN 0
#endif
#ifndef N_LAUNCH_SPLIT
#define N_LAUNCH_SPLIT 0
#endif

#ifndef SHADOW_V
#define SHADOW_V -1
#endif
#ifndef SHADOW_G
#define SHADOW_G -1
#endif
#ifndef REPEAT_MASK
#define REPEAT_MASK 0
#endif
#define NREP(k) ((((REPEAT_MASK) >> (k)) & 1) + 1)
#define LAS __attribute__((address_space(3)))
typedef unsigned char uchar;
typedef unsigned short bf16_t;
typedef short bf16x8 __attribute__((ext_vector_type(8)));
typedef float f32x16 __attribute__((ext_vector_type(16)));
typedef float f32x2_t __attribute__((ext_vector_type(2)));
typedef __bf16 bf16x2_t __attribute__((ext_vector_type(2)));
typedef unsigned u32x4 __attribute__((ext_vector_type(4)));
typedef unsigned u32x2 __attribute__((ext_vector_type(2)));
typedef float f32x4 __attribute__((ext_vector_type(4)));

constexpr int NB = 8, S = 2048, DM = 1024, T = NB * S, NL = 2;
constexpr int NIN = 2144, NINP = 2176;
constexpr float EPS = 1e-6f, LOG2E = 1.4426950408889634f;
constexpr float QSCALE_D = 0.125f * LOG2E;
constexpr float QSCALE_M = 0.10206207261596577f * LOG2E;
constexpr int NPH = 1 + 8 * NL;

constexpr size_t MiB = (size_t)1 << 20;
constexpr size_t WS_CTL = 0, CTL_ZERO_BYTES = 32768;
constexpr size_t WS_SCAL = 1 * MiB;
constexpr size_t WS_ROPE = 1 * MiB + 64 * 1024;
constexpr size_t WS_RSTD1 = 1 * MiB + 512 * 1024;
constexpr size_t WS_RSTD2 = WS_RSTD1 + 64 * 1024;
constexpr size_t WS_GW = WS_RSTD2 + 64 * 1024;
constexpr size_t WS_LIST = 2 * MiB;
constexpr size_t WS_WIN = 4 * MiB;
constexpr size_t WS_WOUT = 13 * MiB;
constexpr size_t WS_WUQ = 17 * MiB;
constexpr size_t WS_WUKV = 17 * MiB + 512 * 1024;
constexpr size_t WS_POOLW = 17 * MiB + 768 * 1024;
constexpr size_t WS_WR = 18 * MiB;
constexpr size_t WS_PSS = 19 * MiB + 512 * 1024;
constexpr size_t WS_HSS = 12 * MiB + 512 * 1024;
constexpr size_t WS_WGU = 20 * MiB;
constexpr size_t WS_WD = 52 * MiB;
constexpr size_t WS_XB = 68 * MiB;
constexpr size_t WS_MIX = 100 * MiB;
constexpr size_t WS_HMID = WS_MIX;
constexpr size_t WS_QD = 132 * MiB, WS_KD = 148 * MiB, WS_VDT = 164 * MiB;
constexpr size_t WS_LAT = 180 * MiB;
constexpr size_t WS_QM = 200 * MiB, WS_KM = 212 * MiB, WS_VMT = 224 * MiB;
constexpr size_t WS_POOLED = 232 * MiB;
constexpr size_t WS_XL = 200 * MiB;
constexpr size_t WS_YS = 132 * MiB;
constexpr size_t WS_END = 240 * MiB;

#define XB_TMO      128
#define XB_XCNT(j)  (256  + 64 * (j))
#define XB_XSUB(j)  (1280 + 64 * (j))
#define XB_XGEN(j)  (2304 + 64 * (j))
#define XB_TOP      3328
#define XB_TOPGEN   3392
#define XCD_BAR_WORDS 3456
#define XB_SPIN_CAP (1u << 18)
constexpr int CW_CNT = 4096;

constexpr int NT = 512;
constexpr int LDS_XB = 147456;
constexpr int LDS_ROW = LDS_XB + 256;
constexpr int LDS_MOE = LDS_ROW + 2048;
constexpr int LDS_BYTES = LDS_MOE + 512;
constexpr int GSTG = 49152;
constexpr int ASTG = 32768;
constexpr int MSTG = 20480;

struct Params {
    const float* in[26];
    float* out;
    unsigned char* ws;
    int ph_lo, ph_hi;
};

__device__ __forceinline__ unsigned pk2(float lo, float hi) { f32x2_t v = {lo, hi}; bf16x2_t b = __builtin_convertvector(v, bf16x2_t); return __builtin_bit_cast(unsigned, b); }
__device__ __forceinline__ float bflo(unsigned w) { return __builtin_bit_cast(float, w << 16); }
__device__ __forceinline__ float bfhi(unsigned w) { return __builtin_bit_cast(float, w & 0xffff0000u); }
__device__ __forceinline__ float bf2f(bf16_t u) { return __builtin_bit_cast(float, (unsigned)u << 16); }
__device__ __forceinline__ bf16_t f2bf(float f) { return (bf16_t)(pk2(f, 0.f) & 0xffffu); }
__device__ __forceinline__ LAS uchar* lds_base() { extern __shared__ __attribute__((aligned(16))) unsigned char smem_dyn_[]; return (LAS uchar*)smem_dyn_; }
__device__ __forceinline__ int tid_opaque() { int t = threadIdx.x; asm volatile("" : "+v"(t)); return t; }
__device__ __forceinline__ int crow(int r, int hi) { return (r & 3) + 8 * (r >> 2) + 4 * hi; }
__device__ __forceinline__ int sigma16(int s) { return (s & ~12) | ((s & 4) << 1) | ((s & 8) >> 1); }
__device__ __forceinline__ float wave_sum(float v) {
#pragma unroll
    for (int o = 32; o >= 1; o >>= 1) v += __shfl_xor(v, o);
    return v;
}
__device__ __forceinline__ void unpack8(u32x4 w, float (&f)[8]) {
    f[0] = bflo(w[0]); f[1] = bfhi(w[0]); f[2] = bflo(w[1]); f[3] = bfhi(w[1]);
    f[4] = bflo(w[2]); f[5] = bfhi(w[2]); f[6] = bflo(w[3]); f[7] = bfhi(w[3]);
}

__device__ __forceinline__ unsigned xb_ld(unsigned* p)              { return __hip_atomic_load(p, __ATOMIC_RELAXED, __HIP_MEMORY_SCOPE_AGENT); }
__device__ __forceinline__ unsigned xb_add(unsigned* p, unsigned v) { return __hip_atomic_fetch_add(p, v, __ATOMIC_RELAXED, __HIP_MEMORY_SCOPE_AGENT); }
__device__ __forceinline__ unsigned xb_xcc_id() { return (unsigned)__builtin_amdgcn_s_getreg((3 << 11) | 20) & 0xFu; }
#define XB_SPIN(cond, bar) do { unsigned _sp = 0; while (cond) { __builtin_amdgcn_s_sleep(1); \
    if ((++_sp & 255u) == 0u) { if (xb_ld(&(bar)[XB_TMO])) break; if (_sp > XB_SPIN_CAP) { atomicAdd(&(bar)[XB_TMO], 1u); break; } } } } while (0)
struct XcdBarrier { unsigned* bar; unsigned x; volatile LAS unsigned* st; };
__device__ __forceinline__ XcdBarrier xcd_barrier_post(unsigned* bar, volatile LAS unsigned* st) {
    XcdBarrier b; b.bar = bar; b.x = xb_xcc_id(); b.st = st;
    if (threadIdx.x == 0) (void)xb_add(&bar[XB_XCNT(b.x)], 1u);
    return b;
}
__device__ __forceinline__ void xcd_barrier_complete(unsigned* bar, unsigned x, unsigned& nloc, unsigned& nx) {
    const unsigned G = gridDim.x * gridDim.y * gridDim.z;
    unsigned sum, cnt, mine, sp = 0u;
    for (;;) {
        sum = 0u; cnt = 0u; mine = 0u;
#pragma unroll
        for (unsigned j = 0; j < 16; ++j) { const unsigned c = xb_ld(&bar[XB_XCNT(j)]); sum += c; cnt += (c > 0u) ? 1u : 0u; mine = (j == x) ? c : mine; }
        if (sum == G) break;
        __builtin_amdgcn_s_sleep(1);
        if ((++sp & 255u) == 0u) { if (xb_ld(&bar[XB_TMO])) break; if (sp > XB_SPIN_CAP) { atomicAdd(&bar[XB_TMO], 1u); break; } }
    }
    nloc = mine > 0u ? mine : 1u; nx = cnt > 0u ? cnt : 1u;
}
__device__ __forceinline__ void xcd_barrier(const XcdBarrier& b) {
    asm volatile("s_waitcnt vmcnt(0)" ::: "memory");
    __syncthreads();
    if (threadIdx.x == 0) {
        unsigned* bar = b.bar;
        __builtin_amdgcn_s_waitcnt(0);
        unsigned nloc = b.st[0], nx = b.st[1];
        if (nloc == 0u) { xcd_barrier_complete(bar, b.x, nloc, nx); b.st[0] = nloc; b.st[1] = nx; }
        const unsigned old = xb_add(&bar[XB_XSUB(b.x)], 1u);
        const unsigned gen = old / nloc;
        if (old + 1u == (gen + 1u) * nloc) {
            __builtin_amdgcn_fence(__ATOMIC_RELEASE, "agent");
            asm volatile("s_waitcnt vmcnt(0)" ::: "memory");
            const unsigned og = xb_add(&bar[XB_TOP], 1u);
            const unsigned tg = og / nx;
            if (og + 1u == (tg + 1u) * nx) xb_add(&bar[XB_TOPGEN], 1u);
            else XB_SPIN(xb_ld(&bar[XB_TOPGEN]) == tg, bar);
            __builtin_amdgcn_fence(__ATOMIC_ACQUIRE, "agent");
            xb_add(&bar[XB_XGEN(b.x)], 1u);
            asm volatile("s_waitcnt vmcnt(0)" ::: "memory");
        } else {
            XB_SPIN(xb_ld(&bar[XB_XGEN(b.x)]) == gen, bar);
            __builtin_amdgcn_fence(__ATOMIC_ACQUIRE, "agent");
            asm volatile("s_waitcnt vmcnt(0)" ::: "memory");
        }
    }
    __syncthreads();
}

__device__ __forceinline__ void glds16(const void* gsrc, LAS uchar* dst_wave_base) {
    __builtin_amdgcn_global_load_lds((const unsigned*)gsrc, (LAS unsigned*)dst_wave_base, 16, 0, 0);
}
__device__ __forceinline__ int sw128(int row, int c) { return row * 128 + ((c ^ ((row >> 1) & 7)) << 4); }
__device__ __forceinline__ int sw64(int row, int c) { return row * 64 + ((c ^ ((row >> 2) & 3)) << 4); }

#define MFMA32(a, b, c) __builtin_amdgcn_mfma_f32_32x32x16_bf16((a), (b), (c), 0, 0, 0)

constexpr int CT_PITCH = 272;
#define WAITV(n) asm volatile("s_waitcnt vmcnt(" #n ")" ::: "memory")
struct ARowNone { static constexpr bool GATHER = false; __device__ __forceinline__ const bf16_t* operator()(int) const { return nullptr; } };
struct ARowLinear { const bf16_t* base; size_t ld; __device__ __forceinline__ const bf16_t* operator()(int r) const { return base + (size_t)r * ld; } };
struct ARowGather { static constexpr bool GATHER = true; const bf16_t* base; const unsigned* list; int nvalid; __device__ __forceinline__ const bf16_t* operator()(int r) const {
    const int rr = r < nvalid ? r : nvalid - 1; const unsigned ent = list[rr]; return base + (size_t)(ent >> 1) * DM; } };

struct AOffLinear { __device__ __forceinline__ int operator()(int kt) const { return kt * 64; } };
struct AOffRouter { int xl_off; __device__ __forceinline__ int operator()(int kt) const { return (kt & 15) * 64 + ((kt >> 4) == 1 ? xl_off : 0); } };
constexpr int CTF_PITCH = 129;
template <bool F32C = false, class ARow, class Epi, class AOff = AOffLinear>
__device__ __forceinline__ void gemm_tile(LAS uchar* lds, const ARow& arow, const bf16_t* Bt, size_t ldb, int K, const Epi& epi, const AOff aoff = AOff()) {
    const int tid = tid_opaque(), lane = tid & 63, wid = __builtin_amdgcn_readfirstlane(tid >> 6);
#if NAIVE_GEMM
    {
        const int r = tid >> 1, nh = tid & 1;
        float acc[64];
#pragma unroll
        for (int n = 0; n < 64; ++n) acc[n] = 0.f;
        const bf16_t* ar = arow(r);
        for (int k = 0; k < K; k += 8) {
            float a[8]; unpack8(*(const u32x4*)(ar + k), a);
#pragma unroll
            for (int n = 0; n < 64; ++n) {
                float b[8]; unpack8(*(const u32x4*)(Bt + (size_t)(nh * 64 + n) * ldb + k), b);
#pragma unroll
                for (int j = 0; j < 8; ++j) acc[n] += a[j] * b[j];
            }
        }
        __syncthreads();
#pragma unroll
        for (int n = 0; n < 64; n += 2) { if (F32C) { ((LAS float*)lds)[r * CTF_PITCH + nh * 64 + n] = acc[n]; ((LAS float*)lds)[r * CTF_PITCH + nh * 64 + n + 1] = acc[n + 1]; } else *(LAS unsigned*)(lds + r * CT_PITCH + (nh * 64 + n) * 2) = pk2(acc[n], acc[n + 1]); }
    }
#else
    {
        const int wm = wid >> 1, wn = wid & 1, r = lane & 31, hh = lane >> 5;
        const int srow = lane >> 3, c0 = (lane & 7) ^ (srow >> 1);
        const bf16_t* asrc[4];
#pragma unroll
        for (int j = 0; j < 4; ++j) asrc[j] = arow(8 * (wid * 4 + j) + srow) + (c0 ^ ((j & 1) << 2)) * 8;
        const bf16_t* bsrc0 = Bt + (size_t)(wid * 16 + srow) * ldb + c0 * 8;
        const bf16_t* bsrc1 = Bt + (size_t)(wid * 16 + 8 + srow) * ldb + (c0 ^ 4) * 8;
        const int lanebase = r * 128 + ((hh ^ ((r >> 1) & 7)) << 4);
        f32x16 acc[2][2];
#pragma unroll
        for (int a = 0; a < 2; ++a)
#pragma unroll
            for (int b = 0; b < 2; ++b)
#pragma unroll
                for (int i = 0; i < 16; ++i) acc[a][b][i] = 0.f;
        const int nt = K >> 6;
#define GT_STAGE(kt, sb) do { _Pragma("unroll") for (int j = 0; j < 4; ++j) \
            glds16(asrc[j] + aoff(kt), lds + (sb) * GSTG + (wid * 4 + j) * 1024); \
            glds16(bsrc0 + (kt) * 64, lds + (sb) * GSTG + 32768 + (wid * 2) * 1024); \
            glds16(bsrc1 + (kt) * 64, lds + (sb) * GSTG + 32768 + (wid * 2 + 1) * 1024); } while (0)
        GT_STAGE(0, 0);
        if (nt > 1) GT_STAGE(1, 1);
        int sb = 0;
        for (int kt = 0; kt < nt; ++kt) {
            if (kt + 1 < nt) WAITV(6); else WAITV(0);
            __builtin_amdgcn_s_barrier();
            if (kt + 2 < nt) { const int sn = sb >= 1 ? sb - 1 : 2; GT_STAGE(kt + 2, sn); }
            const LAS uchar* xs = lds + sb * GSTG + wm * 8192; const LAS uchar* wsb = lds + sb * GSTG + 32768 + wn * 8192;
#pragma unroll
            for (int ks = 0; ks < 4; ++ks) {
                const int lb = lanebase ^ (ks << 5);
                bf16x8 xf[2], wf[2];
#pragma unroll
                for (int mb = 0; mb < 2; ++mb) xf[mb] = *(const LAS bf16x8*)(xs + mb * 4096 + lb);
#pragma unroll
                for (int nb = 0; nb < 2; ++nb) wf[nb] = *(const LAS bf16x8*)(wsb + nb * 4096 + lb);
#pragma unroll
                for (int nb = 0; nb < 2; ++nb)
#pragma unroll
                    for (int mb = 0; mb < 2; ++mb) acc[nb][mb] = MFMA32(wf[nb], xf[mb], acc[nb][mb]);
            }
            sb = sb == 2 ? 0 : sb + 1;
        }
#undef GT_STAGE
        __syncthreads();
#pragma unroll
        for (int nb = 0; nb < 2; ++nb)
#pragma unroll
            for (int mb = 0; mb < 2; ++mb) {
                const int m = 64 * wm + 32 * mb + r;
#pragma unroll
                for (int q4 = 0; q4 < 4; ++q4) {
                    const int n = 64 * wn + 32 * nb + 8 * q4 + 4 * hh;
                    if (F32C) {
#pragma unroll
                        for (int j = 0; j < 4; ++j) ((LAS float*)lds)[m * CTF_PITCH + n + j] = acc[nb][mb][4 * q4 + j];
                    } else {
                        u32x2 v; v[0] = pk2(acc[nb][mb][4 * q4], acc[nb][mb][4 * q4 + 1]); v[1] = pk2(acc[nb][mb][4 * q4 + 2], acc[nb][mb][4 * q4 + 3]);
                        *(LAS u32x2*)(lds + m * CT_PITCH + n * 2) = v;
                    }
                }
            }
    }
#endif
    __syncthreads();
    epi(lds);
    __syncthreads();
}
constexpr int BSTG = 32768, CT2_OFF = 256 * CT_PITCH;
template <int V = 0, class ARow, class EpiMaker>
__device__ __forceinline__ void gemm_big(LAS uchar* lds, const ARow& arow, const bf16_t* Bt, size_t ldb, int K, const EpiMaker& mk) {
    const int tid = tid_opaque(), lane = tid & 63, wid = __builtin_amdgcn_readfirstlane(tid >> 6);
    {
        const int wm = wid >> 2, wn = wid & 3, r = lane & 31, hh = lane >> 5;
        const int srow = lane >> 3, c0 = (lane & 7) ^ (lane >> 4);
        const bf16_t* asrc[4];
#pragma unroll
        for (int j = 0; j < 4; ++j) asrc[j] = arow(wid * 32 + 8 * j + srow) + (c0 ^ ((j & 1) << 2)) * 8;
        const bf16_t* b0 = Bt + (size_t)(wid * 32 + srow) * ldb + c0 * 8; const bf16_t* b1 = Bt + (size_t)(wid * 32 + srow) * ldb + (c0 ^ 4) * 8;
        const int lanebase = r * 128 + ((hh ^ ((r >> 1) & 7)) << 4);
        f32x16 acc[2][4];
#pragma unroll
        for (int a = 0; a < 2; ++a)
#pragma unroll
            for (int b = 0; b < 4; ++b)
#pragma unroll
                for (int i = 0; i < 16; ++i) acc[a][b][i] = 0.f;
        const int nt = K >> 6;
#define GB_STAGE(kt, sb) do { _Pragma("unroll") for (int j = 0; j < 4; ++j) { \
            glds16(asrc[j] + (kt) * 64, lds + (sb) * 65536 + (wid * 4 + j) * 1024); \
            glds16(((j & 1) ? b1 : b0) + (size_t)(8 * j) * ldb + (kt) * 64, lds + (sb) * 65536 + 32768 + (wid * 4 + j) * 1024); } } while (0)
        if (!(V & 4)) GB_STAGE(0, 0);
        for (int kt = 0; kt < nt; ++kt) {
            const int sb = kt & 1;
            WAITV(0);
            __builtin_amdgcn_s_barrier();
            if (!(V & 4) && kt + 1 < nt) GB_STAGE(kt + 1, sb ^ 1);
            const LAS uchar* xs = lds + sb * 65536 + wm * 16384; const LAS uchar* wsb = lds + sb * 65536 + 32768 + wn * 8192;
#pragma unroll
            for (int ks = 0; ks < 4; ++ks) {
                const int lb = lanebase ^ (ks << 5);
                bf16x8 xf[4], wf[2];
#pragma unroll
                for (int mb = 0; mb < 4; ++mb) xf[mb] = *(const LAS bf16x8*)(xs + mb * 4096 + lb);
#pragma unroll
                for (int nb = 0; nb < 2; ++nb) wf[nb] = *(const LAS bf16x8*)(wsb + nb * 4096 + lb);
#pragma unroll
                for (int nb = 0; nb < 2; ++nb)
#pragma unroll
                    for (int mb = 0; mb < 4; ++mb) acc[nb][mb] = MFMA32(wf[nb], xf[mb], acc[nb][mb]);
            }
        }
#undef GB_STAGE
        __syncthreads();
#pragma unroll
        for (int nb = 0; nb < 2; ++nb)
#pragma unroll
            for (int mb = 0; mb < 4; ++mb) {
                const int m = 128 * wm + 32 * mb + r;
#pragma unroll
                for (int q4 = 0; q4 < 4; ++q4) {
                    const int n = 64 * (wn & 1) + 32 * nb + 8 * q4 + 4 * hh;
                    u32x2 v; v[0] = pk2(acc[nb][mb][4 * q4], acc[nb][mb][4 * q4 + 1]); v[1] = pk2(acc[nb][mb][4 * q4 + 2], acc[nb][mb][4 * q4 + 3]);
                    *(LAS u32x2*)(lds + (wn >> 1) * CT2_OFF + m * CT_PITCH + n * 2) = v;
                }
            }
    }
    __syncthreads();
    if (!(V & 1)) { mk(0)(lds); mk(1)(lds + CT2_OFF); }
    __syncthreads();
}
namespace pg8 {
#define PG8_LAS __attribute__((address_space(3)))
typedef ::f32x4 f32x4; typedef ::bf16x8 bf16x8; typedef ::bf16_t bf16_t; typedef ::u32x4 u32x4;
constexpr int BM = 256, BK = 64, HALF = 128, HTB = HALF * BK * 2  , STAGE_BYTES = 8 * HTB, NXCD = 8, WGM = 8;

__host__ __device__ __forceinline__ int lds_byte(int r, int c) { const int st = (r >> 4) * 2 + (c >> 5), rr = r & 15, cc = c & 31, ob = rr * 64 + cc * 2; return st * 1024 + (ob ^ (((ob >> 9) & 1) << 5)); }
__host__ __device__ __forceinline__ void stage_rc(int b, int& R, int& C) { const int st = b / 1024, sb = b % 1024, swz = sb ^ (((sb >> 9) & 1) << 5); R = (st >> 1) * 16 + swz / 64; C = (st & 1) * 32 + (swz % 64) / 2; }
__host__ __device__ __forceinline__ int perm32(int rho) { const int n = rho >> 4, i = rho & 15; return 8 * (i >> 2) + 4 * n + (i & 3); }

struct Unit { int pm, pn; };
struct Gemm { const bf16_t* A; const bf16_t* Bt; int M, N, K; };
template <class Epi, class Sched, bool ALIGN_EPI = false, bool SP2 = false, class ARowT = ARowNone>
__device__ __forceinline__ void gemm_phase(PG8_LAS unsigned char* lds, const Gemm g, const Sched& S, const Epi& E, const ARowT& arow = ARowT()) {
    constexpr bool GATHER = ARowT::GATHER;
    const int tid = tid_opaque(), wid = __builtin_amdgcn_readfirstlane(tid >> 6), lane = tid & 63, wr = wid >> 2, wc = wid & 3, fr = lane & 15, fq = lane >> 4;
    const int K = g.K, nt = K / BK;
    unsigned voffA[2], voffB[2];
#pragma unroll
    for (int i = 0; i < 2; ++i) { int R, C; stage_rc(tid * 16 + i * 8192, R, C); const int Rb = Epi::PERM ? ((R & ~31) + perm32(R & 31)) : R;
        voffA[i] = (unsigned)(R * K + C) * 2u; voffB[i] = (unsigned)(Rb * K + C) * 2u; }
    unsigned aoffg[2][2] = {{0u, 0u}, {0u, 0u}};
    if constexpr (GATHER) {
#pragma unroll
        for (int h = 0; h < 2; ++h)
#pragma unroll
            for (int i = 0; i < 2; ++i) { int R, C; stage_rc(tid * 16 + i * 8192, R, C); aoffg[h][i] = (unsigned)((const char*)(arow(h * HALF + R) + C) - (const char*)g.A); }
    }
    const size_t kstep = (size_t)(BK * 2);
    const size_t hstep = (size_t)HALF * K * 2;
    const size_t tstep = 2 * hstep;
    const unsigned ldsw = (unsigned)wid * 1024u;
    const int aoff = lds_byte(wr * 64 + fr, fq * 8), boff = lds_byte(wc * 32 + fr, fq * 8);
#define PG8_SA(b, h) (((b) * 2 + (h)) * HTB)
#define PG8_SB(b, h) ((4 + (b) * 2 + (h)) * HTB)
#define PG8_STAGE(bufoff, gbase, voff) do { _Pragma("unroll") for (int _i = 0; _i < 2; ++_i) \
        __builtin_amdgcn_global_load_lds((const unsigned*)((const char*)(gbase) + (voff)[_i]), (PG8_LAS unsigned*)(lds + (bufoff) + ldsw + _i * 8192), 16, 0, 0); } while (0)
#define PG8_STAGE_A(b, h, kp) do { if constexpr (GATHER) { _Pragma("unroll") for (int _i = 0; _i < 2; ++_i) \
        __builtin_amdgcn_global_load_lds((const unsigned*)((const char*)g.A + ((kp) - (const char*)0) + aoffg[h][_i]), (PG8_LAS unsigned*)(lds + PG8_SA(b, h) + ldsw + _i * 8192), 16, 0, 0); } \
        else PG8_STAGE(PG8_SA(b, h), (kp) + (h) * hstep, voffA); } while (0)
#define PG8_LDA(dst, b, h) do { _Pragma("unroll") for (int m = 0; m < 4; ++m) _Pragma("unroll") for (int k = 0; k < 2; ++k) dst[m][k] = *(const PG8_LAS bf16x8*)(lds + PG8_SA(b, h) + aoff + m * 2048 + k * 1024); } while (0)
#define PG8_LDB(dst, b, h) do { _Pragma("unroll") for (int n = 0; n < 2; ++n) _Pragma("unroll") for (int k = 0; k < 2; ++k) dst[n][k] = *(const PG8_LAS bf16x8*)(lds + PG8_SB(b, h) + boff + n * 2048 + k * 1024); } while (0)
#define PG8_MMA(ai, bj, At, Bt) do { __builtin_amdgcn_s_setprio(1); _Pragma("unroll") for (int m = 0; m < 4; ++m) _Pragma("unroll") for (int n = 0; n < 2; ++n) _Pragma("unroll") for (int k = 0; k < 2; ++k) \
        acc[ai][bj][m][n] = __builtin_amdgcn_mfma_f32_16x16x32_bf16(Bt[n][k], At[m][k], acc[ai][bj][m][n], 0, 0, 0); __builtin_amdgcn_s_setprio(0); } while (0)
#define PG8_WAIT_V(n) asm volatile("s_waitcnt vmcnt(" #n ")" ::: "memory")
#define PG8_WAIT_L(n) asm volatile("s_waitcnt lgkmcnt(" #n ")" ::: "memory")
#define PG8_BAR __builtin_amdgcn_s_barrier()
#define PG8_SCHED __builtin_amdgcn_sched_barrier(0)
    Unit cur, nxt; int ui = 0;
    if (!S.next(0, cur)) return;
    f32x4 acc[2][2][4][2];
#pragma unroll
    for (int a = 0; a < 2; ++a)
#pragma unroll
        for (int b = 0; b < 2; ++b)
#pragma unroll
            for (int m = 0; m < 4; ++m)
#pragma unroll
                for (int n = 0; n < 2; ++n) acc[a][b][m][n] = (f32x4){0.f, 0.f, 0.f, 0.f};
    bf16x8 At[4][2], B0[2][2], B1[2][2];
    const char* cA = GATHER ? (const char*)0 : (const char*)g.A + (size_t)cur.pm * tstep; const char* cB = (const char*)g.Bt + (size_t)cur.pn * tstep;
    S.a_ready(cur);
    if constexpr (SP2) {
        PG8_STAGE(PG8_SB(0, 0), cB, voffB); PG8_STAGE(PG8_SB(0, 1), cB + hstep, voffB); PG8_STAGE_A(0, 0, cA); PG8_STAGE_A(0, 1, cA);
        if (wr == 1) PG8_BAR;
        PG8_WAIT_V(2); PG8_BAR;
        PG8_STAGE(PG8_SB(1, 0), cB + kstep, voffB); PG8_STAGE_A(1, 0, cA + kstep); PG8_STAGE(PG8_SB(1, 1), cB + hstep + kstep, voffB);
        PG8_WAIT_V(6); PG8_BAR;
    } else {
        PG8_STAGE(PG8_SB(0, 0), cB, voffB); PG8_STAGE_A(0, 0, cA); PG8_STAGE(PG8_SB(0, 1), cB + hstep, voffB); PG8_STAGE_A(0, 1, cA);
        if (wr == 1) PG8_BAR;
        PG8_WAIT_V(4); PG8_BAR;
        PG8_STAGE(PG8_SB(1, 0), cB + kstep, voffB); PG8_STAGE_A(1, 0, cA + kstep); PG8_STAGE(PG8_SB(1, 1), cB + hstep + kstep, voffB);
        PG8_WAIT_V(6); PG8_BAR;
    }
    for (;;) {
        const bool has_next = S.next(ui + 1, nxt);
        const char* nA = (has_next && !GATHER) ? (const char*)g.A + (size_t)nxt.pm * tstep : cA; const char* nB = has_next ? (const char*)g.Bt + (size_t)nxt.pn * tstep : cB;
        for (int t = 0; t < nt; t += 2) {
            const bool last = (t == nt - 2);
            const char* a1 = cA + (size_t)(t + 1) * kstep;
            const char* a2 = last ? nA : cA + (size_t)(t + 2) * kstep; const char* b2 = last ? nB : cB + (size_t)(t + 2) * kstep;
            const char* a3 = a2 + kstep; const char* b3 = b2 + kstep;
            if (last && has_next) S.a_ready(nxt);
            if constexpr (SP2) {
            PG8_LDB(B0, 0, 0); PG8_LDB(B1, 0, 1); PG8_SCHED; PG8_LDA(At, 0, 0); PG8_STAGE_A(1, 1, a1);
            PG8_WAIT_V(8); PG8_WAIT_L(0); PG8_BAR; PG8_MMA(0, 0, At, B0); PG8_MMA(0, 1, At, B1); PG8_BAR; PG8_SCHED;
            PG8_LDA(At, 0, 1); PG8_STAGE(PG8_SB(0, 0), b2, voffB); PG8_STAGE(PG8_SB(0, 1), b2 + hstep, voffB); PG8_STAGE_A(0, 0, a2);
            PG8_WAIT_V(8); PG8_WAIT_L(0); PG8_BAR; PG8_MMA(1, 0, At, B0); PG8_MMA(1, 1, At, B1); PG8_BAR; PG8_SCHED;
            PG8_LDB(B0, 1, 0); PG8_LDB(B1, 1, 1); PG8_SCHED; PG8_LDA(At, 1, 0); PG8_STAGE_A(0, 1, a2);
            PG8_WAIT_V(8); PG8_WAIT_L(0); PG8_BAR; PG8_MMA(0, 0, At, B0); PG8_MMA(0, 1, At, B1); PG8_BAR; PG8_SCHED;
            PG8_LDA(At, 1, 1); PG8_STAGE(PG8_SB(1, 0), b3, voffB); PG8_STAGE(PG8_SB(1, 1), b3 + hstep, voffB); PG8_STAGE_A(1, 0, a3);
            PG8_WAIT_V(8); PG8_WAIT_L(0); PG8_BAR; PG8_MMA(1, 0, At, B0); PG8_MMA(1, 1, At, B1); PG8_BAR; PG8_SCHED;
            } else {
            PG8_LDB(B0, 0, 0); PG8_SCHED; PG8_LDA(At, 0, 0); PG8_STAGE_A(1, 1, a1);
            PG8_WAIT_L(8); PG8_BAR; PG8_WAIT_L(0); PG8_MMA(0, 0, At, B0); PG8_BAR; PG8_SCHED;
            PG8_LDB(B1, 0, 1); PG8_STAGE(PG8_SB(0, 0), b2, voffB);
            PG8_BAR; PG8_WAIT_L(0); PG8_MMA(0, 1, At, B1); PG8_BAR;
            PG8_LDA(At, 0, 1); PG8_STAGE_A(0, 0, a2);
            PG8_BAR; PG8_WAIT_L(0); PG8_MMA(1, 0, At, B0); PG8_BAR; PG8_SCHED;
            PG8_STAGE(PG8_SB(0, 1), b2 + hstep, voffB);
            PG8_WAIT_V(6); PG8_BAR; PG8_MMA(1, 1, At, B1); PG8_BAR;
            PG8_LDB(B0, 1, 0); PG8_SCHED; PG8_LDA(At, 1, 0); PG8_STAGE_A(0, 1, a2);
            PG8_WAIT_L(8); PG8_BAR; PG8_WAIT_L(0); PG8_MMA(0, 0, At, B0); PG8_BAR; PG8_SCHED;
            PG8_LDB(B1, 1, 1); PG8_STAGE(PG8_SB(1, 0), b3, voffB);
            PG8_BAR; PG8_WAIT_L(0); PG8_MMA(0, 1, At, B1); PG8_BAR;
            PG8_LDA(At, 1, 1); PG8_STAGE_A(1, 0, a3);
            PG8_BAR; PG8_WAIT_L(0); PG8_MMA(1, 0, At, B0); PG8_BAR; PG8_SCHED;
            PG8_STAGE(PG8_SB(1, 1), b3 + hstep, voffB);
            PG8_WAIT_V(6); PG8_BAR; PG8_MMA(1, 1, At, B1); PG8_BAR;
            }
        }
        if constexpr (ALIGN_EPI) { if (wr == 0) PG8_BAR; }
        if constexpr (!Epi::AFTER_DRAIN) { E(acc, cur, wr, wc, fr, fq); S.done(cur); }
        if (!has_next) break;
#pragma unroll
        for (int a = 0; a < 2; ++a)
#pragma unroll
            for (int b = 0; b < 2; ++b)
#pragma unroll
                for (int m = 0; m < 4; ++m)
#pragma unroll
                    for (int n = 0; n < 2; ++n) acc[a][b][m][n] = (f32x4){0.f, 0.f, 0.f, 0.f};
        cur = nxt; cA = nA; cB = nB; ++ui;
        if constexpr (ALIGN_EPI) { if (wr == 1) PG8_BAR; }
    }
    PG8_WAIT_V(0);
    if constexpr (!ALIGN_EPI) { if (wr == 0) PG8_BAR; }
    PG8_BAR;
    if constexpr (Epi::AFTER_DRAIN) { E.fused(acc, cur, wr, wc, fr, fq, lds, wid, lane); S.done(cur); }
#undef PG8_SA
#undef PG8_SB
#undef PG8_STAGE
#undef PG8_STAGE_A
#undef PG8_LDA
#undef PG8_LDB
#undef PG8_MMA
#undef PG8_WAIT_V
#undef PG8_WAIT_L
#undef PG8_BAR
#undef PG8_SCHED
}
}

struct OneUnit { __device__ __forceinline__ bool next(int i, pg8::Unit& u) const { u.pm = 0; u.pn = 0; return i == 0; }
    __device__ __forceinline__ void a_ready(const pg8::Unit&) const {} __device__ __forceinline__ void done(const pg8::Unit&) const {} };
template <class EpiMaker> struct EpiViaLds {
    static constexpr bool PERM = false, AFTER_DRAIN = true; const EpiMaker* mk;
    __device__ __forceinline__ void fused(pg8::f32x4 (&acc)[2][2][4][2], const pg8::Unit&, int wr, int wc, int fr, int fq, LAS uchar* lds, int, int) const {
#pragma unroll
        for (int ai = 0; ai < 2; ++ai)
#pragma unroll
            for (int bj = 0; bj < 2; ++bj)
#pragma unroll
                for (int m = 0; m < 4; ++m)
#pragma unroll
                    for (int n = 0; n < 2; ++n) {
                        const int row = 128 * ai + 64 * wr + 16 * m + fr, col = 32 * wc + 16 * n + 4 * fq;
                        u32x2 v; v[0] = pk2(acc[ai][bj][m][n][0], acc[ai][bj][m][n][1]); v[1] = pk2(acc[ai][bj][m][n][2], acc[ai][bj][m][n][3]);
                        *(LAS u32x2*)(lds + bj * CT2_OFF + row * CT_PITCH + col * 2) = v;
                    }
        __syncthreads();
        (*mk)(0)(lds);
        (*mk)(1)(lds + CT2_OFF);
        __syncthreads();
    }
};
template <class EpiMaker>
__device__ __forceinline__ void gemm_big8g(LAS uchar* lds, const ARowGather& ar, const bf16_t* Bt, int K, const EpiMaker& mk) {
    const pg8::Gemm g{ar.base, Bt, 256, 256, K}; const OneUnit S{}; const EpiViaLds<EpiMaker> E{&mk};
    pg8::gemm_phase<EpiViaLds<EpiMaker>, OneUnit, false, true, ARowGather>(lds, g, S, E, ar);
}
template <class EpiMaker>
__device__ __forceinline__ void gemm_big8(LAS uchar* lds, const bf16_t* A, const bf16_t* Bt, int K, const EpiMaker& mk) {
    const pg8::Gemm g{A, Bt, 256, 256, K}; const OneUnit S{}; const EpiViaLds<EpiMaker> E{&mk};
    pg8::gemm_phase<EpiViaLds<EpiMaker>, OneUnit, false, true>(lds, g, S, E);
}
__device__ __forceinline__ u32x4 ct_ld8(const LAS uchar* ct, int r, int c) { return *(const LAS u32x4*)(ct + r * CT_PITCH + c * 2); }
__device__ __forceinline__ float ct_ld1(const LAS uchar* ct, int r, int c) { return bf2f(*(const LAS bf16_t*)(ct + r * CT_PITCH + c * 2)); }

struct EpiProj {
    int mt, nt, l; const Params* p;
    __device__ __forceinline__ void operator()(const LAS uchar* ct) const {
        uchar* ws = p->ws; const int tid = tid_opaque();
        const LAS float* rowS = (const LAS float*)(lds_base() + LDS_ROW);
        const int t0 = mt * 256, b = t0 >> 11, s0 = t0 & 2047;
        if (nt < 8) {
            const int h = nt & 3; const bool isq = nt < 4;
            const int c8 = tid & 7, j = (tid >> 3) & 1, r0 = tid >> 4;
            const float* g = p->in[isq ? 3 : 4] + l * 64 + c8 * 8;
            const f32x4 g0 = *(const f32x4*)g, g1 = *(const f32x4*)(g + 4);
            bf16_t* dbase = (bf16_t*)(ws + (isq ? WS_QD : WS_KD)) + ((((size_t)b * 4 + h) * 2 + j) * S + s0) * 64 + c8 * 8;
#pragma unroll
            for (int it = 0; it < 8; ++it) {
                const int r = it * 32 + r0;
                const float rs = rowS[r];
                float f[8]; unpack8(ct_ld8(ct, r, j * 64 + c8 * 8), f);
                float ss = 0.f;
#pragma unroll
                for (int i = 0; i < 8; ++i) { f[i] *= rs; ss += f[i] * f[i]; }
                ss += __shfl_xor(ss, 1); ss += __shfl_xor(ss, 2); ss += __shfl_xor(ss, 4);
                const float rn = __builtin_amdgcn_rsqf(ss * (1.f / 64.f) + EPS) * (isq ? QSCALE_D : 1.f);
                u32x4 o; o[0] = pk2(f[0] * rn * g0[0], f[1] * rn * g0[1]); o[1] = pk2(f[2] * rn * g0[2], f[3] * rn * g0[3]);
                o[2] = pk2(f[4] * rn * g1[0], f[5] * rn * g1[1]); o[3] = pk2(f[6] * rn * g1[2], f[7] * rn * g1[3]);
                *(u32x4*)(dbase + (size_t)r * 64) = o;
            }
        } else if (nt < 12) {
            const int h = nt - 8, d = tid >> 2, half = tid & 3;
            bf16_t* dst = (bf16_t*)(ws + WS_VDT) + (((size_t)b * 4 + h) * 128 + d) * S + s0 + half * 64;
#pragma unroll
            for (int c8 = 0; c8 < 8; ++c8) { u32x4 o;
#pragma unroll
                for (int i = 0; i < 4; ++i) {
                    const int p0 = c8 * 8 + 2 * i, r0 = half * 64 + sigma16(p0), r1 = half * 64 + sigma16(p0 + 1);
                    o[i] = pk2(ct_ld1(ct, r0, d) * rowS[r0], ct_ld1(ct, r1, d) * rowS[r1]); }
                *(u32x4*)(dst + c8 * 8) = o; }
        } else {
            const int c8 = tid & 15, r0 = tid >> 4;
            bf16_t* dbase = (bf16_t*)(ws + WS_LAT) + (size_t)t0 * 640 + (nt - 12) * 128 + c8 * 8;
            const int hidx = (nt - 12) * 2 + (c8 >> 3);
            float* hss = (float*)(ws + WS_HSS) + (size_t)t0 * 8 + hidx;
#pragma unroll
            for (int it = 0; it < 8; ++it) {
                const int r = it * 32 + r0;
                const float rs = rowS[r];
                float f[8]; unpack8(ct_ld8(ct, r, c8 * 8), f); u32x4 o;
#pragma unroll
                for (int i = 0; i < 4; ++i) o[i] = pk2(f[2 * i] * rs, f[2 * i + 1] * rs);
                *(u32x4*)(dbase + (size_t)r * 640) = o;
                float ss = 0.f;
#pragma unroll
                for (int i = 0; i < 4; ++i) { const float a = bflo(o[i]), bq = bfhi(o[i]); ss += a * a + bq * bq; }
                ss += __shfl_xor(ss, 1); ss += __shfl_xor(ss, 2); ss += __shfl_xor(ss, 4);
                if ((c8 & 7) == 0 && hidx < 8) hss[(size_t)r * 8] = ss;
            }
        }
    }
};

__device__ __forceinline__ float lat_rstd(const bf16_t* seg, int n) {
    float ss = 0.f;
    for (int k = 0; k < n; k += 8) { float f[8]; unpack8(*(const u32x4*)(seg + k), f);
#pragma unroll
        for (int i = 0; i < 8; ++i) ss += f[i] * f[i]; }
    return __builtin_amdgcn_rsqf(ss / (float)n + EPS);
}
__device__ __forceinline__ void norm_rope32(float (&y)[32], const float* g, const float* cosr, const float* sinr, float outscale) {
    float ss = 0.f;
#pragma unroll
    for (int i = 0; i < 32; ++i) ss += y[i] * y[i];
    const float rn = __builtin_amdgcn_rsqf(ss * (1.f / 32.f) + EPS);
#pragma unroll
    for (int i = 0; i < 32; ++i) y[i] = y[i] * rn * g[i];
#pragma unroll
    for (int i = 0; i < 16; ++i) { const float c = cosr[i], sn = sinr[i], x1 = y[i], x2 = y[16 + i];
        y[i] = (x1 * c - x2 * sn) * outscale; y[16 + i] = (x2 * c + x1 * sn) * outscale; }
}

__device__ __forceinline__ u32x4 norm64_piece(float (&f)[8], const float* g8, float outscale) {
    float ss = 0.f;
#pragma unroll
    for (int i = 0; i < 8; ++i) ss += f[i] * f[i];
    ss += __shfl_xor(ss, 1); ss += __shfl_xor(ss, 2); ss += __shfl_xor(ss, 4);
    const float rn = __builtin_amdgcn_rsqf(ss * (1.f / 64.f) + EPS) * outscale;
    const f32x4 g0 = *(const f32x4*)g8, g1 = *(const f32x4*)(g8 + 4);
    u32x4 o; o[0] = pk2(f[0] * rn * g0[0], f[1] * rn * g0[1]); o[1] = pk2(f[2] * rn * g0[2], f[3] * rn * g0[3]);
    o[2] = pk2(f[4] * rn * g1[0], f[5] * rn * g1[1]); o[3] = pk2(f[6] * rn * g1[2], f[7] * rn * g1[3]);
    return o;
}
__device__ __forceinline__ u32x4 norm_rope_piece(float (&f)[8], int c8, const float* g, const float* cosr, const float* sinr, float outscale) {
    float ss = 0.f;
#pragma unroll
    for (int i = 0; i < 8; ++i) ss += f[i] * f[i];
    ss += __shfl_xor(ss, 1); ss += __shfl_xor(ss, 2);
    const float rn = __builtin_amdgcn_rsqf(ss * (1.f / 32.f) + EPS);
    float y[8], z[8];
#pragma unroll
    for (int i = 0; i < 8; ++i) y[i] = f[i] * rn * g[c8 * 8 + i];
#pragma unroll
    for (int i = 0; i < 8; ++i) z[i] = __shfl_xor(y[i], 2);
    const int fi = (c8 & 1) * 8;
    float o[8];
#pragma unroll
    for (int i = 0; i < 8; ++i) { const float c = cosr[fi + i], sn = sinr[fi + i];
        o[i] = ((c8 < 2) ? (y[i] * c - z[i] * sn) : (y[i] * c + z[i] * sn)) * outscale; }
    u32x4 w; w[0] = pk2(o[0], o[1]); w[1] = pk2(o[2], o[3]); w[2] = pk2(o[4], o[5]); w[3] = pk2(o[6], o[7]);
    return w;
}
struct EpiMlaQ {
    int mt, h, l; const Params* p;
    __device__ __forceinline__ void operator()(const LAS uchar* ct) const {
        uchar* ws = p->ws; const int tid = tid_opaque();
        const LAS float* rowS = (const LAS float*)(lds_base() + LDS_ROW);
        const int t0 = mt * 256, b = t0 >> 11, s0 = t0 & 2047;
        bf16_t* dbase = (bf16_t*)(ws + WS_QM) + (((size_t)b * 4 + h) * S + s0) * 96;
        const float* gn = p->in[11] + l * 64; const float* gr = p->in[12] + l * 32;
        {
            const int c8 = tid & 7, r0 = tid >> 3;
#pragma unroll
            for (int it = 0; it < 4; ++it) {
                const int r = it * 64 + r0; const float rs = rowS[r];
                float f[8]; unpack8(ct_ld8(ct, r, c8 * 8), f);
#pragma unroll
                for (int i = 0; i < 8; ++i) f[i] *= rs;
                *(u32x4*)(dbase + (size_t)r * 96 + c8 * 8) = norm64_piece(f, gn + c8 * 8, QSCALE_M);
            }
        }
        {
            const int c8 = tid & 3, r0 = tid >> 2;
#pragma unroll
            for (int it = 0; it < 2; ++it) {
                const int r = it * 128 + r0; const float rs = rowS[r];
                float f[8]; unpack8(ct_ld8(ct, r, 64 + c8 * 8), f);
#pragma unroll
                for (int i = 0; i < 8; ++i) f[i] *= rs;
                const float* cosr = (const float*)(ws + WS_ROPE) + (s0 + r) * 16; const float* sinr = cosr + S * 16;
                *(u32x4*)(dbase + (size_t)r * 96 + 64 + c8 * 8) = norm_rope_piece(f, c8, gr, cosr, sinr, QSCALE_M);
            }
        }
    }
};
struct EpiMlaKV {
    int mt, h, l; const Params* p;
    __device__ __forceinline__ void operator()(const LAS uchar* ct) const {
        uchar* ws = p->ws; const int tid = tid_opaque();
        const LAS float* rowS = (const LAS float*)(lds_base() + LDS_ROW);
        const int t0 = mt * 256, b = t0 >> 11, s0 = t0 & 2047;
        bf16_t* dbase = (bf16_t*)(ws + WS_KM) + (((size_t)b * 4 + h) * S + s0) * 96;
        const float* gn = p->in[13] + l * 64; const float* gr = p->in[14] + l * 32;
        {
            const int c8 = tid & 7, r0 = tid >> 3;
#pragma unroll
            for (int it = 0; it < 4; ++it) {
                const int r = it * 64 + r0; const float rs = rowS[r];
                float f[8]; unpack8(ct_ld8(ct, r, c8 * 8), f);
#pragma unroll
                for (int i = 0; i < 8; ++i) f[i] *= rs;
                *(u32x4*)(dbase + (size_t)r * 96 + c8 * 8) = norm64_piece(f, gn + c8 * 8, 1.f);
            }
        }
        {
            const bf16_t* lat = (const bf16_t*)(ws + WS_LAT) + (size_t)t0 * 640 + 320;
            const int c8 = tid & 3, r0 = tid >> 2;
#pragma unroll
            for (int it = 0; it < 2; ++it) {
                const int r = it * 128 + r0;
                float f[8]; unpack8(*(const u32x4*)(lat + (size_t)r * 640 + c8 * 8), f);
                const float* cosr = (const float*)(ws + WS_ROPE) + (s0 + r) * 16; const float* sinr = cosr + S * 16;
                *(u32x4*)(dbase + (size_t)r * 96 + 64 + c8 * 8) = norm_rope_piece(f, c8, gr, cosr, sinr, 1.f);
            }
        }
        {
            const int d = tid >> 3, q4 = tid & 7;
            bf16_t* dst = (bf16_t*)(ws + WS_VMT) + (((size_t)b * 4 + h) * 64 + d) * S + s0 + q4 * 32;
#pragma unroll
            for (int c8 = 0; c8 < 4; ++c8) { u32x4 o;
#pragma unroll
                for (int i = 0; i < 4; ++i) {
                    const int p0 = c8 * 8 + 2 * i, r0 = q4 * 32 + sigma16(p0), r1 = q4 * 32 + sigma16(p0 + 1);
                    o[i] = pk2(ct_ld1(ct, r0, 64 + d) * rowS[r0], ct_ld1(ct, r1, 64 + d) * rowS[r1]); }
                *(u32x4*)(dst + c8 * 8) = o; }
        }
    }
};
struct EpiPool {
    int mt, g, l; const Params* p;
    __device__ __forceinline__ void operator()(const LAS uchar* ct) const {
        uchar* ws = p->ws; const int tid = tid_opaque(), c8 = tid & 7, r0 = tid >> 3;
        const float* sc = p->in[16] + l * 256 + g * 64 + c8 * 8;
        const f32x4 s0 = *(const f32x4*)sc, s1 = *(const f32x4*)(sc + 4);
        bf16_t* dst = (bf16_t*)(ws + WS_MIX) + (size_t)(mt * 256) * DM + 768 + g * 64 + c8 * 8;
#pragma unroll
        for (int it = 0; it < 4; ++it) {
            const int r = it * 64 + r0;
            float f[8]; unpack8(ct_ld8(ct, r, c8 * 8), f); u32x4 o;
            o[0] = pk2(f[0] * s0[0], f[1] * s0[1]); o[1] = pk2(f[2] * s0[2], f[3] * s0[3]); o[2] = pk2(f[4] * s1[0], f[5] * s1[1]); o[3] = pk2(f[6] * s1[2], f[7] * s1[3]);
            *(u32x4*)(dst + (size_t)r * DM) = o;
        }
    }
};
struct EpiWout {
    int mt, nt; const float* xres; const Params* p;
    __device__ __forceinline__ void operator()(const LAS uchar* ct) const {
        uchar* ws = p->ws; const int tid = tid_opaque();
        const size_t base = (size_t)(mt * 256) * DM + nt * 128;
        float* pss = (float*)(ws + WS_PSS) + (size_t)(mt * 256) * 8 + nt;
#pragma unroll 8
        for (int it = 0; it < 16; ++it) {
            const int item = it * NT + tid, c4 = item & 31, r = item >> 5;
            const size_t off = base + (size_t)r * DM + c4 * 4;
            const u32x2 cw = *(const LAS u32x2*)(ct + r * CT_PITCH + c4 * 8);
            const f32x4 x0 = *(const f32x4*)(xres + off);
            f32x4 y; y[0] = x0[0] + bflo(cw[0]); y[1] = x0[1] + bfhi(cw[0]); y[2] = x0[2] + bflo(cw[1]); y[3] = x0[3] + bfhi(cw[1]);
            u32x2 o; o[0] = pk2(y[0], y[1]); o[1] = pk2(y[2], y[3]);
            *(u32x2*)((bf16_t*)(ws + WS_XB) + off) = o;
            u32x2 ol; ol[0] = pk2(y[0] - bflo(o[0]), y[1] - bfhi(o[0])); ol[1] = pk2(y[2] - bflo(o[1]), y[3] - bfhi(o[1]));
            *(u32x2*)((bf16_t*)(ws + WS_XL) + off) = ol;
            float ss = y[0] * y[0] + y[1] * y[1] + y[2] * y[2] + y[3] * y[3];
            ss += __shfl_xor(ss, 1); ss += __shfl_xor(ss, 2); ss += __shfl_xor(ss, 4); ss += __shfl_xor(ss, 8); ss += __shfl_xor(ss, 16);
            if (c4 == 0) pss[(size_t)r * 8] = ss;
        }
    }
};
struct EpiGU {
    int jt; size_t slot0; const Params* p;
    __device__ __forceinline__ void operator()(const LAS uchar* ct) const {
        uchar* ws = p->ws; const int tid = tid_opaque(), c8 = tid & 7, r0 = tid >> 3;
        const LAS float* rowS = (const LAS float*)(lds_base() + LDS_ROW);
        bf16_t* dbase = (bf16_t*)(ws + WS_HMID) + slot0 * 256 + jt * 64 + c8 * 8;
#pragma unroll
        for (int it = 0; it < 4; ++it) {
            const int r = it * 64 + r0;
            const float rs = rowS[r];
            float g[8], u[8]; unpack8(ct_ld8(ct, r, c8 * 8), g); unpack8(ct_ld8(ct, r, 64 + c8 * 8), u);
            float hv[8];
#pragma unroll
            for (int i = 0; i < 8; ++i) { const float gg = g[i] * rs, uu = u[i] * rs; hv[i] = gg * __builtin_amdgcn_rcpf(1.f + __builtin_amdgcn_exp2f(-gg * LOG2E)) * uu; }
            u32x4 o; o[0] = pk2(hv[0], hv[1]); o[1] = pk2(hv[2], hv[3]); o[2] = pk2(hv[4], hv[5]); o[3] = pk2(hv[6], hv[7]);
            *(u32x4*)(dbase + (size_t)r * 256) = o;
        }
    }
};
struct EpiDown {
    int nt, nvalid; const Params* p;
    __device__ __forceinline__ void operator()(const LAS uchar* ct) const {
        uchar* ws = p->ws; const int tid = tid_opaque(), c8 = tid & 15, r0 = tid >> 4;
        const LAS float* rowS = (const LAS float*)(lds_base() + LDS_ROW); const LAS unsigned* rowE = (const LAS unsigned*)(lds_base() + LDS_ROW + 1024);
        bf16_t* ys = (bf16_t*)(ws + WS_YS) + nt * 128 + c8 * 8;
#pragma unroll
        for (int it = 0; it < 8; ++it) {
            const int r = it * 32 + r0;
            if (r < nvalid) {
                const unsigned ent = rowE[r]; const float w = rowS[r];
                float f[8]; unpack8(ct_ld8(ct, r, c8 * 8), f); u32x4 o;
#pragma unroll
                for (int i = 0; i < 4; ++i) o[i] = pk2(f[2 * i] * w, f[2 * i + 1] * w);
                *(u32x4*)(ys + (size_t)ent * DM) = o;
            }
        }
    }
};

template <int V = 0>
__device__ __forceinline__ void diff_attn_unit(LAS uchar* lds, const Params& p, int l, int b, int h, int qb) {
    uchar* ws = p.ws;
    const int tid = tid_opaque(), lane = tid & 63, wid = __builtin_amdgcn_readfirstlane(tid >> 6);
    const float* scal = (const float*)(ws + WS_SCAL) + 16 * l;
    const float lam = scal[0], oml = scal[1], m2 = scal[2];
    const float slope2 = exp2f(-2.f * (float)(h + 1)) * LOG2E;
    const bf16_t* Q1 = (const bf16_t*)(ws + WS_QD) + (((size_t)b * 4 + h) * 2) * S * 64;
    const bf16_t* K1 = (const bf16_t*)(ws + WS_KD) + (((size_t)b * 4 + h) * 2) * S * 64;
    const bf16_t* VT = (const bf16_t*)(ws + WS_VDT) + (((size_t)b * 4 + h) * 128) * S;
    const float* gsub = p.in[6] + l * 128;
    bf16_t* mix = (bf16_t*)(ws + WS_MIX);
#if NAIVE_ATTN
    {
        const int q = qb * 128 + (tid >> 2), mm = (tid >> 1) & 1, dh = tid & 1;
        const bf16_t* Qp = Q1 + (size_t)mm * S * 64 + (size_t)q * 64; const bf16_t* Kp = K1 + (size_t)mm * S * 64;
        float qv[64];
#pragma unroll
        for (int c8 = 0; c8 < 8; ++c8) { float f[8]; unpack8(*(const u32x4*)(Qp + c8 * 8), f);
#pragma unroll
            for (int i = 0; i < 8; ++i) qv[c8 * 8 + i] = f[i]; }
        float o[64]; float lsum = 0.f;
#pragma unroll
        for (int d = 0; d < 64; ++d) o[d] = 0.f;
        for (int key = 0; key < S; ++key) {
            float sc = 0.f;
#pragma unroll
            for (int c8 = 0; c8 < 8; ++c8) { float f[8]; unpack8(*(const u32x4*)(Kp + (size_t)key * 64 + c8 * 8), f);
#pragma unroll
                for (int i = 0; i < 8; ++i) sc += qv[c8 * 8 + i] * f[i]; }
            const float pv = __builtin_amdgcn_exp2f(sc - slope2 * fabsf((float)(q - key)) - m2);
            lsum += pv;
            const int kp = sigma16(key);
#pragma unroll
            for (int d = 0; d < 64; ++d) o[d] += pv * bf2f(VT[(size_t)(dh * 64 + d) * S + kp]);
        }
        const float inv = 1.f / lsum; float ss = 0.f;
#pragma unroll
        for (int d = 0; d < 64; ++d) { const float mine = o[d] * inv; const float other = __shfl_xor(mine, 2); o[d] = mine - lam * other; ss += o[d] * o[d]; }
        ss += __shfl_xor(ss, 1);
        if (mm == 0) {
            const float rn = __builtin_amdgcn_rsqf(ss * (1.f / 128.f) + EPS) * oml;
            bf16_t* dst = mix + (size_t)(b * S + q) * DM + h * 128 + dh * 64;
#pragma unroll
            for (int d = 0; d < 64; d += 2) *(unsigned*)(dst + d) = pk2(o[d] * rn * gsub[dh * 64 + d], o[d + 1] * rn * gsub[dh * 64 + d + 1]);
        }
    }
#else
    {
        const int r = lane & 31, hh = lane >> 5, qs = wid >> 1, mm = wid & 1, qpos = qb * 128 + qs * 32 + r;
        const bf16_t* Qm_ = Q1 + (size_t)mm * S * 64;
        bf16x8 qf[4];
#pragma unroll
        for (int ks = 0; ks < 4; ++ks) qf[ks] = *(const bf16x8*)(Qm_ + (size_t)qpos * 64 + ks * 16 + hh * 8);
        f32x16 O[4]; float lsum = 0.f;
#pragma unroll
        for (int db = 0; db < 4; ++db)
#pragma unroll
            for (int i = 0; i < 16; ++i) O[db][i] = 0.f;
        const int srow = lane >> 3, c0 = (lane & 7) ^ (srow >> 1);
        const bool isk = wid < 4;
        const bf16_t* sbase = isk ? (K1 + (size_t)(wid >> 1) * S * 64 + (size_t)(wid & 1) * 32 * 64) : (VT + (size_t)(wid - 4) * 32 * S);
        const int rstride = isk ? 64 : S, kstride = isk ? 64 * 64 : 64;
        const bf16_t* sb0 = sbase + (size_t)srow * rstride + c0 * 8;
        const bf16_t* sb1 = sbase + (size_t)srow * rstride + (c0 ^ 4) * 8;
        const int lanebase = r * 128 + ((hh ^ ((r >> 1) & 7)) << 4);
#define DA_STAGE(kt, sbuf) do { _Pragma("unroll") for (int j = 0; j < 4; ++j) \
            glds16(((j & 1) ? sb1 : sb0) + (size_t)(8 * j) * rstride + (size_t)(kt) * kstride, lds + (sbuf) * ASTG + (wid * 4 + j) * 1024); } while (0)
        const int dcut = (int)(160.f / slope2) + 1;
        int kt_lo = (qb * 128 - dcut) >> 6, kt_hi = (qb * 128 + 127 + dcut) >> 6; kt_lo = kt_lo < 0 ? 0 : kt_lo; kt_hi = kt_hi > S / 64 - 1 ? S / 64 - 1 : kt_hi;
        if (!(V & 8)) { DA_STAGE(kt_lo, kt_lo & 3); if (kt_lo + 1 <= kt_hi) DA_STAGE(kt_lo + 1, (kt_lo + 1) & 3); if (kt_lo + 2 <= kt_hi) DA_STAGE(kt_lo + 2, (kt_lo + 2) & 3); }
        const int q0w = qb * 128 + qs * 32;
        const float fq = (float)(qpos - 4 * hh);
        const float baseL = -slope2 * fq - m2, baseR = slope2 * fq - m2;
        for (int kt = kt_lo; kt <= kt_hi; ++kt) {
            if (kt + 2 <= kt_hi) WAITV(8); else if (kt + 1 <= kt_hi) WAITV(4); else WAITV(0);
            __builtin_amdgcn_s_barrier();
            if (!(V & 8) && kt + 3 <= kt_hi) { DA_STAGE(kt + 3, (kt + 3) & 3); }
            const LAS uchar* st = lds + (kt & 3) * ASTG;
            f32x16 sacc[2];
#pragma unroll
            for (int kb = 0; kb < 2; ++kb) {
                const int key0 = kt * 64 + 32 * kb;
                {
                    const float c = (key0 < q0w) ? slope2 : -slope2;
                    const float a = ((key0 < q0w) ? baseL : baseR) + c * (float)key0;
#pragma unroll
                    for (int i = 0; i < 16; ++i) sacc[kb][i] = a + c * (float)((i & 3) + 8 * (i >> 2));
                }
                if (__builtin_expect(key0 == q0w, 0)) {
                    const int kq = key0 + 4 * hh - qpos;
#pragma unroll
                    for (int i = 0; i < 16; ++i) sacc[kb][i] = -slope2 * fabsf((float)(kq + (i & 3) + 8 * (i >> 2))) - m2;
                }
#pragma unroll
                for (int ks = 0; ks < 4; ++ks) {
                    if (V & 4) continue;
                    const bf16x8 kf = (V & 16) ? qf[(ks + 1) & 3] : *(const LAS bf16x8*)(st + mm * 8192 + kb * 4096 + (lanebase ^ (ks << 5)));
                    sacc[kb] = MFMA32(kf, qf[ks], sacc[kb]);
                }
            }
#pragma unroll
            for (int kb = 0; kb < 2; ++kb) {
                float ls = 0.f;
#pragma unroll
                for (int i = 0; i < 16; ++i) { const float pv = (V & 1) ? sacc[kb][i] : __builtin_amdgcn_exp2f(sacc[kb][i]); ls += pv; sacc[kb][i] = pv; }
                lsum += ls;
                bf16x8 pb[2];
#pragma unroll
                for (int s2 = 0; s2 < 2; ++s2) {
                    u32x4 w;
#pragma unroll
                    for (int i = 0; i < 4; ++i) w[i] = pk2(sacc[kb][8 * s2 + 2 * i], sacc[kb][8 * s2 + 2 * i + 1]);
                    pb[s2] = __builtin_bit_cast(bf16x8, w);
                }
#pragma unroll
                for (int db = 0; db < 4; ++db)
#pragma unroll
                    for (int s2 = 0; s2 < 2; ++s2) {
                        if (V & 2) { if (db == 0) O[0][s2] += __builtin_bit_cast(float, (__builtin_bit_cast(u32x4, pb[s2]))[0]); continue; }
                        const bf16x8 vf = (V & 16) ? qf[(db + s2) & 3] : *(const LAS bf16x8*)(st + 16384 + db * 4096 + (lanebase ^ ((2 * kb + s2) << 5)));
                        O[db] = MFMA32(vf, pb[s2], O[db]);
                    }
            }
        }
#undef DA_STAGE
        const float lt = lsum + __shfl_xor(lsum, 32);
        const float sc = (mm == 0) ? (1.f / lt) : (lam / lt);
        __syncthreads();
        LAS float* xch = (LAS float*)lds + qs * 4096;
        if (mm == 1) {
#pragma unroll
            for (int db = 0; db < 4; ++db)
#pragma unroll
                for (int i = 0; i < 16; ++i) xch[(db * 16 + i) * 64 + lane] = O[db][i] * sc;
        }
        __syncthreads();
        if (mm == 0) {
            float ss = 0.f;
#pragma unroll
            for (int db = 0; db < 4; ++db)
#pragma unroll
                for (int i = 0; i < 16; ++i) { const float o = O[db][i] * sc - xch[(db * 16 + i) * 64 + lane]; O[db][i] = o; ss += o * o; }
            ss += __shfl_xor(ss, 32);
            const float rn = __builtin_amdgcn_rsqf(ss * (1.f / 128.f) + EPS) * oml;
            bf16_t* dst = mix + (size_t)(b * S + qpos) * DM + h * 128;
#pragma unroll
            for (int db = 0; db < 4; ++db)
#pragma unroll
                for (int q4 = 0; q4 < 4; ++q4) {
                    const int d = 32 * db + 8 * q4 + 4 * hh;
                    const f32x4 g = *(const f32x4*)(gsub + d);
                    u32x2 w; w[0] = pk2(O[db][4 * q4] * rn * g[0], O[db][4 * q4 + 1] * rn * g[1]);
                    w[1] = pk2(O[db][4 * q4 + 2] * rn * g[2], O[db][4 * q4 + 3] * rn * g[3]);
                    *(u32x2*)(dst + d) = w;
                }
        }
    }
#endif
    __syncthreads();
}

__device__ __forceinline__ void mla_attn_unit(LAS uchar* lds, const Params& p, int l, int unit) {
    uchar* ws = p.ws;
    const int tid = tid_opaque(), lane = tid & 63, wid = __builtin_amdgcn_readfirstlane(tid >> 6);
    const int xg_ = unit & 7, v_ = unit >> 3, qb = v_ & 7, bh_ = (v_ >> 3) * 8 + xg_, h = bh_ & 3, b = bh_ >> 2;
    const float m2 = ((const float*)(ws + WS_SCAL))[16 * l + 3];
    const bf16_t* Q = (const bf16_t*)(ws + WS_QM) + (((size_t)b * 4 + h) * S) * 96;
    const bf16_t* Kp = (const bf16_t*)(ws + WS_KM) + (((size_t)b * 4 + h) * S) * 96;
    const bf16_t* VT = (const bf16_t*)(ws + WS_VMT) + (((size_t)b * 4 + h) * 64) * S;
    bf16_t* mix = (bf16_t*)(ws + WS_MIX);
#if NAIVE_ATTN
    {
        const int q = qb * 256 + (tid >> 1), hf = tid & 1;
        float qv[96];
#pragma unroll
        for (int c8 = 0; c8 < 12; ++c8) { float f[8]; unpack8(*(const u32x4*)(Q + (size_t)q * 96 + c8 * 8), f);
#pragma unroll
            for (int i = 0; i < 8; ++i) qv[c8 * 8 + i] = f[i]; }
        float o[32]; float lsum = 0.f;
#pragma unroll
        for (int d = 0; d < 32; ++d) o[d] = 0.f;
        for (int key = 0; key < S; ++key) {
            float sc = 0.f;
#pragma unroll
            for (int c8 = 0; c8 < 12; ++c8) { float f[8]; unpack8(*(const u32x4*)(Kp + (size_t)key * 96 + c8 * 8), f);
#pragma unroll
                for (int i = 0; i < 8; ++i) sc += qv[c8 * 8 + i] * f[i]; }
            const float pv = __builtin_amdgcn_exp2f(sc - m2);
            lsum += pv;
            const int kp = sigma16(key);
#pragma unroll
            for (int d = 0; d < 32; ++d) o[d] += pv * bf2f(VT[(size_t)(hf * 32 + d) * S + kp]);
        }
        const float inv = 1.f / lsum;
        bf16_t* dst = mix + (size_t)(b * S + q) * DM + 512 + h * 64 + hf * 32;
#pragma unroll
        for (int d = 0; d < 32; d += 2) *(unsigned*)(dst + d) = pk2(o[d] * inv, o[d + 1] * inv);
    }
#else
    {
        const int r = lane & 31, hh = lane >> 5, qpos = qb * 256 + wid * 32 + r;
        bf16x8 qf[6];
#pragma unroll
        for (int ks = 0; ks < 6; ++ks) qf[ks] = *(const bf16x8*)(Q + (size_t)qpos * 96 + ks * 16 + hh * 8);
        f32x16 O[2]; float lsum = 0.f;
#pragma unroll
        for (int db = 0; db < 2; ++db)
#pragma unroll
            for (int i = 0; i < 16; ++i) O[db][i] = 0.f;
        const int lanebase = r * 128 + ((hh ^ ((r >> 1) & 7)) << 4), lanebase64 = r * 64 + ((hh ^ ((r >> 2) & 3)) << 4);
        const bool lo4 = wid < 4;
        const bf16_t* s0p; const bf16_t* s1p; const bf16_t* s2p;
        {
            const int srow = lane >> 3;
            { const int row = 8 * wid + srow; const int c = (lane & 7) ^ ((row >> 1) & 7); s0p = Kp + (size_t)row * 96 + c * 8; }
            if (lo4) { const int row = 16 * wid + (lane >> 2); const int c = (lane & 3) ^ ((row >> 2) & 3); s1p = Kp + (size_t)row * 96 + 64 + c * 8; }
            else { const int row = 8 * (wid - 4) + srow; const int c = (lane & 7) ^ ((row >> 1) & 7); s1p = VT + (size_t)row * S + c * 8; }
            { const int row = 8 * ((wid & 3) + 4) + srow; const int c = (lane & 7) ^ ((row >> 1) & 7); s2p = VT + (size_t)row * S + c * 8; }
        }
        const int k1stride = lo4 ? 64 * 96 : 64;
#define MA_STAGE(kt, sbuf) do { \
            glds16(s0p + (size_t)(kt) * (64 * 96), lds + (sbuf) * MSTG + wid * 1024); \
            glds16(s1p + (size_t)(kt) * k1stride, lds + (sbuf) * MSTG + (wid + 8) * 1024); \
            if (lo4) glds16(s2p + (size_t)(kt) * 64, lds + (sbuf) * MSTG + (wid + 16) * 1024); } while (0)
        MA_STAGE(0, 0); MA_STAGE(1, 1); MA_STAGE(2, 2);
        for (int kt = 0; kt < S / 64; ++kt) {
            if (kt + 2 < S / 64) { if (lo4) WAITV(6); else WAITV(4); } else if (kt + 1 < S / 64) { if (lo4) WAITV(3); else WAITV(2); } else WAITV(0);
            __builtin_amdgcn_s_barrier();
            if (kt + 3 < S / 64) { MA_STAGE(kt + 3, (kt + 3) & 3); }
            const LAS uchar* st = lds + (kt & 3) * MSTG;
#pragma unroll
            for (int kb = 0; kb < 2; ++kb) {
                f32x16 sacc;
#pragma unroll
                for (int i = 0; i < 16; ++i) sacc[i] = -m2;
#pragma unroll
                for (int ks = 0; ks < 4; ++ks) {
                    const bf16x8 kf = *(const LAS bf16x8*)(st + kb * 4096 + (lanebase ^ (ks << 5)));
                    sacc = MFMA32(kf, qf[ks], sacc);
                }
#pragma unroll
                for (int ks = 0; ks < 2; ++ks) {
                    const bf16x8 kf = *(const LAS bf16x8*)(st + 8192 + kb * 2048 + (lanebase64 ^ (ks << 5)));
                    sacc = MFMA32(kf, qf[4 + ks], sacc);
                }
                float ls = 0.f;
#pragma unroll
                for (int i = 0; i < 16; ++i) { const float pv = __builtin_amdgcn_exp2f(sacc[i]); ls += pv; sacc[i] = pv; }
                lsum += ls;
                bf16x8 pb[2];
#pragma unroll
                for (int s2 = 0; s2 < 2; ++s2) {
                    u32x4 w;
#pragma unroll
                    for (int i = 0; i < 4; ++i) w[i] = pk2(sacc[8 * s2 + 2 * i], sacc[8 * s2 + 2 * i + 1]);
                    pb[s2] = __builtin_bit_cast(bf16x8, w);
                }
#pragma unroll
                for (int db = 0; db < 2; ++db)
#pragma unroll
                    for (int s2 = 0; s2 < 2; ++s2) {
                        const bf16x8 vf = *(const LAS bf16x8*)(st + 12288 + db * 4096 + (lanebase ^ ((2 * kb + s2) << 5)));
                        O[db] = MFMA32(vf, pb[s2], O[db]);
                    }
            }
        }
#undef MA_STAGE
        const float lt = lsum + __shfl_xor(lsum, 32); const float inv = 1.f / lt;
        bf16_t* dst = mix + (size_t)(b * S + qpos) * DM + 512 + h * 64;
#pragma unroll
        for (int db = 0; db < 2; ++db)
#pragma unroll
            for (int q4 = 0; q4 < 4; ++q4) {
                const int d = 32 * db + 8 * q4 + 4 * hh;
                u32x2 w; w[0] = pk2(O[db][4 * q4] * inv, O[db][4 * q4 + 1] * inv); w[1] = pk2(O[db][4 * q4 + 2] * inv, O[db][4 * q4 + 3] * inv);
                *(u32x2*)(dst + d) = w;
            }
    }
#endif
    __syncthreads();
}

__device__ __forceinline__ int xp_rowmap(int mode, int n) {
    return mode == 0 ? n : mode == 1 ? (n / 96) * 128 + (n % 96) : mode == 2 ? ((n >> 6) * 128 + (n & 63)) : ((n >> 6) * 128 + 64 + (n & 63));
}
__device__ __forceinline__ void xpose_tile(LAS uchar* lds, const float* src, int K, int N, bf16_t* dst, int ldd, int mode, const float* gain, int kt, int ntile, int lds_src = 0) {
    LAS float* sh = (LAS float*)lds; const int tid = tid_opaque();
    (void)K; const int ldn = lds_src ? lds_src : N;
    {
        const int n4 = tid & 63, n = ntile * 256 + n4 * 4;
        if (n < N) {
#pragma unroll
            for (int i = 0; i < 8; ++i) {
                const int kl = (tid >> 6) + 8 * i, k = kt * 64 + kl;
                f32x4 v = *(const f32x4*)(src + (size_t)k * ldn + n);
                if (gain) { const float gk = gain[k]; v[0] *= gk; v[1] *= gk; v[2] *= gk; v[3] *= gk; }
                LAS float* d = sh + kl * 257 + n4 * 4; d[0] = v[0]; d[1] = v[1]; d[2] = v[2]; d[3] = v[3];
            }
        }
    }
    __syncthreads();
    {
        const int nl = tid >> 1, kh = tid & 1, n = ntile * 256 + nl;
        if (n < N) {
            bf16_t* d = dst + (size_t)xp_rowmap(mode, n) * ldd + kt * 64 + kh * 32;
#pragma unroll
            for (int c8 = 0; c8 < 4; ++c8) { u32x4 o;
#pragma unroll
                for (int i = 0; i < 4; ++i) o[i] = pk2(sh[(kh * 32 + c8 * 8 + 2 * i) * 257 + nl], sh[(kh * 32 + c8 * 8 + 2 * i + 1) * 257 + nl]);
                *(u32x4*)(d + c8 * 8) = o; }
        }
    }
    __syncthreads();
}
__device__ __forceinline__ void xpose_job(LAS uchar* lds, const float* src, int K, int N, bf16_t* dst, int ldd, int mode, const float* gain, int lds_src = 0) {
    const int nkt = K >> 6, nnt = (N + 255) >> 8, tot = nkt * nnt;
    for (int u = blockIdx.x; u < tot; u += gridDim.x) xpose_tile(lds, src, K, N, dst, ldd, mode, gain, u % nkt, u / nkt, lds_src);
}
__device__ __forceinline__ void expert_weights(LAS uchar* lds, const Params& p, int l) {
    bf16_t* wgu = (bf16_t*)(p.ws + WS_WGU); bf16_t* wd = (bf16_t*)(p.ws + WS_WD);
    const float* g2 = p.in[18] + l * DM;
    const int nb = (int)gridDim.x > 64 ? (int)gridDim.x - 64 : (int)gridDim.x, b0 = (int)gridDim.x > 64 ? (int)blockIdx.x - 64 : (int)blockIdx.x;
    if (b0 < 0) return;
    for (int u = b0; u < 32 * 48; u += nb) {
        const int e = u / 48, w = u % 48, job = w >> 4, tl = w & 15;
        if (job == 0) xpose_tile(lds, p.in[23] + ((size_t)l * 32 + e) * DM * 256, DM, 256, wgu + (size_t)e * 512 * DM, DM, 2, g2, tl, 0);
        else if (job == 1) xpose_tile(lds, p.in[24] + ((size_t)l * 32 + e) * DM * 256, DM, 256, wgu + (size_t)e * 512 * DM, DM, 3, g2, tl, 0);
        else xpose_tile(lds, p.in[25] + ((size_t)l * 32 + e) * 256 * DM, 256, DM, wd + (size_t)e * DM * 256, 256, 0, nullptr, tl & 3, tl >> 2);
    }
}
__device__ __forceinline__ void row_prep(const float* xrow, bf16_t* xb, float* rstd, int lane) {
    float ss = 0.f; f32x4 v[4];
#pragma unroll
    for (int i = 0; i < 4; ++i) { v[i] = *(const f32x4*)(xrow + i * 256 + lane * 4); ss += v[i][0] * v[i][0] + v[i][1] * v[i][1] + v[i][2] * v[i][2] + v[i][3] * v[i][3]; }
    ss = wave_sum(ss);
#pragma unroll
    for (int i = 0; i < 4; ++i) { u32x2 o; o[0] = pk2(v[i][0], v[i][1]); o[1] = pk2(v[i][2], v[i][3]); *(u32x2*)(xb + i * 256 + lane * 4) = o; }
    if (lane == 0) *rstd = __builtin_amdgcn_rsqf(ss * (1.f / 1024.f) + EPS);
}

__device__ __forceinline__ void phase0(LAS uchar* lds, const Params& p) {
    uchar* ws = p.ws; const int tid = tid_opaque(), gtid = blockIdx.x * NT + tid, gsz = gridDim.x * NT;
    for (int idx = blockIdx.x; idx < NL * 202; idx += gridDim.x) {
        const int l = idx / 202, j = idx % 202;
        if (j < 128) xpose_tile(lds, p.in[2] + (size_t)l * DM * NIN, DM, 1888, (bf16_t*)(ws + WS_WIN) + (size_t)l * NINP * DM, DM, 0, p.in[1] + l * DM, j & 15, j >> 4, NIN);
        else if (j < 192) xpose_tile(lds, p.in[17] + (size_t)l * DM * DM, DM, DM, (bf16_t*)(ws + WS_WOUT) + (size_t)l * DM * DM, DM, 0, nullptr, (j - 128) & 15, (j - 128) >> 4);
        else if (j < 198) xpose_tile(lds, p.in[9] + (size_t)l * 192 * 384, 192, 384, (bf16_t*)(ws + WS_WUQ) + (size_t)l * 512 * 192, 192, 1, p.in[7] + l * 192, (j - 192) % 3, (j - 192) / 3);
        else xpose_tile(lds, p.in[10] + (size_t)l * 128 * 512, 128, 512, (bf16_t*)(ws + WS_WUKV) + (size_t)l * 512 * 128, 128, 0, p.in[8] + l * 128, (j - 198) & 1, (j - 198) >> 1);
    }
    for (int l = 0; l < NL; ++l) {
        for (int i = gtid; i < 256 * DM; i += gsz) {
            const int k = i & 1023, n = i >> 10, g = n >> 6, d = n & 63;
            const float* wi = p.in[2] + ((size_t)l * DM + k) * NIN + 1888 + g * 64; const float* pw = p.in[15] + ((size_t)l * 4 + g) * 64 * 64 + d;
            float acc = 0.f;
            for (int c = 0; c < 64; ++c) acc += wi[c] * pw[c * 64];
            ((bf16_t*)(ws + WS_WIN))[((size_t)l * NINP + 1888 + n) * DM + k] = f2bf(acc * p.in[1][l * DM + k] * p.in[16][l * 256 + n]);
        }
        { bf16_t* w = (bf16_t*)(ws + WS_WIN) + ((size_t)l * NINP + NIN) * DM; for (int i = gtid; i < 32 * DM; i += gsz) w[i] = 0; }
        { bf16_t* w = (bf16_t*)(ws + WS_WUQ) + (size_t)l * 512 * 192; for (int i = gtid; i < 4 * 32 * 192; i += gsz) { const int hd = i / (32 * 192), rem = i % (32 * 192); w[(size_t)(hd * 128 + 96) * 192 + rem] = 0; } }
    }
    for (int i = gtid; i < NL * 128 * 1024; i += gsz) {
        const int k = i & 1023, n = (i >> 10) & 127, l = i >> 17;
        float v = 0.f;
        if (n < 4) v = p.in[19][((size_t)l * DM + k) * 4 + n]; else if (n < 36) v = p.in[21][((size_t)l * DM + k) * 32 + (n - 4)];
        v *= p.in[18][l * DM + k];
        const bf16_t hi = f2bf(v), lo = f2bf(v - bf2f(hi));
        bf16_t* w = (bf16_t*)(ws + WS_WR) + ((size_t)l * 128 + n) * 3072 + k;
        w[0] = hi; w[1024] = hi; w[2048] = lo;
    }
    for (int i = gtid; i < S * 16; i += gsz) {
        const int pos = i >> 4, f = i & 15;
        double inv = 1.0; for (int k = 0; k < f; ++k) inv *= 0.5623413251903491;
        const double rev = (double)pos * inv * 0.15915494309189535;
        const float fr = (float)(rev - __builtin_rint(rev));
        ((float*)(ws + WS_ROPE))[i] = __builtin_amdgcn_cosf(fr);
        ((float*)(ws + WS_ROPE))[S * 16 + i] = __builtin_amdgcn_sinf(fr);
    }
    if (blockIdx.x == 0 && (tid >> 6) < NL) {
        const int l = tid >> 6, lane = tid & 63; float* sc = (float*)(ws + WS_SCAL) + 16 * l;
        const float* lv = p.in[5] + l * 256;
        const float d1 = wave_sum(lv[lane] * lv[64 + lane]), d2 = wave_sum(lv[128 + lane] * lv[192 + lane]);
        float gq = fabsf(p.in[3][l * 64 + lane]), gk = fabsf(p.in[4][l * 64 + lane]);
        float a = fabsf(p.in[11][l * 64 + lane]), c = fabsf(p.in[13][l * 64 + lane]);
        float bq = fabsf(p.in[12][l * 32 + (lane & 31)]), dk = fabsf(p.in[14][l * 32 + (lane & 31)]);
#pragma unroll
        for (int o = 32; o >= 1; o >>= 1) { gq = fmaxf(gq, __shfl_xor(gq, o)); gk = fmaxf(gk, __shfl_xor(gk, o)); a = fmaxf(a, __shfl_xor(a, o)); c = fmaxf(c, __shfl_xor(c, o));
            bq = fmaxf(bq, __shfl_xor(bq, o)); dk = fmaxf(dk, __shfl_xor(dk, o)); }
        if (lane == 0) {
            const float lam_init = 0.8f - 0.6f * expf(-0.3f * (float)l);
            sc[0] = expf(d1) - expf(d2) + lam_init; sc[1] = 1.f - lam_init;
            sc[2] = gq * gk * 8.f * LOG2E * 1.02f;
            sc[3] = sqrtf(64.f * a * a + 32.f * bq * bq) * sqrtf(64.f * c * c + 32.f * dk * dk) * QSCALE_M * 1.02f;
        }
    }
    {
        const int lane = tid & 63, gw = gtid >> 6, nw = gsz >> 6;
        for (int t = gw; t < T; t += nw) row_prep(p.in[0] + (size_t)t * DM, (bf16_t*)(ws + WS_XB) + (size_t)t * DM, (float*)(ws + WS_RSTD1) + t, lane);
    }
}

struct MkProj { int mt, pn, l; const Params* p; __device__ __forceinline__ EpiProj operator()(int half) const { return EpiProj{mt, 2 * pn + half, l, p}; } };
__device__ __forceinline__ void ph_gemm1(LAS uchar* lds, const Params& p, int l) {
    const bf16_t* xb = (const bf16_t*)(p.ws + WS_XB); const bf16_t* win = (const bf16_t*)(p.ws + WS_WIN) + (size_t)l * NINP * DM;
    if (SHADOW_G >= 0) for (int u0 = blockIdx.x; u0 < 512; u0 += gridDim.x) {
        const int xg = u0 & 7, v = u0 >> 3, mt = (v >> 3) * 8 + xg, pn = v & 7;
        MkProj mk{mt, pn, l, &p};
        { const int tp = tid_opaque(); if (tp < 256) ((LAS float*)(lds + LDS_ROW))[tp] = ((const float*)(p.ws + WS_RSTD1))[mt * 256 + tp]; }
        gemm_big<(SHADOW_G >= 0 ? SHADOW_G : 0)>(lds, ARowLinear{xb + (size_t)mt * 256 * DM, (size_t)DM}, win + (size_t)pn * 256 * DM, (size_t)DM, DM, mk);
    }
    for (int u0 = blockIdx.x; u0 < 64 * 8; u0 += gridDim.x) {
        const int xg = u0 & 7, v = u0 >> 3, mt = (v >> 3) * 8 + xg, pn = ((v & 7) + 4 * ((v >> 5) & 1)) & 7;
        MkProj mk{mt, pn, l, &p};
        { const int tp = tid_opaque(); if (tp < 256) ((LAS float*)(lds + LDS_ROW))[tp] = ((const float*)(p.ws + WS_RSTD1))[mt * 256 + tp]; }
        gemm_big8(lds, xb + (size_t)mt * 256 * DM, win + (size_t)pn * 256 * DM, DM, mk);
    }
}
__device__ __forceinline__ void gemm1_tail_unit(LAS uchar* lds, const Params& p, int l, int mt) {
    const bf16_t* xb = (const bf16_t*)(p.ws + WS_XB); const bf16_t* win = (const bf16_t*)(p.ws + WS_WIN) + (size_t)l * NINP * DM;
    ARowLinear ar{xb + (size_t)mt * 256 * DM, (size_t)DM};
    EpiProj ep{mt, 16, l, &p};
    { const int tp = tid_opaque(); if (tp < 256) ((LAS float*)(lds + LDS_ROW))[tp] = ((const float*)(p.ws + WS_RSTD1))[mt * 256 + tp]; }
    gemm_tile(lds, ar, win + (size_t)16 * 128 * DM, (size_t)DM, DM, ep);
}
template <int HALF>
__device__ __forceinline__ void pool_rows(const float (&v)[48], int sfirst, bf16_t* dst) {
    float run = 0.f;
#pragma unroll
    for (int i = 8 - HALF; i < 8 + HALF; ++i) run += v[i];
#pragma unroll
    for (int r = 0; r < 32; ++r) {
        const int s = sfirst + r; int lo = s - HALF, hi = s + HALF - 1; lo = lo < 0 ? 0 : lo; hi = hi > S - 1 ? S - 1 : hi;
        const float o = run * __builtin_amdgcn_rcpf((float)(hi - lo + 1)) - v[r + 8];
        dst[(size_t)r * DM] = f2bf(o);
        if (r < 31) run += v[r + 8 + HALF] - v[r + 8 - HALF];
    }
}
__device__ __forceinline__ void pooled_unit(LAS uchar* lds, const Params& p, int ut) {
    const int tid = tid_opaque();
    const int t0 = ut * 64, b = t0 >> 11, s0 = t0 & 2047;
    const bf16_t* lat = (const bf16_t*)(p.ws + WS_LAT) + (size_t)b * S * 640 + 352;
    for (int it = 0; it < 5; ++it) {
        const int item = it * NT + tid, c8 = item & 31, rl = item >> 5, sr = s0 - 8 + rl;
        u32x4 v = {0u, 0u, 0u, 0u};
        if (sr >= 0 && sr < S) v = *(const u32x4*)(lat + (size_t)sr * 640 + c8 * 8);
        *(LAS u32x4*)(lds + rl * 512 + c8 * 16) = v;
    }
    __syncthreads();
    {
        const int c = tid & 255, rh = tid >> 8, g = __builtin_amdgcn_readfirstlane(c >> 6);
        bf16_t* dst = (bf16_t*)(p.ws + WS_MIX) + (size_t)(t0 + rh * 32) * DM + 768 + c;
        const LAS bf16_t* col = (const LAS bf16_t*)lds + (rh * 32) * 256 + c;
        float v[48];
#pragma unroll
        for (int i = 0; i < 48; ++i) v[i] = bf2f(col[i * 256]);
        const int sfirst = s0 + rh * 32;
        if (g == 0) pool_rows<1>(v, sfirst, dst); else if (g == 1) pool_rows<2>(v, sfirst, dst); else if (g == 2) pool_rows<4>(v, sfirst, dst); else pool_rows<8>(v, sfirst, dst);
    }
    __syncthreads();
}
__device__ __forceinline__ void mla_up_unit(LAS uchar* lds, const Params& p, int l, int v) {
    const bf16_t* lat = (const bf16_t*)(p.ws + WS_LAT);
    const int mt = v >> 3, w = v & 7, h = w & 3;
    { const int tp = tid_opaque(); if (tp < 256) { const float* hs = (const float*)(p.ws + WS_HSS) + (size_t)(mt * 256 + tp) * 8;
        const f32x4 h0 = *(const f32x4*)hs; const float h4 = hs[4];
        ((LAS float*)(lds + LDS_ROW))[tp] = (w < 4) ? __builtin_amdgcn_rsqf((h0[0] + h0[1] + h0[2]) * (1.f / 192.f) + EPS) : __builtin_amdgcn_rsqf((h0[3] + h4) * (1.f / 128.f) + EPS); } }
    if (w < 4) { ARowLinear ar{lat + (size_t)mt * 256 * 640, (size_t)640}; EpiMlaQ ep{mt, h, l, &p};
        gemm_tile(lds, ar, (const bf16_t*)(p.ws + WS_WUQ) + ((size_t)l * 512 + h * 128) * 192, (size_t)192, 192, ep); }
    else { ARowLinear ar{lat + (size_t)mt * 256 * 640 + 192, (size_t)640}; EpiMlaKV ep{mt, h, l, &p};
        gemm_tile(lds, ar, (const bf16_t*)(p.ws + WS_WUKV) + ((size_t)l * 512 + h * 128) * 128, (size_t)128, 128, ep); }
}
__device__ __forceinline__ void ph_mix_a(LAS uchar* lds, const Params& p, int l) {
    const int G = (int)gridDim.x;
    if (G == 256) {
        const int xg = blockIdx.x & 7, j = blockIdx.x >> 3;
        if (SHADOW_V >= 0) { diff_attn_unit<(SHADOW_V >= 0 ? SHADOW_V : 0)>(lds, p, l, xg, 2 + (j >> 4), j & 15); }
        diff_attn_unit<0>(lds, p, l, xg, 2 + (j >> 4), j & 15);
        if (j < 16) diff_attn_unit<0>(lds, p, l, xg, 1, j);
        else {
            diff_attn_unit<0>(lds, p, l, xg, 0, j - 16);
            if (j < 24) gemm1_tail_unit(lds, p, l, xg + 8 * (j - 16));
            const int n0 = j < 24 ? (j - 16) * 2 : 16 + (j - 24) * 6, n1 = j < 24 ? n0 + 2 : n0 + 6;
            for (int n = n0; n < n1; ++n) mla_up_unit(lds, p, l, (xg + 8 * (n >> 3)) * 8 + (n & 7));
        }
    } else {
        for (int u = blockIdx.x; u < 512 + 512 + 64; u += G) {
            if (u < 512) diff_attn_unit<0>(lds, p, l, u >> 6, (u >> 4) & 3, u & 15);
            else if (u < 1024) mla_up_unit(lds, p, l, u - 512);
            else gemm1_tail_unit(lds, p, l, u - 1024);
        }
    }
}
__device__ __forceinline__ void ph_mix_b(LAS uchar* lds, const Params& p, int l) {
    (void)l;
    for (int u = blockIdx.x; u < 256 + 256; u += gridDim.x) {
        if (u < 256) mla_attn_unit(lds, p, l, u);
        else pooled_unit(lds, p, u - 256);
    }
}
struct MkWout { int mt, pn; const float* xres; const Params* p; __device__ __forceinline__ EpiWout operator()(int half) const { return EpiWout{mt, 2 * pn + half, xres, p}; } };
__device__ __forceinline__ void ph_wout(LAS uchar* lds, const Params& p, int l) {
    const bf16_t* mix = (const bf16_t*)(p.ws + WS_MIX); const bf16_t* wo = (const bf16_t*)(p.ws + WS_WOUT) + (size_t)l * DM * DM;
    const float* xres = (l == 0) ? p.in[0] : p.out;
    for (int u0 = blockIdx.x; u0 < 64 * 4; u0 += gridDim.x) {
        const int xg = u0 & 7, v = u0 >> 3, mt = (v >> 2) * 8 + xg, pn = v & 3;
        MkWout mk{mt, pn, xres, &p};
        gemm_big8(lds, mix + (size_t)mt * 256 * DM, wo + (size_t)pn * 256 * DM, DM, mk);
    }
}
constexpr int LDS_RT = 135168;
struct EpiRouter {
    int mt, l; bool dry; const Params* p;
    __device__ __forceinline__ void operator()(const LAS uchar* ct) const {
        uchar* ws = p->ws; const int tid = tid_opaque();
        const LAS float* ctf = (const LAS float*)ct;
        LAS unsigned* shcnt = (LAS unsigned*)(ct + LDS_RT); LAS unsigned* shbase = shcnt + 32; LAS unsigned* pend = shcnt + 64;
        unsigned* cnt = (unsigned*)(ws + WS_CTL) + CW_CNT + 1024 * l + (dry ? 2048 : 0);
        unsigned* list = (unsigned*)(ws + (dry ? WS_POOLED : WS_LIST)); float* gwt = (float*)(ws + (dry ? WS_POOLED + 4 * MiB : WS_GW)); float* rstd2 = (float*)(ws + (dry ? WS_POOLED + 5 * MiB : WS_RSTD2));
        const float* bg = p->in[20] + l * 4; const float* be = p->in[22] + l * 32;
        if (tid < 32) shcnt[tid] = 0u;
        __syncthreads();
        if (tid < 256) {
            const int t = mt * 256 + tid;
            const float* ps = (const float*)(ws + WS_PSS) + (size_t)t * 8;
            const f32x4 p0 = *(const f32x4*)ps, p1 = *(const f32x4*)(ps + 4);
            const float ss = ((p0[0] + p0[1]) + (p0[2] + p0[3])) + ((p1[0] + p1[1]) + (p1[2] + p1[3]));
            const float rs = __builtin_amdgcn_rsqf(ss * (1.f / 1024.f) + EPS);
            const LAS float* row = ctf + tid * CTF_PITCH;
            float gl[4];
#pragma unroll
            for (int n = 0; n < 4; ++n) gl[n] = row[n] * rs + bg[n];
            int gi = 0; float gm = gl[0];
#pragma unroll
            for (int n = 1; n < 4; ++n) if (gl[n] > gm) { gm = gl[n]; gi = n; }
            float gs = 0.f;
#pragma unroll
            for (int n = 0; n < 4; ++n) gs += __expf(gl[n] - gm);
            const float gtop = 1.f / gs;
            float el[8];
#pragma unroll
            for (int n = 0; n < 8; ++n) el[n] = row[4 + gi * 8 + n] * rs + be[gi * 8 + n];
            int i1 = 0; float m1 = el[0];
#pragma unroll
            for (int n = 1; n < 8; ++n) if (el[n] > m1) { m1 = el[n]; i1 = n; }
            int i2 = -1; float m2v = -3.0e38f;
#pragma unroll
            for (int n = 0; n < 8; ++n) if (n != i1 && el[n] > m2v) { m2v = el[n]; i2 = n; }
            const float e2 = __expf(m2v - m1); const float w1 = gtop / (1.f + e2), w2 = gtop * e2 / (1.f + e2);
            const int ea = gi * 8 + i1, eb = gi * 8 + i2;
            const unsigned pa = __hip_atomic_fetch_add(&shcnt[ea], 1u, __ATOMIC_RELAXED, __HIP_MEMORY_SCOPE_WORKGROUP);
            const unsigned pbk = __hip_atomic_fetch_add(&shcnt[eb], 1u, __ATOMIC_RELAXED, __HIP_MEMORY_SCOPE_WORKGROUP);
            pend[tid * 2] = ((unsigned)ea << 16) | pa; pend[tid * 2 + 1] = ((unsigned)eb << 16) | pbk;
            gwt[t * 2] = w1; gwt[t * 2 + 1] = w2; rstd2[t] = rs;
        }
        __syncthreads();
        if (tid < 32) { const unsigned c = shcnt[tid]; shbase[tid] = c ? atomicAdd(&cnt[tid * 32], c) : 0u; }
        __syncthreads();
        { const unsigned pe = pend[tid], e = pe >> 16, lp = pe & 0xffffu; list[(size_t)e * T + shbase[e] + lp] = (unsigned)((mt * 256 + (tid >> 1)) * 2 + (tid & 1)); }
    }
};
__device__ __forceinline__ void ph_router(LAS uchar* lds, const Params& p, int l, bool dry = false) {
    const bf16_t* xb = (const bf16_t*)(p.ws + WS_XB); const bf16_t* wr = (const bf16_t*)(p.ws + WS_WR) + (size_t)l * 128 * 3072;
    for (int u = blockIdx.x; u < 64; u += gridDim.x) {
        ARowLinear ar{xb + (size_t)u * 256 * DM, (size_t)DM}; EpiRouter ep{u, l, dry, &p};
        AOffRouter ao{(int)((WS_XL - WS_XB) / 2)};
        gemm_tile<true>(lds, ar, wr, (size_t)3072, 3072, ep, ao);
    }
    if (!dry) expert_weights(lds, p, l);
}
struct MoeMap {
    LAS int* m;
    __device__ __forceinline__ void init(LAS uchar* lds, const unsigned* cnt) {
        m = (LAS int*)(lds + LDS_MOE);
        const int tid = tid_opaque();
        if (tid < 64) {
            const int lane = tid, c = lane < 32 ? (int)cnt[lane * 32] : 0, f = c >> 8, pr = (c & 255) ? 1 : 0;
            int sb = f + pr;
#pragma unroll
            for (int o = 1; o < 32; o <<= 1) { const int tb = __shfl_up(sb, o); if (lane >= o) sb += tb; }
            if (lane < 32) { m[lane] = f; m[32 + lane] = pr; m[64 + lane] = sb - (f + pr); m[96 + lane] = c; }
        }
        __syncthreads();
    }
    __device__ __forceinline__ int group_total(int g, int NB, int NS) const {
        int t = 0;
#pragma unroll
        for (int i = 0; i < 4; ++i) t += m[g + 8 * i] * NB + m[32 + g + 8 * i] * NS;
        return __builtin_amdgcn_readfirstlane(t);
    }
    __device__ __forceinline__ void group_find(int g, int v, int NB, int NS, bool& big, int& col, int& e, int& rb, int& rbg, int& nvalid) const {
        big = false; col = 0; e = g; rb = 0; rbg = 0; nvalid = 256; bool found = false;
#pragma unroll
        for (int i = 0; i < 4; ++i) { const int ee = g + 8 * i, fe = __builtin_amdgcn_readfirstlane(m[ee]), n = fe * NB;
            if (!found) { if (v < n) { found = true; big = true; e = ee; rb = v / NB; col = v % NB; rbg = __builtin_amdgcn_readfirstlane(m[64 + ee]) + rb; nvalid = 256; } else v -= n; } }
#pragma unroll
        for (int i = 0; i < 4; ++i) { const int ee = g + 8 * i, pe = __builtin_amdgcn_readfirstlane(m[32 + ee]), n = pe * NS;
            if (!found) { if (v < n) { found = true; big = false; e = ee; rb = __builtin_amdgcn_readfirstlane(m[ee]); col = v; rbg = __builtin_amdgcn_readfirstlane(m[64 + ee]) + rb; nvalid = __builtin_amdgcn_readfirstlane(m[96 + ee]) & 255; } else v -= n; } }
    }
};
struct MkGU { int pn; size_t slot0; const Params* p; __device__ __forceinline__ EpiGU operator()(int half) const { return EpiGU{2 * pn + half, slot0, p}; } };
__device__ __forceinline__ void ph_gateup(LAS uchar* lds, const Params& p, int l) {
    uchar* ws = p.ws; const unsigned* cnt = (const unsigned*)(ws + WS_CTL) + CW_CNT + 1024 * l;
    MoeMap mm; mm.init(lds, cnt);
    const int grp = blockIdx.x & 7, rank = blockIdx.x >> 3, nrank = ((int)gridDim.x + 7 - grp) >> 3, tot = mm.group_total(grp, 2, 4);
    for (int u = rank; u < tot; u += nrank) {
        bool big; int col, e, rb, rbg, nvalid; mm.group_find(grp, u, 2, 4, big, col, e, rb, rbg, nvalid);
        const unsigned* list = (const unsigned*)(ws + WS_LIST) + (size_t)e * T + rb * 256;
        ARowGather ar{(const bf16_t*)(ws + WS_XB), list, nvalid};
        { const int tp = tid_opaque(); if (tp < 256) { const int rr = tp < nvalid ? tp : nvalid - 1; ((LAS float*)(lds + LDS_ROW))[tp] = ((const float*)(ws + WS_RSTD2))[list[rr] >> 1]; } }
        if (big) { const int pn = col; MkGU mk{pn, (size_t)rbg * 256, &p};
            gemm_big8g(lds, ar, (const bf16_t*)(ws + WS_WGU) + ((size_t)e * 512 + pn * 256) * DM, DM, mk); }
        else { const int jt = col; EpiGU ep{jt, (size_t)rbg * 256, &p};
            gemm_tile(lds, ar, (const bf16_t*)(ws + WS_WGU) + ((size_t)e * 512 + jt * 128) * DM, (size_t)DM, DM, ep); }
    }
}
struct MkDown { int pn, nvalid; const Params* p; __device__ __forceinline__ EpiDown operator()(int half) const { return EpiDown{2 * pn + half, nvalid, p}; } };
__device__ __forceinline__ void ph_down(LAS uchar* lds, const Params& p, int l) {
    uchar* ws = p.ws; const unsigned* cnt = (const unsigned*)(ws + WS_CTL) + CW_CNT + 1024 * l;
    MoeMap mm; mm.init(lds, cnt);
    const int grp = blockIdx.x & 7, rank = blockIdx.x >> 3, nrank = ((int)gridDim.x + 7 - grp) >> 3, tot = mm.group_total(grp, 4, 8);
    for (int u = rank; u < tot; u += nrank) {
        bool big; int col, e, rb, rbg, nvalid; mm.group_find(grp, u, 4, 8, big, col, e, rb, rbg, nvalid);
        const unsigned* list = (const unsigned*)(ws + WS_LIST) + (size_t)e * T + rb * 256;
        ARowLinear ar{(const bf16_t*)(ws + WS_HMID) + (size_t)rbg * 256 * 256, (size_t)256};
        { const int tp = tid_opaque(); if (tp < 256) { const int rr = tp < nvalid ? tp : nvalid - 1; const unsigned ent = list[rr];
            ((LAS unsigned*)(lds + LDS_ROW + 1024))[tp] = ent; ((LAS float*)(lds + LDS_ROW))[tp] = ((const float*)(ws + WS_GW))[ent]; } }
        if (big) { const int pn = col; MkDown mk{pn, nvalid, &p};
            gemm_big(lds, ar, (const bf16_t*)(ws + WS_WD) + ((size_t)e * DM + pn * 256) * 256, (size_t)256, 256, mk); }
        else { const int nt = col; EpiDown ep{nt, nvalid, &p};
            gemm_tile(lds, ar, (const bf16_t*)(ws + WS_WD) + ((size_t)e * DM + nt * 128) * 256, (size_t)256, 256, ep); }
    }
}
__device__ __forceinline__ void ph_combine(LAS uchar* lds, const Params& p, int l, bool dry = false) {
    uchar* ws = p.ws; const int tid = tid_opaque(), lane = tid & 63;
    const int gw = blockIdx.x * 8 + (tid >> 6), nw = gridDim.x * 8;
    const bf16_t* ys = (const bf16_t*)(ws + WS_YS);
    for (int t = gw; t < T; t += nw) {
        const bf16_t* xh = (const bf16_t*)(ws + WS_XB) + (size_t)t * DM; const bf16_t* xl = (const bf16_t*)(ws + WS_XL) + (size_t)t * DM;
        const bf16_t* y0 = ys + (size_t)(2 * t) * DM; const bf16_t* y1 = y0 + DM;
        float* xw = dry ? (float*)(ws + WS_POOLED) + (size_t)(t & 511) * DM : p.out + (size_t)t * DM;
        bf16_t* xb = dry ? (bf16_t*)(ws + WS_POOLED + 4 * MiB) + (size_t)(t & 511) * DM : (bf16_t*)(ws + WS_XB) + (size_t)t * DM;
        float ss = 0.f;
#pragma unroll
        for (int i = 0; i < 4; ++i) {
            const int c = i * 256 + lane * 4;
            const u32x2 hv = *(const u32x2*)(xh + c), lv = *(const u32x2*)(xl + c);
            f32x4 v; v[0] = bflo(hv[0]) + bflo(lv[0]); v[1] = bfhi(hv[0]) + bfhi(lv[0]); v[2] = bflo(hv[1]) + bflo(lv[1]); v[3] = bfhi(hv[1]) + bfhi(lv[1]);
            const u32x2 a = *(const u32x2*)(y0 + c), bq = *(const u32x2*)(y1 + c);
            v[0] += bflo(a[0]) + bflo(bq[0]); v[1] += bfhi(a[0]) + bfhi(bq[0]); v[2] += bflo(a[1]) + bflo(bq[1]); v[3] += bfhi(a[1]) + bfhi(bq[1]);
            *(f32x4*)(xw + c) = v; ss += v[0] * v[0] + v[1] * v[1] + v[2] * v[2] + v[3] * v[3];
            u32x2 o; o[0] = pk2(v[0], v[1]); o[1] = pk2(v[2], v[3]); *(u32x2*)(xb + c) = o;
        }
        ss = wave_sum(ss);
        if (lane == 0) ((float*)(ws + (dry ? WS_POOLED + 6 * MiB : WS_RSTD1)))[t] = __builtin_amdgcn_rsqf(ss * (1.f / 1024.f) + EPS);
    }

}

__global__ void __launch_bounds__(NT, 2) mega(Params p) {
    extern __shared__ __attribute__((aligned(16))) unsigned char smem[];
    LAS uchar* lds = (LAS uchar*)smem;
    if (threadIdx.x == 0) { *(LAS u32x4*)(lds + LDS_XB) = (u32x4){0u, 0u, 0u, 0u}; }
    __syncthreads();
    XcdBarrier bar = xcd_barrier_post((unsigned*)(p.ws + WS_CTL), (volatile LAS unsigned*)(lds + LDS_XB));
#define IN(k) (p.ph_lo <= (k) && (k) < p.ph_hi)
#define SEAM(k) do { if (IN(k) && IN((k) + 1)) xcd_barrier(bar); } while (0)
    if (IN(0)) for (int rep = 0; rep < NREP(8); ++rep) phase0(lds, p);
    SEAM(0);
#define LAUNDER(v) asm volatile("" : "+s"(v))
#pragma unroll 1
    for (int l0 = 0; l0 < NL; ++l0) {
        const int pb = 1 + 8 * l0;
        { int l = l0; LAUNDER(l); if (IN(pb + 0)) for (int rep = 0; rep < NREP(0); ++rep) ph_gemm1(lds, p, l); }
        SEAM(pb + 0);
        { int l = l0; LAUNDER(l); if (IN(pb + 1)) for (int rep = 0; rep < NREP(1); ++rep) ph_mix_a(lds, p, l); }
        SEAM(pb + 1);
        { int l = l0; LAUNDER(l); if (IN(pb + 2)) for (int rep = 0; rep < NREP(2); ++rep) ph_mix_b(lds, p, l); }
        SEAM(pb + 2);
        { int l = l0; LAUNDER(l); if (IN(pb + 3)) for (int rep = 0; rep < (l == 0 ? NREP(3) : 1); ++rep) ph_wout(lds, p, l); }
        SEAM(pb + 3);
        { int l = l0; LAUNDER(l); if (IN(pb + 4)) { if (NREP(4) > 1) ph_router(lds, p, l, true); ph_router(lds, p, l); } }
        SEAM(pb + 4);
        { int l = l0; LAUNDER(l); if (IN(pb + 5)) for (int rep = 0; rep < NREP(5); ++rep) ph_gateup(lds, p, l); }
        SEAM(pb + 5);
        { int l = l0; LAUNDER(l); if (IN(pb + 6)) for (int rep = 0; rep < NREP(6); ++rep) ph_down(lds, p, l); }
        SEAM(pb + 6);
        { int l = l0; LAUNDER(l); if (IN(pb + 7)) { if (NREP(7) > 1) ph_combine(lds, p, l, true); ph_combine(lds, p, l); } }
        SEAM(pb + 7);
    }
}

extern "C" void kernel_launch(void* const* d_in, const int* in_sizes, int n_in, void* d_out, int out_size, void* d_ws, size_t ws_size, hipStream_t stream) {
    (void)in_sizes; (void)n_in; (void)out_size;
    static int grid = 0;
    if (!grid) {
        int dev = 0, cus = 0, per_cu = 0;
        hipGetDevice(&dev);
        hipDeviceGetAttribute(&cus, hipDeviceAttributeMultiprocessorCount, dev);
        hipFuncSetAttribute((const void*)mega, hipFuncAttributeMaxDynamicSharedMemorySize, LDS_BYTES);
        hipOccupancyMaxActiveBlocksPerMultiprocessor(&per_cu, (const void*)mega, NT, LDS_BYTES);
        if (per_cu > 1) per_cu = 1;
        if (per_cu < 1) per_cu = 1;
        grid = cus * per_cu;
    }
    if (ws_size < WS_END) { fprintf(stderr, "workspace too small: %zu < %zu\n", ws_size, (size_t)WS_END); return; }
    hipMemsetAsync(d_ws, 0, CTL_ZERO_BYTES, stream);
    Params p{};
    for (int i = 0; i < 26; ++i) p.in[i] = (const float*)d_in[i];
    p.out = (float*)d_out; p.ws = (unsigned char*)d_ws;
#if N_LAUNCH_SPLIT
    for (int k = 0; k < NPH; ++k) { p.ph_lo = k; p.ph_hi = k + 1; hipLaunchKernelGGL(mega, dim3(grid), dim3(NT), LDS_BYTES, stream, p); }
#else
    p.ph_lo = 0; p.ph_hi = NPH;
    hipLaunchKernelGGL(mega, dim3(grid), dim3(NT), LDS_BYTES, stream, p);
#endif
}
```

```cpp
#include <hip/hip_runtime.h>
#include <stdint.h>
#include <stdio.h>

#ifndef NAIVE_GEMM
#define NAIVE_GEMM 0
#endif
#ifndef NAIVE_ATTN
#define NAIVE_ATTN 0
#endif
#ifndef N_LAUNCH_SPLIT
#define N_LAUNCH_SPLIT 0
#endif

#ifndef SHADOW_V
#define SHADOW_V -1
#endif
#ifndef SHADOW_G
#define SHADOW_G -1
#endif
#ifndef REPEAT_MASK
#define REPEAT_MASK 0
#endif
#define NREP(k) ((((REPEAT_MASK) >> (k)) & 1) + 1)
#define LAS __attribute__((address_space(3)))
typedef unsigned char uchar;
typedef unsigned short bf16_t;
typedef short bf16x8 __attribute__((ext_vector_type(8)));
typedef float f32x16 __attribute__((ext_vector_type(16)));
typedef float f32x2_t __attribute__((ext_vector_type(2)));
typedef __bf16 bf16x2_t __attribute__((ext_vector_type(2)));
typedef unsigned u32x4 __attribute__((ext_vector_type(4)));
typedef unsigned u32x2 __attribute__((ext_vector_type(2)));
typedef float f32x4 __attribute__((ext_vector_type(4)));

constexpr int NB = 8, S = 2048, DM = 1024, T = NB * S, NL = 2;
constexpr int NIN = 2144, NINP = 2176;
constexpr float EPS = 1e-6f, LOG2E = 1.4426950408889634f;
constexpr float QSCALE_D = 0.125f * LOG2E;
constexpr float QSCALE_M = 0.10206207261596577f * LOG2E;
constexpr int NPH = 1 + 8 * NL;

constexpr size_t MiB = (size_t)1 << 20;
constexpr size_t WS_CTL = 0, CTL_ZERO_BYTES = 32768;
constexpr size_t WS_SCAL = 1 * MiB;
constexpr size_t WS_ROPE = 1 * MiB + 64 * 1024;
constexpr size_t WS_RSTD1 = 1 * MiB + 512 * 1024;
constexpr size_t WS_RSTD2 = WS_RSTD1 + 64 * 1024;
constexpr size_t WS_GW = WS_RSTD2 + 64 * 1024;
constexpr size_t WS_LIST = 2 * MiB;
constexpr size_t WS_WIN = 4 * MiB;
constexpr size_t WS_WOUT = 13 * MiB;
constexpr size_t WS_WUQ = 17 * MiB;
constexpr size_t WS_WUKV = 17 * MiB + 512 * 1024;
constexpr size_t WS_POOLW = 17 * MiB + 768 * 1024;
constexpr size_t WS_WR = 18 * MiB;
constexpr size_t WS_PSS = 19 * MiB + 512 * 1024;
constexpr size_t WS_HSS = 12 * MiB + 512 * 1024;
constexpr size_t WS_WGU = 20 * MiB;
constexpr size_t WS_WD = 52 * MiB;
constexpr size_t WS_XB = 68 * MiB;
constexpr size_t WS_MIX = 100 * MiB;
constexpr size_t WS_HMID = WS_MIX;
constexpr size_t WS_QD = 132 * MiB, WS_KD = 148 * MiB, WS_VDT = 164 * MiB;
constexpr size_t WS_LAT = 180 * MiB;
constexpr size_t WS_QM = 200 * MiB, WS_KM = 212 * MiB, WS_VMT = 224 * MiB;
constexpr size_t WS_POOLED = 232 * MiB;
constexpr size_t WS_XL = 200 * MiB;
constexpr size_t WS_YS = 132 * MiB;
constexpr size_t WS_END = 240 * MiB;

#define XB_TMO      128
#define XB_XCNT(j)  (256  + 64 * (j))
#define XB_XSUB(j)  (1280 + 64 * (j))
#define XB_XGEN(j)  (2304 + 64 * (j))
#define XB_TOP      3328
#define XB_TOPGEN   3392
#define XCD_BAR_WORDS 3456
#define XB_SPIN_CAP (1u << 18)
constexpr int CW_CNT = 4096;

constexpr int NT = 512;
constexpr int LDS_XB = 147456;
constexpr int LDS_ROW = LDS_XB + 256;
constexpr int LDS_MOE = LDS_ROW + 2048;
constexpr int LDS_BYTES = LDS_MOE + 512;
constexpr int GSTG = 49152;
constexpr int ASTG = 32768;
constexpr int MSTG = 20480;

struct Params {
    const float* in[26];
    float* out;
    unsigned char* ws;
    int ph_lo, ph_hi;
};

__device__ __forceinline__ unsigned pk2(float lo, float hi) { f32x2_t v = {lo, hi}; bf16x2_t b = __builtin_convertvector(v, bf16x2_t); return __builtin_bit_cast(unsigned, b); }
__device__ __forceinline__ float bflo(unsigned w) { return __builtin_bit_cast(float, w << 16); }
__device__ __forceinline__ float bfhi(unsigned w) { return __builtin_bit_cast(float, w & 0xffff0000u); }
__device__ __forceinline__ float bf2f(bf16_t u) { return __builtin_bit_cast(float, (unsigned)u << 16); }
__device__ __forceinline__ bf16_t f2bf(float f) { return (bf16_t)(pk2(f, 0.f) & 0xffffu); }
__device__ __forceinline__ LAS uchar* lds_base() { extern __shared__ __attribute__((aligned(16))) unsigned char smem_dyn_[]; return (LAS uchar*)smem_dyn_; }
__device__ __forceinline__ int tid_opaque() { int t = threadIdx.x; asm volatile("" : "+v"(t)); return t; }
__device__ __forceinline__ int crow(int r, int hi) { return (r & 3) + 8 * (r >> 2) + 4 * hi; }
__device__ __forceinline__ int sigma16(int s) { return (s & ~12) | ((s & 4) << 1) | ((s & 8) >> 1); }
__device__ __forceinline__ float wave_sum(float v) {
#pragma unroll
    for (int o = 32; o >= 1; o >>= 1) v += __shfl_xor(v, o);
    return v;
}
__device__ __forceinline__ void unpack8(u32x4 w, float (&f)[8]) {
    f[0] = bflo(w[0]); f[1] = bfhi(w[0]); f[2] = bflo(w[1]); f[3] = bfhi(w[1]);
    f[4] = bflo(w[2]); f[5] = bfhi(w[2]); f[6] = bflo(w[3]); f[7] = bfhi(w[3]);
}

__device__ __forceinline__ unsigned xb_ld(unsigned* p)              { return __hip_atomic_load(p, __ATOMIC_RELAXED, __HIP_MEMORY_SCOPE_AGENT); }
__device__ __forceinline__ unsigned xb_add(unsigned* p, unsigned v) { return __hip_atomic_fetch_add(p, v, __ATOMIC_RELAXED, __HIP_MEMORY_SCOPE_AGENT); }
__device__ __forceinline__ unsigned xb_xcc_id() { return (unsigned)__builtin_amdgcn_s_getreg((3 << 11) | 20) & 0xFu; }
#define XB_SPIN(cond, bar) do { unsigned _sp = 0; while (cond) { __builtin_amdgcn_s_sleep(1); \
    if ((++_sp & 255u) == 0u) { if (xb_ld(&(bar)[XB_TMO])) break; if (_sp > XB_SPIN_CAP) { atomicAdd(&(bar)[XB_TMO], 1u); break; } } } } while (0)
struct XcdBarrier { unsigned* bar; unsigned x; volatile LAS unsigned* st; };
__device__ __forceinline__ XcdBarrier xcd_barrier_post(unsigned* bar, volatile LAS unsigned* st) {
    XcdBarrier b; b.bar = bar; b.x = xb_xcc_id(); b.st = st;
    if (threadIdx.x == 0) (void)xb_add(&bar[XB_XCNT(b.x)], 1u);
    return b;
}
__device__ __forceinline__ void xcd_barrier_complete(unsigned* bar, unsigned x, unsigned& nloc, unsigned& nx) {
    const unsigned G = gridDim.x * gridDim.y * gridDim.z;
    unsigned sum, cnt, mine, sp = 0u;
    for (;;) {
        sum = 0u; cnt = 0u; mine = 0u;
#pragma unroll
        for (unsigned j = 0; j < 16; ++j) { const unsigned c = xb_ld(&bar[XB_XCNT(j)]); sum += c; cnt += (c > 0u) ? 1u : 0u; mine = (j == x) ? c : mine; }
        if (sum == G) break;
        __builtin_amdgcn_s_sleep(1);
        if ((++sp & 255u) == 0u) { if (xb_ld(&bar[XB_TMO])) break; if (sp > XB_SPIN_CAP) { atomicAdd(&bar[XB_TMO], 1u); break; } }
    }
    nloc = mine > 0u ? mine : 1u; nx = cnt > 0u ? cnt : 1u;
}
__device__ __forceinline__ void xcd_barrier(const XcdBarrier& b) {
    asm volatile("s_waitcnt vmcnt(0)" ::: "memory");
    __syncthreads();
    if (threadIdx.x == 0) {
        unsigned* bar = b.bar;
        __builtin_amdgcn_s_waitcnt(0);
        unsigned nloc = b.st[0], nx = b.st[1];
        if (nloc == 0u) { xcd_barrier_complete(bar, b.x, nloc, nx); b.st[0] = nloc; b.st[1] = nx; }
        const unsigned old = xb_add(&bar[XB_XSUB(b.x)], 1u);
        const unsigned gen = old / nloc;
        if (old + 1u == (gen + 1u) * nloc) {
            __builtin_amdgcn_fence(__ATOMIC_RELEASE, "agent");
            asm volatile("s_waitcnt vmcnt(0)" ::: "memory");
            const unsigned og = xb_add(&bar[XB_TOP], 1u);
            const unsigned tg = og / nx;
            if (og + 1u == (tg + 1u) * nx) xb_add(&bar[XB_TOPGEN], 1u);
            else XB_SPIN(xb_ld(&bar[XB_TOPGEN]) == tg, bar);
            __builtin_amdgcn_fence(__ATOMIC_ACQUIRE, "agent");
            xb_add(&bar[XB_XGEN(b.x)], 1u);
            asm volatile("s_waitcnt vmcnt(0)" ::: "memory");
        } else {
            XB_SPIN(xb_ld(&bar[XB_XGEN(b.x)]) == gen, bar);
            __builtin_amdgcn_fence(__ATOMIC_ACQUIRE, "agent");
            asm volatile("s_waitcnt vmcnt(0)" ::: "memory");
        }
    }
    __syncthreads();
}

__device__ __forceinline__ void glds16(const void* gsrc, LAS uchar* dst_wave_base) {
    __builtin_amdgcn_global_load_lds((const unsigned*)gsrc, (LAS unsigned*)dst_wave_base, 16, 0, 0);
}
__device__ __forceinline__ int sw128(int row, int c) { return row * 128 + ((c ^ ((row >> 1) & 7)) << 4); }
__device__ __forceinline__ int sw64(int row, int c) { return row * 64 + ((c ^ ((row >> 2) & 3)) << 4); }

#define MFMA32(a, b, c) __builtin_amdgcn_mfma_f32_32x32x16_bf16((a), (b), (c), 0, 0, 0)

constexpr int CT_PITCH = 272;
#define WAITV(n) asm volatile("s_waitcnt vmcnt(" #n ")" ::: "memory")
struct ARowNone { static constexpr bool GATHER = false; __device__ __forceinline__ const bf16_t* operator()(int) const { return nullptr; } };
struct ARowLinear { const bf16_t* base; size_t ld; __device__ __forceinline__ const bf16_t* operator()(int r) const { return base + (size_t)r * ld; } };
struct ARowGather { static constexpr bool GATHER = true; const bf16_t* base; const unsigned* list; int nvalid; __device__ __forceinline__ const bf16_t* operator()(int r) const {
    const int rr = r < nvalid ? r : nvalid - 1; const unsigned ent = list[rr]; return base + (size_t)(ent >> 1) * DM; } };

struct AOffLinear { __device__ __forceinline__ int operator()(int kt) const { return kt * 64; } };
struct AOffRouter { int xl_off; __device__ __forceinline__ int operator()(int kt) const { return (kt & 15) * 64 + ((kt >> 4) == 1 ? xl_off : 0); } };
constexpr int CTF_PITCH = 129;
template <bool F32C = false, class ARow, class Epi, class AOff = AOffLinear>
__device__ __forceinline__ void gemm_tile(LAS uchar* lds, const ARow& arow, const bf16_t* Bt, size_t ldb, int K, const Epi& epi, const AOff aoff = AOff()) {
    const int tid = tid_opaque(), lane = tid & 63, wid = __builtin_amdgcn_readfirstlane(tid >> 6);
#if NAIVE_GEMM
    {
        const int r = tid >> 1, nh = tid & 1;
        float acc[64];
#pragma unroll
        for (int n = 0; n < 64; ++n) acc[n] = 0.f;
        const bf16_t* ar = arow(r);
        for (int k = 0; k < K; k += 8) {
            float a[8]; unpack8(*(const u32x4*)(ar + k), a);
#pragma unroll
            for (int n = 0; n < 64; ++n) {
                float b[8]; unpack8(*(const u32x4*)(Bt + (size_t)(nh * 64 + n) * ldb + k), b);
#pragma unroll
                for (int j = 0; j < 8; ++j) acc[n] += a[j] * b[j];
            }
        }
        __syncthreads();
#pragma unroll
        for (int n = 0; n < 64; n += 2) { if (F32C) { ((LAS float*)lds)[r * CTF_PITCH + nh * 64 + n] = acc[n]; ((LAS float*)lds)[r * CTF_PITCH + nh * 64 + n + 1] = acc[n + 1]; } else *(LAS unsigned*)(lds + r * CT_PITCH + (nh * 64 + n) * 2) = pk2(acc[n], acc[n + 1]); }
    }
#else
    {
        const int wm = wid >> 1, wn = wid & 1, r = lane & 31, hh = lane >> 5;
        const int srow = lane >> 3, c0 = (lane & 7) ^ (srow >> 1);
        const bf16_t* asrc[4];
#pragma unroll
        for (int j = 0; j < 4; ++j) asrc[j] = arow(8 * (wid * 4 + j) + srow) + (c0 ^ ((j & 1) << 2)) * 8;
        const bf16_t* bsrc0 = Bt + (size_t)(wid * 16 + srow) * ldb + c0 * 8;
        const bf16_t* bsrc1 = Bt + (size_t)(wid * 16 + 8 + srow) * ldb + (c0 ^ 4) * 8;
        const int lanebase = r * 128 + ((hh ^ ((r >> 1) & 7)) << 4);
        f32x16 acc[2][2];
#pragma unroll
        for (int a = 0; a < 2; ++a)
#pragma unroll
            for (int b = 0; b < 2; ++b)
#pragma unroll
                for (int i = 0; i < 16; ++i) acc[a][b][i] = 0.f;
        const int nt = K >> 6;
#define GT_STAGE(kt, sb) do { _Pragma("unroll") for (int j = 0; j < 4; ++j) \
            glds16(asrc[j] + aoff(kt), lds + (sb) * GSTG + (wid * 4 + j) * 1024); \
            glds16(bsrc0 + (kt) * 64, lds + (sb) * GSTG + 32768 + (wid * 2) * 1024); \
            glds16(bsrc1 + (kt) * 64, lds + (sb) * GSTG + 32768 + (wid * 2 + 1) * 1024); } while (0)
        GT_STAGE(0, 0);
        if (nt > 1) GT_STAGE(1, 1);
        int sb = 0;
        for (int kt = 0; kt < nt; ++kt) {
            if (kt + 1 < nt) WAITV(6); else WAITV(0);
            __builtin_amdgcn_s_barrier();
            if (kt + 2 < nt) { const int sn = sb >= 1 ? sb - 1 : 2; GT_STAGE(kt + 2, sn); }
            const LAS uchar* xs = lds + sb * GSTG + wm * 8192; const LAS uchar* wsb = lds + sb * GSTG + 32768 + wn * 8192;
#pragma unroll
            for (int ks = 0; ks < 4; ++ks) {
                const int lb = lanebase ^ (ks << 5);
                bf16x8 xf[2], wf[2];
#pragma unroll
                for (int mb = 0; mb < 2; ++mb) xf[mb] = *(const LAS bf16x8*)(xs + mb * 4096 + lb);
#pragma unroll
                for (int nb = 0; nb < 2; ++nb) wf[nb] = *(const LAS bf16x8*)(wsb + nb * 4096 + lb);
#pragma unroll
                for (int nb = 0; nb < 2; ++nb)
#pragma unroll
                    for (int mb = 0; mb < 2; ++mb) acc[nb][mb] = MFMA32(wf[nb], xf[mb], acc[nb][mb]);
            }
            sb = sb == 2 ? 0 : sb + 1;
        }
#undef GT_STAGE
        __syncthreads();
#pragma unroll
        for (int nb = 0; nb < 2; ++nb)
#pragma unroll
            for (int mb = 0; mb < 2; ++mb) {
                const int m = 64 * wm + 32 * mb + r;
#pragma unroll
                for (int q4 = 0; q4 < 4; ++q4) {
                    const int n = 64 * wn + 32 * nb + 8 * q4 + 4 * hh;
                    if (F32C) {
#pragma unroll
                        for (int j = 0; j < 4; ++j) ((LAS float*)lds)[m * CTF_PITCH + n + j] = acc[nb][mb][4 * q4 + j];
                    } else {
                        u32x2 v; v[0] = pk2(acc[nb][mb][4 * q4], acc[nb][mb][4 * q4 + 1]); v[1] = pk2(acc[nb][mb][4 * q4 + 2], acc[nb][mb][4 * q4 + 3]);
                        *(LAS u32x2*)(lds + m * CT_PITCH + n * 2) = v;
                    }
                }
            }
    }
#endif
    __syncthreads();
    epi(lds);
    __syncthreads();
}
constexpr int BSTG = 32768, CT2_OFF = 256 * CT_PITCH;
template <int V = 0, class ARow, class EpiMaker>
__device__ __forceinline__ void gemm_big(LAS uchar* lds, const ARow& arow, const bf16_t* Bt, size_t ldb, int K, const EpiMaker& mk) {
    const int tid = tid_opaque(), lane = tid & 63, wid = __builtin_amdgcn_readfirstlane(tid >> 6);
    {
        const int wm = wid >> 2, wn = wid & 3, r = lane & 31, hh = lane >> 5;
        const int srow = lane >> 3, c0 = (lane & 7) ^ (lane >> 4);
        const bf16_t* asrc[4];
#pragma unroll
        for (int j = 0; j < 4; ++j) asrc[j] = arow(wid * 32 + 8 * j + srow) + (c0 ^ ((j & 1) << 2)) * 8;
        const bf16_t* b0 = Bt + (size_t)(wid * 32 + srow) * ldb + c0 * 8; const bf16_t* b1 = Bt + (size_t)(wid * 32 + srow) * ldb + (c0 ^ 4) * 8;
        const int lanebase = r * 128 + ((hh ^ ((r >> 1) & 7)) << 4);
        f32x16 acc[2][4];
#pragma unroll
        for (int a = 0; a < 2; ++a)
#pragma unroll
            for (int b = 0; b < 4; ++b)
#pragma unroll
                for (int i = 0; i < 16; ++i) acc[a][b][i] = 0.f;
        const int nt = K >> 6;
#define GB_STAGE(kt, sb) do { _Pragma("unroll") for (int j = 0; j < 4; ++j) { \
            glds16(asrc[j] + (kt) * 64, lds + (sb) * 65536 + (wid * 4 + j) * 1024); \
            glds16(((j & 1) ? b1 : b0) + (size_t)(8 * j) * ldb + (kt) * 64, lds + (sb) * 65536 + 32768 + (wid * 4 + j) * 1024); } } while (0)
        if (!(V & 4)) GB_STAGE(0, 0);
        for (int kt = 0; kt < nt; ++kt) {
            const int sb = kt & 1;
            WAITV(0);
            __builtin_amdgcn_s_barrier();
            if (!(V & 4) && kt + 1 < nt) GB_STAGE(kt + 1, sb ^ 1);
            const LAS uchar* xs = lds + sb * 65536 + wm * 16384; const LAS uchar* wsb = lds + sb * 65536 + 32768 + wn * 8192;
#pragma unroll
            for (int ks = 0; ks < 4; ++ks) {
                const int lb = lanebase ^ (ks << 5);
                bf16x8 xf[4], wf[2];
#pragma unroll
                for (int mb = 0; mb < 4; ++mb) xf[mb] = *(const LAS bf16x8*)(xs + mb * 4096 + lb);
#pragma unroll
                for (int nb = 0; nb < 2; ++nb) wf[nb] = *(const LAS bf16x8*)(wsb + nb * 4096 + lb);
#pragma unroll
                for (int nb = 0; nb < 2; ++nb)
#pragma unroll
                    for (int mb = 0; mb < 4; ++mb) acc[nb][mb] = MFMA32(wf[nb], xf[mb], acc[nb][mb]);
            }
        }
#undef GB_STAGE
        __syncthreads();
#pragma unroll
        for (int nb = 0; nb < 2; ++nb)
#pragma unroll
            for (int mb = 0; mb < 4; ++mb) {
                const int m = 128 * wm + 32 * mb + r;
#pragma unroll
                for (int q4 = 0; q4 < 4; ++q4) {
                    const int n = 64 * (wn & 1) + 32 * nb + 8 * q4 + 4 * hh;
                    u32x2 v; v[0] = pk2(acc[nb][mb][4 * q4], acc[nb][mb][4 * q4 + 1]); v[1] = pk2(acc[nb][mb][4 * q4 + 2], acc[nb][mb][4 * q4 + 3]);
                    *(LAS u32x2*)(lds + (wn >> 1) * CT2_OFF + m * CT_PITCH + n * 2) = v;
                }
            }
    }
    __syncthreads();
    if (!(V & 1)) { mk(0)(lds); mk(1)(lds + CT2_OFF); }
    __syncthreads();
}
namespace pg8 {
#define PG8_LAS __attribute__((address_space(3)))
typedef ::f32x4 f32x4; typedef ::bf16x8 bf16x8; typedef ::bf16_t bf16_t; typedef ::u32x4 u32x4;
constexpr int BM = 256, BK = 64, HALF = 128, HTB = HALF * BK * 2  , STAGE_BYTES = 8 * HTB, NXCD = 8, WGM = 8;

__host__ __device__ __forceinline__ int lds_byte(int r, int c) { const int st = (r >> 4) * 2 + (c >> 5), rr = r & 15, cc = c & 31, ob = rr * 64 + cc * 2; return st * 1024 + (ob ^ (((ob >> 9) & 1) << 5)); }
__host__ __device__ __forceinline__ void stage_rc(int b, int& R, int& C) { const int st = b / 1024, sb = b % 1024, swz = sb ^ (((sb >> 9) & 1) << 5); R = (st >> 1) * 16 + swz / 64; C = (st & 1) * 32 + (swz % 64) / 2; }
__host__ __device__ __forceinline__ int perm32(int rho) { const int n = rho >> 4, i = rho & 15; return 8 * (i >> 2) + 4 * n + (i & 3); }

struct Unit { int pm, pn; };
struct Gemm { const bf16_t* A; const bf16_t* Bt; int M, N, K; };
template <class Epi, class Sched, bool ALIGN_EPI = false, bool SP2 = false, class ARowT = ARowNone>
__device__ __forceinline__ void gemm_phase(PG8_LAS unsigned char* lds, const Gemm g, const Sched& S, const Epi& E, const ARowT& arow = ARowT()) {
    constexpr bool GATHER = ARowT::GATHER;
    const int tid = tid_opaque(), wid = __builtin_amdgcn_readfirstlane(tid >> 6), lane = tid & 63, wr = wid >> 2, wc = wid & 3, fr = lane & 15, fq = lane >> 4;
    const int K = g.K, nt = K / BK;
    unsigned voffA[2], voffB[2];
#pragma unroll
    for (int i = 0; i < 2; ++i) { int R, C; stage_rc(tid * 16 + i * 8192, R, C); const int Rb = Epi::PERM ? ((R & ~31) + perm32(R & 31)) : R;
        voffA[i] = (unsigned)(R * K + C) * 2u; voffB[i] = (unsigned)(Rb * K + C) * 2u; }
    unsigned aoffg[2][2] = {{0u, 0u}, {0u, 0u}};
    if constexpr (GATHER) {
#pragma unroll
        for (int h = 0; h < 2; ++h)
#pragma unroll
            for (int i = 0; i < 2; ++i) { int R, C; stage_rc(tid * 16 + i * 8192, R, C); aoffg[h][i] = (unsigned)((const char*)(arow(h * HALF + R) + C) - (const char*)g.A); }
    }
    const size_t kstep = (size_t)(BK * 2);
    const size_t hstep = (size_t)HALF * K * 2;
    const size_t tstep = 2 * hstep;
    const unsigned ldsw = (unsigned)wid * 1024u;
    const int aoff = lds_byte(wr * 64 + fr, fq * 8), boff = lds_byte(wc * 32 + fr, fq * 8);
#define PG8_SA(b, h) (((b) * 2 + (h)) * HTB)
#define PG8_SB(b, h) ((4 + (b) * 2 + (h)) * HTB)
#define PG8_STAGE(bufoff, gbase, voff) do { _Pragma("unroll") for (int _i = 0; _i < 2; ++_i) \
        __builtin_amdgcn_global_load_lds((const unsigned*)((const char*)(gbase) + (voff)[_i]), (PG8_LAS unsigned*)(lds + (bufoff) + ldsw + _i * 8192), 16, 0, 0); } while (0)
#define PG8_STAGE_A(b, h, kp) do { if constexpr (GATHER) { _Pragma("unroll") for (int _i = 0; _i < 2; ++_i) \
        __builtin_amdgcn_global_load_lds((const unsigned*)((const char*)g.A + ((kp) - (const char*)0) + aoffg[h][_i]), (PG8_LAS unsigned*)(lds + PG8_SA(b, h) + ldsw + _i * 8192), 16, 0, 0); } \
        else PG8_STAGE(PG8_SA(b, h), (kp) + (h) * hstep, voffA); } while (0)
#define PG8_LDA(dst, b, h) do { _Pragma("unroll") for (int m = 0; m < 4; ++m) _Pragma("unroll") for (int k = 0; k < 2; ++k) dst[m][k] = *(const PG8_LAS bf16x8*)(lds + PG8_SA(b, h) + aoff + m * 2048 + k * 1024); } while (0)
#define PG8_LDB(dst, b, h) do { _Pragma("unroll") for (int n = 0; n < 2; ++n) _Pragma("unroll") for (int k = 0; k < 2; ++k) dst[n][k] = *(const PG8_LAS bf16x8*)(lds + PG8_SB(b, h) + boff + n * 2048 + k * 1024); } while (0)
#define PG8_MMA(ai, bj, At, Bt) do { __builtin_amdgcn_s_setprio(1); _Pragma("unroll") for (int m = 0; m < 4; ++m) _Pragma("unroll") for (int n = 0; n < 2; ++n) _Pragma("unroll") for (int k = 0; k < 2; ++k) \
        acc[ai][bj][m][n] = __builtin_amdgcn_mfma_f32_16x16x32_bf16(Bt[n][k], At[m][k], acc[ai][bj][m][n], 0, 0, 0); __builtin_amdgcn_s_setprio(0); } while (0)
#define PG8_WAIT_V(n) asm volatile("s_waitcnt vmcnt(" #n ")" ::: "memory")
#define PG8_WAIT_L(n) asm volatile("s_waitcnt lgkmcnt(" #n ")" ::: "memory")
#define PG8_BAR __builtin_amdgcn_s_barrier()
#define PG8_SCHED __builtin_amdgcn_sched_barrier(0)
    Unit cur, nxt; int ui = 0;
    if (!S.next(0, cur)) return;
    f32x4 acc[2][2][4][2];
#pragma unroll
    for (int a = 0; a < 2; ++a)
#pragma unroll
        for (int b = 0; b < 2; ++b)
#pragma unroll
            for (int m = 0; m < 4; ++m)
#pragma unroll
                for (int n = 0; n < 2; ++n) acc[a][b][m][n] = (f32x4){0.f, 0.f, 0.f, 0.f};
    bf16x8 At[4][2], B0[2][2], B1[2][2];
    const char* cA = GATHER ? (const char*)0 : (const char*)g.A + (size_t)cur.pm * tstep; const char* cB = (const char*)g.Bt + (size_t)cur.pn * tstep;
    S.a_ready(cur);
    if constexpr (SP2) {
        PG8_STAGE(PG8_SB(0, 0), cB, voffB); PG8_STAGE(PG8_SB(0, 1), cB + hstep, voffB); PG8_STAGE_A(0, 0, cA); PG8_STAGE_A(0, 1, cA);
        if (wr == 1) PG8_BAR;
        PG8_WAIT_V(2); PG8_BAR;
        PG8_STAGE(PG8_SB(1, 0), cB + kstep, voffB); PG8_STAGE_A(1, 0, cA + kstep); PG8_STAGE(PG8_SB(1, 1), cB + hstep + kstep, voffB);
        PG8_WAIT_V(6); PG8_BAR;
    } else {
        PG8_STAGE(PG8_SB(0, 0), cB, voffB); PG8_STAGE_A(0, 0, cA); PG8_STAGE(PG8_SB(0, 1), cB + hstep, voffB); PG8_STAGE_A(0, 1, cA);
        if (wr == 1) PG8_BAR;
        PG8_WAIT_V(4); PG8_BAR;
        PG8_STAGE(PG8_SB(1, 0), cB + kstep, voffB); PG8_STAGE_A(1, 0, cA + kstep); PG8_STAGE(PG8_SB(1, 1), cB + hstep + kstep, voffB);
        PG8_WAIT_V(6); PG8_BAR;
    }
    for (;;) {
        const bool has_next = S.next(ui + 1, nxt);
        const char* nA = (has_next && !GATHER) ? (const char*)g.A + (size_t)nxt.pm * tstep : cA; const char* nB = has_next ? (const char*)g.Bt + (size_t)nxt.pn * tstep : cB;
        for (int t = 0; t < nt; t += 2) {
            const bool last = (t == nt - 2);
            const char* a1 = cA + (size_t)(t + 1) * kstep;
            const char* a2 = last ? nA : cA + (size_t)(t + 2) * kstep; const char* b2 = last ? nB : cB + (size_t)(t + 2) * kstep;
            const char* a3 = a2 + kstep; const char* b3 = b2 + kstep;
            if (last && has_next) S.a_ready(nxt);
            if constexpr (SP2) {
            PG8_LDB(B0, 0, 0); PG8_LDB(B1, 0, 1); PG8_SCHED; PG8_LDA(At, 0, 0); PG8_STAGE_A(1, 1, a1);
            PG8_WAIT_V(8); PG8_WAIT_L(0); PG8_BAR; PG8_MMA(0, 0, At, B0); PG8_MMA(0, 1, At, B1); PG8_BAR; PG8_SCHED;
            PG8_LDA(At, 0, 1); PG8_STAGE(PG8_SB(0, 0), b2, voffB); PG8_STAGE(PG8_SB(0, 1), b2 + hstep, voffB); PG8_STAGE_A(0, 0, a2);
            PG8_WAIT_V(8); PG8_WAIT_L(0); PG8_BAR; PG8_MMA(1, 0, At, B0); PG8_MMA(1, 1, At, B1); PG8_BAR; PG8_SCHED;
            PG8_LDB(B0, 1, 0); PG8_LDB(B1, 1, 1); PG8_SCHED; PG8_LDA(At, 1, 0); PG8_STAGE_A(0, 1, a2);
            PG8_WAIT_V(8); PG8_WAIT_L(0); PG8_BAR; PG8_MMA(0, 0, At, B0); PG8_MMA(0, 1, At, B1); PG8_BAR; PG8_SCHED;
            PG8_LDA(At, 1, 1); PG8_STAGE(PG8_SB(1, 0), b3, voffB); PG8_STAGE(PG8_SB(1, 1), b3 + hstep, voffB); PG8_STAGE_A(1, 0, a3);
            PG8_WAIT_V(8); PG8_WAIT_L(0); PG8_BAR; PG8_MMA(1, 0, At, B0); PG8_MMA(1, 1, At, B1); PG8_BAR; PG8_SCHED;
            } else {
            PG8_LDB(B0, 0, 0); PG8_SCHED; PG8_LDA(At, 0, 0); PG8_STAGE_A(1, 1, a1);
            PG8_WAIT_L(8); PG8_BAR; PG8_WAIT_L(0); PG8_MMA(0, 0, At, B0); PG8_BAR; PG8_SCHED;
            PG8_LDB(B1, 0, 1); PG8_STAGE(PG8_SB(0, 0), b2, voffB);
            PG8_BAR; PG8_WAIT_L(0); PG8_MMA(0, 1, At, B1); PG8_BAR;
            PG8_LDA(At, 0, 1); PG8_STAGE_A(0, 0, a2);
            PG8_BAR; PG8_WAIT_L(0); PG8_MMA(1, 0, At, B0); PG8_BAR; PG8_SCHED;
            PG8_STAGE(PG8_SB(0, 1), b2 + hstep, voffB);
            PG8_WAIT_V(6); PG8_BAR; PG8_MMA(1, 1, At, B1); PG8_BAR;
            PG8_LDB(B0, 1, 0); PG8_SCHED; PG8_LDA(At, 1, 0); PG8_STAGE_A(0, 1, a2);
            PG8_WAIT_L(8); PG8_BAR; PG8_WAIT_L(0); PG8_MMA(0, 0, At, B0); PG8_BAR; PG8_SCHED;
            PG8_LDB(B1, 1, 1); PG8_STAGE(PG8_SB(1, 0), b3, voffB);
            PG8_BAR; PG8_WAIT_L(0); PG8_MMA(0, 1, At, B1); PG8_BAR;
            PG8_LDA(At, 1, 1); PG8_STAGE_A(1, 0, a3);
            PG8_BAR; PG8_WAIT_L(0); PG8_MMA(1, 0, At, B0); PG8_BAR; PG8_SCHED;
            PG8_STAGE(PG8_SB(1, 1), b3 + hstep, voffB);
            PG8_WAIT_V(6); PG8_BAR; PG8_MMA(1, 1, At, B1); PG8_BAR;
            }
        }
        if constexpr (ALIGN_EPI) { if (wr == 0) PG8_BAR; }
        if constexpr (!Epi::AFTER_DRAIN) { E(acc, cur, wr, wc, fr, fq); S.done(cur); }
        if (!has_next) break;
#pragma unroll
        for (int a = 0; a < 2; ++a)
#pragma unroll
            for (int b = 0; b < 2; ++b)
#pragma unroll
                for (int m = 0; m < 4; ++m)
#pragma unroll
                    for (int n = 0; n < 2; ++n) acc[a][b][m][n] = (f32x4){0.f, 0.f, 0.f, 0.f};
        cur = nxt; cA = nA; cB = nB; ++ui;
        if constexpr (ALIGN_EPI) { if (wr == 1) PG8_BAR; }
    }
    PG8_WAIT_V(0);
    if constexpr (!ALIGN_EPI) { if (wr == 0) PG8_BAR; }
    PG8_BAR;
    if constexpr (Epi::AFTER_DRAIN) { E.fused(acc, cur, wr, wc, fr, fq, lds, wid, lane); S.done(cur); }
#undef PG8_SA
#undef PG8_SB
#undef PG8_STAGE
#undef PG8_STAGE_A
#undef PG8_LDA
#undef PG8_LDB
#undef PG8_MMA
#undef PG8_WAIT_V
#undef PG8_WAIT_L
#undef PG8_BAR
#undef PG8_SCHED
}
}

struct OneUnit { __device__ __forceinline__ bool next(int i, pg8::Unit& u) const { u.pm = 0; u.pn = 0; return i == 0; }
    __device__ __forceinline__ void a_ready(const pg8::Unit&) const {} __device__ __forceinline__ void done(const pg8::Unit&) const {} };
template <class EpiMaker> struct EpiViaLds {
    static constexpr bool PERM = false, AFTER_DRAIN = true; const EpiMaker* mk;
    __device__ __forceinline__ void fused(pg8::f32x4 (&acc)[2][2][4][2], const pg8::Unit&, int wr, int wc, int fr, int fq, LAS uchar* lds, int, int) const {
#pragma unroll
        for (int ai = 0; ai < 2; ++ai)
#pragma unroll
            for (int bj = 0; bj < 2; ++bj)
#pragma unroll
                for (int m = 0; m < 4; ++m)
#pragma unroll
                    for (int n = 0; n < 2; ++n) {
                        const int row = 128 * ai + 64 * wr + 16 * m + fr, col = 32 * wc + 16 * n + 4 * fq;
                        u32x2 v; v[0] = pk2(acc[ai][bj][m][n][0], acc[ai][bj][m][n][1]); v[1] = pk2(acc[ai][bj][m][n][2], acc[ai][bj][m][n][3]);
                        *(LAS u32x2*)(lds + bj * CT2_OFF + row * CT_PITCH + col * 2) = v;
                    }
        __syncthreads();
        (*mk)(0)(lds);
        (*mk)(1)(lds + CT2_OFF);
        __syncthreads();
    }
};
template <class EpiMaker>
__device__ __forceinline__ void gemm_big8g(LAS uchar* lds, const ARowGather& ar, const bf16_t* Bt, int K, const EpiMaker& mk) {
    const pg8::Gemm g{ar.base, Bt, 256, 256, K}; const OneUnit S{}; const EpiViaLds<EpiMaker> E{&mk};
    pg8::gemm_phase<EpiViaLds<EpiMaker>, OneUnit, false, true, ARowGather>(lds, g, S, E, ar);
}
template <class EpiMaker>
__device__ __forceinline__ void gemm_big8(LAS uchar* lds, const bf16_t* A, const bf16_t* Bt, int K, const EpiMaker& mk) {
    const pg8::Gemm g{A, Bt, 256, 256, K}; const OneUnit S{}; const EpiViaLds<EpiMaker> E{&mk};
    pg8::gemm_phase<EpiViaLds<EpiMaker>, OneUnit, false, true>(lds, g, S, E);
}
__device__ __forceinline__ u32x4 ct_ld8(const LAS uchar* ct, int r, int c) { return *(const LAS u32x4*)(ct + r * CT_PITCH + c * 2); }
__device__ __forceinline__ float ct_ld1(const LAS uchar* ct, int r, int c) { return bf2f(*(const LAS bf16_t*)(ct + r * CT_PITCH + c * 2)); }

struct EpiProj {
    int mt, nt, l; const Params* p;
    __device__ __forceinline__ void operator()(const LAS uchar* ct) const {
        uchar* ws = p->ws; const int tid = tid_opaque();
        const LAS float* rowS = (const LAS float*)(lds_base() + LDS_ROW);
        const int t0 = mt * 256, b = t0 >> 11, s0 = t0 & 2047;
        if (nt < 8) {
            const int h = nt & 3; const bool isq = nt < 4;
            const int c8 = tid & 7, j = (tid >> 3) & 1, r0 = tid >> 4;
            const float* g = p->in[isq ? 3 : 4] + l * 64 + c8 * 8;
            const f32x4 g0 = *(const f32x4*)g, g1 = *(const f32x4*)(g + 4);
            bf16_t* dbase = (bf16_t*)(ws + (isq ? WS_QD : WS_KD)) + ((((size_t)b * 4 + h) * 2 + j) * S + s0) * 64 + c8 * 8;
#pragma unroll
            for (int it = 0; it < 8; ++it) {
                const int r = it * 32 + r0;
                const float rs = rowS[r];
                float f[8]; unpack8(ct_ld8(ct, r, j * 64 + c8 * 8), f);
                float ss = 0.f;
#pragma unroll
                for (int i = 0; i < 8; ++i) { f[i] *= rs; ss += f[i] * f[i]; }
                ss += __shfl_xor(ss, 1); ss += __shfl_xor(ss, 2); ss += __shfl_xor(ss, 4);
                const float rn = __builtin_amdgcn_rsqf(ss * (1.f / 64.f) + EPS) * (isq ? QSCALE_D : 1.f);
                u32x4 o; o[0] = pk2(f[0] * rn * g0[0], f[1] * rn * g0[1]); o[1] = pk2(f[2] * rn * g0[2], f[3] * rn * g0[3]);
                o[2] = pk2(f[4] * rn * g1[0], f[5] * rn * g1[1]); o[3] = pk2(f[6] * rn * g1[2], f[7] * rn * g1[3]);
                *(u32x4*)(dbase + (size_t)r * 64) = o;
            }
        } else if (nt < 12) {
            const int h = nt - 8, d = tid >> 2, half = tid & 3;
            bf16_t* dst = (bf16_t*)(ws + WS_VDT) + (((size_t)b * 4 + h) * 128 + d) * S + s0 + half * 64;
#pragma unroll
            for (int c8 = 0; c8 < 8; ++c8) { u32x4 o;
#pragma unroll
                for (int i = 0; i < 4; ++i) {
                    const int p0 = c8 * 8 + 2 * i, r0 = half * 64 + sigma16(p0), r1 = half * 64 + sigma16(p0 + 1);
                    o[i] = pk2(ct_ld1(ct, r0, d) * rowS[r0], ct_ld1(ct, r1, d) * rowS[r1]); }
                *(u32x4*)(dst + c8 * 8) = o; }
        } else {
            const int c8 = tid & 15, r0 = tid >> 4;
            bf16_t* dbase = (bf16_t*)(ws + WS_LAT) + (size_t)t0 * 640 + (nt - 12) * 128 + c8 * 8;
            const int hidx = (nt - 12) * 2 + (c8 >> 3);
            float* hss = (float*)(ws + WS_HSS) + (size_t)t0 * 8 + hidx;
#pragma unroll
            for (int it = 0; it < 8; ++it) {
                const int r = it * 32 + r0;
                const float rs = rowS[r];
                float f[8]; unpack8(ct_ld8(ct, r, c8 * 8), f); u32x4 o;
#pragma unroll
                for (int i = 0; i < 4; ++i) o[i] = pk2(f[2 * i] * rs, f[2 * i + 1] * rs);
                *(u32x4*)(dbase + (size_t)r * 640) = o;
                float ss = 0.f;
#pragma unroll
                for (int i = 0; i < 4; ++i) { const float a = bflo(o[i]), bq = bfhi(o[i]); ss += a * a + bq * bq; }
                ss += __shfl_xor(ss, 1); ss += __shfl_xor(ss, 2); ss += __shfl_xor(ss, 4);
                if ((c8 & 7) == 0 && hidx < 8) hss[(size_t)r * 8] = ss;
            }
        }
    }
};

__device__ __forceinline__ float lat_rstd(const bf16_t* seg, int n) {
    float ss = 0.f;
    for (int k = 0; k < n; k += 8) { float f[8]; unpack8(*(const u32x4*)(seg + k), f);
#pragma unroll
        for (int i = 0; i < 8; ++i) ss += f[i] * f[i]; }
    return __builtin_amdgcn_rsqf(ss / (float)n + EPS);
}
__device__ __forceinline__ void norm_rope32(float (&y)[32], const float* g, const float* cosr, const float* sinr, float outscale) {
    float ss = 0.f;
#pragma unroll
    for (int i = 0; i < 32; ++i) ss += y[i] * y[i];
    const float rn = __builtin_amdgcn_rsqf(ss * (1.f / 32.f) + EPS);
#pragma unroll
    for (int i = 0; i < 32; ++i) y[i] = y[i] * rn * g[i];
#pragma unroll
    for (int i = 0; i < 16; ++i) { const float c = cosr[i], sn = sinr[i], x1 = y[i], x2 = y[16 + i];
        y[i] = (x1 * c - x2 * sn) * outscale; y[16 + i] = (x2 * c + x1 * sn) * outscale; }
}

__device__ __forceinline__ u32x4 norm64_piece(float (&f)[8], const float* g8, float outscale) {
    float ss = 0.f;
#pragma unroll
    for (int i = 0; i < 8; ++i) ss += f[i] * f[i];
    ss += __shfl_xor(ss, 1); ss += __shfl_xor(ss, 2); ss += __shfl_xor(ss, 4);
    const float rn = __builtin_amdgcn_rsqf(ss * (1.f / 64.f) + EPS) * outscale;
    const f32x4 g0 = *(const f32x4*)g8, g1 = *(const f32x4*)(g8 + 4);
    u32x4 o; o[0] = pk2(f[0] * rn * g0[0], f[1] * rn * g0[1]); o[1] = pk2(f[2] * rn * g0[2], f[3] * rn * g0[3]);
    o[2] = pk2(f[4] * rn * g1[0], f[5] * rn * g1[1]); o[3] = pk2(f[6] * rn * g1[2], f[7] * rn * g1[3]);
    return o;
}
__device__ __forceinline__ u32x4 norm_rope_piece(float (&f)[8], int c8, const float* g, const float* cosr, const float* sinr, float outscale) {
    float ss = 0.f;
#pragma unroll
    for (int i = 0; i < 8; ++i) ss += f[i] * f[i];
    ss += __shfl_xor(ss, 1); ss += __shfl_xor(ss, 2);
    const float rn = __builtin_amdgcn_rsqf(ss * (1.f / 32.f) + EPS);
    float y[8], z[8];
#pragma unroll
    for (int i = 0; i < 8; ++i) y[i] = f[i] * rn * g[c8 * 8 + i];
#pragma unroll
    for (int i = 0; i < 8; ++i) z[i] = __shfl_xor(y[i], 2);
    const int fi = (c8 & 1) * 8;
    float o[8];
#pragma unroll
    for (int i = 0; i < 8; ++i) { const float c = cosr[fi + i], sn = sinr[fi + i];
        o[i] = ((c8 < 2) ? (y[i] * c - z[i] * sn) : (y[i] * c + z[i] * sn)) * outscale; }
    u32x4 w; w[0] = pk2(o[0], o[1]); w[1] = pk2(o[2], o[3]); w[2] = pk2(o[4], o[5]); w[3] = pk2(o[6], o[7]);
    return w;
}
struct EpiMlaQ {
    int mt, h, l; const Params* p;
    __device__ __forceinline__ void operator()(const LAS uchar* ct) const {
        uchar* ws = p->ws; const int tid = tid_opaque();
        const LAS float* rowS = (const LAS float*)(lds_base() + LDS_ROW);
        const int t0 = mt * 256, b = t0 >> 11, s0 = t0 & 2047;
        bf16_t* dbase = (bf16_t*)(ws + WS_QM) + (((size_t)b * 4 + h) * S + s0) * 96;
        const float* gn = p->in[11] + l * 64; const float* gr = p->in[12] + l * 32;
        {
            const int c8 = tid & 7, r0 = tid >> 3;
#pragma unroll
            for (int it = 0; it < 4; ++it) {
                const int r = it * 64 + r0; const float rs = rowS[r];
                float f[8]; unpack8(ct_ld8(ct, r, c8 * 8), f);
#pragma unroll
                for (int i = 0; i < 8; ++i) f[i] *= rs;
                *(u32x4*)(dbase + (size_t)r * 96 + c8 * 8) = norm64_piece(f, gn + c8 * 8, QSCALE_M);
            }
        }
        {
            const int c8 = tid & 3, r0 = tid >> 2;
#pragma unroll
            for (int it = 0; it < 2; ++it) {
                const int r = it * 128 + r0; const float rs = rowS[r];
                float f[8]; unpack8(ct_ld8(ct, r, 64 + c8 * 8), f);
#pragma unroll
                for (int i = 0; i < 8; ++i) f[i] *= rs;
                const float* cosr = (const float*)(ws + WS_ROPE) + (s0 + r) * 16; const float* sinr = cosr + S * 16;
                *(u32x4*)(dbase + (size_t)r * 96 + 64 + c8 * 8) = norm_rope_piece(f, c8, gr, cosr, sinr, QSCALE_M);
            }
        }
    }
};
struct EpiMlaKV {
    int mt, h, l; const Params* p;
    __device__ __forceinline__ void operator()(const LAS uchar* ct) const {
        uchar* ws = p->ws; const int tid = tid_opaque();
        const LAS float* rowS = (const LAS float*)(lds_base() + LDS_ROW);
        const int t0 = mt * 256, b = t0 >> 11, s0 = t0 & 2047;
        bf16_t* dbase = (bf16_t*)(ws + WS_KM) + (((size_t)b * 4 + h) * S + s0) * 96;
        const float* gn = p->in[13] + l * 64; const float* gr = p->in[14] + l * 32;
        {
            const int c8 = tid & 7, r0 = tid >> 3;
#pragma unroll
            for (int it = 0; it < 4; ++it) {
                const int r = it * 64 + r0; const float rs = rowS[r];
                float f[8]; unpack8(ct_ld8(ct, r, c8 * 8), f);
#pragma unroll
                for (int i = 0; i < 8; ++i) f[i] *= rs;
                *(u32x4*)(dbase + (size_t)r * 96 + c8 * 8) = norm64_piece(f, gn + c8 * 8, 1.f);
            }
        }
        {
            const bf16_t* lat = (const bf16_t*)(ws + WS_LAT) + (size_t)t0 * 640 + 320;
            const int c8 = tid & 3, r0 = tid >> 2;
#pragma unroll
            for (int it = 0; it < 2; ++it) {
                const int r = it * 128 + r0;
                float f[8]; unpack8(*(const u32x4*)(lat + (size_t)r * 640 + c8 * 8), f);
                const float* cosr = (const float*)(ws + WS_ROPE) + (s0 + r) * 16; const float* sinr = cosr + S * 16;
                *(u32x4*)(dbase + (size_t)r * 96 + 64 + c8 * 8) = norm_rope_piece(f, c8, gr, cosr, sinr, 1.f);
            }
        }
        {
            const int d = tid >> 3, q4 = tid & 7;
            bf16_t* dst = (bf16_t*)(ws + WS_VMT) + (((size_t)b * 4 + h) * 64 + d) * S + s0 + q4 * 32;
#pragma unroll
            for (int c8 = 0; c8 < 4; ++c8) { u32x4 o;
#pragma unroll
                for (int i = 0; i < 4; ++i) {
                    const int p0 = c8 * 8 + 2 * i, r0 = q4 * 32 + sigma16(p0), r1 = q4 * 32 + sigma16(p0 + 1);
                    o[i] = pk2(ct_ld1(ct, r0, 64 + d) * rowS[r0], ct_ld1(ct, r1, 64 + d) * rowS[r1]); }
                *(u32x4*)(dst + c8 * 8) = o; }
        }
    }
};
struct EpiPool {
    int mt, g, l; const Params* p;
    __device__ __forceinline__ void operator()(const LAS uchar* ct) const {
        uchar* ws = p->ws; const int tid = tid_opaque(), c8 = tid & 7, r0 = tid >> 3;
        const float* sc = p->in[16] + l * 256 + g * 64 + c8 * 8;
        const f32x4 s0 = *(const f32x4*)sc, s1 = *(const f32x4*)(sc + 4);
        bf16_t* dst = (bf16_t*)(ws + WS_MIX) + (size_t)(mt * 256) * DM + 768 + g * 64 + c8 * 8;
#pragma unroll
        for (int it = 0; it < 4; ++it) {
            const int r = it * 64 + r0;
            float f[8]; unpack8(ct_ld8(ct, r, c8 * 8), f); u32x4 o;
            o[0] = pk2(f[0] * s0[0], f[1] * s0[1]); o[1] = pk2(f[2] * s0[2], f[3] * s0[3]); o[2] = pk2(f[4] * s1[0], f[5] * s1[1]); o[3] = pk2(f[6] * s1[2], f[7] * s1[3]);
            *(u32x4*)(dst + (size_t)r * DM) = o;
        }
    }
};
struct EpiWout {
    int mt, nt; const float* xres; const Params* p;
    __device__ __forceinline__ void operator()(const LAS uchar* ct) const {
        uchar* ws = p->ws; const int tid = tid_opaque();
        const size_t base = (size_t)(mt * 256) * DM + nt * 128;
        float* pss = (float*)(ws + WS_PSS) + (size_t)(mt * 256) * 8 + nt;
#pragma unroll 8
        for (int it = 0; it < 16; ++it) {
            const int item = it * NT + tid, c4 = item & 31, r = item >> 5;
            const size_t off = base + (size_t)r * DM + c4 * 4;
            const u32x2 cw = *(const LAS u32x2*)(ct + r * CT_PITCH + c4 * 8);
            const f32x4 x0 = *(const f32x4*)(xres + off);
            f32x4 y; y[0] = x0[0] + bflo(cw[0]); y[1] = x0[1] + bfhi(cw[0]); y[2] = x0[2] + bflo(cw[1]); y[3] = x0[3] + bfhi(cw[1]);
            u32x2 o; o[0] = pk2(y[0], y[1]); o[1] = pk2(y[2], y[3]);
            *(u32x2*)((bf16_t*)(ws + WS_XB) + off) = o;
            u32x2 ol; ol[0] = pk2(y[0] - bflo(o[0]), y[1] - bfhi(o[0])); ol[1] = pk2(y[2] - bflo(o[1]), y[3] - bfhi(o[1]));
            *(u32x2*)((bf16_t*)(ws + WS_XL) + off) = ol;
            float ss = y[0] * y[0] + y[1] * y[1] + y[2] * y[2] + y[3] * y[3];
            ss += __shfl_xor(ss, 1); ss += __shfl_xor(ss, 2); ss += __shfl_xor(ss, 4); ss += __shfl_xor(ss, 8); ss += __shfl_xor(ss, 16);
            if (c4 == 0) pss[(size_t)r * 8] = ss;
        }
    }
};
struct EpiGU {
    int jt; size_t slot0; const Params* p;
    __device__ __forceinline__ void operator()(const LAS uchar* ct) const {
        uchar* ws = p->ws; const int tid = tid_opaque(), c8 = tid & 7, r0 = tid >> 3;
        const LAS float* rowS = (const LAS float*)(lds_base() + LDS_ROW);
        bf16_t* dbase = (bf16_t*)(ws + WS_HMID) + slot0 * 256 + jt * 64 + c8 * 8;
#pragma unroll
        for (int it = 0; it < 4; ++it) {
            const int r = it * 64 + r0;
            const float rs = rowS[r];
            float g[8], u[8]; unpack8(ct_ld8(ct, r, c8 * 8), g); unpack8(ct_ld8(ct, r, 64 + c8 * 8), u);
            float hv[8];
#pragma unroll
            for (int i = 0; i < 8; ++i) { const float gg = g[i] * rs, uu = u[i] * rs; hv[i] = gg * __builtin_amdgcn_rcpf(1.f + __builtin_amdgcn_exp2f(-gg * LOG2E)) * uu; }
            u32x4 o; o[0] = pk2(hv[0], hv[1]); o[1] = pk2(hv[2], hv[3]); o[2] = pk2(hv[4], hv[5]); o[3] = pk2(hv[6], hv[7]);
            *(u32x4*)(dbase + (size_t)r * 256) = o;
        }
    }
};
struct EpiDown {
    int nt, nvalid; const Params* p;
    __device__ __forceinline__ void operator()(const LAS uchar* ct) const {
        uchar* ws = p->ws; const int tid = tid_opaque(), c8 = tid & 15, r0 = tid >> 4;
        const LAS float* rowS = (const LAS float*)(lds_base() + LDS_ROW); const LAS unsigned* rowE = (const LAS unsigned*)(lds_base() + LDS_ROW + 1024);
        bf16_t* ys = (bf16_t*)(ws + WS_YS) + nt * 128 + c8 * 8;
#pragma unroll
        for (int it = 0; it < 8; ++it) {
            const int r = it * 32 + r0;
            if (r < nvalid) {
                const unsigned ent = rowE[r]; const float w = rowS[r];
                float f[8]; unpack8(ct_ld8(ct, r, c8 * 8), f); u32x4 o;
#pragma unroll
                for (int i = 0; i < 4; ++i) o[i] = pk2(f[2 * i] * w, f[2 * i + 1] * w);
                *(u32x4*)(ys + (size_t)ent * DM) = o;
            }
        }
    }
};

template <int V = 0>
__device__ __forceinline__ void diff_attn_unit(LAS uchar* lds, const Params& p, int l, int b, int h, int qb) {
    uchar* ws = p.ws;
    const int tid = tid_opaque(), lane = tid & 63, wid = __builtin_amdgcn_readfirstlane(tid >> 6);
    const float* scal = (const float*)(ws + WS_SCAL) + 16 * l;
    const float lam = scal[0], oml = scal[1], m2 = scal[2];
    const float slope2 = exp2f(-2.f * (float)(h + 1)) * LOG2E;
    const bf16_t* Q1 = (const bf16_t*)(ws + WS_QD) + (((size_t)b * 4 + h) * 2) * S * 64;
    const bf16_t* K1 = (const bf16_t*)(ws + WS_KD) + (((size_t)b * 4 + h) * 2) * S * 64;
    const bf16_t* VT = (const bf16_t*)(ws + WS_VDT) + (((size_t)b * 4 + h) * 128) * S;
    const float* gsub = p.in[6] + l * 128;
    bf16_t* mix = (bf16_t*)(ws + WS_MIX);
#if NAIVE_ATTN
    {
        const int q = qb * 128 + (tid >> 2), mm = (tid >> 1) & 1, dh = tid & 1;
        const bf16_t* Qp = Q1 + (size_t)mm * S * 64 + (size_t)q * 64; const bf16_t* Kp = K1 + (size_t)mm * S * 64;
        float qv[64];
#pragma unroll
        for (int c8 = 0; c8 < 8; ++c8) { float f[8]; unpack8(*(const u32x4*)(Qp + c8 * 8), f);
#pragma unroll
            for (int i = 0; i < 8; ++i) qv[c8 * 8 + i] = f[i]; }
        float o[64]; float lsum = 0.f;
#pragma unroll
        for (int d = 0; d < 64; ++d) o[d] = 0.f;
        for (int key = 0; key < S; ++key) {
            float sc = 0.f;
#pragma unroll
            for (int c8 = 0; c8 < 8; ++c8) { float f[8]; unpack8(*(const u32x4*)(Kp + (size_t)key * 64 + c8 * 8), f);
#pragma unroll
                for (int i = 0; i < 8; ++i) sc += qv[c8 * 8 + i] * f[i]; }
            const float pv = __builtin_amdgcn_exp2f(sc - slope2 * fabsf((float)(q - key)) - m2);
            lsum += pv;
            const int kp = sigma16(key);
#pragma unroll
            for (int d = 0; d < 64; ++d) o[d] += pv * bf2f(VT[(size_t)(dh * 64 + d) * S + kp]);
        }
        const float inv = 1.f / lsum; float ss = 0.f;
#pragma unroll
        for (int d = 0; d < 64; ++d) { const float mine = o[d] * inv; const float other = __shfl_xor(mine, 2); o[d] = mine - lam * other; ss += o[d] * o[d]; }
        ss += __shfl_xor(ss, 1);
        if (mm == 0) {
            const float rn = __builtin_amdgcn_rsqf(ss * (1.f / 128.f) + EPS) * oml;
            bf16_t* dst = mix + (size_t)(b * S + q) * DM + h * 128 + dh * 64;
#pragma unroll
            for (int d = 0; d < 64; d += 2) *(unsigned*)(dst + d) = pk2(o[d] * rn * gsub[dh * 64 + d], o[d + 1] * rn * gsub[dh * 64 + d + 1]);
        }
    }
#else
    {
        const int r = lane & 31, hh = lane >> 5, qs = wid >> 1, mm = wid & 1, qpos = qb * 128 + qs * 32 + r;
        const bf16_t* Qm_ = Q1 + (size_t)mm * S * 64;
        bf16x8 qf[4];
#pragma unroll
        for (int ks = 0; ks < 4; ++ks) qf[ks] = *(const bf16x8*)(Qm_ + (size_t)qpos * 64 + ks * 16 + hh * 8);
        f32x16 O[4]; float lsum = 0.f;
#pragma unroll
        for (int db = 0; db < 4; ++db)
#pragma unroll
            for (int i = 0; i < 16; ++i) O[db][i] = 0.f;
        const int srow = lane >> 3, c0 = (lane & 7) ^ (srow >> 1);
        const bool isk = wid < 4;
        const bf16_t* sbase = isk ? (K1 + (size_t)(wid >> 1) * S * 64 + (size_t)(wid & 1) * 32 * 64) : (VT + (size_t)(wid - 4) * 32 * S);
        const int rstride = isk ? 64 : S, kstride = isk ? 64 * 64 : 64;
        const bf16_t* sb0 = sbase + (size_t)srow * rstride + c0 * 8;
        const bf16_t* sb1 = sbase + (size_t)srow * rstride + (c0 ^ 4) * 8;
        const int lanebase = r * 128 + ((hh ^ ((r >> 1) & 7)) << 4);
#define DA_STAGE(kt, sbuf) do { _Pragma("unroll") for (int j = 0; j < 4; ++j) \
            glds16(((j & 1) ? sb1 : sb0) + (size_t)(8 * j) * rstride + (size_t)(kt) * kstride, lds + (sbuf) * ASTG + (wid * 4 + j) * 1024); } while (0)
        const int dcut = (int)(160.f / slope2) + 1;
        int kt_lo = (qb * 128 - dcut) >> 6, kt_hi = (qb * 128 + 127 + dcut) >> 6; kt_lo = kt_lo < 0 ? 0 : kt_lo; kt_hi = kt_hi > S / 64 - 1 ? S / 64 - 1 : kt_hi;
        if (!(V & 8)) { DA_STAGE(kt_lo, kt_lo & 3); if (kt_lo + 1 <= kt_hi) DA_STAGE(kt_lo + 1, (kt_lo + 1) & 3); if (kt_lo + 2 <= kt_hi) DA_STAGE(kt_lo + 2, (kt_lo + 2) & 3); }
        const int q0w = qb * 128 + qs * 32;
        const float fq = (float)(qpos - 4 * hh);
        const float baseL = -slope2 * fq - m2, baseR = slope2 * fq - m2;
        for (int kt = kt_lo; kt <= kt_hi; ++kt) {
            if (kt + 2 <= kt_hi) WAITV(8); else if (kt + 1 <= kt_hi) WAITV(4); else WAITV(0);
            __builtin_amdgcn_s_barrier();
            if (!(V & 8) && kt + 3 <= kt_hi) { DA_STAGE(kt + 3, (kt + 3) & 3); }
            const LAS uchar* st = lds + (kt & 3) * ASTG;
            f32x16 sacc[2];
#pragma unroll
            for (int kb = 0; kb < 2; ++kb) {
                const int key0 = kt * 64 + 32 * kb;
                {
                    const float c = (key0 < q0w) ? slope2 : -slope2;
                    const float a = ((key0 < q0w) ? baseL : baseR) + c * (float)key0;
#pragma unroll
                    for (int i = 0; i < 16; ++i) sacc[kb][i] = a + c * (float)((i & 3) + 8 * (i >> 2));
                }
                if (__builtin_expect(key0 == q0w, 0)) {
                    const int kq = key0 + 4 * hh - qpos;
#pragma unroll
                    for (int i = 0; i < 16; ++i) sacc[kb][i] = -slope2 * fabsf((float)(kq + (i & 3) + 8 * (i >> 2))) - m2;
                }
#pragma unroll
                for (int ks = 0; ks < 4; ++ks) {
                    if (V & 4) continue;
                    const bf16x8 kf = (V & 16) ? qf[(ks + 1) & 3] : *(const LAS bf16x8*)(st + mm * 8192 + kb * 4096 + (lanebase ^ (ks << 5)));
                    sacc[kb] = MFMA32(kf, qf[ks], sacc[kb]);
                }
            }
#pragma unroll
            for (int kb = 0; kb < 2; ++kb) {
                float ls = 0.f;
#pragma unroll
                for (int i = 0; i < 16; ++i) { const float pv = (V & 1) ? sacc[kb][i] : __builtin_amdgcn_exp2f(sacc[kb][i]); ls += pv; sacc[kb][i] = pv; }
                lsum += ls;
                bf16x8 pb[2];
#pragma unroll
                for (int s2 = 0; s2 < 2; ++s2) {
                    u32x4 w;
#pragma unroll
                    for (int i = 0; i < 4; ++i) w[i] = pk2(sacc[kb][8 * s2 + 2 * i], sacc[kb][8 * s2 + 2 * i + 1]);
                    pb[s2] = __builtin_bit_cast(bf16x8, w);
                }
#pragma unroll
                for (int db = 0; db < 4; ++db)
#pragma unroll
                    for (int s2 = 0; s2 < 2; ++s2) {
                        if (V & 2) { if (db == 0) O[0][s2] += __builtin_bit_cast(float, (__builtin_bit_cast(u32x4, pb[s2]))[0]); continue; }
                        const bf16x8 vf = (V & 16) ? qf[(db + s2) & 3] : *(const LAS bf16x8*)(st + 16384 + db * 4096 + (lanebase ^ ((2 * kb + s2) << 5)));
                        O[db] = MFMA32(vf, pb[s2], O[db]);
                    }
            }
        }
#undef DA_STAGE
        const float lt = lsum + __shfl_xor(lsum, 32);
        const float sc = (mm == 0) ? (1.f / lt) : (lam / lt);
        __syncthreads();
        LAS float* xch = (LAS float*)lds + qs * 4096;
        if (mm == 1) {
#pragma unroll
            for (int db = 0; db < 4; ++db)
#pragma unroll
                for (int i = 0; i < 16; ++i) xch[(db * 16 + i) * 64 + lane] = O[db][i] * sc;
        }
        __syncthreads();
        if (mm == 0) {
            float ss = 0.f;
#pragma unroll
            for (int db = 0; db < 4; ++db)
#pragma unroll
                for (int i = 0; i < 16; ++i) { const float o = O[db][i] * sc - xch[(db * 16 + i) * 64 + lane]; O[db][i] = o; ss += o * o; }
            ss += __shfl_xor(ss, 32);
            const float rn = __builtin_amdgcn_rsqf(ss * (1.f / 128.f) + EPS) * oml;
            bf16_t* dst = mix + (size_t)(b * S + qpos) * DM + h * 128;
#pragma unroll
            for (int db = 0; db < 4; ++db)
#pragma unroll
                for (int q4 = 0; q4 < 4; ++q4) {
                    const int d = 32 * db + 8 * q4 + 4 * hh;
                    const f32x4 g = *(const f32x4*)(gsub + d);
                    u32x2 w; w[0] = pk2(O[db][4 * q4] * rn * g[0], O[db][4 * q4 + 1] * rn * g[1]);
                    w[1] = pk2(O[db][4 * q4 + 2] * rn * g[2], O[db][4 * q4 + 3] * rn * g[3]);
                    *(u32x2*)(dst + d) = w;
                }
        }
    }
#endif
    __syncthreads();
}

__device__ __forceinline__ void mla_attn_unit(LAS uchar* lds, const Params& p, int l, int unit) {
    uchar* ws = p.ws;
    const int tid = tid_opaque(), lane = tid & 63, wid = __builtin_amdgcn_readfirstlane(tid >> 6);
    const int xg_ = unit & 7, v_ = unit >> 3, qb = v_ & 7, bh_ = (v_ >> 3) * 8 + xg_, h = bh_ & 3, b = bh_ >> 2;
    const float m2 = ((const float*)(ws + WS_SCAL))[16 * l + 3];
    const bf16_t* Q = (const bf16_t*)(ws + WS_QM) + (((size_t)b * 4 + h) * S) * 96;
    const bf16_t* Kp = (const bf16_t*)(ws + WS_KM) + (((size_t)b * 4 + h) * S) * 96;
    const bf16_t* VT = (const bf16_t*)(ws + WS_VMT) + (((size_t)b * 4 + h) * 64) * S;
    bf16_t* mix = (bf16_t*)(ws + WS_MIX);
#if NAIVE_ATTN
    {
        const int q = qb * 256 + (tid >> 1), hf = tid & 1;
        float qv[96];
#pragma unroll
        for (int c8 = 0; c8 < 12; ++c8) { float f[8]; unpack8(*(const u32x4*)(Q + (size_t)q * 96 + c8 * 8), f);
#pragma unroll
            for (int i = 0; i < 8; ++i) qv[c8 * 8 + i] = f[i]; }
        float o[32]; float lsum = 0.f;
#pragma unroll
        for (int d = 0; d < 32; ++d) o[d] = 0.f;
        for (int key = 0; key < S; ++key) {
            float sc = 0.f;
#pragma unroll
            for (int c8 = 0; c8 < 12; ++c8) { float f[8]; unpack8(*(const u32x4*)(Kp + (size_t)key * 96 + c8 * 8), f);
#pragma unroll
                for (int i = 0; i < 8; ++i) sc += qv[c8 * 8 + i] * f[i]; }
            const float pv = __builtin_amdgcn_exp2f(sc - m2);
            lsum += pv;
            const int kp = sigma16(key);
#pragma unroll
            for (int d = 0; d < 32; ++d) o[d] += pv * bf2f(VT[(size_t)(hf * 32 + d) * S + kp]);
        }
        const float inv = 1.f / lsum;
        bf16_t* dst = mix + (size_t)(b * S + q) * DM + 512 + h * 64 + hf * 32;
#pragma unroll
        for (int d = 0; d < 32; d += 2) *(unsigned*)(dst + d) = pk2(o[d] * inv, o[d + 1] * inv);
    }
#else
    {
        const int r = lane & 31, hh = lane >> 5, qpos = qb * 256 + wid * 32 + r;
        bf16x8 qf[6];
#pragma unroll
        for (int ks = 0; ks < 6; ++ks) qf[ks] = *(const bf16x8*)(Q + (size_t)qpos * 96 + ks * 16 + hh * 8);
        f32x16 O[2]; float lsum = 0.f;
#pragma unroll
        for (int db = 0; db < 2; ++db)
#pragma unroll
            for (int i = 0; i < 16; ++i) O[db][i] = 0.f;
        const int lanebase = r * 128 + ((hh ^ ((r >> 1) & 7)) << 4), lanebase64 = r * 64 + ((hh ^ ((r >> 2) & 3)) << 4);
        const bool lo4 = wid < 4;
        const bf16_t* s0p; const bf16_t* s1p; const bf16_t* s2p;
        {
            const int srow = lane >> 3;
            { const int row = 8 * wid + srow; const int c = (lane & 7) ^ ((row >> 1) & 7); s0p = Kp + (size_t)row * 96 + c * 8; }
            if (lo4) { const int row = 16 * wid + (lane >> 2); const int c = (lane & 3) ^ ((row >> 2) & 3); s1p = Kp + (size_t)row * 96 + 64 + c * 8; }
            else { const int row = 8 * (wid - 4) + srow; const int c = (lane & 7) ^ ((row >> 1) & 7); s1p = VT + (size_t)row * S + c * 8; }
            { const int row = 8 * ((wid & 3) + 4) + srow; const int c = (lane & 7) ^ ((row >> 1) & 7); s2p = VT + (size_t)row * S + c * 8; }
        }
        const int k1stride = lo4 ? 64 * 96 : 64;
#define MA_STAGE(kt, sbuf) do { \
            glds16(s0p + (size_t)(kt) * (64 * 96), lds + (sbuf) * MSTG + wid * 1024); \
            glds16(s1p + (size_t)(kt) * k1stride, lds + (sbuf) * MSTG + (wid + 8) * 1024); \
            if (lo4) glds16(s2p + (size_t)(kt) * 64, lds + (sbuf) * MSTG + (wid + 16) * 1024); } while (0)
        MA_STAGE(0, 0); MA_STAGE(1, 1); MA_STAGE(2, 2);
        for (int kt = 0; kt < S / 64; ++kt) {
            if (kt + 2 < S / 64) { if (lo4) WAITV(6); else WAITV(4); } else if (kt + 1 < S / 64) { if (lo4) WAITV(3); else WAITV(2); } else WAITV(0);
            __builtin_amdgcn_s_barrier();
            if (kt + 3 < S / 64) { MA_STAGE(kt + 3, (kt + 3) & 3); }
            const LAS uchar* st = lds + (kt & 3) * MSTG;
#pragma unroll
            for (int kb = 0; kb < 2; ++kb) {
                f32x16 sacc;
#pragma unroll
                for (int i = 0; i < 16; ++i) sacc[i] = -m2;
#pragma unroll
                for (int ks = 0; ks < 4; ++ks) {
                    const bf16x8 kf = *(const LAS bf16x8*)(st + kb * 4096 + (lanebase ^ (ks << 5)));
                    sacc = MFMA32(kf, qf[ks], sacc);
                }
#pragma unroll
                for (int ks = 0; ks < 2; ++ks) {
                    const bf16x8 kf = *(const LAS bf16x8*)(st + 8192 + kb * 2048 + (lanebase64 ^ (ks << 5)));
                    sacc = MFMA32(kf, qf[4 + ks], sacc);
                }
                float ls = 0.f;
#pragma unroll
                for (int i = 0; i < 16; ++i) { const float pv = __builtin_amdgcn_exp2f(sacc[i]); ls += pv; sacc[i] = pv; }
                lsum += ls;
                bf16x8 pb[2];
#pragma unroll
                for (int s2 = 0; s2 < 2; ++s2) {
                    u32x4 w;
#pragma unroll
                    for (int i = 0; i < 4; ++i) w[i] = pk2(sacc[8 * s2 + 2 * i], sacc[8 * s2 + 2 * i + 1]);
                    pb[s2] = __builtin_bit_cast(bf16x8, w);
                }
#pragma unroll
                for (int db = 0; db < 2; ++db)
#pragma unroll
                    for (int s2 = 0; s2 < 2; ++s2) {
                        const bf16x8 vf = *(const LAS bf16x8*)(st + 12288 + db * 4096 + (lanebase ^ ((2 * kb + s2) << 5)));
                        O[db] = MFMA32(vf, pb[s2], O[db]);
                    }
            }
        }
#undef MA_STAGE
        const float lt = lsum + __shfl_xor(lsum, 32); const float inv = 1.f / lt;
        bf16_t* dst = mix + (size_t)(b * S + qpos) * DM + 512 + h * 64;
#pragma unroll
        for (int db = 0; db < 2; ++db)
#pragma unroll
            for (int q4 = 0; q4 < 4; ++q4) {
                const int d = 32 * db + 8 * q4 + 4 * hh;
                u32x2 w; w[0] = pk2(O[db][4 * q4] * inv, O[db][4 * q4 + 1] * inv); w[1] = pk2(O[db][4 * q4 + 2] * inv, O[db][4 * q4 + 3] * inv);
                *(u32x2*)(dst + d) = w;
            }
    }
#endif
    __syncthreads();
}

__device__ __forceinline__ int xp_rowmap(int mode, int n) {
    return mode == 0 ? n : mode == 1 ? (n / 96) * 128 + (n % 96) : mode == 2 ? ((n >> 6) * 128 + (n & 63)) : ((n >> 6) * 128 + 64 + (n & 63));
}
__device__ __forceinline__ void xpose_tile(LAS uchar* lds, const float* src, int K, int N, bf16_t* dst, int ldd, int mode, const float* gain, int kt, int ntile, int lds_src = 0) {
    LAS float* sh = (LAS float*)lds; const int tid = tid_opaque();
    (void)K; const int ldn = lds_src ? lds_src : N;
    {
        const int n4 = tid & 63, n = ntile * 256 + n4 * 4;
        if (n < N) {
#pragma unroll
            for (int i = 0; i < 8; ++i) {
                const int kl = (tid >> 6) + 8 * i, k = kt * 64 + kl;
                f32x4 v = *(const f32x4*)(src + (size_t)k * ldn + n);
                if (gain) { const float gk = gain[k]; v[0] *= gk; v[1] *= gk; v[2] *= gk; v[3] *= gk; }
                LAS float* d = sh + kl * 257 + n4 * 4; d[0] = v[0]; d[1] = v[1]; d[2] = v[2]; d[3] = v[3];
            }
        }
    }
    __syncthreads();
    {
        const int nl = tid >> 1, kh = tid & 1, n = ntile * 256 + nl;
        if (n < N) {
            bf16_t* d = dst + (size_t)xp_rowmap(mode, n) * ldd + kt * 64 + kh * 32;
#pragma unroll
            for (int c8 = 0; c8 < 4; ++c8) { u32x4 o;
#pragma unroll
                for (int i = 0; i < 4; ++i) o[i] = pk2(sh[(kh * 32 + c8 * 8 + 2 * i) * 257 + nl], sh[(kh * 32 + c8 * 8 + 2 * i + 1) * 257 + nl]);
                *(u32x4*)(d + c8 * 8) = o; }
        }
    }
    __syncthreads();
}
__device__ __forceinline__ void xpose_job(LAS uchar* lds, const float* src, int K, int N, bf16_t* dst, int ldd, int mode, const float* gain, int lds_src = 0) {
    const int nkt = K >> 6, nnt = (N + 255) >> 8, tot = nkt * nnt;
    for (int u = blockIdx.x; u < tot; u += gridDim.x) xpose_tile(lds, src, K, N, dst, ldd, mode, gain, u % nkt, u / nkt, lds_src);
}
__device__ __forceinline__ void expert_weights(LAS uchar* lds, const Params& p, int l) {
    bf16_t* wgu = (bf16_t*)(p.ws + WS_WGU); bf16_t* wd = (bf16_t*)(p.ws + WS_WD);
    const float* g2 = p.in[18] + l * DM;
    const int nb = (int)gridDim.x > 64 ? (int)gridDim.x - 64 : (int)gridDim.x, b0 = (int)gridDim.x > 64 ? (int)blockIdx.x - 64 : (int)blockIdx.x;
    if (b0 < 0) return;
    for (int u = b0; u < 32 * 48; u += nb) {
        const int e = u / 48, w = u % 48, job = w >> 4, tl = w & 15;
        if (job == 0) xpose_tile(lds, p.in[23] + ((size_t)l * 32 + e) * DM * 256, DM, 256, wgu + (size_t)e * 512 * DM, DM, 2, g2, tl, 0);
        else if (job == 1) xpose_tile(lds, p.in[24] + ((size_t)l * 32 + e) * DM * 256, DM, 256, wgu + (size_t)e * 512 * DM, DM, 3, g2, tl, 0);
        else xpose_tile(lds, p.in[25] + ((size_t)l * 32 + e) * 256 * DM, 256, DM, wd + (size_t)e * DM * 256, 256, 0, nullptr, tl & 3, tl >> 2);
    }
}
__device__ __forceinline__ void row_prep(const float* xrow, bf16_t* xb, float* rstd, int lane) {
    float ss = 0.f; f32x4 v[4];
#pragma unroll
    for (int i = 0; i < 4; ++i) { v[i] = *(const f32x4*)(xrow + i * 256 + lane * 4); ss += v[i][0] * v[i][0] + v[i][1] * v[i][1] + v[i][2] * v[i][2] + v[i][3] * v[i][3]; }
    ss = wave_sum(ss);
#pragma unroll
    for (int i = 0; i < 4; ++i) { u32x2 o; o[0] = pk2(v[i][0], v[i][1]); o[1] = pk2(v[i][2], v[i][3]); *(u32x2*)(xb + i * 256 + lane * 4) = o; }
    if (lane == 0) *rstd = __builtin_amdgcn_rsqf(ss * (1.f / 1024.f) + EPS);
}

__device__ __forceinline__ void phase0(LAS uchar* lds, const Params& p) {
    uchar* ws = p.ws; const int tid = tid_opaque(), gtid = blockIdx.x * NT + tid, gsz = gridDim.x * NT;
    for (int idx = blockIdx.x; idx < NL * 202; idx += gridDim.x) {
        const int l = idx / 202, j = idx % 202;
        if (j < 128) xpose_tile(lds, p.in[2] + (size_t)l * DM * NIN, DM, 1888, (bf16_t*)(ws + WS_WIN) + (size_t)l * NINP * DM, DM, 0, p.in[1] + l * DM, j & 15, j >> 4, NIN);
        else if (j < 192) xpose_tile(lds, p.in[17] + (size_t)l * DM * DM, DM, DM, (bf16_t*)(ws + WS_WOUT) + (size_t)l * DM * DM, DM, 0, nullptr, (j - 128) & 15, (j - 128) >> 4);
        else if (j < 198) xpose_tile(lds, p.in[9] + (size_t)l * 192 * 384, 192, 384, (bf16_t*)(ws + WS_WUQ) + (size_t)l * 512 * 192, 192, 1, p.in[7] + l * 192, (j - 192) % 3, (j - 192) / 3);
        else xpose_tile(lds, p.in[10] + (size_t)l * 128 * 512, 128, 512, (bf16_t*)(ws + WS_WUKV) + (size_t)l * 512 * 128, 128, 0, p.in[8] + l * 128, (j - 198) & 1, (j - 198) >> 1);
    }
    for (int l = 0; l < NL; ++l) {
        for (int i = gtid; i < 256 * DM; i += gsz) {
            const int k = i & 1023, n = i >> 10, g = n >> 6, d = n & 63;
            const float* wi = p.in[2] + ((size_t)l * DM + k) * NIN + 1888 + g * 64; const float* pw = p.in[15] + ((size_t)l * 4 + g) * 64 * 64 + d;
            float acc = 0.f;
            for (int c = 0; c < 64; ++c) acc += wi[c] * pw[c * 64];
            ((bf16_t*)(ws + WS_WIN))[((size_t)l * NINP + 1888 + n) * DM + k] = f2bf(acc * p.in[1][l * DM + k] * p.in[16][l * 256 + n]);
        }
        { bf16_t* w = (bf16_t*)(ws + WS_WIN) + ((size_t)l * NINP + NIN) * DM; for (int i = gtid; i < 32 * DM; i += gsz) w[i] = 0; }
        { bf16_t* w = (bf16_t*)(ws + WS_WUQ) + (size_t)l * 512 * 192; for (int i = gtid; i < 4 * 32 * 192; i += gsz) { const int hd = i / (32 * 192), rem = i % (32 * 192); w[(size_t)(hd * 128 + 96) * 192 + rem] = 0; } }
    }
    for (int i = gtid; i < NL * 128 * 1024; i += gsz) {
        const int k = i & 1023, n = (i >> 10) & 127, l = i >> 17;
        float v = 0.f;
        if (n < 4) v = p.in[19][((size_t)l * DM + k) * 4 + n]; else if (n < 36) v = p.in[21][((size_t)l * DM + k) * 32 + (n - 4)];
        v *= p.in[18][l * DM + k];
        const bf16_t hi = f2bf(v), lo = f2bf(v - bf2f(hi));
        bf16_t* w = (bf16_t*)(ws + WS_WR) + ((size_t)l * 128 + n) * 3072 + k;
        w[0] = hi; w[1024] = hi; w[2048] = lo;
    }
    for (int i = gtid; i < S * 16; i += gsz) {
        const int pos = i >> 4, f = i & 15;
        double inv = 1.0; for (int k = 0; k < f; ++k) inv *= 0.5623413251903491;
        const double rev = (double)pos * inv * 0.15915494309189535;
        const float fr = (float)(rev - __builtin_rint(rev));
        ((float*)(ws + WS_ROPE))[i] = __builtin_amdgcn_cosf(fr);
        ((float*)(ws + WS_ROPE))[S * 16 + i] = __builtin_amdgcn_sinf(fr);
    }
    if (blockIdx.x == 0 && (tid >> 6) < NL) {
        const int l = tid >> 6, lane = tid & 63; float* sc = (float*)(ws + WS_SCAL) + 16 * l;
        const float* lv = p.in[5] + l * 256;
        const float d1 = wave_sum(lv[lane] * lv[64 + lane]), d2 = wave_sum(lv[128 + lane] * lv[192 + lane]);
        float gq = fabsf(p.in[3][l * 64 + lane]), gk = fabsf(p.in[4][l * 64 + lane]);
        float a = fabsf(p.in[11][l * 64 + lane]), c = fabsf(p.in[13][l * 64 + lane]);
        float bq = fabsf(p.in[12][l * 32 + (lane & 31)]), dk = fabsf(p.in[14][l * 32 + (lane & 31)]);
#pragma unroll
        for (int o = 32; o >= 1; o >>= 1) { gq = fmaxf(gq, __shfl_xor(gq, o)); gk = fmaxf(gk, __shfl_xor(gk, o)); a = fmaxf(a, __shfl_xor(a, o)); c = fmaxf(c, __shfl_xor(c, o));
            bq = fmaxf(bq, __shfl_xor(bq, o)); dk = fmaxf(dk, __shfl_xor(dk, o)); }
        if (lane == 0) {
            const float lam_init = 0.8f - 0.6f * expf(-0.3f * (float)l);
            sc[0] = expf(d1) - expf(d2) + lam_init; sc[1] = 1.f - lam_init;
            sc[2] = gq * gk * 8.f * LOG2E * 1.02f;
            sc[3] = sqrtf(64.f * a * a + 32.f * bq * bq) * sqrtf(64.f * c * c + 32.f * dk * dk) * QSCALE_M * 1.02f;
        }
    }
    {
        const int lane = tid & 63, gw = gtid >> 6, nw = gsz >> 6;
        for (int t = gw; t < T; t += nw) row_prep(p.in[0] + (size_t)t * DM, (bf16_t*)(ws + WS_XB) + (size_t)t * DM, (float*)(ws + WS_RSTD1) + t, lane);
    }
}

struct MkProj { int mt, pn, l; const Params* p; __device__ __forceinline__ EpiProj operator()(int half) const { return EpiProj{mt, 2 * pn + half, l, p}; } };
__device__ __forceinline__ void ph_gemm1(LAS uchar* lds, const Params& p, int l) {
    const bf16_t* xb = (const bf16_t*)(p.ws + WS_XB); const bf16_t* win = (const bf16_t*)(p.ws + WS_WIN) + (size_t)l * NINP * DM;
    if (SHADOW_G >= 0) for (int u0 = blockIdx.x; u0 < 512; u0 += gridDim.x) {
        const int xg = u0 & 7, v = u0 >> 3, mt = (v >> 3) * 8 + xg, pn = v & 7;
        MkProj mk{mt, pn, l, &p};
        { const int tp = tid_opaque(); if (tp < 256) ((LAS float*)(lds + LDS_ROW))[tp] = ((const float*)(p.ws + WS_RSTD1))[mt * 256 + tp]; }
        gemm_big<(SHADOW_G >= 0 ? SHADOW_G : 0)>(lds, ARowLinear{xb + (size_t)mt * 256 * DM, (size_t)DM}, win + (size_t)pn * 256 * DM, (size_t)DM, DM, mk);
    }
    for (int u0 = blockIdx.x; u0 < 64 * 8; u0 += gridDim.x) {
        const int xg = u0 & 7, v = u0 >> 3, mt = (v >> 3) * 8 + xg, pn = ((v & 7) + 4 * ((v >> 5) & 1)) & 7;
        MkProj mk{mt, pn, l, &p};
        { const int tp = tid_opaque(); if (tp < 256) ((LAS float*)(lds + LDS_ROW))[tp] = ((const float*)(p.ws + WS_RSTD1))[mt * 256 + tp]; }
        gemm_big8(lds, xb + (size_t)mt * 256 * DM, win + (size_t)pn * 256 * DM, DM, mk);
    }
}
__device__ __forceinline__ void gemm1_tail_unit(LAS uchar* lds, const Params& p, int l, int mt) {
    const bf16_t* xb = (const bf16_t*)(p.ws + WS_XB); const bf16_t* win = (const bf16_t*)(p.ws + WS_WIN) + (size_t)l * NINP * DM;
    ARowLinear ar{xb + (size_t)mt * 256 * DM, (size_t)DM};
    EpiProj ep{mt, 16, l, &p};
    { const int tp = tid_opaque(); if (tp < 256) ((LAS float*)(lds + LDS_ROW))[tp] = ((const float*)(p.ws + WS_RSTD1))[mt * 256 + tp]; }
    gemm_tile(lds, ar, win + (size_t)16 * 128 * DM, (size_t)DM, DM, ep);
}
template <int HALF>
__device__ __forceinline__ void pool_rows(const float (&v)[48], int sfirst, bf16_t* dst) {
    float run = 0.f;
#pragma unroll
    for (int i = 8 - HALF; i < 8 + HALF; ++i) run += v[i];
#pragma unroll
    for (int r = 0; r < 32; ++r) {
        const int s = sfirst + r; int lo = s - HALF, hi = s + HALF - 1; lo = lo < 0 ? 0 : lo; hi = hi > S - 1 ? S - 1 : hi;
        const float o = run * __builtin_amdgcn_rcpf((float)(hi - lo + 1)) - v[r + 8];
        dst[(size_t)r * DM] = f2bf(o);
        if (r < 31) run += v[r + 8 + HALF] - v[r + 8 - HALF];
    }
}
__device__ __forceinline__ void pooled_unit(LAS uchar* lds, const Params& p, int ut) {
    const int tid = tid_opaque();
    const int t0 = ut * 64, b = t0 >> 11, s0 = t0 & 2047;
    const bf16_t* lat = (const bf16_t*)(p.ws + WS_LAT) + (size_t)b * S * 640 + 352;
    for (int it = 0; it < 5; ++it) {
        const int item = it * NT + tid, c8 = item & 31, rl = item >> 5, sr = s0 - 8 + rl;
        u32x4 v = {0u, 0u, 0u, 0u};
        if (sr >= 0 && sr < S) v = *(const u32x4*)(lat + (size_t)sr * 640 + c8 * 8);
        *(LAS u32x4*)(lds + rl * 512 + c8 * 16) = v;
    }
    __syncthreads();
    {
        const int c = tid & 255, rh = tid >> 8, g = __builtin_amdgcn_readfirstlane(c >> 6);
        bf16_t* dst = (bf16_t*)(p.ws + WS_MIX) + (size_t)(t0 + rh * 32) * DM + 768 + c;
        const LAS bf16_t* col = (const LAS bf16_t*)lds + (rh * 32) * 256 + c;
        float v[48];
#pragma unroll
        for (int i = 0; i < 48; ++i) v[i] = bf2f(col[i * 256]);
        const int sfirst = s0 + rh * 32;
        if (g == 0) pool_rows<1>(v, sfirst, dst); else if (g == 1) pool_rows<2>(v, sfirst, dst); else if (g == 2) pool_rows<4>(v, sfirst, dst); else pool_rows<8>(v, sfirst, dst);
    }
    __syncthreads();
}
__device__ __forceinline__ void mla_up_unit(LAS uchar* lds, const Params& p, int l, int v) {
    const bf16_t* lat = (const bf16_t*)(p.ws + WS_LAT);
    const int mt = v >> 3, w = v & 7, h = w & 3;
    { const int tp = tid_opaque(); if (tp < 256) { const float* hs = (const float*)(p.ws + WS_HSS) + (size_t)(mt * 256 + tp) * 8;
        const f32x4 h0 = *(const f32x4*)hs; const float h4 = hs[4];
        ((LAS float*)(lds + LDS_ROW))[tp] = (w < 4) ? __builtin_amdgcn_rsqf((h0[0] + h0[1] + h0[2]) * (1.f / 192.f) + EPS) : __builtin_amdgcn_rsqf((h0[3] + h4) * (1.f / 128.f) + EPS); } }
    if (w < 4) { ARowLinear ar{lat + (size_t)mt * 256 * 640, (size_t)640}; EpiMlaQ ep{mt, h, l, &p};
        gemm_tile(lds, ar, (const bf16_t*)(p.ws + WS_WUQ) + ((size_t)l * 512 + h * 128) * 192, (size_t)192, 192, ep); }
    else { ARowLinear ar{lat + (size_t)mt * 256 * 640 + 192, (size_t)640}; EpiMlaKV ep{mt, h, l, &p};
        gemm_tile(lds, ar, (const bf16_t*)(p.ws + WS_WUKV) + ((size_t)l * 512 + h * 128) * 128, (size_t)128, 128, ep); }
}
__device__ __forceinline__ void ph_mix_a(LAS uchar* lds, const Params& p, int l) {
    const int G = (int)gridDim.x;
    if (G == 256) {
        const int xg = blockIdx.x & 7, j = blockIdx.x >> 3;
        if (SHADOW_V >= 0) { diff_attn_unit<(SHADOW_V >= 0 ? SHADOW_V : 0)>(lds, p, l, xg, 2 + (j >> 4), j & 15); }
        diff_attn_unit<0>(lds, p, l, xg, 2 + (j >> 4), j & 15);
        if (j < 16) diff_attn_unit<0>(lds, p, l, xg, 1, j);
        else {
            diff_attn_unit<0>(lds, p, l, xg, 0, j - 16);
            if (j < 24) gemm1_tail_unit(lds, p, l, xg + 8 * (j - 16));
            const int n0 = j < 24 ? (j - 16) * 2 : 16 + (j - 24) * 6, n1 = j < 24 ? n0 + 2 : n0 + 6;
            for (int n = n0; n < n1; ++n) mla_up_unit(lds, p, l, (xg + 8 * (n >> 3)) * 8 + (n & 7));
        }
    } else {
        for (int u = blockIdx.x; u < 512 + 512 + 64; u += G) {
            if (u < 512) diff_attn_unit<0>(lds, p, l, u >> 6, (u >> 4) & 3, u & 15);
            else if (u < 1024) mla_up_unit(lds, p, l, u - 512);
            else gemm1_tail_unit(lds, p, l, u - 1024);
        }
    }
}
__device__ __forceinline__ void ph_mix_b(LAS uchar* lds, const Params& p, int l) {
    (void)l;
    for (int u = blockIdx.x; u < 256 + 256; u += gridDim.x) {
        if (u < 256) mla_attn_unit(lds, p, l, u);
        else pooled_unit(lds, p, u - 256);
    }
}
struct MkWout { int mt, pn; const float* xres; const Params* p; __device__ __forceinline__ EpiWout operator()(int half) const { return EpiWout{mt, 2 * pn + half, xres, p}; } };
__device__ __forceinline__ void ph_wout(LAS uchar* lds, const Params& p, int l) {
    const bf16_t* mix = (const bf16_t*)(p.ws + WS_MIX); const bf16_t* wo = (const bf16_t*)(p.ws + WS_WOUT) + (size_t)l * DM * DM;
    const float* xres = (l == 0) ? p.in[0] : p.out;
    for (int u0 = blockIdx.x; u0 < 64 * 4; u0 += gridDim.x) {
        const int xg = u0 & 7, v = u0 >> 3, mt = (v >> 2) * 8 + xg, pn = v & 3;
        MkWout mk{mt, pn, xres, &p};
        gemm_big8(lds, mix + (size_t)mt * 256 * DM, wo + (size_t)pn * 256 * DM, DM, mk);
    }
}
constexpr int LDS_RT = 135168;
struct EpiRouter {
    int mt, l; bool dry; const Params* p;
    __device__ __forceinline__ void operator()(const LAS uchar* ct) const {
        uchar* ws = p->ws; const int tid = tid_opaque();
        const LAS float* ctf = (const LAS float*)ct;
        LAS unsigned* shcnt = (LAS unsigned*)(ct + LDS_RT); LAS unsigned* shbase = shcnt + 32; LAS unsigned* pend = shcnt + 64;
        unsigned* cnt = (unsigned*)(ws + WS_CTL) + CW_CNT + 1024 * l + (dry ? 2048 : 0);
        unsigned* list = (unsigned*)(ws + (dry ? WS_POOLED : WS_LIST)); float* gwt = (float*)(ws + (dry ? WS_POOLED + 4 * MiB : WS_GW)); float* rstd2 = (float*)(ws + (dry ? WS_POOLED + 5 * MiB : WS_RSTD2));
        const float* bg = p->in[20] + l * 4; const float* be = p->in[22] + l * 32;
        if (tid < 32) shcnt[tid] = 0u;
        __syncthreads();
        if (tid < 256) {
            const int t = mt * 256 + tid;
            const float* ps = (const float*)(ws + WS_PSS) + (size_t)t * 8;
            const f32x4 p0 = *(const f32x4*)ps, p1 = *(const f32x4*)(ps + 4);
            const float ss = ((p0[0] + p0[1]) + (p0[2] + p0[3])) + ((p1[0] + p1[1]) + (p1[2] + p1[3]));
            const float rs = __builtin_amdgcn_rsqf(ss * (1.f / 1024.f) + EPS);
            const LAS float* row = ctf + tid * CTF_PITCH;
            float gl[4];
#pragma unroll
            for (int n = 0; n < 4; ++n) gl[n] = row[n] * rs + bg[n];
            int gi = 0; float gm = gl[0];
#pragma unroll
            for (int n = 1; n < 4; ++n) if (gl[n] > gm) { gm = gl[n]; gi = n; }
            float gs = 0.f;
#pragma unroll
            for (int n = 0; n < 4; ++n) gs += __expf(gl[n] - gm);
            const float gtop = 1.f / gs;
            float el[8];
#pragma unroll
            for (int n = 0; n < 8; ++n) el[n] = row[4 + gi * 8 + n] * rs + be[gi * 8 + n];
            int i1 = 0; float m1 = el[0];
#pragma unroll
            for (int n = 1; n < 8; ++n) if (el[n] > m1) { m1 = el[n]; i1 = n; }
            int i2 = -1; float m2v = -3.0e38f;
#pragma unroll
            for (int n = 0; n < 8; ++n) if (n != i1 && el[n] > m2v) { m2v = el[n]; i2 = n; }
            const float e2 = __expf(m2v - m1); const float w1 = gtop / (1.f + e2), w2 = gtop * e2 / (1.f + e2);
            const int ea = gi * 8 + i1, eb = gi * 8 + i2;
            const unsigned pa = __hip_atomic_fetch_add(&shcnt[ea], 1u, __ATOMIC_RELAXED, __HIP_MEMORY_SCOPE_WORKGROUP);
            const unsigned pbk = __hip_atomic_fetch_add(&shcnt[eb], 1u, __ATOMIC_RELAXED, __HIP_MEMORY_SCOPE_WORKGROUP);
            pend[tid * 2] = ((unsigned)ea << 16) | pa; pend[tid * 2 + 1] = ((unsigned)eb << 16) | pbk;
            gwt[t * 2] = w1; gwt[t * 2 + 1] = w2; rstd2[t] = rs;
        }
        __syncthreads();
        if (tid < 32) { const unsigned c = shcnt[tid]; shbase[tid] = c ? atomicAdd(&cnt[tid * 32], c) : 0u; }
        __syncthreads();
        { const unsigned pe = pend[tid], e = pe >> 16, lp = pe & 0xffffu; list[(size_t)e * T + shbase[e] + lp] = (unsigned)((mt * 256 + (tid >> 1)) * 2 + (tid & 1)); }
    }
};
__device__ __forceinline__ void ph_router(LAS uchar* lds, const Params& p, int l, bool dry = false) {
    const bf16_t* xb = (const bf16_t*)(p.ws + WS_XB); const bf16_t* wr = (const bf16_t*)(p.ws + WS_WR) + (size_t)l * 128 * 3072;
    for (int u = blockIdx.x; u < 64; u += gridDim.x) {
        ARowLinear ar{xb + (size_t)u * 256 * DM, (size_t)DM}; EpiRouter ep{u, l, dry, &p};
        AOffRouter ao{(int)((WS_XL - WS_XB) / 2)};
        gemm_tile<true>(lds, ar, wr, (size_t)3072, 3072, ep, ao);
    }
    if (!dry) expert_weights(lds, p, l);
}
struct MoeMap {
    LAS int* m;
    __device__ __forceinline__ void init(LAS uchar* lds, const unsigned* cnt) {
        m = (LAS int*)(lds + LDS_MOE);
        const int tid = tid_opaque();
        if (tid < 64) {
            const int lane = tid, c = lane < 32 ? (int)cnt[lane * 32] : 0, f = c >> 8, pr = (c & 255) ? 1 : 0;
            int sb = f + pr;
#pragma unroll
            for (int o = 1; o < 32; o <<= 1) { const int tb = __shfl_up(sb, o); if (lane >= o) sb += tb; }
            if (lane < 32) { m[lane] = f; m[32 + lane] = pr; m[64 + lane] = sb - (f + pr); m[96 + lane] = c; }
        }
        __syncthreads();
    }
    __device__ __forceinline__ int group_total(int g, int NB, int NS) const {
        int t = 0;
#pragma unroll
        for (int i = 0; i < 4; ++i) t += m[g + 8 * i] * NB + m[32 + g + 8 * i] * NS;
        return __builtin_amdgcn_readfirstlane(t);
    }
    __device__ __forceinline__ void group_find(int g, int v, int NB, int NS, bool& big, int& col, int& e, int& rb, int& rbg, int& nvalid) const {
        big = false; col = 0; e = g; rb = 0; rbg = 0; nvalid = 256; bool found = false;
#pragma unroll
        for (int i = 0; i < 4; ++i) { const int ee = g + 8 * i, fe = __builtin_amdgcn_readfirstlane(m[ee]), n = fe * NB;
            if (!found) { if (v < n) { found = true; big = true; e = ee; rb = v / NB; col = v % NB; rbg = __builtin_amdgcn_readfirstlane(m[64 + ee]) + rb; nvalid = 256; } else v -= n; } }
#pragma unroll
        for (int i = 0; i < 4; ++i) { const int ee = g + 8 * i, pe = __builtin_amdgcn_readfirstlane(m[32 + ee]), n = pe * NS;
            if (!found) { if (v < n) { found = true; big = false; e = ee; rb = __builtin_amdgcn_readfirstlane(m[ee]); col = v; rbg = __builtin_amdgcn_readfirstlane(m[64 + ee]) + rb; nvalid = __builtin_amdgcn_readfirstlane(m[96 + ee]) & 255; } else v -= n; } }
    }
};
struct MkGU { int pn; size_t slot0; const Params* p; __device__ __forceinline__ EpiGU operator()(int half) const { return EpiGU{2 * pn + half, slot0, p}; } };
__device__ __forceinline__ void ph_gateup(LAS uchar* lds, const Params& p, int l) {
    uchar* ws = p.ws; const unsigned* cnt = (const unsigned*)(ws + WS_CTL) + CW_CNT + 1024 * l;
    MoeMap mm; mm.init(lds, cnt);
    const int grp = blockIdx.x & 7, rank = blockIdx.x >> 3, nrank = ((int)gridDim.x + 7 - grp) >> 3, tot = mm.group_total(grp, 2, 4);
    for (int u = rank; u < tot; u += nrank) {
        bool big; int col, e, rb, rbg, nvalid; mm.group_find(grp, u, 2, 4, big, col, e, rb, rbg, nvalid);
        const unsigned* list = (const unsigned*)(ws + WS_LIST) + (size_t)e * T + rb * 256;
        ARowGather ar{(const bf16_t*)(ws + WS_XB), list, nvalid};
        { const int tp = tid_opaque(); if (tp < 256) { const int rr = tp < nvalid ? tp : nvalid - 1; ((LAS float*)(lds + LDS_ROW))[tp] = ((const float*)(ws + WS_RSTD2))[list[rr] >> 1]; } }
        if (big) { const int pn = col; MkGU mk{pn, (size_t)rbg * 256, &p};
            gemm_big8g(lds, ar, (const bf16_t*)(ws + WS_WGU) + ((size_t)e * 512 + pn * 256) * DM, DM, mk); }
        else { const int jt = col; EpiGU ep{jt, (size_t)rbg * 256, &p};
            gemm_tile(lds, ar, (const bf16_t*)(ws + WS_WGU) + ((size_t)e * 512 + jt * 128) * DM, (size_t)DM, DM, ep); }
    }
}
struct MkDown { int pn, nvalid; const Params* p; __device__ __forceinline__ EpiDown operator()(int half) const { return EpiDown{2 * pn + half, nvalid, p}; } };
__device__ __forceinline__ void ph_down(LAS uchar* lds, const Params& p, int l) {
    uchar* ws = p.ws; const unsigned* cnt = (const unsigned*)(ws + WS_CTL) + CW_CNT + 1024 * l;
    MoeMap mm; mm.init(lds, cnt);
    const int grp = blockIdx.x & 7, rank = blockIdx.x >> 3, nrank = ((int)gridDim.x + 7 - grp) >> 3, tot = mm.group_total(grp, 4, 8);
    for (int u = rank; u < tot; u += nrank) {
        bool big; int col, e, rb, rbg, nvalid; mm.group_find(grp, u, 4, 8, big, col, e, rb, rbg, nvalid);
        const unsigned* list = (const unsigned*)(ws + WS_LIST) + (size_t)e * T + rb * 256;
        ARowLinear ar{(const bf16_t*)(ws + WS_HMID) + (size_t)rbg * 256 * 256, (size_t)256};
        { const int tp = tid_opaque(); if (tp < 256) { const int rr = tp < nvalid ? tp : nvalid - 1; const unsigned ent = list[rr];
            ((LAS unsigned*)(lds + LDS_ROW + 1024))[tp] = ent; ((LAS float*)(lds + LDS_ROW))[tp] = ((const float*)(ws + WS_GW))[ent]; } }
        if (big) { const int pn = col; MkDown mk{pn, nvalid, &p};
            gemm_big(lds, ar, (const bf16_t*)(ws + WS_WD) + ((size_t)e * DM + pn * 256) * 256, (size_t)256, 256, mk); }
        else { const int nt = col; EpiDown ep{nt, nvalid, &p};
            gemm_tile(lds, ar, (const bf16_t*)(ws + WS_WD) + ((size_t)e * DM + nt * 128) * 256, (size_t)256, 256, ep); }
    }
}
__device__ __forceinline__ void ph_combine(LAS uchar* lds, const Params& p, int l, bool dry = false) {
    uchar* ws = p.ws; const int tid = tid_opaque(), lane = tid & 63;
    const int gw = blockIdx.x * 8 + (tid >> 6), nw = gridDim.x * 8;
    const bf16_t* ys = (const bf16_t*)(ws + WS_YS);
    for (int t = gw; t < T; t += nw) {
        const bf16_t* xh = (const bf16_t*)(ws + WS_XB) + (size_t)t * DM; const bf16_t* xl = (const bf16_t*)(ws + WS_XL) + (size_t)t * DM;
        const bf16_t* y0 = ys + (size_t)(2 * t) * DM; const bf16_t* y1 = y0 + DM;
        float* xw = dry ? (float*)(ws + WS_POOLED) + (size_t)(t & 511) * DM : p.out + (size_t)t * DM;
        bf16_t* xb = dry ? (bf16_t*)(ws + WS_POOLED + 4 * MiB) + (size_t)(t & 511) * DM : (bf16_t*)(ws + WS_XB) + (size_t)t * DM;
        float ss = 0.f;
#pragma unroll
        for (int i = 0; i < 4; ++i) {
            const int c = i * 256 + lane * 4;
            const u32x2 hv = *(const u32x2*)(xh + c), lv = *(const u32x2*)(xl + c);
            f32x4 v; v[0] = bflo(hv[0]) + bflo(lv[0]); v[1] = bfhi(hv[0]) + bfhi(lv[0]); v[2] = bflo(hv[1]) + bflo(lv[1]); v[3] = bfhi(hv[1]) + bfhi(lv[1]);
            const u32x2 a = *(const u32x2*)(y0 + c), bq = *(const u32x2*)(y1 + c);
            v[0] += bflo(a[0]) + bflo(bq[0]); v[1] += bfhi(a[0]) + bfhi(bq[0]); v[2] += bflo(a[1]) + bflo(bq[1]); v[3] += bfhi(a[1]) + bfhi(bq[1]);
            *(f32x4*)(xw + c) = v; ss += v[0] * v[0] + v[1] * v[1] + v[2] * v[2] + v[3] * v[3];
            if (l + 1 < NL || dry) { u32x2 o; o[0] = pk2(v[0], v[1]); o[1] = pk2(v[2], v[3]); *(u32x2*)(xb + c) = o; }
        }
        ss = wave_sum(ss);
        if (lane == 0) ((float*)(ws + (dry ? WS_POOLED + 6 * MiB : WS_RSTD1)))[t] = __builtin_amdgcn_rsqf(ss * (1.f / 1024.f) + EPS);
    }

}

__global__ void __launch_bounds__(NT, 2) mega(Params p) {
    extern __shared__ __attribute__((aligned(16))) unsigned char smem[];
    LAS uchar* lds = (LAS uchar*)smem;
    if (threadIdx.x == 0) { *(LAS u32x4*)(lds + LDS_XB) = (u32x4){0u, 0u, 0u, 0u}; }
    __syncthreads();
    XcdBarrier bar = xcd_barrier_post((unsigned*)(p.ws + WS_CTL), (volatile LAS unsigned*)(lds + LDS_XB));
#define IN(k) (p.ph_lo <= (k) && (k) < p.ph_hi)
#define SEAM(k) do { if (IN(k) && IN((k) + 1)) xcd_barrier(bar); } while (0)
    if (IN(0)) for (int rep = 0; rep < NREP(8); ++rep) phase0(lds, p);
    SEAM(0);
#define LAUNDER(v) asm volatile("" : "+s"(v))
#pragma unroll 1
    for (int l0 = 0; l0 < NL; ++l0) {
        const int pb = 1 + 8 * l0;
        { int l = l0; LAUNDER(l); if (IN(pb + 0)) for (int rep = 0; rep < NREP(0); ++rep) ph_gemm1(lds, p, l); }
        SEAM(pb + 0);
        { int l = l0; LAUNDER(l); if (IN(pb + 1)) for (int rep = 0; rep < NREP(1); ++rep) ph_mix_a(lds, p, l); }
        SEAM(pb + 1);
        { int l = l0; LAUNDER(l); if (IN(pb + 2)) for (int rep = 0; rep < NREP(2); ++rep) ph_mix_b(lds, p, l); }
        SEAM(pb + 2);
        { int l = l0; LAUNDER(l); if (IN(pb + 3)) for (int rep = 0; rep < (l == 0 ? NREP(3) : 1); ++rep) ph_wout(lds, p, l); }
        SEAM(pb + 3);
        { int l = l0; LAUNDER(l); if (IN(pb + 4)) { if (NREP(4) > 1) ph_router(lds, p, l, true); ph_router(lds, p, l); } }
        SEAM(pb + 4);
        { int l = l0; LAUNDER(l); if (IN(pb + 5)) for (int rep = 0; rep < NREP(5); ++rep) ph_gateup(lds, p, l); }
        SEAM(pb + 5);
        { int l = l0; LAUNDER(l); if (IN(pb + 6)) for (int rep = 0; rep < NREP(6); ++rep) ph_down(lds, p, l); }
        SEAM(pb + 6);
        { int l = l0; LAUNDER(l); if (IN(pb + 7)) { if (NREP(7) > 1) ph_combine(lds, p, l, true); ph_combine(lds, p, l); } }
        SEAM(pb + 7);
    }
}

extern "C" void kernel_launch(void* const* d_in, const int* in_sizes, int n_in, void* d_out, int out_size, void* d_ws, size_t ws_size, hipStream_t stream) {
    (void)in_sizes; (void)n_in; (void)out_size;
    static int grid = 0;
    if (!grid) {
        int dev = 0, cus = 0, per_cu = 0;
        hipGetDevice(&dev);
        hipDeviceGetAttribute(&cus, hipDeviceAttributeMultiprocessorCount, dev);
        hipFuncSetAttribute((const void*)mega, hipFuncAttributeMaxDynamicSharedMemorySize, LDS_BYTES);
        hipOccupancyMaxActiveBlocksPerMultiprocessor(&per_cu, (const void*)mega, NT, LDS_BYTES);
        if (per_cu > 1) per_cu = 1;
        if (per_cu < 1) per_cu = 1;
        grid = cus * per_cu;
    }
    if (ws_size < WS_END) { fprintf(stderr, "workspace too small: %zu < %zu\n", ws_size, (size_t)WS_END); return; }
    hipMemsetAsync(d_ws, 0, CTL_ZERO_BYTES, stream);
    Params p{};
    for (int i = 0; i < 26; ++i) p.in[i] = (const float*)d_in[i];
    p.out = (float*)d_out; p.ws = (unsigned char*)d_ws;
#if N_LAUNCH_SPLIT
    for (int k = 0; k < NPH; ++k) { p.ph_lo = k; p.ph_hi = k + 1; hipLaunchKernelGGL(mega, dim3(grid), dim3(NT), LDS_BYTES, stream, p); }
#else
    p.ph_lo = 0; p.ph_hi = NPH;
    hipLaunchKernelGGL(mega, dim3(grid), dim3(NT), LDS_BYTES, stream, p);
#endif
}
```

```cpp
#include <hip/hip_runtime.h>
#include <stdint.h>
#include <stdio.h>

#ifndef NAIVE_GEMM
#define NAIVE_GEMM 0
#endif
#ifndef NAIVE_ATTN
#define NAIVE_ATTN 0
#endif
#ifndef N_LAUNCH_SPLIT
#define N_LAUNCH_SPLIT 0
#endif

#ifndef SHADOW_V
#define SHADOW_V -1
#endif
#ifndef SHADOW_G
#define SHADOW_G -1
#endif
#ifndef REPEAT_MASK
#define REPEAT_MASK 0
#endif
#define NREP(k) ((((REPEAT_MASK) >> (k)) & 1) + 1)
#define LAS __attribute__((address_space(3)))
typedef unsigned char uchar;
typedef unsigned short bf16_t;
typedef short bf16x8 __attribute__((ext_vector_type(8)));
typedef float f32x16 __attribute__((ext_vector_type(16)));
typedef float f32x2_t __attribute__((ext_vector_type(2)));
typedef __bf16 bf16x2_t __attribute__((ext_vector_type(2)));
typedef unsigned u32x4 __attribute__((ext_vector_type(4)));
typedef unsigned u32x2 __attribute__((ext_vector_type(2)));
typedef float f32x4 __attribute__((ext_vector_type(4)));

constexpr int NB = 8, S = 2048, DM = 1024, T = NB * S, NL = 2;
constexpr int NIN = 2144, NINP = 2176;
constexpr float EPS = 1e-6f, LOG2E = 1.4426950408889634f;
constexpr float QSCALE_D = 0.125f * LOG2E;
constexpr float QSCALE_M = 0.10206207261596577f * LOG2E;
constexpr int NPH = 1 + 8 * NL;

constexpr size_t MiB = (size_t)1 << 20;
constexpr size_t WS_CTL = 0, CTL_ZERO_BYTES = 32768;
constexpr size_t WS_SCAL = 1 * MiB;
constexpr size_t WS_ROPE = 1 * MiB + 64 * 1024;
constexpr size_t WS_RSTD1 = 1 * MiB + 512 * 1024;
constexpr size_t WS_RSTD2 = WS_RSTD1 + 64 * 1024;
constexpr size_t WS_GW = WS_RSTD2 + 64 * 1024;
constexpr size_t WS_LIST = 2 * MiB;
constexpr size_t WS_WIN = 4 * MiB;
constexpr size_t WS_WOUT = 13 * MiB;
constexpr size_t WS_WUQ = 17 * MiB;
constexpr size_t WS_WUKV = 17 * MiB + 512 * 1024;
constexpr size_t WS_POOLW = 17 * MiB + 768 * 1024;
constexpr size_t WS_WR = 18 * MiB;
constexpr size_t WS_PSS = 19 * MiB + 512 * 1024;
constexpr size_t WS_HSS = 12 * MiB + 512 * 1024;
constexpr size_t WS_WGU = 20 * MiB;
constexpr size_t WS_WD = 52 * MiB;
constexpr size_t WS_XB = 68 * MiB;
constexpr size_t WS_MIX = 100 * MiB;
constexpr size_t WS_HMID = WS_MIX;
constexpr size_t WS_QD = 132 * MiB, WS_KD = 148 * MiB, WS_VDT = 164 * MiB;
constexpr size_t WS_LAT = 180 * MiB;
constexpr size_t WS_QM = 200 * MiB, WS_KM = 212 * MiB, WS_VMT = 224 * MiB;
constexpr size_t WS_LRS = 236 * MiB;
constexpr size_t WS_LGW = 238 * MiB;
constexpr size_t WS_POOLED = 232 * MiB;
constexpr size_t WS_YS = 132 * MiB;
constexpr size_t WS_END = 240 * MiB;

#define XB_TMO      128
#define XB_XCNT(j)  (256  + 64 * (j))
#define XB_XSUB(j)  (1280 + 64 * (j))
#define XB_XGEN(j)  (2304 + 64 * (j))
#define XB_TOP      3328
#define XB_TOPGEN   3392
#define XCD_BAR_WORDS 3456
#define XB_SPIN_CAP (1u << 18)
constexpr int CW_XROW = 3584;
constexpr int CW_CNT = 4096;

constexpr int NT = 512;
constexpr int LDS_XB = 147456;
constexpr int LDS_ROW = LDS_XB + 256;
constexpr int LDS_MOE = LDS_ROW + 2048;
constexpr int LDS_BYTES = LDS_MOE + 512;
constexpr int GSTG = 49152;
constexpr int ASTG = 32768;
constexpr int MSTG = 20480;

struct Params {
    const float* in[26];
    float* out;
    unsigned char* ws;
    int ph_lo, ph_hi;
};

__device__ __forceinline__ unsigned pk2(float lo, float hi) { f32x2_t v = {lo, hi}; bf16x2_t b = __builtin_convertvector(v, bf16x2_t); return __builtin_bit_cast(unsigned, b); }
__device__ __forceinline__ float bflo(unsigned w) { return __builtin_bit_cast(float, w << 16); }
__device__ __forceinline__ float bfhi(unsigned w) { return __builtin_bit_cast(float, w & 0xffff0000u); }
__device__ __forceinline__ float bf2f(bf16_t u) { return __builtin_bit_cast(float, (unsigned)u << 16); }
__device__ __forceinline__ bf16_t f2bf(float f) { return (bf16_t)(pk2(f, 0.f) & 0xffffu); }
__device__ __forceinline__ LAS uchar* lds_base() { extern __shared__ __attribute__((aligned(16))) unsigned char smem_dyn_[]; return (LAS uchar*)smem_dyn_; }
__device__ __forceinline__ int tid_opaque() { int t = threadIdx.x; asm volatile("" : "+v"(t)); return t; }
__device__ __forceinline__ int crow(int r, int hi) { return (r & 3) + 8 * (r >> 2) + 4 * hi; }
__device__ __forceinline__ int sigma16(int s) { return (s & ~12) | ((s & 4) << 1) | ((s & 8) >> 1); }
template <int CTRL> __device__ __forceinline__ float dpp_get(float v) { return __builtin_bit_cast(float, __builtin_amdgcn_update_dpp(0, __builtin_bit_cast(int, v), CTRL, 0xf, 0xf, false)); }
__device__ __forceinline__ float sum4(float v) { v += dpp_get<0xB1>(v); v += dpp_get<0x4E>(v); return v; }
__device__ __forceinline__ float sum8(float v) { v = sum4(v); v += dpp_get<0x141>(v); return v; }
__device__ __forceinline__ float sum16(float v) { v = sum8(v); v += dpp_get<0x140>(v); return v; }
__device__ __forceinline__ float wave_sum(float v) {
    v = sum16(v); v += __shfl_xor(v, 16); v += __shfl_xor(v, 32);
    return v;
}
__device__ __forceinline__ void unpack8(u32x4 w, float (&f)[8]) {
    f[0] = bflo(w[0]); f[1] = bfhi(w[0]); f[2] = bflo(w[1]); f[3] = bfhi(w[1]);
    f[4] = bflo(w[2]); f[5] = bfhi(w[2]); f[6] = bflo(w[3]); f[7] = bfhi(w[3]);
}

__device__ __forceinline__ unsigned xb_ld(unsigned* p)              { return __hip_atomic_load(p, __ATOMIC_RELAXED, __HIP_MEMORY_SCOPE_AGENT); }
__device__ __forceinline__ unsigned xb_add(unsigned* p, unsigned v) { return __hip_atomic_fetch_add(p, v, __ATOMIC_RELAXED, __HIP_MEMORY_SCOPE_AGENT); }
__device__ __forceinline__ unsigned xb_xcc_id() { return (unsigned)__builtin_amdgcn_s_getreg((3 << 11) | 20) & 0xFu; }
#define XB_SPIN(cond, bar) do { unsigned _sp = 0; while (cond) { __builtin_amdgcn_s_sleep(1); \
    if ((++_sp & 255u) == 0u) { if (xb_ld(&(bar)[XB_TMO])) break; if (_sp > XB_SPIN_CAP) { atomicAdd(&(bar)[XB_TMO], 1u); break; } } } } while (0)
struct XcdBarrier { unsigned* bar; unsigned x; volatile LAS unsigned* st; };
__device__ __forceinline__ XcdBarrier xcd_barrier_post(unsigned* bar, volatile LAS unsigned* st) {
    XcdBarrier b; b.bar = bar; b.x = xb_xcc_id(); b.st = st;
    if (threadIdx.x == 0) (void)xb_add(&bar[XB_XCNT(b.x)], 1u);
    return b;
}
__device__ __forceinline__ void xcd_barrier_complete(unsigned* bar, unsigned x, unsigned& nloc, unsigned& nx) {
    const unsigned G = gridDim.x * gridDim.y * gridDim.z;
    unsigned sum, cnt, mine, sp = 0u;
    for (;;) {
        sum = 0u; cnt = 0u; mine = 0u;
#pragma unroll
        for (unsigned j = 0; j < 16; ++j) { const unsigned c = xb_ld(&bar[XB_XCNT(j)]); sum += c; cnt += (c > 0u) ? 1u : 0u; mine = (j == x) ? c : mine; }
        if (sum == G) break;
        __builtin_amdgcn_s_sleep(1);
        if ((++sp & 255u) == 0u) { if (xb_ld(&bar[XB_TMO])) break; if (sp > XB_SPIN_CAP) { atomicAdd(&bar[XB_TMO], 1u); break; } }
    }
    nloc = mine > 0u ? mine : 1u; nx = cnt > 0u ? cnt : 1u;
}
__device__ __forceinline__ void xcd_barrier(const XcdBarrier& b) {
    asm volatile("s_waitcnt vmcnt(0)" ::: "memory");
    __syncthreads();
    if (threadIdx.x == 0) {
        unsigned* bar = b.bar;
        __builtin_amdgcn_s_waitcnt(0);
        unsigned nloc = b.st[0], nx = b.st[1];
        if (nloc == 0u) { xcd_barrier_complete(bar, b.x, nloc, nx); b.st[0] = nloc; b.st[1] = nx; }
        const unsigned old = xb_add(&bar[XB_XSUB(b.x)], 1u);
        const unsigned gen = old / nloc;
        if (old + 1u == (gen + 1u) * nloc) {
            __builtin_amdgcn_fence(__ATOMIC_RELEASE, "agent");
            asm volatile("s_waitcnt vmcnt(0)" ::: "memory");
            const unsigned og = xb_add(&bar[XB_TOP], 1u);
            const unsigned tg = og / nx;
            if (og + 1u == (tg + 1u) * nx) xb_add(&bar[XB_TOPGEN], 1u);
            else XB_SPIN(xb_ld(&bar[XB_TOPGEN]) == tg, bar);
            __builtin_amdgcn_fence(__ATOMIC_ACQUIRE, "agent");
            asm volatile("s_waitcnt vmcnt(0)" ::: "memory");
        } else {
            XB_SPIN(xb_ld(&bar[XB_TOPGEN]) == gen, bar);
            __builtin_amdgcn_fence(__ATOMIC_ACQUIRE, "agent");
            asm volatile("s_waitcnt vmcnt(0)" ::: "memory");
        }
    }
    __syncthreads();
}

__device__ __forceinline__ void glds16(const void* gsrc, LAS uchar* dst_wave_base) {
    __builtin_amdgcn_global_load_lds((const unsigned*)gsrc, (LAS unsigned*)dst_wave_base, 16, 0, 0);
}
__device__ __forceinline__ void glds16_nt(const void* gsrc, LAS uchar* dst_wave_base) {
    __builtin_amdgcn_global_load_lds((const unsigned*)gsrc, (LAS unsigned*)dst_wave_base, 16, 0, 2);
}
__device__ __forceinline__ int sw128(int row, int c) { return row * 128 + ((c ^ ((row >> 1) & 7)) << 4); }
__device__ __forceinline__ int sw64(int row, int c) { return row * 64 + ((c ^ ((row >> 2) & 3)) << 4); }

#define MFMA32(a, b, c) __builtin_amdgcn_mfma_f32_32x32x16_bf16((a), (b), (c), 0, 0, 0)

constexpr int CT_PITCH = 272;
#define WAITV(n) asm volatile("s_waitcnt vmcnt(" #n ")" ::: "memory")
struct ARowNone { static constexpr bool GATHER = false; __device__ __forceinline__ const bf16_t* operator()(int) const { return nullptr; } };
struct ARowLinear { const bf16_t* base; size_t ld; __device__ __forceinline__ const bf16_t* operator()(int r) const { return base + (size_t)r * ld; } };
struct ARowGather { static constexpr bool GATHER = true; const bf16_t* base; const unsigned* list; int nvalid; __device__ __forceinline__ const bf16_t* operator()(int r) const {
    const int rr = r < nvalid ? r : nvalid - 1; const unsigned ent = list[rr]; return base + (size_t)(ent >> 1) * DM; } };

struct AOffLinear { __device__ __forceinline__ int operator()(int kt) const { return kt * 64; } };
constexpr int CTF_PITCH = 129;
template <bool F32C = false, class ARow, class Epi, class AOff = AOffLinear>
__device__ __forceinline__ void gemm_tile(LAS uchar* lds, const ARow& arow, const bf16_t* Bt, size_t ldb, int K, const Epi& epi, const AOff aoff = AOff()) {
    const int tid = tid_opaque(), lane = tid & 63, wid = __builtin_amdgcn_readfirstlane(tid >> 6);
#if NAIVE_GEMM
    {
        const int r = tid >> 1, nh = tid & 1;
        float acc[64];
#pragma unroll
        for (int n = 0; n < 64; ++n) acc[n] = 0.f;
        const bf16_t* ar = arow(r);
        for (int k = 0; k < K; k += 8) {
            float a[8]; unpack8(*(const u32x4*)(ar + k), a);
#pragma unroll
            for (int n = 0; n < 64; ++n) {
                float b[8]; unpack8(*(const u32x4*)(Bt + (size_t)(nh * 64 + n) * ldb + k), b);
#pragma unroll
                for (int j = 0; j < 8; ++j) acc[n] += a[j] * b[j];
            }
        }
        __syncthreads();
#pragma unroll
        for (int n = 0; n < 64; n += 2) { if (F32C) { ((LAS float*)lds)[r * CTF_PITCH + nh * 64 + n] = acc[n]; ((LAS float*)lds)[r * CTF_PITCH + nh * 64 + n + 1] = acc[n + 1]; } else *(LAS unsigned*)(lds + r * CT_PITCH + (nh * 64 + n) * 2) = pk2(acc[n], acc[n + 1]); }
    }
#else
    {
        const int wm = wid >> 1, wn = wid & 1, r = lane & 31, hh = lane >> 5;
        const int srow = lane >> 3, c0 = (lane & 7) ^ (srow >> 1);
        const bf16_t* asrc[4];
#pragma unroll
        for (int j = 0; j < 4; ++j) asrc[j] = arow(8 * (wid * 4 + j) + srow) + (c0 ^ ((j & 1) << 2)) * 8;
        const bf16_t* bsrc0 = Bt + (size_t)(wid * 16 + srow) * ldb + c0 * 8;
        const bf16_t* bsrc1 = Bt + (size_t)(wid * 16 + 8 + srow) * ldb + (c0 ^ 4) * 8;
        const int lanebase = r * 128 + ((hh ^ ((r >> 1) & 7)) << 4);
        f32x16 acc[2][2];
#pragma unroll
        for (int a = 0; a < 2; ++a)
#pragma unroll
            for (int b = 0; b < 2; ++b)
#pragma unroll
                for (int i = 0; i < 16; ++i) acc[a][b][i] = 0.f;
        const int nt = K >> 6;
#define GT_STAGE(kt, sb) do { _Pragma("unroll") for (int j = 0; j < 4; ++j) \
            glds16(asrc[j] + aoff(kt), lds + (sb) * GSTG + (wid * 4 + j) * 1024); \
            glds16(bsrc0 + (kt) * 64, lds + (sb) * GSTG + 32768 + (wid * 2) * 1024); \
            glds16(bsrc1 + (kt) * 64, lds + (sb) * GSTG + 32768 + (wid * 2 + 1) * 1024); } while (0)
        GT_STAGE(0, 0);
        if (nt > 1) GT_STAGE(1, 1);
        int sb = 0;
        for (int kt = 0; kt < nt; ++kt) {
            if (kt + 1 < nt) WAITV(6); else WAITV(0);
            __builtin_amdgcn_s_barrier();
            if (kt + 2 < nt) { const int sn = sb >= 1 ? sb - 1 : 2; GT_STAGE(kt + 2, sn); }
            const LAS uchar* xs = lds + sb * GSTG + wm * 8192; const LAS uchar* wsb = lds + sb * GSTG + 32768 + wn * 8192;
#pragma unroll
            for (int ks = 0; ks < 4; ++ks) {
                const int lb = lanebase ^ (ks << 5);
                bf16x8 xf[2], wf[2];
#pragma unroll
                for (int mb = 0; mb < 2; ++mb) xf[mb] = *(const LAS bf16x8*)(xs + mb * 4096 + lb);
#pragma unroll
                for (int nb = 0; nb < 2; ++nb) wf[nb] = *(const LAS bf16x8*)(wsb + nb * 4096 + lb);
#pragma unroll
                for (int nb = 0; nb < 2; ++nb)
#pragma unroll
                    for (int mb = 0; mb < 2; ++mb) acc[nb][mb] = MFMA32(wf[nb], xf[mb], acc[nb][mb]);
            }
            sb = sb == 2 ? 0 : sb + 1;
        }
#undef GT_STAGE
        __syncthreads();
#pragma unroll
        for (int nb = 0; nb < 2; ++nb)
#pragma unroll
            for (int mb = 0; mb < 2; ++mb) {
                const int m = 64 * wm + 32 * mb + r;
#pragma unroll
                for (int q4 = 0; q4 < 4; ++q4) {
                    const int n = 64 * wn + 32 * nb + 8 * q4 + 4 * hh;
                    if (F32C) {
#pragma unroll
                        for (int j = 0; j < 4; ++j) ((LAS float*)lds)[m * CTF_PITCH + n + j] = acc[nb][mb][4 * q4 + j];
                    } else {
                        u32x2 v; v[0] = pk2(acc[nb][mb][4 * q4], acc[nb][mb][4 * q4 + 1]); v[1] = pk2(acc[nb][mb][4 * q4 + 2], acc[nb][mb][4 * q4 + 3]);
                        *(LAS u32x2*)(lds + m * CT_PITCH + n * 2) = v;
                    }
                }
            }
    }
#endif
    __syncthreads();
    epi(lds);
    __syncthreads();
}
constexpr int G64STG = 40960;
template <class ARow, class Epi>
__device__ __forceinline__ void gemm_tile_n64(LAS uchar* lds, const ARow& arow, const bf16_t* B0, const bf16_t* B1, size_t ldb, int K, const Epi& epi) {
    const int tid = tid_opaque(), lane = tid & 63, wid = __builtin_amdgcn_readfirstlane(tid >> 6);
    {
        const int r = lane & 31, hh = lane >> 5;
        const int srow = lane >> 3, c0 = (lane & 7) ^ (srow >> 1);
        const bf16_t* asrc[4];
#pragma unroll
        for (int j = 0; j < 4; ++j) asrc[j] = arow(8 * (wid * 4 + j) + srow) + (c0 ^ ((j & 1) << 2)) * 8;
        const bf16_t* bsrc = (wid < 4 ? B0 + (size_t)(8 * wid + srow) * ldb : B1 + (size_t)(8 * (wid - 4) + srow) * ldb) + (c0 ^ ((wid & 1) << 2)) * 8;
        const int lanebase = r * 128 + ((hh ^ ((r >> 1) & 7)) << 4);
        f32x16 acc[2];
#pragma unroll
        for (int b = 0; b < 2; ++b)
#pragma unroll
            for (int i = 0; i < 16; ++i) acc[b][i] = 0.f;
        const int nt = K >> 6;
#define G6_STAGE(kt, sb) do { _Pragma("unroll") for (int j = 0; j < 4; ++j) glds16(asrc[j] + (kt) * 64, lds + (sb) * G64STG + (wid * 4 + j) * 1024); \
            glds16(bsrc + (kt) * 64, lds + (sb) * G64STG + 32768 + wid * 1024); } while (0)
        G6_STAGE(0, 0);
        if (nt > 1) G6_STAGE(1, 1);
        int sb = 0;
        for (int kt = 0; kt < nt; ++kt) {
            if (kt + 1 < nt) WAITV(5); else WAITV(0);
            __builtin_amdgcn_s_barrier();
            if (kt + 2 < nt) { const int sn = sb >= 1 ? sb - 1 : 2; G6_STAGE(kt + 2, sn); }
            const LAS uchar* xs = lds + sb * G64STG + wid * 4096; const LAS uchar* wsb = lds + sb * G64STG + 32768;
#pragma unroll
            for (int ks = 0; ks < 4; ++ks) {
                const int lb = lanebase ^ (ks << 5);
                const bf16x8 xf = *(const LAS bf16x8*)(xs + lb);
                bf16x8 wf[2];
#pragma unroll
                for (int nb = 0; nb < 2; ++nb) wf[nb] = *(const LAS bf16x8*)(wsb + nb * 4096 + lb);
#pragma unroll
                for (int nb = 0; nb < 2; ++nb) acc[nb] = MFMA32(wf[nb], xf, acc[nb]);
            }
            sb = sb == 2 ? 0 : sb + 1;
        }
#undef G6_STAGE
        __syncthreads();
#pragma unroll
        for (int nb = 0; nb < 2; ++nb) {
            const int m = 32 * wid + r;
#pragma unroll
            for (int q4 = 0; q4 < 4; ++q4) {
                const int n = 32 * nb + 8 * q4 + 4 * hh;
                u32x2 v; v[0] = pk2(acc[nb][4 * q4], acc[nb][4 * q4 + 1]); v[1] = pk2(acc[nb][4 * q4 + 2], acc[nb][4 * q4 + 3]);
                *(LAS u32x2*)(lds + m * CT_PITCH + n * 2) = v;
            }
        }
    }
    __syncthreads();
    epi(lds);
    __syncthreads();
}
constexpr int BSTG = 32768, CT2_OFF = 256 * CT_PITCH;
template <int V = 0, class ARow, class EpiMaker>
__device__ __forceinline__ void gemm_big(LAS uchar* lds, const ARow& arow, const bf16_t* Bt, size_t ldb, int K, const EpiMaker& mk) {
    const int tid = tid_opaque(), lane = tid & 63, wid = __builtin_amdgcn_readfirstlane(tid >> 6);
    {
        const int wm = wid >> 2, wn = wid & 3, r = lane & 31, hh = lane >> 5;
        const int srow = lane >> 3, c0 = (lane & 7) ^ (lane >> 4);
        const bf16_t* asrc[4];
#pragma unroll
        for (int j = 0; j < 4; ++j) asrc[j] = arow(wid * 32 + 8 * j + srow) + (c0 ^ ((j & 1) << 2)) * 8;
        const bf16_t* b0 = Bt + (size_t)(wid * 32 + srow) * ldb + c0 * 8; const bf16_t* b1 = Bt + (size_t)(wid * 32 + srow) * ldb + (c0 ^ 4) * 8;
        const int lanebase = r * 128 + ((hh ^ ((r >> 1) & 7)) << 4);
        f32x16 acc[2][4];
#pragma unroll
        for (int a = 0; a < 2; ++a)
#pragma unroll
            for (int b = 0; b < 4; ++b)
#pragma unroll
                for (int i = 0; i < 16; ++i) acc[a][b][i] = 0.f;
        const int nt = K >> 6;
#define GB_STAGE(kt, sb) do { _Pragma("unroll") for (int j = 0; j < 4; ++j) { \
            glds16(asrc[j] + (kt) * 64, lds + (sb) * 65536 + (wid * 4 + j) * 1024); \
            glds16(((j & 1) ? b1 : b0) + (size_t)(8 * j) * ldb + (kt) * 64, lds + (sb) * 65536 + 32768 + (wid * 4 + j) * 1024); } } while (0)
        if (!(V & 4)) GB_STAGE(0, 0);
        for (int kt = 0; kt < nt; ++kt) {
            const int sb = kt & 1;
            WAITV(0);
            __builtin_amdgcn_s_barrier();
            if (!(V & 4) && kt + 1 < nt) GB_STAGE(kt + 1, sb ^ 1);
            const LAS uchar* xs = lds + sb * 65536 + wm * 16384; const LAS uchar* wsb = lds + sb * 65536 + 32768 + wn * 8192;
#pragma unroll
            for (int ks = 0; ks < 4; ++ks) {
                const int lb = lanebase ^ (ks << 5);
                bf16x8 xf[4], wf[2];
#pragma unroll
                for (int mb = 0; mb < 4; ++mb) xf[mb] = *(const LAS bf16x8*)(xs + mb * 4096 + lb);
#pragma unroll
                for (int nb = 0; nb < 2; ++nb) wf[nb] = *(const LAS bf16x8*)(wsb + nb * 4096 + lb);
#pragma unroll
                for (int nb = 0; nb < 2; ++nb)
#pragma unroll
                    for (int mb = 0; mb < 4; ++mb) acc[nb][mb] = MFMA32(wf[nb], xf[mb], acc[nb][mb]);
            }
        }
#undef GB_STAGE
        __syncthreads();
#pragma unroll
        for (int nb = 0; nb < 2; ++nb)
#pragma unroll
            for (int mb = 0; mb < 4; ++mb) {
                const int m = 128 * wm + 32 * mb + r;
#pragma unroll
                for (int q4 = 0; q4 < 4; ++q4) {
                    const int n = 64 * (wn & 1) + 32 * nb + 8 * q4 + 4 * hh;
                    u32x2 v; v[0] = pk2(acc[nb][mb][4 * q4], acc[nb][mb][4 * q4 + 1]); v[1] = pk2(acc[nb][mb][4 * q4 + 2], acc[nb][mb][4 * q4 + 3]);
                    *(LAS u32x2*)(lds + (wn >> 1) * CT2_OFF + m * CT_PITCH + n * 2) = v;
                }
            }
    }
    __syncthreads();
    if (!(V & 1)) { mk(0)(lds); mk(1)(lds + CT2_OFF); }
    __syncthreads();
}
template <class ARow, class EpiMaker, class Rows>
__device__ __forceinline__ void gemm_big32(LAS uchar* lds, const ARow& arow, const bf16_t* Bt, size_t ldb, int K, const EpiMaker& mk, Rows& rows) {
    const int tid = tid_opaque(), lane = tid & 63, wid = __builtin_amdgcn_readfirstlane(tid >> 6);
    {
        const int wm = wid >> 2, wn = wid & 3, r = lane & 31, hh = lane >> 5;
        const int srow = lane >> 2, cs = (lane & 3) ^ ((srow >> 2) & 3);
        const bf16_t* a0 = arow(wid * 32 + srow) + cs * 8; const bf16_t* a1 = arow(wid * 32 + 16 + srow) + cs * 8;
        const bf16_t* b0 = Bt + (size_t)(wid * 32 + srow) * ldb + cs * 8; const bf16_t* b1 = b0 + 16 * ldb;
        const int lanebase = r * 64 + ((hh ^ ((r >> 2) & 3)) << 4);
        f32x16 acc[2][4];
#pragma unroll
        for (int a = 0; a < 2; ++a)
#pragma unroll
            for (int b = 0; b < 4; ++b)
#pragma unroll
                for (int i = 0; i < 16; ++i) acc[a][b][i] = 0.f;
        const int nt = K >> 5;
#define GB3_STAGE(kt, sb) do { LAS uchar* _d = lds + (sb) * 32768 + wid * 2048; \
            glds16(a0 + (kt) * 32, _d); glds16(a1 + (kt) * 32, _d + 1024); glds16(b0 + (kt) * 32, _d + 16384); glds16(b1 + (kt) * 32, _d + 16384 + 1024); } while (0)
        rows.early();
        GB3_STAGE(0, 0);
        if (nt > 1) GB3_STAGE(1, 1);
        if (nt > 2) GB3_STAGE(2, 2);
        for (int kt = 0; kt < nt; ++kt) {
            if (kt + 2 < nt) WAITV(8); else if (kt + 1 < nt) WAITV(4); else WAITV(0);
            __builtin_amdgcn_s_barrier();
            if (kt + 3 < nt) GB3_STAGE(kt + 3, (kt + 3) & 3);
            const LAS uchar* xs = lds + (kt & 3) * 32768 + wm * 8192; const LAS uchar* wsb = lds + (kt & 3) * 32768 + 16384 + wn * 4096;
#pragma unroll
            for (int ks = 0; ks < 2; ++ks) {
                const int lb = lanebase ^ (ks << 5);
                bf16x8 xf[4], wf[2];
#pragma unroll
                for (int mb = 0; mb < 4; ++mb) xf[mb] = *(const LAS bf16x8*)(xs + mb * 2048 + lb);
#pragma unroll
                for (int nb = 0; nb < 2; ++nb) wf[nb] = *(const LAS bf16x8*)(wsb + nb * 2048 + lb);
#pragma unroll
                for (int nb = 0; nb < 2; ++nb)
#pragma unroll
                    for (int mb = 0; mb < 4; ++mb) acc[nb][mb] = MFMA32(wf[nb], xf[mb], acc[nb][mb]);
            }
        }
#undef GB3_STAGE
        __syncthreads();
#pragma unroll
        for (int nb = 0; nb < 2; ++nb)
#pragma unroll
            for (int mb = 0; mb < 4; ++mb) {
                const int m = 128 * wm + 32 * mb + r;
#pragma unroll
                for (int q4 = 0; q4 < 4; ++q4) {
                    const int n = 64 * (wn & 1) + 32 * nb + 8 * q4 + 4 * hh;
                    u32x2 v; v[0] = pk2(acc[nb][mb][4 * q4], acc[nb][mb][4 * q4 + 1]); v[1] = pk2(acc[nb][mb][4 * q4 + 2], acc[nb][mb][4 * q4 + 3]);
                    *(LAS u32x2*)(lds + (wn >> 1) * CT2_OFF + m * CT_PITCH + n * 2) = v;
                }
            }
    }
    rows.store(lds);
    __syncthreads();
    mk(0)(lds); mk(1)(lds + CT2_OFF);
    __syncthreads();
}
namespace pg8 {
#define PG8_LAS __attribute__((address_space(3)))
typedef ::f32x4 f32x4; typedef ::bf16x8 bf16x8; typedef ::bf16_t bf16_t; typedef ::u32x4 u32x4;
constexpr int BM = 256, BK = 64, HALF = 128, HTB = HALF * BK * 2  , STAGE_BYTES = 8 * HTB, NXCD = 8, WGM = 8;

__host__ __device__ __forceinline__ int lds_byte(int r, int c) { const int st = (r >> 4) * 2 + (c >> 5), rr = r & 15, cc = c & 31, ob = rr * 64 + cc * 2; return st * 1024 + (ob ^ (((ob >> 9) & 1) << 5)); }
__host__ __device__ __forceinline__ void stage_rc(int b, int& R, int& C) { const int st = b / 1024, sb = b % 1024, swz = sb ^ (((sb >> 9) & 1) << 5); R = (st >> 1) * 16 + swz / 64; C = (st & 1) * 32 + (swz % 64) / 2; }
__host__ __device__ __forceinline__ int perm32(int rho) { const int n = rho >> 4, i = rho & 15; return 8 * (i >> 2) + 4 * n + (i & 3); }

struct Unit { int pm, pn; };
struct Gemm { const bf16_t* A; const bf16_t* Bt; int M, N, K; };
template <class Epi, class Sched, bool ALIGN_EPI = false, bool SP2 = false, class ARowT = ARowNone>
__device__ __forceinline__ void gemm_phase(PG8_LAS unsigned char* lds, const Gemm g, const Sched& S, const Epi& E, const ARowT& arow = ARowT()) {
    constexpr bool GATHER = ARowT::GATHER;
    const int tid = tid_opaque(), wid = __builtin_amdgcn_readfirstlane(tid >> 6), lane = tid & 63, wr = wid >> 2, wc = wid & 3, fr = lane & 15, fq = lane >> 4;
    const int K = g.K, nt = K / BK;
    unsigned voffA[2], voffB[2];
#pragma unroll
    for (int i = 0; i < 2; ++i) { int R, C; stage_rc(tid * 16 + i * 8192, R, C); const int Rb = Epi::PERM ? ((R & ~31) + perm32(R & 31)) : R;
        voffA[i] = (unsigned)(R * K + C) * 2u; voffB[i] = (unsigned)(Rb * K + C) * 2u; }
    unsigned aoffg[2][2] = {{0u, 0u}, {0u, 0u}};
    if constexpr (GATHER) {
#pragma unroll
        for (int h = 0; h < 2; ++h)
#pragma unroll
            for (int i = 0; i < 2; ++i) { int R, C; stage_rc(tid * 16 + i * 8192, R, C); aoffg[h][i] = (unsigned)((const char*)(arow(h * HALF + R) + C) - (const char*)g.A); }
    }
    const size_t kstep = (size_t)(BK * 2);
    const size_t hstep = (size_t)HALF * K * 2;
    const size_t tstep = 2 * hstep;
    const unsigned ldsw = (unsigned)wid * 1024u;
    const int aoff = lds_byte(wr * 64 + fr, fq * 8), boff = lds_byte(wc * 32 + fr, fq * 8);
#define PG8_SA(b, h) (((b) * 2 + (h)) * HTB)
#define PG8_SB(b, h) ((4 + (b) * 2 + (h)) * HTB)
#define PG8_STAGE(bufoff, gbase, voff) do { _Pragma("unroll") for (int _i = 0; _i < 2; ++_i) \
        __builtin_amdgcn_global_load_lds((const unsigned*)((const char*)(gbase) + (voff)[_i]), (PG8_LAS unsigned*)(lds + (bufoff) + ldsw + _i * 8192), 16, 0, 0); } while (0)
#define PG8_STAGE_A(b, h, kp) do { if constexpr (GATHER) { _Pragma("unroll") for (int _i = 0; _i < 2; ++_i) \
        __builtin_amdgcn_global_load_lds((const unsigned*)((const char*)g.A + ((kp) - (const char*)0) + aoffg[h][_i]), (PG8_LAS unsigned*)(lds + PG8_SA(b, h) + ldsw + _i * 8192), 16, 0, 0); } \
        else PG8_STAGE(PG8_SA(b, h), (kp) + (h) * hstep, voffA); } while (0)
#define PG8_LDA(dst, b, h) do { _Pragma("unroll") for (int m = 0; m < 4; ++m) _Pragma("unroll") for (int k = 0; k < 2; ++k) dst[m][k] = *(const PG8_LAS bf16x8*)(lds + PG8_SA(b, h) + aoff + m * 2048 + k * 1024); } while (0)
#define PG8_LDB(dst, b, h) do { _Pragma("unroll") for (int n = 0; n < 2; ++n) _Pragma("unroll") for (int k = 0; k < 2; ++k) dst[n][k] = *(const PG8_LAS bf16x8*)(lds + PG8_SB(b, h) + boff + n * 2048 + k * 1024); } while (0)
#define PG8_MMA(ai, bj, At, Bt) do { __builtin_amdgcn_s_setprio(1); _Pragma("unroll") for (int m = 0; m < 4; ++m) _Pragma("unroll") for (int n = 0; n < 2; ++n) _Pragma("unroll") for (int k = 0; k < 2; ++k) \
        acc[ai][bj][m][n] = __builtin_amdgcn_mfma_f32_16x16x32_bf16(Bt[n][k], At[m][k], acc[ai][bj][m][n], 0, 0, 0); __builtin_amdgcn_s_setprio(0); } while (0)
#define PG8_WAIT_V(n) asm volatile("s_waitcnt vmcnt(" #n ")" ::: "memory")
#define PG8_WAIT_L(n) asm volatile("s_waitcnt lgkmcnt(" #n ")" ::: "memory")
#define PG8_BAR __builtin_amdgcn_s_barrier()
#define PG8_SCHED __builtin_amdgcn_sched_barrier(0)
    Unit cur, nxt; int ui = 0;
    if (!S.next(0, cur)) return;
    f32x4 acc[2][2][4][2];
#pragma unroll
    for (int a = 0; a < 2; ++a)
#pragma unroll
        for (int b = 0; b < 2; ++b)
#pragma unroll
            for (int m = 0; m < 4; ++m)
#pragma unroll
                for (int n = 0; n < 2; ++n) acc[a][b][m][n] = (f32x4){0.f, 0.f, 0.f, 0.f};
    bf16x8 At[4][2], B0[2][2], B1[2][2];
    const char* cA = GATHER ? (const char*)0 : (const char*)g.A + (size_t)cur.pm * tstep; const char* cB = (const char*)g.Bt + (size_t)cur.pn * tstep;
    S.a_ready(cur);
    if constexpr (SP2) {
        PG8_STAGE(PG8_SB(0, 0), cB, voffB); PG8_STAGE(PG8_SB(0, 1), cB + hstep, voffB); PG8_STAGE_A(0, 0, cA); PG8_STAGE_A(0, 1, cA);
        if (wr == 1) PG8_BAR;
        PG8_WAIT_V(2); PG8_BAR;
        PG8_STAGE(PG8_SB(1, 0), cB + kstep, voffB); PG8_STAGE_A(1, 0, cA + kstep); PG8_STAGE(PG8_SB(1, 1), cB + hstep + kstep, voffB);
        PG8_WAIT_V(6); PG8_BAR;
    } else {
        PG8_STAGE(PG8_SB(0, 0), cB, voffB); PG8_STAGE_A(0, 0, cA); PG8_STAGE(PG8_SB(0, 1), cB + hstep, voffB); PG8_STAGE_A(0, 1, cA);
        if (wr == 1) PG8_BAR;
        PG8_WAIT_V(4); PG8_BAR;
        PG8_STAGE(PG8_SB(1, 0), cB + kstep, voffB); PG8_STAGE_A(1, 0, cA + kstep); PG8_STAGE(PG8_SB(1, 1), cB + hstep + kstep, voffB);
        PG8_WAIT_V(6); PG8_BAR;
    }
    for (;;) {
        const bool has_next = S.next(ui + 1, nxt);
        const char* nA = (has_next && !GATHER) ? (const char*)g.A + (size_t)nxt.pm * tstep : cA; const char* nB = has_next ? (const char*)g.Bt + (size_t)nxt.pn * tstep : cB;
        for (int t = 0; t < nt; t += 2) {
            const bool last = (t == nt - 2);
            const char* a1 = cA + (size_t)(t + 1) * kstep;
            const char* a2 = last ? nA : cA + (size_t)(t + 2) * kstep; const char* b2 = last ? nB : cB + (size_t)(t + 2) * kstep;
            const char* a3 = a2 + kstep; const char* b3 = b2 + kstep;
            if (last && has_next) S.a_ready(nxt);
            if constexpr (SP2) {
            PG8_LDB(B0, 0, 0); PG8_LDB(B1, 0, 1); PG8_SCHED; PG8_LDA(At, 0, 0); PG8_STAGE_A(1, 1, a1);
            PG8_WAIT_V(8); PG8_WAIT_L(0); PG8_BAR; PG8_MMA(0, 0, At, B0); PG8_MMA(0, 1, At, B1); PG8_BAR; PG8_SCHED;
            PG8_LDA(At, 0, 1); PG8_STAGE(PG8_SB(0, 0), b2, voffB); PG8_STAGE(PG8_SB(0, 1), b2 + hstep, voffB); PG8_STAGE_A(0, 0, a2);
            PG8_WAIT_V(8); PG8_WAIT_L(0); PG8_BAR; PG8_MMA(1, 0, At, B0); PG8_MMA(1, 1, At, B1); PG8_BAR; PG8_SCHED;
            PG8_LDB(B0, 1, 0); PG8_LDB(B1, 1, 1); PG8_SCHED; PG8_LDA(At, 1, 0); PG8_STAGE_A(0, 1, a2);
            PG8_WAIT_V(8); PG8_WAIT_L(0); PG8_BAR; PG8_MMA(0, 0, At, B0); PG8_MMA(0, 1, At, B1); PG8_BAR; PG8_SCHED;
            PG8_LDA(At, 1, 1); PG8_STAGE(PG8_SB(1, 0), b3, voffB); PG8_STAGE(PG8_SB(1, 1), b3 + hstep, voffB); PG8_STAGE_A(1, 0, a3);
            PG8_WAIT_V(8); PG8_WAIT_L(0); PG8_BAR; PG8_MMA(1, 0, At, B0); PG8_MMA(1, 1, At, B1); PG8_BAR; PG8_SCHED;
            } else {
            PG8_LDB(B0, 0, 0); PG8_SCHED; PG8_LDA(At, 0, 0); PG8_STAGE_A(1, 1, a1);
            PG8_WAIT_L(8); PG8_BAR; PG8_WAIT_L(0); PG8_MMA(0, 0, At, B0); PG8_BAR; PG8_SCHED;
            PG8_LDB(B1, 0, 1); PG8_STAGE(PG8_SB(0, 0), b2, voffB);
            PG8_BAR; PG8_WAIT_L(0); PG8_MMA(0, 1, At, B1); PG8_BAR;
            PG8_LDA(At, 0, 1); PG8_STAGE_A(0, 0, a2);
            PG8_BAR; PG8_WAIT_L(0); PG8_MMA(1, 0, At, B0); PG8_BAR; PG8_SCHED;
            PG8_STAGE(PG8_SB(0, 1), b2 + hstep, voffB);
            PG8_WAIT_V(6); PG8_BAR; PG8_MMA(1, 1, At, B1); PG8_BAR;
            PG8_LDB(B0, 1, 0); PG8_SCHED; PG8_LDA(At, 1, 0); PG8_STAGE_A(0, 1, a2);
            PG8_WAIT_L(8); PG8_BAR; PG8_WAIT_L(0); PG8_MMA(0, 0, At, B0); PG8_BAR; PG8_SCHED;
            PG8_LDB(B1, 1, 1); PG8_STAGE(PG8_SB(1, 0), b3, voffB);
            PG8_BAR; PG8_WAIT_L(0); PG8_MMA(0, 1, At, B1); PG8_BAR;
            PG8_LDA(At, 1, 1); PG8_STAGE_A(1, 0, a3);
            PG8_BAR; PG8_WAIT_L(0); PG8_MMA(1, 0, At, B0); PG8_BAR; PG8_SCHED;
            PG8_STAGE(PG8_SB(1, 1), b3 + hstep, voffB);
            PG8_WAIT_V(6); PG8_BAR; PG8_MMA(1, 1, At, B1); PG8_BAR;
            }
        }
        if constexpr (ALIGN_EPI) { if (wr == 0) PG8_BAR; }
        if constexpr (!Epi::AFTER_DRAIN) { E(acc, cur, wr, wc, fr, fq); S.done(cur); }
        if (!has_next) break;
#pragma unroll
        for (int a = 0; a < 2; ++a)
#pragma unroll
            for (int b = 0; b < 2; ++b)
#pragma unroll
                for (int m = 0; m < 4; ++m)
#pragma unroll
                    for (int n = 0; n < 2; ++n) acc[a][b][m][n] = (f32x4){0.f, 0.f, 0.f, 0.f};
        cur = nxt; cA = nA; cB = nB; ++ui;
        if constexpr (ALIGN_EPI) { if (wr == 1) PG8_BAR; }
    }
    PG8_WAIT_V(0);
    if constexpr (!ALIGN_EPI) { if (wr == 0) PG8_BAR; }
    PG8_BAR;
    if constexpr (Epi::AFTER_DRAIN) { E.fused(acc, cur, wr, wc, fr, fq, lds, wid, lane); S.done(cur); }
#undef PG8_SA
#undef PG8_SB
#undef PG8_STAGE
#undef PG8_STAGE_A
#undef PG8_LDA
#undef PG8_LDB
#undef PG8_MMA
#undef PG8_WAIT_V
#undef PG8_WAIT_L
#undef PG8_BAR
#undef PG8_SCHED
}
}

struct OneUnit { __device__ __forceinline__ bool next(int i, pg8::Unit& u) const { u.pm = 0; u.pn = 0; return i == 0; }
    __device__ __forceinline__ void a_ready(const pg8::Unit&) const {} __device__ __forceinline__ void done(const pg8::Unit&) const {} };
template <class EpiMaker> struct EpiViaLds {
    static constexpr bool PERM = false, AFTER_DRAIN = true; const EpiMaker* mk;
    __device__ __forceinline__ void fused(pg8::f32x4 (&acc)[2][2][4][2], const pg8::Unit&, int wr, int wc, int fr, int fq, LAS uchar* lds, int, int) const {
#pragma unroll
        for (int ai = 0; ai < 2; ++ai)
#pragma unroll
            for (int bj = 0; bj < 2; ++bj)
#pragma unroll
                for (int m = 0; m < 4; ++m)
#pragma unroll
                    for (int n = 0; n < 2; ++n) {
                        const int row = 128 * ai + 64 * wr + 16 * m + fr, col = 32 * wc + 16 * n + 4 * fq;
                        u32x2 v; v[0] = pk2(acc[ai][bj][m][n][0], acc[ai][bj][m][n][1]); v[1] = pk2(acc[ai][bj][m][n][2], acc[ai][bj][m][n][3]);
                        *(LAS u32x2*)(lds + bj * CT2_OFF + row * CT_PITCH + col * 2) = v;
                    }
        __syncthreads();
        (*mk)(0)(lds);
        (*mk)(1)(lds + CT2_OFF);
        __syncthreads();
    }
};
template <class EpiMaker>
__device__ __forceinline__ void gemm_big8g(LAS uchar* lds, const ARowGather& ar, const bf16_t* Bt, int K, const EpiMaker& mk) {
    const pg8::Gemm g{ar.base, Bt, 256, 256, K}; const OneUnit S{}; const EpiViaLds<EpiMaker> E{&mk};
    pg8::gemm_phase<EpiViaLds<EpiMaker>, OneUnit, false, true, ARowGather>(lds, g, S, E, ar);
}
template <class EpiMaker>
__device__ __forceinline__ void gemm_big8(LAS uchar* lds, const bf16_t* A, const bf16_t* Bt, int K, const EpiMaker& mk) {
    const pg8::Gemm g{A, Bt, 256, 256, K}; const OneUnit S{}; const EpiViaLds<EpiMaker> E{&mk};
    pg8::gemm_phase<EpiViaLds<EpiMaker>, OneUnit, false, true>(lds, g, S, E);
}
__device__ __forceinline__ u32x4 ct_ld8(const LAS uchar* ct, int r, int c) { return *(const LAS u32x4*)(ct + r * CT_PITCH + c * 2); }
__device__ __forceinline__ float ct_ld1(const LAS uchar* ct, int r, int c) { return bf2f(*(const LAS bf16_t*)(ct + r * CT_PITCH + c * 2)); }

struct EpiProj {
    int mt, nt, l; const Params* p;
    __device__ __forceinline__ void operator()(const LAS uchar* ct) const {
        uchar* ws = p->ws; const int tid = tid_opaque();
        const LAS float* rowS = (const LAS float*)(lds_base() + LDS_ROW);
        const int t0 = mt * 256, b = t0 >> 11, s0 = t0 & 2047;
        if (nt < 8) {
            const int h = nt & 3; const bool isq = nt < 4;
            const int c8 = tid & 7, j = (tid >> 3) & 1, r0 = tid >> 4;
            const float* g = p->in[isq ? 3 : 4] + l * 64 + c8 * 8;
            const f32x4 g0 = *(const f32x4*)g, g1 = *(const f32x4*)(g + 4);
            bf16_t* dbase = (bf16_t*)(ws + (isq ? WS_QD : WS_KD)) + ((((size_t)b * 4 + h) * 2 + j) * S + s0) * 64 + c8 * 8;
#pragma unroll
            for (int it = 0; it < 8; ++it) {
                const int r = it * 32 + r0;
                float f[8]; unpack8(ct_ld8(ct, r, j * 64 + c8 * 8), f);
                float ss = 0.f;
#pragma unroll
                for (int i = 0; i < 8; ++i) ss += f[i] * f[i];
                ss = sum8(ss);
                const float rn = __builtin_amdgcn_rsqf(ss * (1.f / 64.f) + EPS) * (isq ? QSCALE_D : 1.f);
                u32x4 o; o[0] = pk2(f[0] * rn * g0[0], f[1] * rn * g0[1]); o[1] = pk2(f[2] * rn * g0[2], f[3] * rn * g0[3]);
                o[2] = pk2(f[4] * rn * g1[0], f[5] * rn * g1[1]); o[3] = pk2(f[6] * rn * g1[2], f[7] * rn * g1[3]);
                *(u32x4*)(dbase + (size_t)r * 64) = o;
            }
        } else if (nt < 12) {
            const int h = nt - 8, dp = tid & 63, sg = tid >> 6;
            const LAS uchar* cb = ct + (sg * 32) * CT_PITCH + dp * 4;
            unsigned w[32];
#pragma unroll
            for (int q = 0; q < 32; ++q) w[q] = *(const LAS unsigned*)(cb + ((q & 16) + sigma16(q & 15)) * CT_PITCH);
            bf16_t* dst = (bf16_t*)(ws + WS_VDT) + (((size_t)b * 4 + h) * 128 + 2 * dp) * S + s0 + sg * 32;
#pragma unroll
            for (int c8 = 0; c8 < 4; ++c8) { u32x4 o0, o1;
#pragma unroll
                for (int i = 0; i < 4; ++i) { const unsigned a = w[c8 * 8 + 2 * i], bq = w[c8 * 8 + 2 * i + 1];
                    o0[i] = (a & 0xffffu) | (bq << 16); o1[i] = (a >> 16) | (bq & 0xffff0000u); }
                *(u32x4*)(dst + c8 * 8) = o0; *(u32x4*)(dst + S + c8 * 8) = o1; }
        } else {
            const int c8 = tid & 15, r0 = tid >> 4;
            bf16_t* dbase = (bf16_t*)(ws + WS_LAT) + (size_t)t0 * 640 + (nt - 12) * 128 + c8 * 8;
            const int hidx = (nt - 12) * 2 + (c8 >> 3);
            float* hss = (float*)(ws + WS_HSS) + (size_t)t0 * 8 + hidx;
#pragma unroll
            for (int it = 0; it < 8; ++it) {
                const int r = it * 32 + r0;
                const u32x4 o = ct_ld8(ct, r, c8 * 8);
                *(u32x4*)(dbase + (size_t)r * 640) = o;
                float ss = 0.f;
#pragma unroll
                for (int i = 0; i < 4; ++i) { const float a = bflo(o[i]), bq = bfhi(o[i]); ss += a * a + bq * bq; }
                ss = sum8(ss);
                if ((c8 & 7) == 0 && hidx < 8) hss[(size_t)r * 8] = ss;
            }
        }
    }
};

__device__ __forceinline__ float lat_rstd(const bf16_t* seg, int n) {
    float ss = 0.f;
    for (int k = 0; k < n; k += 8) { float f[8]; unpack8(*(const u32x4*)(seg + k), f);
#pragma unroll
        for (int i = 0; i < 8; ++i) ss += f[i] * f[i]; }
    return __builtin_amdgcn_rsqf(ss / (float)n + EPS);
}
__device__ __forceinline__ void norm_rope32(float (&y)[32], const float* g, const float* cosr, const float* sinr, float outscale) {
    float ss = 0.f;
#pragma unroll
    for (int i = 0; i < 32; ++i) ss += y[i] * y[i];
    const float rn = __builtin_amdgcn_rsqf(ss * (1.f / 32.f) + EPS);
#pragma unroll
    for (int i = 0; i < 32; ++i) y[i] = y[i] * rn * g[i];
#pragma unroll
    for (int i = 0; i < 16; ++i) { const float c = cosr[i], sn = sinr[i], x1 = y[i], x2 = y[16 + i];
        y[i] = (x1 * c - x2 * sn) * outscale; y[16 + i] = (x2 * c + x1 * sn) * outscale; }
}

__device__ __forceinline__ u32x4 norm64_piece(float (&f)[8], const float* g8, float outscale) {
    float ss = 0.f;
#pragma unroll
    for (int i = 0; i < 8; ++i) ss += f[i] * f[i];
    ss = sum8(ss);
    const float rn = __builtin_amdgcn_rsqf(ss * (1.f / 64.f) + EPS) * outscale;
    const f32x4 g0 = *(const f32x4*)g8, g1 = *(const f32x4*)(g8 + 4);
    u32x4 o; o[0] = pk2(f[0] * rn * g0[0], f[1] * rn * g0[1]); o[1] = pk2(f[2] * rn * g0[2], f[3] * rn * g0[3]);
    o[2] = pk2(f[4] * rn * g1[0], f[5] * rn * g1[1]); o[3] = pk2(f[6] * rn * g1[2], f[7] * rn * g1[3]);
    return o;
}
__device__ __forceinline__ u32x4 norm_rope_piece(float (&f)[8], int c8, const float* g, const float* cosr, const float* sinr, float outscale) {
    float ss = 0.f;
#pragma unroll
    for (int i = 0; i < 8; ++i) ss += f[i] * f[i];
    ss = sum4(ss);
    const float rn = __builtin_amdgcn_rsqf(ss * (1.f / 32.f) + EPS);
    float y[8], z[8];
#pragma unroll
    for (int i = 0; i < 8; ++i) y[i] = f[i] * rn * g[c8 * 8 + i];
#pragma unroll
    for (int i = 0; i < 8; ++i) z[i] = dpp_get<0x4E>(y[i]);
    const int fi = (c8 & 1) * 8;
    float o[8];
#pragma unroll
    for (int i = 0; i < 8; ++i) { const float c = cosr[fi + i], sn = sinr[fi + i];
        o[i] = ((c8 < 2) ? (y[i] * c - z[i] * sn) : (y[i] * c + z[i] * sn)) * outscale; }
    u32x4 w; w[0] = pk2(o[0], o[1]); w[1] = pk2(o[2], o[3]); w[2] = pk2(o[4], o[5]); w[3] = pk2(o[6], o[7]);
    return w;
}
struct EpiMlaQ {
    int mt, h, l; const Params* p;
    __device__ __forceinline__ void operator()(const LAS uchar* ct) const {
        uchar* ws = p->ws; const int tid = tid_opaque();
        const LAS float* rowS = (const LAS float*)(lds_base() + LDS_ROW);
        const int t0 = mt * 256, b = t0 >> 11, s0 = t0 & 2047;
        bf16_t* dbase = (bf16_t*)(ws + WS_QM) + (((size_t)b * 4 + h) * S + s0) * 96;
        const float* gn = p->in[11] + l * 64; const float* gr = p->in[12] + l * 32;
        {
            const int c8 = tid & 7, r0 = tid >> 3;
#pragma unroll
            for (int it = 0; it < 4; ++it) {
                const int r = it * 64 + r0; const float rs = rowS[r];
                float f[8]; unpack8(ct_ld8(ct, r, c8 * 8), f);
#pragma unroll
                for (int i = 0; i < 8; ++i) f[i] *= rs;
                *(u32x4*)(dbase + (size_t)r * 96 + c8 * 8) = norm64_piece(f, gn + c8 * 8, QSCALE_M);
            }
        }
        {
            const int c8 = tid & 3, r0 = tid >> 2;
#pragma unroll
            for (int it = 0; it < 2; ++it) {
                const int r = it * 128 + r0; const float rs = rowS[r];
                float f[8]; unpack8(ct_ld8(ct, r, 64 + c8 * 8), f);
#pragma unroll
                for (int i = 0; i < 8; ++i) f[i] *= rs;
                const float* cosr = (const float*)(ws + WS_ROPE) + (s0 + r) * 16; const float* sinr = cosr + S * 16;
                *(u32x4*)(dbase + (size_t)r * 96 + 64 + c8 * 8) = norm_rope_piece(f, c8, gr, cosr, sinr, QSCALE_M);
            }
        }
    }
};
struct EpiMlaKV {
    int mt, h, l; const Params* p;
    __device__ __forceinline__ void operator()(const LAS uchar* ct) const {
        uchar* ws = p->ws; const int tid = tid_opaque();
        const LAS float* rowS = (const LAS float*)(lds_base() + LDS_ROW);
        const int t0 = mt * 256, b = t0 >> 11, s0 = t0 & 2047;
        bf16_t* dbase = (bf16_t*)(ws + WS_KM) + (((size_t)b * 4 + h) * S + s0) * 96;
        const float* gn = p->in[13] + l * 64; const float* gr = p->in[14] + l * 32;
        {
            const int c8 = tid & 7, r0 = tid >> 3;
#pragma unroll
            for (int it = 0; it < 4; ++it) {
                const int r = it * 64 + r0; const float rs = rowS[r];
                float f[8]; unpack8(ct_ld8(ct, r, c8 * 8), f);
#pragma unroll
                for (int i = 0; i < 8; ++i) f[i] *= rs;
                *(u32x4*)(dbase + (size_t)r * 96 + c8 * 8) = norm64_piece(f, gn + c8 * 8, 1.f);
            }
        }
        {
            const bf16_t* lat = (const bf16_t*)(ws + WS_LAT) + (size_t)t0 * 640 + 320;
            const int c8 = tid & 3, r0 = tid >> 2;
#pragma unroll
            for (int it = 0; it < 2; ++it) {
                const int r = it * 128 + r0;
                float f[8]; unpack8(*(const u32x4*)(lat + (size_t)r * 640 + c8 * 8), f);
                const float* cosr = (const float*)(ws + WS_ROPE) + (s0 + r) * 16; const float* sinr = cosr + S * 16;
                *(u32x4*)(dbase + (size_t)r * 96 + 64 + c8 * 8) = norm_rope_piece(f, c8, gr, cosr, sinr, 1.f);
            }
        }
        {
            const int dp = tid & 31, sg = tid >> 5;
            const LAS uchar* cb = ct + (sg * 16) * CT_PITCH + (64 + 2 * dp) * 2;
            bf16_t* dst = (bf16_t*)(ws + WS_VMT) + (((size_t)b * 4 + h) * 64 + 2 * dp) * S + s0 + sg * 16;
            float v0[16], v1[16];
#pragma unroll
            for (int q = 0; q < 16; ++q) { const int rr = sigma16(q); const unsigned u = *(const LAS unsigned*)(cb + rr * CT_PITCH); const float rs = rowS[sg * 16 + rr];
                v0[q] = bflo(u) * rs; v1[q] = bfhi(u) * rs; }
#pragma unroll
            for (int c8 = 0; c8 < 2; ++c8) { u32x4 o0, o1;
#pragma unroll
                for (int i = 0; i < 4; ++i) { o0[i] = pk2(v0[c8 * 8 + 2 * i], v0[c8 * 8 + 2 * i + 1]); o1[i] = pk2(v1[c8 * 8 + 2 * i], v1[c8 * 8 + 2 * i + 1]); }
                *(u32x4*)(dst + c8 * 8) = o0; *(u32x4*)(dst + S + c8 * 8) = o1; }
        }
    }
};
struct EpiPool {
    int mt, g, l; const Params* p;
    __device__ __forceinline__ void operator()(const LAS uchar* ct) const {
        uchar* ws = p->ws; const int tid = tid_opaque(), c8 = tid & 7, r0 = tid >> 3;
        const float* sc = p->in[16] + l * 256 + g * 64 + c8 * 8;
        const f32x4 s0 = *(const f32x4*)sc, s1 = *(const f32x4*)(sc + 4);
        bf16_t* dst = (bf16_t*)(ws + WS_MIX) + (size_t)(mt * 256) * DM + 768 + g * 64 + c8 * 8;
#pragma unroll
        for (int it = 0; it < 4; ++it) {
            const int r = it * 64 + r0;
            float f[8]; unpack8(ct_ld8(ct, r, c8 * 8), f); u32x4 o;
            o[0] = pk2(f[0] * s0[0], f[1] * s0[1]); o[1] = pk2(f[2] * s0[2], f[3] * s0[3]); o[2] = pk2(f[4] * s1[0], f[5] * s1[1]); o[3] = pk2(f[6] * s1[2], f[7] * s1[3]);
            *(u32x4*)(dst + (size_t)r * DM) = o;
        }
    }
};
struct EpiWout {
    int mt, nt; const Params* p;
    __device__ __forceinline__ void operator()(const LAS uchar* ct) const {
        uchar* ws = p->ws; const int tid = tid_opaque();
        const LAS float* rowS = (const LAS float*)(lds_base() + LDS_ROW);
        const size_t base = (size_t)(mt * 256) * DM + nt * 128;
        float* pss = (float*)(ws + WS_PSS) + (size_t)(mt * 256) * 8 + nt;
#pragma unroll
        for (int it = 0; it < 8; ++it) {
            const int item = it * NT + tid, c8 = item & 15, r = item >> 4;
            const size_t off = base + (size_t)r * DM + c8 * 8;
            float c[8], x0[8]; unpack8(ct_ld8(ct, r, c8 * 8), c);
            unpack8(*(const u32x4*)((const bf16_t*)(ws + WS_XB) + off), x0);
            const float ir = rowS[r];
            float ss = 0.f; u32x4 o;
#pragma unroll
            for (int i = 0; i < 4; ++i) { const float y0 = x0[2 * i] * ir + c[2 * i], y1 = x0[2 * i + 1] * ir + c[2 * i + 1]; o[i] = pk2(y0, y1); ss += y0 * y0 + y1 * y1; }
            *(u32x4*)((bf16_t*)(ws + WS_XB) + off) = o;
            ss = sum16(ss);
            if (c8 == 0) pss[(size_t)r * 8] = ss;
        }
    }
};
struct EpiGU {
    int jt; size_t slot0; const Params* p;
    __device__ __forceinline__ void operator()(const LAS uchar* ct) const {
        uchar* ws = p->ws; const int tid = tid_opaque(), c8 = tid & 7, r0 = tid >> 3;
        const LAS float* rowS = (const LAS float*)(lds_base() + LDS_ROW);
        bf16_t* dbase = (bf16_t*)(ws + WS_HMID) + slot0 * 256 + jt * 64 + c8 * 8;
#pragma unroll
        for (int it = 0; it < 4; ++it) {
            const int r = it * 64 + r0;
            const float rs = rowS[r];
            float g[8], u[8]; unpack8(ct_ld8(ct, r, c8 * 8), g); unpack8(ct_ld8(ct, r, 64 + c8 * 8), u);
            float hv[8];
#pragma unroll
            for (int i = 0; i < 8; ++i) { const float gg = g[i] * rs, uu = u[i] * rs; hv[i] = gg * __builtin_amdgcn_rcpf(1.f + __builtin_amdgcn_exp2f(-gg * LOG2E)) * uu; }
            u32x4 o; o[0] = pk2(hv[0], hv[1]); o[1] = pk2(hv[2], hv[3]); o[2] = pk2(hv[4], hv[5]); o[3] = pk2(hv[6], hv[7]);
            *(u32x4*)(dbase + (size_t)r * 256) = o;
        }
    }
};
struct EpiGU64 {
    int jt, hq; size_t slot0; const Params* p;
    __device__ __forceinline__ void operator()(const LAS uchar* ct) const {
        uchar* ws = p->ws; const int tid = tid_opaque(), c8 = tid & 3, r0 = tid >> 2;
        const LAS float* rowS = (const LAS float*)(lds_base() + LDS_ROW);
        bf16_t* dbase = (bf16_t*)(ws + WS_HMID) + slot0 * 256 + jt * 64 + hq * 32 + c8 * 8;
#pragma unroll
        for (int it = 0; it < 2; ++it) {
            const int r = it * 128 + r0;
            const float rs = rowS[r];
            float g[8], u[8]; unpack8(ct_ld8(ct, r, c8 * 8), g); unpack8(ct_ld8(ct, r, 32 + c8 * 8), u);
            float hv[8];
#pragma unroll
            for (int i = 0; i < 8; ++i) { const float gg = g[i] * rs, uu = u[i] * rs; hv[i] = gg * __builtin_amdgcn_rcpf(1.f + __builtin_amdgcn_exp2f(-gg * LOG2E)) * uu; }
            u32x4 o; o[0] = pk2(hv[0], hv[1]); o[1] = pk2(hv[2], hv[3]); o[2] = pk2(hv[4], hv[5]); o[3] = pk2(hv[6], hv[7]);
            *(u32x4*)(dbase + (size_t)r * 256) = o;
        }
    }
};
struct EpiDown {
    int nt, nvalid; const Params* p;
    __device__ __forceinline__ void operator()(const LAS uchar* ct) const {
        uchar* ws = p->ws; const int tid = tid_opaque(), c16 = tid & 7, r0 = tid >> 3;
        const LAS float* rowS = (const LAS float*)(lds_base() + LDS_ROW); const LAS unsigned* rowE = (const LAS unsigned*)(lds_base() + LDS_ROW + 1024);
        uchar* ys = ws + WS_YS + nt * 128 + c16 * 16;
#pragma unroll
        for (int it = 0; it < 4; ++it) {
            const int r = it * 64 + r0;
            if (r < nvalid) {
                const unsigned ent = rowE[r]; const float w = rowS[r];
                float f[16]; { float a[8], b2[8]; unpack8(ct_ld8(ct, r, c16 * 16), a); unpack8(ct_ld8(ct, r, c16 * 16 + 8), b2);
#pragma unroll
                    for (int i = 0; i < 8; ++i) { f[i] = a[i] * w; f[8 + i] = b2[i] * w; } }
                u32x4 o;
#pragma unroll
                for (int i = 0; i < 4; ++i) { int v = 0; v = __builtin_amdgcn_cvt_pk_bf8_f32(f[4 * i], f[4 * i + 1], v, false); v = __builtin_amdgcn_cvt_pk_bf8_f32(f[4 * i + 2], f[4 * i + 3], v, true); o[i] = (unsigned)v; }
                *(u32x4*)(ys + (size_t)ent * DM) = o;
            }
        }
    }
};

template <int V = 0>
__device__ __forceinline__ void diff_attn_unit(LAS uchar* lds, const Params& p, int l, int b, int h, int qb) {
    uchar* ws = p.ws;
    const int tid = tid_opaque(), lane = tid & 63, wid = __builtin_amdgcn_readfirstlane(tid >> 6);
    const float* scal = (const float*)(ws + WS_SCAL) + 16 * l;
    const float lam = scal[0], oml = scal[1], m2 = scal[2];
    const float slope2 = exp2f(-2.f * (float)(h + 1)) * LOG2E;
    const bf16_t* Q1 = (const bf16_t*)(ws + WS_QD) + (((size_t)b * 4 + h) * 2) * S * 64;
    const bf16_t* K1 = (const bf16_t*)(ws + WS_KD) + (((size_t)b * 4 + h) * 2) * S * 64;
    const bf16_t* VT = (const bf16_t*)(ws + WS_VDT) + (((size_t)b * 4 + h) * 128) * S;
    const float* gsub = p.in[6] + l * 128;
    bf16_t* mix = (bf16_t*)(ws + WS_MIX);
#if NAIVE_ATTN
    {
        const int q = qb * 128 + (tid >> 2), mm = (tid >> 1) & 1, dh = tid & 1;
        const bf16_t* Qp = Q1 + (size_t)mm * S * 64 + (size_t)q * 64; const bf16_t* Kp = K1 + (size_t)mm * S * 64;
        float qv[64];
#pragma unroll
        for (int c8 = 0; c8 < 8; ++c8) { float f[8]; unpack8(*(const u32x4*)(Qp + c8 * 8), f);
#pragma unroll
            for (int i = 0; i < 8; ++i) qv[c8 * 8 + i] = f[i]; }
        float o[64]; float lsum = 0.f;
#pragma unroll
        for (int d = 0; d < 64; ++d) o[d] = 0.f;
        for (int key = 0; key < S; ++key) {
            float sc = 0.f;
#pragma unroll
            for (int c8 = 0; c8 < 8; ++c8) { float f[8]; unpack8(*(const u32x4*)(Kp + (size_t)key * 64 + c8 * 8), f);
#pragma unroll
                for (int i = 0; i < 8; ++i) sc += qv[c8 * 8 + i] * f[i]; }
            const float pv = __builtin_amdgcn_exp2f(sc - slope2 * fabsf((float)(q - key)) - m2);
            lsum += pv;
            const int kp = sigma16(key);
#pragma unroll
            for (int d = 0; d < 64; ++d) o[d] += pv * bf2f(VT[(size_t)(dh * 64 + d) * S + kp]);
        }
        const float inv = 1.f / lsum; float ss = 0.f;
#pragma unroll
        for (int d = 0; d < 64; ++d) { const float mine = o[d] * inv; const float other = __shfl_xor(mine, 2); o[d] = mine - lam * other; ss += o[d] * o[d]; }
        ss += __shfl_xor(ss, 1);
        if (mm == 0) {
            const float rn = __builtin_amdgcn_rsqf(ss * (1.f / 128.f) + EPS) * oml;
            bf16_t* dst = mix + (size_t)(b * S + q) * DM + h * 128 + dh * 64;
#pragma unroll
            for (int d = 0; d < 64; d += 2) *(unsigned*)(dst + d) = pk2(o[d] * rn * gsub[dh * 64 + d], o[d + 1] * rn * gsub[dh * 64 + d + 1]);
        }
    }
#else
    {
        const int r = lane & 31, hh = lane >> 5, qs = wid >> 1, mm = wid & 1, qpos = qb * 128 + qs * 32 + r;
        const bf16_t* Qm_ = Q1 + (size_t)mm * S * 64;
        bf16x8 qf[4];
#pragma unroll
        for (int ks = 0; ks < 4; ++ks) qf[ks] = *(const bf16x8*)(Qm_ + (size_t)qpos * 64 + ks * 16 + hh * 8);
        f32x16 O[4]; float lsum = 0.f;
#pragma unroll
        for (int db = 0; db < 4; ++db)
#pragma unroll
            for (int i = 0; i < 16; ++i) O[db][i] = 0.f;
        const int srow = lane >> 3, c0 = (lane & 7) ^ (srow >> 1);
        const bool isk = wid < 4;
        const bf16_t* sbase = isk ? (K1 + (size_t)(wid >> 1) * S * 64 + (size_t)(wid & 1) * 32 * 64) : (VT + (size_t)(wid - 4) * 32 * S);
        const int rstride = isk ? 64 : S, kstride = isk ? 64 * 64 : 64;
        const bf16_t* sb0 = sbase + (size_t)srow * rstride + c0 * 8;
        const bf16_t* sb1 = sbase + (size_t)srow * rstride + (c0 ^ 4) * 8;
        const int lanebase = r * 128 + ((hh ^ ((r >> 1) & 7)) << 4);
#define DA_STAGE(kt, sbuf) do { _Pragma("unroll") for (int j = 0; j < 4; ++j) \
            glds16(((j & 1) ? sb1 : sb0) + (size_t)(8 * j) * rstride + (size_t)(kt) * kstride, lds + (sbuf) * ASTG + (wid * 4 + j) * 1024); } while (0)
        const int dcut = (int)(160.f / slope2) + 1;
        int kt_lo = (qb * 128 - dcut) >> 6, kt_hi = (qb * 128 + 127 + dcut) >> 6; kt_lo = kt_lo < 0 ? 0 : kt_lo; kt_hi = kt_hi > S / 64 - 1 ? S / 64 - 1 : kt_hi;
        if (!(V & 8)) { DA_STAGE(kt_lo, kt_lo & 3); if (kt_lo + 1 <= kt_hi) DA_STAGE(kt_lo + 1, (kt_lo + 1) & 3); if (kt_lo + 2 <= kt_hi) DA_STAGE(kt_lo + 2, (kt_lo + 2) & 3); }
        const int q0w = qb * 128 + qs * 32;
        const float fq = (float)(qpos - 4 * hh);
        const float baseL = -slope2 * fq - m2, baseR = slope2 * fq - m2;
#define DSR128(dst, addr, off) asm volatile("ds_read_b128 %0, %1 offset:%2" : "=v"(dst) : "v"(addr), "n"(off) : "memory")
#define LGKM0() do { asm volatile("s_waitcnt lgkmcnt(0)" ::: "memory"); __builtin_amdgcn_sched_barrier(0); } while (0)
        const unsigned lds0 = (unsigned)(uintptr_t)lds;
        for (int kt = kt_lo; kt <= kt_hi; ++kt) {
            if (kt + 2 <= kt_hi) WAITV(8); else if (kt + 1 <= kt_hi) WAITV(4); else WAITV(0);
            __builtin_amdgcn_s_barrier();
            if (kt + 3 <= kt_hi) { DA_STAGE(kt + 3, (kt + 3) & 3); }
            const unsigned sb = lds0 + (unsigned)(kt & 3) * ASTG;
            unsigned VA[4], KA[4];
#pragma unroll
            for (int j = 0; j < 4; ++j) { VA[j] = sb + (unsigned)(lanebase ^ (j << 5)); KA[j] = VA[j] + (unsigned)mm * 8192u; }
            bf16x8 kf[2][4];
#pragma unroll
            for (int ks = 0; ks < 4; ++ks) { DSR128(kf[0][ks], KA[ks], 0); DSR128(kf[1][ks], KA[ks], 4096); }
            f32x16 sacc[2];
#pragma unroll
            for (int kb = 0; kb < 2; ++kb) {
                const int key0 = kt * 64 + 32 * kb;
                {
                    const float c = (key0 < q0w) ? slope2 : -slope2;
                    const float a = ((key0 < q0w) ? baseL : baseR) + c * (float)key0;
#pragma unroll
                    for (int i = 0; i < 16; ++i) sacc[kb][i] = a + c * (float)((i & 3) + 8 * (i >> 2));
                }
                if (__builtin_expect(key0 == q0w, 0)) {
                    const int kq = key0 + 4 * hh - qpos;
#pragma unroll
                    for (int i = 0; i < 16; ++i) sacc[kb][i] = -slope2 * fabsf((float)(kq + (i & 3) + 8 * (i >> 2))) - m2;
                }
            }
            LGKM0();
#define SB() __builtin_amdgcn_sched_barrier(0)
#pragma unroll
            for (int ks = 0; ks < 4; ++ks) sacc[0] = MFMA32(kf[0][ks], qf[ks], sacc[0]);
            bf16x8 vf0[4][2], vf1[4][2];
#pragma unroll
            for (int s2 = 0; s2 < 2; ++s2) { DSR128(vf0[0][s2], VA[s2], 16384); DSR128(vf0[1][s2], VA[s2], 16384 + 4096); DSR128(vf0[2][s2], VA[s2], 16384 + 8192); DSR128(vf0[3][s2], VA[s2], 16384 + 12288); }
            SB();
            unsigned w0[8], w1[8]; float ls = 0.f;
#pragma unroll
            for (int ks = 0; ks < 4; ++ks) {
                sacc[1] = MFMA32(kf[1][ks], qf[ks], sacc[1]);
#pragma unroll
                for (int g = 2 * ks; g < 2 * ks + 2; ++g) { const float e0 = __builtin_amdgcn_exp2f(sacc[0][2 * g]), e1 = __builtin_amdgcn_exp2f(sacc[0][2 * g + 1]); ls += e0 + e1; w0[g] = pk2(e0, e1); }
                SB();
            }
            bf16x8 pb0[2], pb1[2];
            { u32x4 a = {w0[0], w0[1], w0[2], w0[3]}, b2 = {w0[4], w0[5], w0[6], w0[7]}; pb0[0] = __builtin_bit_cast(bf16x8, a); pb0[1] = __builtin_bit_cast(bf16x8, b2); }
            LGKM0();
#pragma unroll
            for (int s2 = 0; s2 < 2; ++s2) { DSR128(vf1[0][s2], VA[2 + s2], 16384); DSR128(vf1[1][s2], VA[2 + s2], 16384 + 4096); DSR128(vf1[2][s2], VA[2 + s2], 16384 + 8192); DSR128(vf1[3][s2], VA[2 + s2], 16384 + 12288); }
            SB();
#pragma unroll
            for (int g = 0; g < 8; ++g) {
                O[g & 3] = MFMA32(vf0[g & 3][g >> 2], pb0[g >> 2], O[g & 3]);
                const float e0 = __builtin_amdgcn_exp2f(sacc[1][2 * g]), e1 = __builtin_amdgcn_exp2f(sacc[1][2 * g + 1]);
                ls += e0 + e1; w1[g] = pk2(e0, e1);
                SB();
            }
            lsum += ls;
            { u32x4 a = {w1[0], w1[1], w1[2], w1[3]}, b2 = {w1[4], w1[5], w1[6], w1[7]}; pb1[0] = __builtin_bit_cast(bf16x8, a); pb1[1] = __builtin_bit_cast(bf16x8, b2); }
            LGKM0();
#pragma unroll
            for (int s2 = 0; s2 < 2; ++s2)
#pragma unroll
                for (int db = 0; db < 4; ++db) O[db] = MFMA32(vf1[db][s2], pb1[s2], O[db]);
#undef SB
        }
#undef DSR128
#undef LGKM0
#undef DA_STAGE
        const float lt = lsum + __shfl_xor(lsum, 32);
        const float sc = (mm == 0) ? (1.f / lt) : (lam / lt);
        f32x4 gv[4][4];
        if (mm == 0) {
#pragma unroll
            for (int db = 0; db < 4; ++db)
#pragma unroll
                for (int q4 = 0; q4 < 4; ++q4) gv[db][q4] = *(const f32x4*)(gsub + 32 * db + 8 * q4 + 4 * hh);
        }
        __syncthreads();
        LAS float* xch = (LAS float*)lds + qs * (64 * 68) + lane * 68;
        if (mm == 1) {
#pragma unroll
            for (int db = 0; db < 4; ++db)
#pragma unroll
                for (int q4 = 0; q4 < 4; ++q4) { f32x4 t; t[0] = O[db][4 * q4] * sc; t[1] = O[db][4 * q4 + 1] * sc; t[2] = O[db][4 * q4 + 2] * sc; t[3] = O[db][4 * q4 + 3] * sc;
                    *(LAS f32x4*)(xch + db * 16 + q4 * 4) = t; }
        }
        __syncthreads();
        if (mm == 0) {
            float ss = 0.f;
#pragma unroll
            for (int db = 0; db < 4; ++db)
#pragma unroll
                for (int q4 = 0; q4 < 4; ++q4) { const f32x4 x = *(const LAS f32x4*)(xch + db * 16 + q4 * 4);
#pragma unroll
                    for (int j = 0; j < 4; ++j) { const float o = O[db][4 * q4 + j] * sc - x[j]; O[db][4 * q4 + j] = o; ss += o * o; } }
            ss += __shfl_xor(ss, 32);
            const float rn = __builtin_amdgcn_rsqf(ss * (1.f / 128.f) + EPS) * oml;
            bf16_t* dst = mix + (size_t)(b * S + qpos) * DM + h * 128 + 8 * hh;
#pragma unroll
            for (int db = 0; db < 4; ++db)
#pragma unroll
                for (int q2 = 0; q2 < 2; ++q2) {
                    unsigned a[2], c[2];
#pragma unroll
                    for (int e = 0; e < 2; ++e) { const int q4 = 2 * q2 + e; const f32x4 g = gv[db][q4];
                        const unsigned w0 = pk2(O[db][4 * q4] * rn * g[0], O[db][4 * q4 + 1] * rn * g[1]), w1 = pk2(O[db][4 * q4 + 2] * rn * g[2], O[db][4 * q4 + 3] * rn * g[3]);
                        if (e == 0) { a[0] = w0; a[1] = w1; } else { c[0] = w0; c[1] = w1; } }
#pragma unroll
                    for (int e = 0; e < 2; ++e) { auto r2 = __builtin_amdgcn_permlane32_swap(a[e], c[e], false, false); a[e] = r2[0]; c[e] = r2[1]; }
                    u32x4 w = {a[0], a[1], c[0], c[1]};
                    *(u32x4*)(dst + 32 * db + 16 * q2) = w;
                }
        }
    }
#endif
    __syncthreads();
}

__device__ __forceinline__ void mla_attn_unit(LAS uchar* lds, const Params& p, int l, int unit) {
    uchar* ws = p.ws;
    const int tid = tid_opaque(), lane = tid & 63, wid = __builtin_amdgcn_readfirstlane(tid >> 6);
    const int xg_ = unit & 7, v_ = unit >> 3, qb = v_ & 7, bh_ = (v_ >> 3) * 8 + xg_, h = bh_ & 3, b = bh_ >> 2;
    const float m2 = ((const float*)(ws + WS_SCAL))[16 * l + 3];
    const bf16_t* Q = (const bf16_t*)(ws + WS_QM) + (((size_t)b * 4 + h) * S) * 96;
    const bf16_t* Kp = (const bf16_t*)(ws + WS_KM) + (((size_t)b * 4 + h) * S) * 96;
    const bf16_t* VT = (const bf16_t*)(ws + WS_VMT) + (((size_t)b * 4 + h) * 64) * S;
    bf16_t* mix = (bf16_t*)(ws + WS_MIX);
#if NAIVE_ATTN
    {
        const int q = qb * 256 + (tid >> 1), hf = tid & 1;
        float qv[96];
#pragma unroll
        for (int c8 = 0; c8 < 12; ++c8) { float f[8]; unpack8(*(const u32x4*)(Q + (size_t)q * 96 + c8 * 8), f);
#pragma unroll
            for (int i = 0; i < 8; ++i) qv[c8 * 8 + i] = f[i]; }
        float o[32]; float lsum = 0.f;
#pragma unroll
        for (int d = 0; d < 32; ++d) o[d] = 0.f;
        for (int key = 0; key < S; ++key) {
            float sc = 0.f;
#pragma unroll
            for (int c8 = 0; c8 < 12; ++c8) { float f[8]; unpack8(*(const u32x4*)(Kp + (size_t)key * 96 + c8 * 8), f);
#pragma unroll
                for (int i = 0; i < 8; ++i) sc += qv[c8 * 8 + i] * f[i]; }
            const float pv = __builtin_amdgcn_exp2f(sc - m2);
            lsum += pv;
            const int kp = sigma16(key);
#pragma unroll
            for (int d = 0; d < 32; ++d) o[d] += pv * bf2f(VT[(size_t)(hf * 32 + d) * S + kp]);
        }
        const float inv = 1.f / lsum;
        bf16_t* dst = mix + (size_t)(b * S + q) * DM + 512 + h * 64 + hf * 32;
#pragma unroll
        for (int d = 0; d < 32; d += 2) *(unsigned*)(dst + d) = pk2(o[d] * inv, o[d + 1] * inv);
    }
#else
    {
        const int r = lane & 31, hh = lane >> 5, qpos = qb * 256 + wid * 32 + r;
        bf16x8 qf[6];
#pragma unroll
        for (int ks = 0; ks < 6; ++ks) qf[ks] = *(const bf16x8*)(Q + (size_t)qpos * 96 + ks * 16 + hh * 8);
        f32x16 O[2]; float lsum = 0.f;
#pragma unroll
        for (int db = 0; db < 2; ++db)
#pragma unroll
            for (int i = 0; i < 16; ++i) O[db][i] = 0.f;
        const int lanebase = r * 128 + ((hh ^ ((r >> 1) & 7)) << 4), lanebase64 = r * 64 + ((hh ^ ((r >> 2) & 3)) << 4);
        const bool lo4 = wid < 4;
        const bf16_t* s0p; const bf16_t* s1p; const bf16_t* s2p;
        {
            const int srow = lane >> 3;
            { const int row = 8 * wid + srow; const int c = (lane & 7) ^ ((row >> 1) & 7); s0p = Kp + (size_t)row * 96 + c * 8; }
            if (lo4) { const int row = 16 * wid + (lane >> 2); const int c = (lane & 3) ^ ((row >> 2) & 3); s1p = Kp + (size_t)row * 96 + 64 + c * 8; }
            else { const int row = 8 * (wid - 4) + srow; const int c = (lane & 7) ^ ((row >> 1) & 7); s1p = VT + (size_t)row * S + c * 8; }
            { const int row = 8 * ((wid & 3) + 4) + srow; const int c = (lane & 7) ^ ((row >> 1) & 7); s2p = VT + (size_t)row * S + c * 8; }
        }
        const int k1stride = lo4 ? 64 * 96 : 64;
#define MA_STAGE(kt, sbuf) do { \
            glds16(s0p + (size_t)(kt) * (64 * 96), lds + (sbuf) * MSTG + wid * 1024); \
            glds16(s1p + (size_t)(kt) * k1stride, lds + (sbuf) * MSTG + (wid + 8) * 1024); \
            if (lo4) glds16(s2p + (size_t)(kt) * 64, lds + (sbuf) * MSTG + (wid + 16) * 1024); } while (0)
        MA_STAGE(0, 0); MA_STAGE(1, 1); MA_STAGE(2, 2);
        for (int kt = 0; kt < S / 64; ++kt) {
            if (kt + 2 < S / 64) { if (lo4) WAITV(6); else WAITV(4); } else if (kt + 1 < S / 64) { if (lo4) WAITV(3); else WAITV(2); } else WAITV(0);
            __builtin_amdgcn_s_barrier();
            if (kt + 3 < S / 64) { MA_STAGE(kt + 3, (kt + 3) & 3); }
            const LAS uchar* st = lds + (kt & 3) * MSTG;
#pragma unroll
            for (int kb = 0; kb < 2; ++kb) {
                f32x16 sacc;
#pragma unroll
                for (int i = 0; i < 16; ++i) sacc[i] = -m2;
#pragma unroll
                for (int ks = 0; ks < 4; ++ks) {
                    const bf16x8 kf = *(const LAS bf16x8*)(st + kb * 4096 + (lanebase ^ (ks << 5)));
                    sacc = MFMA32(kf, qf[ks], sacc);
                }
#pragma unroll
                for (int ks = 0; ks < 2; ++ks) {
                    const bf16x8 kf = *(const LAS bf16x8*)(st + 8192 + kb * 2048 + (lanebase64 ^ (ks << 5)));
                    sacc = MFMA32(kf, qf[4 + ks], sacc);
                }
                float ls = 0.f;
#pragma unroll
                for (int i = 0; i < 16; ++i) { const float pv = __builtin_amdgcn_exp2f(sacc[i]); ls += pv; sacc[i] = pv; }
                lsum += ls;
                bf16x8 pb[2];
#pragma unroll
                for (int s2 = 0; s2 < 2; ++s2) {
                    u32x4 w;
#pragma unroll
                    for (int i = 0; i < 4; ++i) w[i] = pk2(sacc[8 * s2 + 2 * i], sacc[8 * s2 + 2 * i + 1]);
                    pb[s2] = __builtin_bit_cast(bf16x8, w);
                }
#pragma unroll
                for (int db = 0; db < 2; ++db)
#pragma unroll
                    for (int s2 = 0; s2 < 2; ++s2) {
                        const bf16x8 vf = *(const LAS bf16x8*)(st + 12288 + db * 4096 + (lanebase ^ ((2 * kb + s2) << 5)));
                        O[db] = MFMA32(vf, pb[s2], O[db]);
                    }
            }
        }
#undef MA_STAGE
        const float lt = lsum + __shfl_xor(lsum, 32); const float inv = 1.f / lt;
        bf16_t* dst = mix + (size_t)(b * S + qpos) * DM + 512 + h * 64;
#pragma unroll
        for (int db = 0; db < 2; ++db)
#pragma unroll
            for (int q4 = 0; q4 < 4; ++q4) {
                const int d = 32 * db + 8 * q4 + 4 * hh;
                u32x2 w; w[0] = pk2(O[db][4 * q4] * inv, O[db][4 * q4 + 1] * inv); w[1] = pk2(O[db][4 * q4 + 2] * inv, O[db][4 * q4 + 3] * inv);
                *(u32x2*)(dst + d) = w;
            }
    }
#endif
    __syncthreads();
}

__device__ __forceinline__ int xp_rowmap(int mode, int n) {
    return mode == 0 ? n : mode == 1 ? (n / 96) * 128 + (n % 96) : mode == 2 ? ((n >> 6) * 128 + (n & 63)) : ((n >> 6) * 128 + 64 + (n & 63));
}
__device__ __forceinline__ void xpose_tile(LAS uchar* lds, const float* src, int K, int N, bf16_t* dst, int ldd, int mode, const float* gain, int kt, int ntile, int lds_src = 0) {
    LAS float* sh = (LAS float*)lds; const int tid = tid_opaque();
    (void)K; const int ldn = lds_src ? lds_src : N;
    {
        const int n4 = tid & 63, n = ntile * 256 + n4 * 4;
        if (n < N) {
#pragma unroll
            for (int i = 0; i < 8; ++i) {
                const int kl = (tid >> 6) + 8 * i, k = kt * 64 + kl;
                f32x4 v = *(const f32x4*)(src + (size_t)k * ldn + n);
                if (gain) { const float gk = gain[k]; v[0] *= gk; v[1] *= gk; v[2] *= gk; v[3] *= gk; }
                LAS float* d = sh + kl * 257 + n4 * 4; d[0] = v[0]; d[1] = v[1]; d[2] = v[2]; d[3] = v[3];
            }
        }
    }
    __syncthreads();
    {
        const int nl = tid >> 1, kh = tid & 1, n = ntile * 256 + nl;
        if (n < N) {
            bf16_t* d = dst + (size_t)xp_rowmap(mode, n) * ldd + kt * 64 + kh * 32;
#pragma unroll
            for (int c8 = 0; c8 < 4; ++c8) { u32x4 o;
#pragma unroll
                for (int i = 0; i < 4; ++i) o[i] = pk2(sh[(kh * 32 + c8 * 8 + 2 * i) * 257 + nl], sh[(kh * 32 + c8 * 8 + 2 * i + 1) * 257 + nl]);
                *(u32x4*)(d + c8 * 8) = o; }
        }
    }
    __syncthreads();
}
__device__ __forceinline__ void xpose_job(LAS uchar* lds, const float* src, int K, int N, bf16_t* dst, int ldd, int mode, const float* gain, int lds_src = 0) {
    const int nkt = K >> 6, nnt = (N + 255) >> 8, tot = nkt * nnt;
    for (int u = blockIdx.x; u < tot; u += gridDim.x) xpose_tile(lds, src, K, N, dst, ldd, mode, gain, u % nkt, u / nkt, lds_src);
}
constexpr int XS_PITCH = 1040, XS_STAGE = 64 * XS_PITCH;
struct XTile { const float* src; bf16_t* dst; const float* gain; int ldn; int dpitch; };
__device__ __forceinline__ XTile expert_tile_desc(const Params& p, int l, int u, int nq, int ko) {
    const int e = u / 48, w = u % 48, job = w >> 4, tl = w & 15, n = 4 * nq;
    XTile t;
    if (job < 2) {
        t.src = p.in[23 + job] + ((size_t)l * 32 + e) * DM * 256 + (size_t)tl * 64 * 256; t.ldn = 256; t.gain = p.in[18] + l * DM + tl * 64 + ko * 8;
        t.dst = (bf16_t*)(p.ws + WS_WGU) + ((size_t)e * 512 + (n >> 6) * 128 + job * 64 + (n & 63)) * DM + tl * 64 + ko * 8; t.dpitch = DM;
    } else {
        const int kt = tl & 3, ntile = tl >> 2;
        t.src = p.in[25] + ((size_t)l * 32 + e) * 256 * DM + (size_t)kt * 64 * DM + ntile * 256; t.ldn = DM; t.gain = nullptr;
        t.dst = (bf16_t*)(p.ws + WS_WD) + ((size_t)e * DM + ntile * 256 + n) * 256 + kt * 64 + ko * 8; t.dpitch = 256;
    }
    return t;
}
__device__ __forceinline__ void expert_stream(LAS uchar* lds, const Params& p, int l, int u0, int ustep, int uend) {
    const int tid = tid_opaque(), lane = tid & 63, wid = __builtin_amdgcn_readfirstlane(tid >> 6);
    const int nq = wid * 8 + (lane & 7), ko = lane >> 3;
    const int cnt = u0 < uend ? (uend - 1 - u0) / ustep + 1 : 0;
#define XS_ISSUE(i) do { const XTile t_ = expert_tile_desc(p, l, u0 + (i) * ustep, nq, ko); _Pragma("unroll") for (int j = 0; j < 8; ++j) \
        glds16_nt(t_.src + (size_t)(wid * 8 + j) * t_.ldn + lane * 4, lds + ((i) & 1) * XS_STAGE + (wid * 8 + j) * XS_PITCH); } while (0)
    if (cnt > 0) XS_ISSUE(0);
    if (cnt > 1) XS_ISSUE(1);
    for (int i = 0; i < cnt; ++i) {
        if (i + 1 < cnt) WAITV(8); else WAITV(0);
        __builtin_amdgcn_s_barrier();
        const XTile t = expert_tile_desc(p, l, u0 + i * ustep, nq, ko);
        const LAS uchar* sh = lds + (i & 1) * XS_STAGE + (ko * 8) * XS_PITCH + nq * 16;
        f32x4 v[8];
#pragma unroll
        for (int kk = 0; kk < 8; ++kk) v[kk] = *(const LAS f32x4*)(sh + kk * XS_PITCH);
        if (t.gain) { const f32x4 g0 = *(const f32x4*)t.gain, g1 = *(const f32x4*)(t.gain + 4);
#pragma unroll
            for (int kk = 0; kk < 8; ++kk) { const float g = kk < 4 ? g0[kk] : g1[kk - 4]; v[kk][0] *= g; v[kk][1] *= g; v[kk][2] *= g; v[kk][3] *= g; } }
#pragma unroll
        for (int c = 0; c < 4; ++c) { u32x4 o;
#pragma unroll
            for (int q = 0; q < 4; ++q) o[q] = pk2(v[2 * q][c], v[2 * q + 1][c]);
            *(u32x4*)(t.dst + (size_t)c * t.dpitch) = o; }
        __builtin_amdgcn_s_barrier();
        if (i + 2 < cnt) XS_ISSUE(i + 2);
    }
#undef XS_ISSUE
    __syncthreads();
}
__device__ __forceinline__ void expert_weights(LAS uchar* lds, const Params& p, int l) {
    const bool full = (int)gridDim.x == 256; const int b = (int)blockIdx.x;
    const int u0 = !full ? b : b >= 64 ? b - 64 : 1344 + b, ustep = !full ? (int)gridDim.x : b >= 64 ? 192 : 64, uend = !full ? 1536 : b >= 64 ? 1344 : 1536;
    expert_stream(lds, p, l, u0, ustep, uend);
}
__device__ __forceinline__ void row_prep(const float* xrow, bf16_t* xb, float* rstd, int lane) {
    float ss = 0.f; f32x4 v[4];
#pragma unroll
    for (int i = 0; i < 4; ++i) { v[i] = __builtin_nontemporal_load((const f32x4*)(xrow + (i >> 1) * 512 + lane * 8 + (i & 1) * 4)); ss += v[i][0] * v[i][0] + v[i][1] * v[i][1] + v[i][2] * v[i][2] + v[i][3] * v[i][3]; }
    ss = wave_sum(ss);
    const float ms = ss * (1.f / 1024.f) + EPS, rs = __builtin_amdgcn_rsqf(ms);
#pragma unroll
    for (int i = 0; i < 2; ++i) { u32x4 o; o[0] = pk2(v[2 * i][0] * rs, v[2 * i][1] * rs); o[1] = pk2(v[2 * i][2] * rs, v[2 * i][3] * rs); o[2] = pk2(v[2 * i + 1][0] * rs, v[2 * i + 1][1] * rs); o[3] = pk2(v[2 * i + 1][2] * rs, v[2 * i + 1][3] * rs);
        *(u32x4*)(xb + i * 512 + lane * 8) = o; }
    if (lane == 0) *rstd = ms * rs;
}

__device__ __forceinline__ void phase0(LAS uchar* lds, const Params& p) {
    uchar* ws = p.ws; const int tid = tid_opaque(), gtid = blockIdx.x * NT + tid, gsz = gridDim.x * NT;
    for (int idx = blockIdx.x; idx < NL * 202; idx += gridDim.x) {
        const int l = idx / 202, j = idx % 202;
        if (j < 128) xpose_tile(lds, p.in[2] + (size_t)l * DM * NIN, DM, 1888, (bf16_t*)(ws + WS_WIN) + (size_t)l * NINP * DM, DM, 0, p.in[1] + l * DM, j & 15, j >> 4, NIN);
        else if (j < 192) xpose_tile(lds, p.in[17] + (size_t)l * DM * DM, DM, DM, (bf16_t*)(ws + WS_WOUT) + (size_t)l * DM * DM, DM, 0, nullptr, (j - 128) & 15, (j - 128) >> 4);
        else if (j < 198) xpose_tile(lds, p.in[9] + (size_t)l * 192 * 384, 192, 384, (bf16_t*)(ws + WS_WUQ) + (size_t)l * 512 * 192, 192, 1, p.in[7] + l * 192, (j - 192) % 3, (j - 192) / 3);
        else xpose_tile(lds, p.in[10] + (size_t)l * 128 * 512, 128, 512, (bf16_t*)(ws + WS_WUKV) + (size_t)l * 512 * 128, 128, 0, p.in[8] + l * 128, (j - 198) & 1, (j - 198) >> 1);
    }
    for (int l = 0; l < NL; ++l) {
        for (int i = gtid; i < 64 * DM; i += gsz) {
            const int n = (i & 63) * 4, k = i >> 6, g = n >> 6, d = n & 63;
            const float* wi = p.in[2] + ((size_t)l * DM + k) * NIN + 1888 + g * 64; const float* pw = p.in[15] + ((size_t)l * 4 + g) * 64 * 64 + d;
            f32x4 acc = {0.f, 0.f, 0.f, 0.f};
#pragma unroll 4
            for (int c4 = 0; c4 < 16; ++c4) { const f32x4 w4 = *(const f32x4*)(wi + 4 * c4);
#pragma unroll
                for (int j = 0; j < 4; ++j) { const float w = w4[j]; const f32x4 pv = *(const f32x4*)(pw + (4 * c4 + j) * 64); acc[0] += w * pv[0]; acc[1] += w * pv[1]; acc[2] += w * pv[2]; acc[3] += w * pv[3]; } }
            const float gk = p.in[1][l * DM + k]; const f32x4 sc = *(const f32x4*)(p.in[16] + l * 256 + n);
#pragma unroll
            for (int j = 0; j < 4; ++j) ((bf16_t*)(ws + WS_WIN))[((size_t)l * NINP + 1888 + n + j) * DM + k] = f2bf(acc[j] * gk * sc[j]);
        }
        { bf16_t* w = (bf16_t*)(ws + WS_WIN) + ((size_t)l * NINP + NIN) * DM; for (int i = gtid; i < 32 * DM; i += gsz) w[i] = 0; }
        { bf16_t* w = (bf16_t*)(ws + WS_WUQ) + (size_t)l * 512 * 192; for (int i = gtid; i < 4 * 32 * 192; i += gsz) { const int hd = i / (32 * 192), rem = i % (32 * 192); w[(size_t)(hd * 128 + 96) * 192 + rem] = 0; } }
    }
    for (int i = gtid; i < NL * 128 * 1024; i += gsz) {
        const int k = i & 1023, n = (i >> 10) & 127, l = i >> 17;
        const int sn = n < 36 ? n : (n >= 64 && n < 100) ? n - 64 : -1;
        float v = 0.f;
        if (sn >= 0) { v = sn < 4 ? p.in[19][((size_t)l * DM + k) * 4 + sn] : p.in[21][((size_t)l * DM + k) * 32 + (sn - 4)]; v *= p.in[18][l * DM + k]; }
        const bf16_t hi = f2bf(v), lo = f2bf(v - bf2f(hi));
        ((bf16_t*)(ws + WS_WR))[i] = n < 64 ? hi : lo;
    }
    for (int i = gtid; i < S * 16; i += gsz) {
        const int pos = i >> 4, f = i & 15;
        double inv = 1.0; for (int k = 0; k < f; ++k) inv *= 0.5623413251903491;
        const double rev = (double)pos * inv * 0.15915494309189535;
        const float fr = (float)(rev - __builtin_rint(rev));
        ((float*)(ws + WS_ROPE))[i] = __builtin_amdgcn_cosf(fr);
        ((float*)(ws + WS_ROPE))[S * 16 + i] = __builtin_amdgcn_sinf(fr);
    }
    if (blockIdx.x == 0 && (tid >> 6) < NL) {
        const int l = tid >> 6, lane = tid & 63; float* sc = (float*)(ws + WS_SCAL) + 16 * l;
        const float* lv = p.in[5] + l * 256;
        const float d1 = wave_sum(lv[lane] * lv[64 + lane]), d2 = wave_sum(lv[128 + lane] * lv[192 + lane]);
        float gq = fabsf(p.in[3][l * 64 + lane]), gk = fabsf(p.in[4][l * 64 + lane]);
        float a = fabsf(p.in[11][l * 64 + lane]), c = fabsf(p.in[13][l * 64 + lane]);
        float bq = fabsf(p.in[12][l * 32 + (lane & 31)]), dk = fabsf(p.in[14][l * 32 + (lane & 31)]);
#pragma unroll
        for (int o = 32; o >= 1; o >>= 1) { gq = fmaxf(gq, __shfl_xor(gq, o)); gk = fmaxf(gk, __shfl_xor(gk, o)); a = fmaxf(a, __shfl_xor(a, o)); c = fmaxf(c, __shfl_xor(c, o));
            bq = fmaxf(bq, __shfl_xor(bq, o)); dk = fmaxf(dk, __shfl_xor(dk, o)); }
        if (lane == 0) {
            const float lam_init = 0.8f - 0.6f * expf(-0.3f * (float)l);
            sc[0] = expf(d1) - expf(d2) + lam_init; sc[1] = 1.f - lam_init;
            sc[2] = gq * gk * 8.f * LOG2E * 1.02f;
            sc[3] = sqrtf(64.f * a * a + 32.f * bq * bq) * sqrtf(64.f * c * c + 32.f * dk * dk) * QSCALE_M * 1.02f;
        }
    }
    {
        const int lane = tid & 63, w = tid >> 6;
        unsigned* head = (unsigned*)(ws + WS_CTL) + CW_XROW;
        LAS unsigned* slot = (LAS unsigned*)(lds + LDS_ROW);
        if (tid == 0) slot[0] = atomicAdd(head, 1u);
        __syncthreads();
        unsigned c = slot[0]; int par = 0;
        while (c < (unsigned)(T / 32)) {
            unsigned nx = 0u;
            if (tid == 0) nx = atomicAdd(head, 1u);
#pragma unroll 1
            for (int r = 0; r < 4; ++r) { const int t = (int)c * 32 + r * 8 + w;
                row_prep(p.in[0] + (size_t)t * DM, (bf16_t*)(ws + WS_XB) + (size_t)t * DM, (float*)(ws + WS_RSTD1) + t, lane); }
            par ^= 1;
            if (tid == 0) slot[par] = nx;
            __syncthreads();
            c = slot[par];
        }
    }
}

struct MkProj { int mt, pn, l; const Params* p; __device__ __forceinline__ EpiProj operator()(int half) const { return EpiProj{mt, 2 * pn + half, l, p}; } };
__device__ __forceinline__ void ph_gemm1(LAS uchar* lds, const Params& p, int l) {
    const bf16_t* xb = (const bf16_t*)(p.ws + WS_XB); const bf16_t* win = (const bf16_t*)(p.ws + WS_WIN) + (size_t)l * NINP * DM;
    if (SHADOW_G >= 0) for (int u0 = blockIdx.x; u0 < 512; u0 += gridDim.x) {
        const int xg = u0 & 7, v = u0 >> 3, mt = (v >> 3) * 8 + xg, pn = v & 7;
        MkProj mk{mt, pn, l, &p};
        gemm_big<(SHADOW_G >= 0 ? SHADOW_G : 0)>(lds, ARowLinear{xb + (size_t)mt * 256 * DM, (size_t)DM}, win + (size_t)pn * 256 * DM, (size_t)DM, DM, mk);
    }
    for (int u0 = blockIdx.x; u0 < 64 * 8; u0 += gridDim.x) {
        const int xg = u0 & 7, v = u0 >> 3, mt = (v >> 3) * 8 + xg, pn = ((v & 7) + 4 * ((v >> 5) & 1)) & 7;
        MkProj mk{mt, pn, l, &p};
        gemm_big8(lds, xb + (size_t)mt * 256 * DM, win + (size_t)pn * 256 * DM, DM, mk);
    }
}
__device__ __forceinline__ void gemm1_tail_unit(LAS uchar* lds, const Params& p, int l, int mt) {
    const bf16_t* xb = (const bf16_t*)(p.ws + WS_XB); const bf16_t* win = (const bf16_t*)(p.ws + WS_WIN) + (size_t)l * NINP * DM;
    ARowLinear ar{xb + (size_t)mt * 256 * DM, (size_t)DM};
    EpiProj ep{mt, 16, l, &p};
    gemm_tile(lds, ar, win + (size_t)16 * 128 * DM, (size_t)DM, DM, ep);
}
template <int HALF>
__device__ __forceinline__ void pool_rows2(const float (&va)[32], const float (&vb)[32], int sfirst, bf16_t* dst) {
    float ra = 0.f, rb = 0.f;
#pragma unroll
    for (int i = 8 - HALF; i < 8 + HALF; ++i) { ra += va[i]; rb += vb[i]; }
#pragma unroll
    for (int r = 0; r < 16; ++r) {
        const int s = sfirst + r; int lo = s - HALF, hi = s + HALF - 1; lo = lo < 0 ? 0 : lo; hi = hi > S - 1 ? S - 1 : hi;
        const float inv = __builtin_amdgcn_rcpf((float)(hi - lo + 1));
        *(unsigned*)(dst + (size_t)r * DM) = pk2(ra * inv - va[r + 8], rb * inv - vb[r + 8]);
        if (r < 15) { ra += va[r + 8 + HALF] - va[r + 8 - HALF]; rb += vb[r + 8 + HALF] - vb[r + 8 - HALF]; }
    }
}
__device__ __forceinline__ void pooled_unit(LAS uchar* lds, const Params& p, int ut) {
    const int tid = tid_opaque();
    const int t0 = ut * 64, b = t0 >> 11, s0 = t0 & 2047;
    const bf16_t* lat = (const bf16_t*)(p.ws + WS_LAT) + (size_t)b * S * 640 + 352;
    for (int it = 0; it < 5; ++it) {
        const int item = it * NT + tid, c8 = item & 31, rl = item >> 5, sr = s0 - 8 + rl;
        u32x4 v = {0u, 0u, 0u, 0u};
        if (sr >= 0 && sr < S) v = *(const u32x4*)(lat + (size_t)sr * 640 + c8 * 8);
        *(LAS u32x4*)(lds + rl * 512 + c8 * 16) = v;
    }
    __syncthreads();
    {
        const int w = tid >> 6, lane = tid & 63, g = __builtin_amdgcn_readfirstlane(w & 3), rq = (w >> 2) * 2 + (lane >> 5), cp = g * 32 + (lane & 31);
        bf16_t* dst = (bf16_t*)(p.ws + WS_MIX) + (size_t)(t0 + rq * 16) * DM + 768 + cp * 2;
        const LAS unsigned* col = (const LAS unsigned*)lds + (rq * 16) * 128 + cp;
        float va[32], vb[32];
#pragma unroll
        for (int i = 0; i < 32; ++i) { const unsigned u = col[i * 128]; va[i] = bflo(u); vb[i] = bfhi(u); }
        const int sfirst = s0 + rq * 16;
        if (g == 0) pool_rows2<1>(va, vb, sfirst, dst); else if (g == 1) pool_rows2<2>(va, vb, sfirst, dst); else if (g == 2) pool_rows2<4>(va, vb, sfirst, dst); else pool_rows2<8>(va, vb, sfirst, dst);
    }
    __syncthreads();
}
__device__ __forceinline__ void mla_up_unit(LAS uchar* lds, const Params& p, int l, int v) {
    const bf16_t* lat = (const bf16_t*)(p.ws + WS_LAT);
    const int mt = v >> 3, w = v & 7, h = w & 3;
    { const int tp = tid_opaque(); if (tp < 256) { const float* hs = (const float*)(p.ws + WS_HSS) + (size_t)(mt * 256 + tp) * 8;
        const f32x4 h0 = *(const f32x4*)hs; const float h4 = hs[4];
        ((LAS float*)(lds + LDS_ROW))[tp] = (w < 4) ? __builtin_amdgcn_rsqf((h0[0] + h0[1] + h0[2]) * (1.f / 192.f) + EPS) : __builtin_amdgcn_rsqf((h0[3] + h4) * (1.f / 128.f) + EPS); } }
    if (w < 4) { ARowLinear ar{lat + (size_t)mt * 256 * 640, (size_t)640}; EpiMlaQ ep{mt, h, l, &p};
        gemm_tile(lds, ar, (const bf16_t*)(p.ws + WS_WUQ) + ((size_t)l * 512 + h * 128) * 192, (size_t)192, 192, ep); }
    else { ARowLinear ar{lat + (size_t)mt * 256 * 640 + 192, (size_t)640}; EpiMlaKV ep{mt, h, l, &p};
        gemm_tile(lds, ar, (const bf16_t*)(p.ws + WS_WUKV) + ((size_t)l * 512 + h * 128) * 128, (size_t)128, 128, ep); }
}
__device__ __forceinline__ void ph_mix_a(LAS uchar* lds, const Params& p, int l) {
    const int G = (int)gridDim.x;
    if (G == 256) {
        const int xg = blockIdx.x & 7, j = blockIdx.x >> 3;
        if (SHADOW_V >= 0) { diff_attn_unit<(SHADOW_V >= 0 ? SHADOW_V : 0)>(lds, p, l, xg, 2 + (j >> 4), j & 15); }
        diff_attn_unit<0>(lds, p, l, xg, 2 + (j >> 4), j & 15);
        if (j < 16) { diff_attn_unit<0>(lds, p, l, xg, 1, j); mla_up_unit(lds, p, l, (xg + 8 * (j >> 3)) * 8 + (j & 7)); }
        else {
            const int i = j - 16;
            diff_attn_unit<0>(lds, p, l, xg, 0, i);
            const int cnt = (0x3210554444550123ull >> (4 * (15 - i))) & 15;
            int n0 = 16; for (int q = 0; q < i; ++q) n0 += (int)((0x3210554444550123ull >> (4 * (15 - q))) & 15);
            if (i < 4 || i >= 12) gemm1_tail_unit(lds, p, l, xg + 8 * (i < 4 ? i : i - 8));
            for (int n = n0; n < n0 + cnt; ++n) mla_up_unit(lds, p, l, (xg + 8 * (n >> 3)) * 8 + (n & 7));
        }
    } else {
        for (int u = blockIdx.x; u < 512 + 512 + 64; u += G) {
            if (u < 512) diff_attn_unit<0>(lds, p, l, u >> 6, (u >> 4) & 3, u & 15);
            else if (u < 1024) mla_up_unit(lds, p, l, u - 512);
            else gemm1_tail_unit(lds, p, l, u - 1024);
        }
    }
}
__device__ __forceinline__ void ph_mix_b(LAS uchar* lds, const Params& p, int l) {
    (void)l;
    for (int u = blockIdx.x; u < 256 + 256; u += gridDim.x) {
        if (u < 256) mla_attn_unit(lds, p, l, u);
        else pooled_unit(lds, p, u - 256);
    }
}
struct MkWout { int mt, pn; const Params* p; __device__ __forceinline__ EpiWout operator()(int half) const { return EpiWout{mt, 2 * pn + half, p}; } };
__device__ __forceinline__ void ph_wout(LAS uchar* lds, const Params& p, int l) {
    const bf16_t* mix = (const bf16_t*)(p.ws + WS_MIX); const bf16_t* wo = (const bf16_t*)(p.ws + WS_WOUT) + (size_t)l * DM * DM;
    for (int u0 = blockIdx.x; u0 < 64 * 4; u0 += gridDim.x) {
        const int xg = u0 & 7, v = u0 >> 3, mt = (v >> 2) * 8 + xg, pn = v & 3;
        MkWout mk{mt, pn, &p};
        { const int tp = tid_opaque(); if (tp < 256) ((LAS float*)(lds + LDS_ROW))[tp] = ((const float*)(p.ws + WS_RSTD1))[mt * 256 + tp]; }
        gemm_big8(lds, mix + (size_t)mt * 256 * DM, wo + (size_t)pn * 256 * DM, DM, mk);
    }
}
constexpr int LDS_RT = 135168;
struct EpiRouter {
    int mt, l; bool dry; const Params* p;
    __device__ __forceinline__ void operator()(const LAS uchar* ct) const {
        uchar* ws = p->ws; const int tid = tid_opaque();
        const LAS float* ctf = (const LAS float*)ct;
        LAS unsigned* shcnt = (LAS unsigned*)(ct + LDS_RT); LAS unsigned* shbase = shcnt + 32; LAS unsigned* pend = shcnt + 64;
        LAS float* pendw = (LAS float*)(pend + 512); LAS float* pendr = pendw + 512;
        float* lrs = (float*)(ws + (dry ? WS_POOLED + 2 * MiB : WS_LRS)); float* lgw = (float*)(ws + (dry ? WS_POOLED + 2 * MiB : WS_LGW));
        unsigned* cnt = (unsigned*)(ws + WS_CTL) + CW_CNT + 1024 * l + (dry ? 2048 : 0);
        unsigned* list = (unsigned*)(ws + (dry ? WS_POOLED : WS_LIST)); float* gwt = (float*)(ws + (dry ? WS_POOLED + 4 * MiB : WS_GW)); float* rstd2 = (float*)(ws + (dry ? WS_POOLED + 5 * MiB : WS_RSTD2));
        const float* bg = p->in[20] + l * 4; const float* be = p->in[22] + l * 32;
        if (tid < 32) shcnt[tid] = 0u;
        __syncthreads();
        if (tid < 256) {
            const int t = mt * 256 + tid;
            const float* ps = (const float*)(ws + WS_PSS) + (size_t)t * 8;
            const f32x4 p0 = *(const f32x4*)ps, p1 = *(const f32x4*)(ps + 4);
            const float ss = ((p0[0] + p0[1]) + (p0[2] + p0[3])) + ((p1[0] + p1[1]) + (p1[2] + p1[3]));
            const float rs = __builtin_amdgcn_rsqf(ss * (1.f / 1024.f) + EPS);
            const LAS float* row = ctf + tid * CTF_PITCH;
            float gl[4];
#pragma unroll
            for (int n = 0; n < 4; ++n) gl[n] = (row[n] + row[64 + n]) * rs + bg[n];
            int gi = 0; float gm = gl[0];
#pragma unroll
            for (int n = 1; n < 4; ++n) if (gl[n] > gm) { gm = gl[n]; gi = n; }
            float gs = 0.f;
#pragma unroll
            for (int n = 0; n < 4; ++n) gs += __expf(gl[n] - gm);
            const float gtop = 1.f / gs;
            float el[8];
#pragma unroll
            for (int n = 0; n < 8; ++n) el[n] = (row[4 + gi * 8 + n] + row[68 + gi * 8 + n]) * rs + be[gi * 8 + n];
            int i1 = 0; float m1 = el[0];
#pragma unroll
            for (int n = 1; n < 8; ++n) if (el[n] > m1) { m1 = el[n]; i1 = n; }
            int i2 = -1; float m2v = -3.0e38f;
#pragma unroll
            for (int n = 0; n < 8; ++n) if (n != i1 && el[n] > m2v) { m2v = el[n]; i2 = n; }
            const float e2 = __expf(m2v - m1); const float w1 = gtop / (1.f + e2), w2 = gtop * e2 / (1.f + e2);
            const int ea = gi * 8 + i1, eb = gi * 8 + i2;
            const unsigned pa = __hip_atomic_fetch_add(&shcnt[ea], 1u, __ATOMIC_RELAXED, __HIP_MEMORY_SCOPE_WORKGROUP);
            const unsigned pbk = __hip_atomic_fetch_add(&shcnt[eb], 1u, __ATOMIC_RELAXED, __HIP_MEMORY_SCOPE_WORKGROUP);
            pend[tid * 2] = ((unsigned)ea << 16) | pa; pend[tid * 2 + 1] = ((unsigned)eb << 16) | pbk;
            pendw[tid * 2] = w1; pendw[tid * 2 + 1] = w2; pendr[tid] = rs;
            gwt[t * 2] = w1; gwt[t * 2 + 1] = w2; rstd2[t] = rs;
        }
        __syncthreads();
        if (tid < 32) { const unsigned c = shcnt[tid]; shbase[tid] = c ? atomicAdd(&cnt[tid * 32], c) : 0u; }
        __syncthreads();
        { const unsigned pe = pend[tid], e = pe >> 16, lp = pe & 0xffffu; const size_t idx = (size_t)e * T + shbase[e] + lp;
          list[idx] = (unsigned)((mt * 256 + (tid >> 1)) * 2 + (tid & 1)); lgw[idx] = pendw[tid]; lrs[idx] = pendr[tid >> 1]; }
    }
};
__device__ __forceinline__ void ph_router(LAS uchar* lds, const Params& p, int l, bool dry = false) {
    const bf16_t* xb = (const bf16_t*)(p.ws + WS_XB); const bf16_t* wr = (const bf16_t*)(p.ws + WS_WR) + (size_t)l * 128 * 1024;
    for (int u = blockIdx.x; u < 64; u += gridDim.x) {
        ARowLinear ar{xb + (size_t)u * 256 * DM, (size_t)DM}; EpiRouter ep{u, l, dry, &p};
        gemm_tile<true>(lds, ar, wr, (size_t)1024, 1024, ep);
    }
    if (!dry) expert_weights(lds, p, l);
}
struct MoeMap {
    LAS int* m;
    __device__ __forceinline__ void init(LAS uchar* lds, const unsigned* cnt) {
        m = (LAS int*)(lds + LDS_MOE);
        const int tid = tid_opaque();
        if (tid < 64) {
            const int lane = tid, c = lane < 32 ? (int)cnt[lane * 32] : 0, f = c >> 8, pr = (c & 255) ? 1 : 0;
            int sb = f + pr;
#pragma unroll
            for (int o = 1; o < 32; o <<= 1) { const int tb = __shfl_up(sb, o); if (lane >= o) sb += tb; }
            if (lane < 32) { m[lane] = f; m[32 + lane] = pr; m[64 + lane] = sb - (f + pr); m[96 + lane] = c; }
        }
        __syncthreads();
    }
    __device__ __forceinline__ int group_total(int g, int NB, int NS) const {
        int t = 0;
#pragma unroll
        for (int i = 0; i < 4; ++i) t += m[g + 8 * i] * NB + m[32 + g + 8 * i] * NS;
        return __builtin_amdgcn_readfirstlane(t);
    }
    __device__ __forceinline__ void group_find(int g, int v, int NB, int NS, bool& big, int& col, int& e, int& rb, int& rbg, int& nvalid) const {
        big = false; col = 0; e = g; rb = 0; rbg = 0; nvalid = 256; bool found = false;
#pragma unroll
        for (int i = 0; i < 4; ++i) { const int ee = g + 8 * i, fe = __builtin_amdgcn_readfirstlane(m[ee]), n = fe * NB;
            if (!found) { if (v < n) { found = true; big = true; e = ee; rb = v / NB; col = v % NB; rbg = __builtin_amdgcn_readfirstlane(m[64 + ee]) + rb; nvalid = 256; } else v -= n; } }
#pragma unroll
        for (int i = 0; i < 4; ++i) { const int ee = g + 8 * i, pe = __builtin_amdgcn_readfirstlane(m[32 + ee]), n = pe * NS;
            if (!found) { if (v < n) { found = true; big = false; e = ee; rb = __builtin_amdgcn_readfirstlane(m[ee]); col = v; rbg = __builtin_amdgcn_readfirstlane(m[64 + ee]) + rb; nvalid = __builtin_amdgcn_readfirstlane(m[96 + ee]) & 255; } else v -= n; } }
    }
};
struct MkGU { int pn; size_t slot0; const Params* p; __device__ __forceinline__ EpiGU operator()(int half) const { return EpiGU{2 * pn + half, slot0, p}; } };
__device__ __forceinline__ void ph_gateup(LAS uchar* lds, const Params& p, int l) {
    uchar* ws = p.ws; const unsigned* cnt = (const unsigned*)(ws + WS_CTL) + CW_CNT + 1024 * l;
    MoeMap mm; mm.init(lds, cnt);
    const int grp = blockIdx.x & 7, rank = blockIdx.x >> 3, nrank = ((int)gridDim.x + 7 - grp) >> 3, tot = mm.group_total(grp, 2, 8);
    for (int u = rank; u < tot; u += nrank) {
        bool big; int col, e, rb, rbg, nvalid; mm.group_find(grp, u, 2, 8, big, col, e, rb, rbg, nvalid);
        const unsigned* list = (const unsigned*)(ws + WS_LIST) + (size_t)e * T + rb * 256;
        ARowGather ar{(const bf16_t*)(ws + WS_XB), list, nvalid};
        { const int tp = tid_opaque(); if (tp < 256) { const int rr = tp < nvalid ? tp : nvalid - 1; ((LAS float*)(lds + LDS_ROW))[tp] = ((const float*)(ws + WS_LRS))[(size_t)e * T + rb * 256 + rr]; } }
        if (big) { const int pn = col; MkGU mk{pn, (size_t)rbg * 256, &p};
            gemm_big8g(lds, ar, (const bf16_t*)(ws + WS_WGU) + ((size_t)e * 512 + pn * 256) * DM, DM, mk); }
        else { const int jt = col >> 1, hq = col & 1; EpiGU64 ep{jt, hq, (size_t)rbg * 256, &p};
            const bf16_t* b0 = (const bf16_t*)(ws + WS_WGU) + ((size_t)e * 512 + jt * 128 + hq * 32) * DM;
            gemm_tile_n64(lds, ar, b0, b0 + (size_t)64 * DM, (size_t)DM, DM, ep); }
    }
}
struct RowsDown { const unsigned* list; const float* lgw; int nvalid; unsigned ent; float w;
    __device__ __forceinline__ void early() { const int tp = tid_opaque(); if (tp < 256) { const int rr = tp < nvalid ? tp : nvalid - 1; ent = list[rr]; w = lgw[rr]; } }
    __device__ __forceinline__ void store(LAS uchar* lds) { const int tp = tid_opaque(); if (tp < 256) { ((LAS unsigned*)(lds + LDS_ROW + 1024))[tp] = ent; ((LAS float*)(lds + LDS_ROW))[tp] = w; } } };
struct MkDown { int pn, nvalid; const Params* p; __device__ __forceinline__ EpiDown operator()(int half) const { return EpiDown{2 * pn + half, nvalid, p}; } };
__device__ __forceinline__ void ph_down(LAS uchar* lds, const Params& p, int l) {
    uchar* ws = p.ws; const unsigned* cnt = (const unsigned*)(ws + WS_CTL) + CW_CNT + 1024 * l;
    MoeMap mm; mm.init(lds, cnt);
    const int grp = blockIdx.x & 7, rank = blockIdx.x >> 3, nrank = ((int)gridDim.x + 7 - grp) >> 3, tot = mm.group_total(grp, 4, 8);
    const int nmine = rank < tot ? (tot - 1 - rank) / nrank + 1 : 0;
    for (int k = 0; k < nmine; ++k) {
        const int u = rank + nrank * ((rank & 1) ? nmine - 1 - k : k);
        bool big; int col, e, rb, rbg, nvalid; mm.group_find(grp, u, 4, 8, big, col, e, rb, rbg, nvalid);
        const unsigned* list = (const unsigned*)(ws + WS_LIST) + (size_t)e * T + rb * 256;
        ARowLinear ar{(const bf16_t*)(ws + WS_HMID) + (size_t)rbg * 256 * 256, (size_t)256};
        const float* lgw = (const float*)(ws + WS_LGW) + (size_t)e * T + rb * 256;
        if (big) { const int pn = col; MkDown mk{pn, nvalid, &p}; RowsDown rows{list, lgw, nvalid, 0u, 0.f};
            gemm_big32(lds, ar, (const bf16_t*)(ws + WS_WD) + ((size_t)e * DM + pn * 256) * 256, (size_t)256, 256, mk, rows); }
        else { const int nt = col; EpiDown ep{nt, nvalid, &p};
            { const int tp = tid_opaque(); if (tp < 256) { const int rr = tp < nvalid ? tp : nvalid - 1;
                ((LAS unsigned*)(lds + LDS_ROW + 1024))[tp] = list[rr]; ((LAS float*)(lds + LDS_ROW))[tp] = lgw[rr]; } }
            gemm_tile(lds, ar, (const bf16_t*)(ws + WS_WD) + ((size_t)e * DM + nt * 128) * 256, (size_t)256, 256, ep); }
    }
}
__device__ __forceinline__ void ph_combine(LAS uchar* lds, const Params& p, int l, bool dry = false) {
    uchar* ws = p.ws; const int tid = tid_opaque(), lane = tid & 63;
    const int gw = blockIdx.x * 8 + (tid >> 6), nw = gridDim.x * 8;
    const uchar* ys = ws + WS_YS;
    for (int t = gw; t < T; t += nw) {
        const bf16_t* xh = (const bf16_t*)(ws + WS_XB) + (size_t)t * DM;
        const uchar* y0 = ys + (size_t)(2 * t) * DM; const uchar* y1 = y0 + DM;
        float* xw = dry ? (float*)(ws + WS_POOLED) + (size_t)(t & 511) * DM : p.out + (size_t)t * DM;
        bf16_t* xb = dry ? (bf16_t*)(ws + WS_POOLED + 4 * MiB) + (size_t)(t & 511) * DM : (bf16_t*)(ws + WS_XB) + (size_t)t * DM;
        float ss = 0.f; float v[2][8];
#pragma unroll
        for (int i = 0; i < 2; ++i) {
            const int c = i * 512 + lane * 8;
            float a[8], bq[8];
            unpack8(*(const u32x4*)(xh + c), v[i]);
            { const u32x2 ya = *(const u32x2*)(y0 + c), yb = *(const u32x2*)(y1 + c);
#pragma unroll
              for (int q = 0; q < 2; ++q) { const auto a0 = __builtin_amdgcn_cvt_pk_f32_bf8((int)ya[q], false), a1 = __builtin_amdgcn_cvt_pk_f32_bf8((int)ya[q], true);
                  const auto b0 = __builtin_amdgcn_cvt_pk_f32_bf8((int)yb[q], false), b1 = __builtin_amdgcn_cvt_pk_f32_bf8((int)yb[q], true);
                  a[4 * q] = a0[0]; a[4 * q + 1] = a0[1]; a[4 * q + 2] = a1[0]; a[4 * q + 3] = a1[1]; bq[4 * q] = b0[0]; bq[4 * q + 1] = b0[1]; bq[4 * q + 2] = b1[0]; bq[4 * q + 3] = b1[1]; } }
#pragma unroll
            for (int j = 0; j < 8; ++j) { v[i][j] += a[j] + bq[j]; ss += v[i][j] * v[i][j]; }
            if (l + 1 == NL || dry) {
                f32x4 w0 = {v[i][0], v[i][1], v[i][2], v[i][3]}, w1 = {v[i][4], v[i][5], v[i][6], v[i][7]};
                __builtin_nontemporal_store(w0, (f32x4*)(xw + c)); __builtin_nontemporal_store(w1, (f32x4*)(xw + c + 4)); }
        }
        ss = wave_sum(ss);
        const float ms = ss * (1.f / 1024.f) + EPS, rs = __builtin_amdgcn_rsqf(ms);
        if (l + 1 < NL || dry) {
#pragma unroll
            for (int i = 0; i < 2; ++i) { u32x4 o; o[0] = pk2(v[i][0] * rs, v[i][1] * rs); o[1] = pk2(v[i][2] * rs, v[i][3] * rs); o[2] = pk2(v[i][4] * rs, v[i][5] * rs); o[3] = pk2(v[i][6] * rs, v[i][7] * rs);
                *(u32x4*)(xb + i * 512 + lane * 8) = o; }
        }
        if (lane == 0) ((float*)(ws + (dry ? WS_POOLED + 6 * MiB : WS_RSTD1)))[t] = ms * rs;
    }

}

__global__ void __launch_bounds__(NT, 2) mega(Params p) {
    extern __shared__ __attribute__((aligned(16))) unsigned char smem[];
    LAS uchar* lds = (LAS uchar*)smem;
    if (threadIdx.x == 0) { *(LAS u32x4*)(lds + LDS_XB) = (u32x4){0u, 0u, 0u, 0u}; }
    __syncthreads();
    XcdBarrier bar = xcd_barrier_post((unsigned*)(p.ws + WS_CTL), (volatile LAS unsigned*)(lds + LDS_XB));
#define IN(k) (p.ph_lo <= (k) && (k) < p.ph_hi)
#define SEAM(k) do { if (IN(k) && IN((k) + 1)) xcd_barrier(bar); } while (0)
    if (IN(0)) for (int rep = 0; rep < NREP(8); ++rep) phase0(lds, p);
    SEAM(0);
#define LAUNDER(v) asm volatile("" : "+s"(v))
#pragma unroll 1
    for (int l0 = 0; l0 < NL; ++l0) {
        const int pb = 1 + 8 * l0;
        { int l = l0; LAUNDER(l); if (IN(pb + 0)) for (int rep = 0; rep < NREP(0); ++rep) ph_gemm1(lds, p, l); }
        SEAM(pb + 0);
        { int l = l0; LAUNDER(l); if (IN(pb + 1)) for (int rep = 0; rep < NREP(1); ++rep) ph_mix_a(lds, p, l); }
        SEAM(pb + 1);
        { int l = l0; LAUNDER(l); if (IN(pb + 2)) for (int rep = 0; rep < NREP(2); ++rep) ph_mix_b(lds, p, l); }
        SEAM(pb + 2);
        { int l = l0; LAUNDER(l); if (IN(pb + 3)) for (int rep = 0; rep < (l == 0 ? NREP(3) : 1); ++rep) ph_wout(lds, p, l); }
        SEAM(pb + 3);
        { int l = l0; LAUNDER(l); if (IN(pb + 4)) { if (NREP(4) > 1) ph_router(lds, p, l, true); ph_router(lds, p, l); } }
        SEAM(pb + 4);
        { int l = l0; LAUNDER(l); if (IN(pb + 5)) for (int rep = 0; rep < NREP(5); ++rep) ph_gateup(lds, p, l); }
        SEAM(pb + 5);
        { int l = l0; LAUNDER(l); if (IN(pb + 6)) for (int rep = 0; rep < NREP(6); ++rep) ph_down(lds, p, l); }
        SEAM(pb + 6);
        { int l = l0; LAUNDER(l); if (IN(pb + 7)) { if (NREP(7) > 1) ph_combine(lds, p, l, true); ph_combine(lds, p, l); } }
        SEAM(pb + 7);
    }
}

extern "C" void kernel_launch(void* const* d_in, const int* in_sizes, int n_in, void* d_out, int out_size, void* d_ws, size_t ws_size, hipStream_t stream) {
    (void)in_sizes; (void)n_in; (void)out_size;
    static int grid = 0;
    if (!grid) {
        int dev = 0, cus = 0, per_cu = 0;
        hipGetDevice(&dev);
        hipDeviceGetAttribute(&cus, hipDeviceAttributeMultiprocessorCount, dev);
        hipFuncSetAttribute((const void*)mega, hipFuncAttributeMaxDynamicSharedMemorySize, LDS_BYTES);
        hipOccupancyMaxActiveBlocksPerMultiprocessor(&per_cu, (const void*)mega, NT, LDS_BYTES);
        if (per_cu > 1) per_cu = 1;
        if (per_cu < 1) per_cu = 1;
        grid = cus * per_cu;
    }
    if (ws_size < WS_END) { fprintf(stderr, "workspace too small: %zu < %zu\n", ws_size, (size_t)WS_END); return; }
    hipMemsetAsync(d_ws, 0, CTL_ZERO_BYTES, stream);
    Params p{};
    for (int i = 0; i < 26; ++i) p.in[i] = (const float*)d_in[i];
    p.out = (float*)d_out; p.ws = (unsigned char*)d_ws;
#if N_LAUNCH_SPLIT
    for (int k = 0; k < NPH; ++k) { p.ph_lo = k; p.ph_hi = k + 1; hipLaunchKernelGGL(mega, dim3(grid), dim3(NT), LDS_BYTES, stream, p); }
#else
    p.ph_lo = 0; p.ph_hi = NPH;
    hipLaunchKernelGGL(mega, dim3(grid), dim3(NT), LDS_BYTES, stream, p);
#endif
}
```
